# Optimizing an MI355X kernel written in HIP

```python
import jax
import jax.numpy as jnp
from jax import lax
import numpy as np

D_MODEL = 2048
BATCH = 1
SEQ = 8192
DEPTH = 4

HEAD_DIM = 128
N_HEADS_NSA = 8
N_KV_NSA = 2
N_HEADS_SB = 8
D_MIX = (N_HEADS_NSA + N_HEADS_SB) * HEAD_DIM
ROPE_DIM = HEAD_DIM // 4
ROPE_THETA = 500000.0
CMP_BLOCK = 32
CMP_STRIDE = 16
CMP_HIDDEN = 256
SLC_BLOCK = 64
SLC_TOP_N = 16
WINDOW = 512
Q_BLOCK = 128
N_BRANCH = 3
D_FF = ((8 * D_MODEL + 3 * 256 - 1) // (3 * 256)) * 256
EPS = 1e-6
NEG_INF = -1e30
FORCE_SCORE = 1e4
NEG_SCORE = -1e4
SPLIT_SIZES = [N_HEADS_NSA * HEAD_DIM] + [N_KV_NSA * HEAD_DIM] * 6 + [N_BRANCH * N_HEADS_NSA] + [N_HEADS_SB * HEAD_DIM] * 3
D_IN = sum(SPLIT_SIZES)

kernel_name = 'hybrid_nsa_stickbreaking_trunk'


def rms_norm(x, g):
    xf = x.astype(jnp.float32)
    y = xf * lax.rsqrt(jnp.mean(xf * xf, axis=-1, keepdims=True) + EPS)
    return (y * g.astype(jnp.float32)).astype(x.dtype)


def rope_tables(pos):
    inv = ROPE_THETA ** (-jnp.arange(0, ROPE_DIM, 2, dtype=jnp.float32) / ROPE_DIM)
    ang = pos.astype(jnp.float32)[..., None] * inv
    return jnp.cos(ang)[:, None], jnp.sin(ang)[:, None]


def apply_partial_rope(x, cos, sin):
    half = ROPE_DIM // 2
    x1 = x[..., :half].astype(jnp.float32)
    x2 = x[..., half:ROPE_DIM].astype(jnp.float32)
    r1 = (x1 * cos - x2 * sin).astype(x.dtype)
    r2 = (x2 * cos + x1 * sin).astype(x.dtype)
    return jnp.concatenate([r1, r2, x[..., ROPE_DIM:]], axis=-1)


def masked_softmax(s, mask):
    s = jnp.where(mask, s.astype(jnp.float32), NEG_INF)
    p = jax.nn.softmax(s, axis=-1)
    return jnp.where(mask, p, 0.0)


def unblock(o, axis):
    o = jnp.moveaxis(o, 0, axis)
    shp = o.shape
    return o.reshape(shp[:axis] + (shp[axis] * shp[axis + 1],) + shp[axis + 2:])


def nsa_attention(q, k_c, v_c, k_s, v_s, k_w, v_w, gates, positions, cos, sin,
                  cmp_pos, w_ck1, w_ck2, w_cv1, w_cv2):
    B, H, S, d = q.shape
    G = k_c.shape[1]
    R = H // G
    scale = d ** -0.5
    q = apply_partial_rope(q, cos, sin)
    k_s = apply_partial_rope(k_s, cos, sin)
    k_w = apply_partial_rope(k_w, cos, sin)
    qg = q.reshape(B, G, R, S, d)
    t_idx = jnp.arange(S)

    n_cmp = (S - CMP_BLOCK) // CMP_STRIDE + 1
    blk_idx = jnp.arange(n_cmp)[:, None] * CMP_STRIDE + jnp.arange(CMP_BLOCK)[None, :]

    def compress(t, w1, w2):
        blocks = t[:, :, blk_idx, :] + cmp_pos
        flat = blocks.reshape(B, G, n_cmp, CMP_BLOCK * d)
        return jax.nn.gelu(flat @ w1) @ w2

    kc = compress(k_c, w_ck1, w_ck2)
    vc = compress(v_c, w_cv1, w_cv2)
    cmp_end = jnp.arange(n_cmp) * CMP_STRIDE + CMP_BLOCK - 1
    ccos, csin = rope_tables(positions[:, cmp_end])
    kc = apply_partial_rope(kc, ccos, csin)
    s_cmp = jnp.einsum('bgrsd,bgnd->bgrsn', qg, kc) * scale
    mask_cmp = cmp_end[None, :] <= t_idx[:, None]
    p_cmp = masked_softmax(s_cmp, mask_cmp)
    o_cmp = jnp.einsum('bgrsn,bgnd->bgrsd', p_cmp.astype(vc.dtype), vc)

    n_slc = S // SLC_BLOCK
    nb = CMP_BLOCK // CMP_STRIDE
    ratio = SLC_BLOCK // CMP_STRIDE
    p_imp = p_cmp.sum(axis=2)
    p_ext = jnp.pad(p_imp, ((0, 0), (0, 0), (0, 0), (nb - 1, ratio * n_slc - n_cmp)))
    q_imp = p_ext[..., nb - 1: nb - 1 + ratio * n_slc]
    for n in range(1, nb):
        q_imp = q_imp + p_ext[..., nb - 1 - n: nb - 1 - n + ratio * n_slc]
    p_slc = q_imp.reshape(B, G, S, n_slc, ratio).sum(axis=-1)
    blk_t = t_idx // SLC_BLOCK
    j = jnp.arange(n_slc)
    causal_blk = j[None, :] <= blk_t[:, None]
    forced = (j[None, :] == 0) | (j[None, :] == blk_t[:, None]) | (j[None, :] == blk_t[:, None] - 1)
    imp = jnp.where(causal_blk, jnp.where(forced, FORCE_SCORE, p_slc), NEG_SCORE)
    top_n = min(SLC_TOP_N, n_slc)
    sel_val, sel_idx = lax.top_k(imp, top_n)
    sel_ok = sel_val > 0.5 * NEG_SCORE

    k_blocks = k_s.reshape(B, G, n_slc, SLC_BLOCK, d)
    v_blocks = v_s.reshape(B, G, n_slc, SLC_BLOCK, d)
    k_w_pad = jnp.pad(k_w, ((0, 0), (0, 0), (WINDOW, 0), (0, 0)))
    v_w_pad = jnp.pad(v_w, ((0, 0), (0, 0), (WINDOW, 0), (0, 0)))
    bi = jnp.arange(B)[:, None, None, None]
    gi = jnp.arange(G)[None, :, None, None]
    off = jnp.arange(SLC_BLOCK)
    n_keys = top_n * SLC_BLOCK

    def block(nq):
        q0 = nq * Q_BLOCK
        qb = lax.dynamic_slice_in_dim(qg, q0, Q_BLOCK, axis=3)
        tq = q0 + jnp.arange(Q_BLOCK)
        idx = lax.dynamic_slice_in_dim(sel_idx, q0, Q_BLOCK, axis=2)
        ok = lax.dynamic_slice_in_dim(sel_ok, q0, Q_BLOCK, axis=2)
        ks = k_blocks[bi, gi, idx].reshape(B, G, Q_BLOCK, n_keys, d)
        vs = v_blocks[bi, gi, idx].reshape(B, G, Q_BLOCK, n_keys, d)
        kpos = (idx[..., None] * SLC_BLOCK + off).reshape(B, G, Q_BLOCK, n_keys)
        kok = jnp.broadcast_to(ok[..., None], (B, G, Q_BLOCK, top_n, SLC_BLOCK)).reshape(B, G, Q_BLOCK, n_keys)
        m_s = kok & (kpos <= tq[:, None])
        s_s = jnp.einsum('bgrqd,bgqkd->bgrqk', qb, ks) * scale
        p_s = masked_softmax(s_s, m_s[:, :, None])
        o_s = jnp.einsum('bgrqk,bgqkd->bgrqd', p_s.astype(vs.dtype), vs)
        kw = lax.dynamic_slice_in_dim(k_w_pad, q0, WINDOW + Q_BLOCK, axis=2)
        vw = lax.dynamic_slice_in_dim(v_w_pad, q0, WINDOW + Q_BLOCK, axis=2)
        wpos = q0 - WINDOW + jnp.arange(WINDOW + Q_BLOCK)
        diff = tq[:, None] - wpos[None, :]
        m_w = (wpos[None, :] >= 0) & (diff >= 0) & (diff < WINDOW)
        s_w = jnp.einsum('bgrqd,bgkd->bgrqk', qb, kw) * scale
        p_w = masked_softmax(s_w, m_w)
        o_w = jnp.einsum('bgrqk,bgkd->bgrqd', p_w.astype(vw.dtype), vw)
        return o_s, o_w

    o_slc, o_win = lax.map(block, jnp.arange(S // Q_BLOCK))
    o_slc = unblock(o_slc, 3).reshape(B, H, S, d)
    o_win = unblock(o_win, 3).reshape(B, H, S, d)
    o_cmp = o_cmp.reshape(B, H, S, d)
    return gates[:, 0] * o_cmp + gates[:, 1] * o_slc + gates[:, 2] * o_win


def stick_breaking_attention(q, k, v):
    B, H, S, d = q.shape
    scale = d ** -0.5
    kpos = jnp.arange(S)

    def block(nq):
        q0 = nq * Q_BLOCK
        qb = lax.dynamic_slice_in_dim(q, q0, Q_BLOCK, axis=2)
        tq = q0 + jnp.arange(Q_BLOCK)
        valid = kpos[None, :] < tq[:, None]
        z = jnp.einsum('bhqd,bhkd->bhqk', qb, k).astype(jnp.float32) * scale
        log_1m = jnp.where(valid, jax.nn.log_sigmoid(-z), 0.0)
        after = lax.cumsum(log_1m, axis=3, reverse=True) - log_1m
        a = jnp.where(valid, jnp.exp(jax.nn.log_sigmoid(z) + after), 0.0)
        return jnp.einsum('bhqk,bhkd->bhqd', a.astype(v.dtype), v)

    o = lax.map(block, jnp.arange(S // Q_BLOCK))
    return unblock(o, 2)


def hybrid_mixer(xn, positions, cos, sin, w_in, b_gate, cmp_pos, w_ck1, w_ck2,
                 w_cv1, w_cv2, g_grp, w_out):
    B, S, _ = xn.shape
    proj = xn @ w_in
    offsets = [int(o) for o in np.cumsum(SPLIT_SIZES)[:-1]]
    q_n, kc, vc, ksl, vsl, kw, vw, g_logit, q_sb, k_sb, v_sb = jnp.split(proj, offsets, axis=-1)

    def heads(t, h):
        return t.reshape(B, S, h, HEAD_DIM).transpose(0, 2, 1, 3)

    gates = jax.nn.sigmoid((g_logit + b_gate).astype(jnp.float32))
    gates = gates.reshape(B, S, N_BRANCH, N_HEADS_NSA).transpose(0, 2, 3, 1)[..., None]
    o_nsa = nsa_attention(heads(q_n, N_HEADS_NSA), heads(kc, N_KV_NSA), heads(vc, N_KV_NSA),
                          heads(ksl, N_KV_NSA), heads(vsl, N_KV_NSA), heads(kw, N_KV_NSA),
                          heads(vw, N_KV_NSA), gates, positions, cos, sin, cmp_pos,
                          w_ck1, w_ck2, w_cv1, w_cv2)
    o_sb = stick_breaking_attention(heads(q_sb, N_HEADS_SB), heads(k_sb, N_HEADS_SB), heads(v_sb, N_HEADS_SB))
    o = jnp.concatenate([o_nsa.astype(jnp.float32), o_sb.astype(jnp.float32)], axis=1)
    o = o.transpose(0, 2, 1, 3)
    o = o * lax.rsqrt(jnp.mean(o * o, axis=-1, keepdims=True) + EPS)
    o = o.reshape(B, S, D_MIX) * g_grp.astype(jnp.float32)
    return o.astype(xn.dtype) @ w_out


def swiglu(xn, w_gate, w_up, w_down):
    return (jax.nn.silu(xn @ w_gate) * (xn @ w_up)) @ w_down


def setup_inputs(seed: int = 0) -> dict:
    key = jax.random.key(seed)
    ks = jax.random.split(key, 16)
    f32 = jnp.float32

    def nrm(k, shape, scale):
        return jax.random.normal(k, shape, f32) * scale

    L = DEPTH
    return {
        'x': nrm(ks[0], (BATCH, SEQ, D_MODEL), 1.0),
        'positions': jnp.broadcast_to(jnp.arange(SEQ, dtype=jnp.int32)[None, :], (BATCH, SEQ)),
        'norm_mix': 1.0 + nrm(ks[1], (L, D_MODEL), 0.02),
        'w_in': nrm(ks[2], (L, D_MODEL, D_IN), D_MODEL ** -0.5),
        'b_gate': nrm(ks[3], (L, N_BRANCH * N_HEADS_NSA), 0.01),
        'cmp_pos': nrm(ks[4], (L, CMP_BLOCK, HEAD_DIM), 0.1),
        'w_cmp_k1': nrm(ks[5], (L, CMP_BLOCK * HEAD_DIM, CMP_HIDDEN), (CMP_BLOCK * HEAD_DIM) ** -0.5),
        'w_cmp_k2': nrm(ks[6], (L, CMP_HIDDEN, HEAD_DIM), CMP_HIDDEN ** -0.5),
        'w_cmp_v1': nrm(ks[7], (L, CMP_BLOCK * HEAD_DIM, CMP_HIDDEN), (CMP_BLOCK * HEAD_DIM) ** -0.5),
        'w_cmp_v2': nrm(ks[8], (L, CMP_HIDDEN, HEAD_DIM), CMP_HIDDEN ** -0.5),
        'norm_grp': 1.0 + nrm(ks[9], (L, D_MIX), 0.02),
        'w_out': nrm(ks[10], (L, D_MIX, D_MODEL), D_MIX ** -0.5),
        'norm_ffn': 1.0 + nrm(ks[11], (L, D_MODEL), 0.02),
        'w_gate': nrm(ks[12], (L, D_MODEL, D_FF), D_MODEL ** -0.5),
        'w_up': nrm(ks[13], (L, D_MODEL, D_FF), D_MODEL ** -0.5),
        'w_down': nrm(ks[14], (L, D_FF, D_MODEL), D_FF ** -0.5),
        'norm_final': 1.0 + nrm(ks[15], (D_MODEL,), 0.02),
    }


def reference(x, positions, norm_mix, w_in, b_gate, cmp_pos, w_cmp_k1, w_cmp_k2,
              w_cmp_v1, w_cmp_v2, norm_grp, w_out, norm_ffn, w_gate, w_up, w_down,
              norm_final):
    cos, sin = rope_tables(positions)
    h = x
    for layer in range(DEPTH):
        xn = rms_norm(h, norm_mix[layer])
        h = h + hybrid_mixer(xn, positions, cos, sin, w_in[layer], b_gate[layer], cmp_pos[layer],
                             w_cmp_k1[layer], w_cmp_k2[layer], w_cmp_v1[layer], w_cmp_v2[layer],
                             norm_grp[layer], w_out[layer]).astype(h.dtype)
        xn = rms_norm(h, norm_ffn[layer])
        h = h + swiglu(xn, w_gate[layer], w_up[layer], w_down[layer]).astype(h.dtype)
    return rms_norm(h, norm_final)
```

```cpp
#include <hip/hip_runtime.h>
#include <cstdio>
#include <cstdint>
namespace pg8 {
#define PG8_LAS __attribute__((address_space(3)))
typedef unsigned short bf16_t;
typedef _Float16 bf16x8 __attribute__((ext_vector_type(8)));
typedef float f32x4 __attribute__((ext_vector_type(4)));
typedef unsigned u32x4 __attribute__((ext_vector_type(4)));
constexpr int BM = 256, BK = 64, HALF = 128, HTB = HALF * BK * 2  , STAGE_BYTES = 8 * HTB, NXCD = 8, WGM = 8;

__host__ __device__ __forceinline__ int lds_byte(int r, int c) { const int st = (r >> 4) * 2 + (c >> 5), rr = r & 15, cc = c & 31, ob = rr * 64 + cc * 2; return st * 1024 + (ob ^ (((ob >> 9) & 1) << 5)); }
__host__ __device__ __forceinline__ void stage_rc(int b, int& R, int& C) { const int st = b / 1024, sb = b % 1024, swz = sb ^ (((sb >> 9) & 1) << 5); R = (st >> 1) * 16 + swz / 64; C = (st & 1) * 32 + (swz % 64) / 2; }
__host__ __device__ __forceinline__ int perm32(int rho) { const int n = rho >> 4, i = rho & 15; return 8 * (i >> 2) + 4 * n + (i & 3); }

struct Unit { int pm, pn; };
struct Gemm { const bf16_t* A; const bf16_t* Bt; int M, N, K; };

struct StaticOrder {
    int nM, nN, nwg, G, c;
    __host__ __device__ void init(int M, int N, int G_, int c_) { nM = M / BM; nN = N / BM; nwg = nM * nN; G = G_; c = c_; }
    __host__ __device__ bool next(int i, Unit& u) const {
        const long L = (long)i * G + c; if (L >= nwg) return false;
        int wgid = (int)L; { const int q = nwg / NXCD, r = nwg % NXCD, xcd = wgid % NXCD, off = wgid / NXCD; wgid = (xcd < r ? xcd * (q + 1) : r * (q + 1) + (xcd - r) * q) + off; }
        const int nig = WGM * nN, gid = wgid / nig, fm = gid * WGM, gsz = (nM - fm) < WGM ? (nM - fm) : WGM;
        u.pm = fm + ((wgid % nig) % gsz); u.pn = (wgid % nig) / gsz; return true;
    }
    __device__ __forceinline__ void a_ready(const Unit&) const {}
    __device__ __forceinline__ void done(const Unit&) const {}
};
__device__ __forceinline__ unsigned cvt_pk_bf16(float lo, float hi) { unsigned r; asm volatile("v_cvt_pk_bf16_f32 %0, %1, %2" : "=v"(r) : "v"(lo), "v"(hi)); return r; }
typedef float f32x2 __attribute__((ext_vector_type(2)));
template <class Epi, class Sched, bool ALIGN_EPI = false, bool SP2 = false>
__device__ __forceinline__ void gemm_phase(PG8_LAS unsigned char* lds, const Gemm g, const Sched& S, const Epi& E) {
    const int tid = threadIdx.x, wid = __builtin_amdgcn_readfirstlane(tid >> 6), lane = tid & 63, wr = wid >> 2, wc = wid & 3, fr = lane & 15, fq = lane >> 4;
    const int K = g.K, nt = K / BK;
    unsigned voffA[2], voffB[2];
#pragma unroll
    for (int i = 0; i < 2; ++i) { int R, C; stage_rc(tid * 16 + i * 8192, R, C); const int Rb = Epi::PERM ? ((R & ~31) + perm32(R & 31)) : R;
        voffA[i] = (unsigned)(R * K + C) * 2u; voffB[i] = (unsigned)(Rb * K + C) * 2u; }
    const size_t kstep = (size_t)(BK * 2);
    const size_t hstep = (size_t)HALF * K * 2;
    const size_t tstep = 2 * hstep;
    const unsigned ldsw = (unsigned)wid * 1024u;
    const int aoff = lds_byte(wr * 64 + fr, fq * 8), boff = lds_byte(wc * 32 + fr, fq * 8);
#define PG8_SA(b, h) (((b) * 2 + (h)) * HTB)
#define PG8_SB(b, h) ((4 + (b) * 2 + (h)) * HTB)
#define PG8_STAGE(bufoff, gbase, voff) do { _Pragma("unroll") for (int _i = 0; _i < 2; ++_i) \
        __builtin_amdgcn_global_load_lds((const unsigned*)((const char*)(gbase) + (voff)[_i]), (PG8_LAS unsigned*)(lds + (bufoff) + ldsw + _i * 8192), 16, 0, 0); } while (0)
#define PG8_LDA(dst, b, h) do { _Pragma("unroll") for (int m = 0; m < 4; ++m) _Pragma("unroll") for (int k = 0; k < 2; ++k) dst[m][k] = *(const PG8_LAS bf16x8*)(lds + PG8_SA(b, h) + aoff + m * 2048 + k * 1024); } while (0)
#define PG8_LDB(dst, b, h) do { _Pragma("unroll") for (int n = 0; n < 2; ++n) _Pragma("unroll") for (int k = 0; k < 2; ++k) dst[n][k] = *(const PG8_LAS bf16x8*)(lds + PG8_SB(b, h) + boff + n * 2048 + k * 1024); } while (0)
#define PG8_MMA(ai, bj, At, Bt) do { __builtin_amdgcn_s_setprio(1); _Pragma("unroll") for (int m = 0; m < 4; ++m) _Pragma("unroll") for (int n = 0; n < 2; ++n) _Pragma("unroll") for (int k = 0; k < 2; ++k) \
        acc[ai][bj][m][n] = __builtin_amdgcn_mfma_f32_16x16x32_f16(Bt[n][k], At[m][k], acc[ai][bj][m][n], 0, 0, 0); __builtin_amdgcn_s_setprio(0); } while (0)
#define PG8_WAIT_V(n) asm volatile("s_waitcnt vmcnt(" #n ")" ::: "memory")
#define PG8_WAIT_L(n) asm volatile("s_waitcnt lgkmcnt(" #n ")" ::: "memory")
#define PG8_BAR __builtin_amdgcn_s_barrier()
#define PG8_SCHED __builtin_amdgcn_sched_barrier(0)
    Unit cur, nxt; int ui = 0;
    if (!S.next(0, cur)) return;
    f32x4 acc[2][2][4][2];
#pragma unroll
    for (int a = 0; a < 2; ++a)
#pragma unroll
        for (int b = 0; b < 2; ++b)
#pragma unroll
            for (int m = 0; m < 4; ++m)
#pragma unroll
                for (int n = 0; n < 2; ++n) acc[a][b][m][n] = (f32x4){0.f, 0.f, 0.f, 0.f};
    bf16x8 At[4][2], B0[2][2], B1[2][2];
    const char* cA = (const char*)g.A + (size_t)cur.pm * tstep; const char* cB = (const char*)g.Bt + (size_t)cur.pn * tstep;
    S.a_ready(cur);
    if constexpr (SP2) {
        PG8_STAGE(PG8_SB(0, 0), cB, voffB); PG8_STAGE(PG8_SB(0, 1), cB + hstep, voffB); PG8_STAGE(PG8_SA(0, 0), cA, voffA); PG8_STAGE(PG8_SA(0, 1), cA + hstep, voffA);
        if (wr == 1) PG8_BAR;
        PG8_WAIT_V(2); PG8_BAR;
        PG8_STAGE(PG8_SB(1, 0), cB + kstep, voffB); PG8_STAGE(PG8_SA(1, 0), cA + kstep, voffA); PG8_STAGE(PG8_SB(1, 1), cB + hstep + kstep, voffB);
        PG8_WAIT_V(6); PG8_BAR;
    } else {
        PG8_STAGE(PG8_SB(0, 0), cB, voffB); PG8_STAGE(PG8_SA(0, 0), cA, voffA); PG8_STAGE(PG8_SB(0, 1), cB + hstep, voffB); PG8_STAGE(PG8_SA(0, 1), cA + hstep, voffA);
        if (wr == 1) PG8_BAR;
        PG8_WAIT_V(4); PG8_BAR;
        PG8_STAGE(PG8_SB(1, 0), cB + kstep, voffB); PG8_STAGE(PG8_SA(1, 0), cA + kstep, voffA); PG8_STAGE(PG8_SB(1, 1), cB + hstep + kstep, voffB);
        PG8_WAIT_V(6); PG8_BAR;
    }
    for (;;) {
        const bool has_next = S.next(ui + 1, nxt);
        const char* nA = has_next ? (const char*)g.A + (size_t)nxt.pm * tstep : cA; const char* nB = has_next ? (const char*)g.Bt + (size_t)nxt.pn * tstep : cB;
        for (int t = 0; t < nt; t += 2) {
            const bool last = (t == nt - 2);
            const char* a1 = cA + (size_t)(t + 1) * kstep;
            const char* a2 = last ? nA : cA + (size_t)(t + 2) * kstep; const char* b2 = last ? nB : cB + (size_t)(t + 2) * kstep;
            const char* a3 = a2 + kstep; const char* b3 = b2 + kstep;
            if (last && has_next) S.a_ready(nxt);
            if constexpr (SP2) {
            PG8_LDB(B0, 0, 0); PG8_LDB(B1, 0, 1); PG8_SCHED; PG8_LDA(At, 0, 0); PG8_STAGE(PG8_SA(1, 1), a1 + hstep, voffA);
            PG8_WAIT_V(8); PG8_WAIT_L(0); PG8_BAR; PG8_MMA(0, 0, At, B0); PG8_MMA(0, 1, At, B1); PG8_BAR; PG8_SCHED;
            PG8_LDA(At, 0, 1); PG8_STAGE(PG8_SB(0, 0), b2, voffB); PG8_STAGE(PG8_SB(0, 1), b2 + hstep, voffB); PG8_STAGE(PG8_SA(0, 0), a2, voffA);
            PG8_WAIT_V(8); PG8_WAIT_L(0); PG8_BAR; PG8_MMA(1, 0, At, B0); PG8_MMA(1, 1, At, B1); PG8_BAR; PG8_SCHED;
            PG8_LDB(B0, 1, 0); PG8_LDB(B1, 1, 1); PG8_SCHED; PG8_LDA(At, 1, 0); PG8_STAGE(PG8_SA(0, 1), a2 + hstep, voffA);
            PG8_WAIT_V(8); PG8_WAIT_L(0); PG8_BAR; PG8_MMA(0, 0, At, B0); PG8_MMA(0, 1, At, B1); PG8_BAR; PG8_SCHED;
            PG8_LDA(At, 1, 1); PG8_STAGE(PG8_SB(1, 0), b3, voffB); PG8_STAGE(PG8_SB(1, 1), b3 + hstep, voffB); PG8_STAGE(PG8_SA(1, 0), a3, voffA);
            PG8_WAIT_V(8); PG8_WAIT_L(0); PG8_BAR; PG8_MMA(1, 0, At, B0); PG8_MMA(1, 1, At, B1); PG8_BAR; PG8_SCHED;
            } else {
            PG8_LDB(B0, 0, 0); PG8_SCHED; PG8_LDA(At, 0, 0); PG8_STAGE(PG8_SA(1, 1), a1 + hstep, voffA);
            PG8_WAIT_L(8); PG8_BAR; PG8_WAIT_L(0); PG8_MMA(0, 0, At, B0); PG8_BAR; PG8_SCHED;
            PG8_LDB(B1, 0, 1); PG8_STAGE(PG8_SB(0, 0), b2, voffB);
            PG8_BAR; PG8_WAIT_L(0); PG8_MMA(0, 1, At, B1); PG8_BAR;
            PG8_LDA(At, 0, 1); PG8_STAGE(PG8_SA(0, 0), a2, voffA);
            PG8_BAR; PG8_WAIT_L(0); PG8_MMA(1, 0, At, B0); PG8_BAR; PG8_SCHED;
            PG8_STAGE(PG8_SB(0, 1), b2 + hstep, voffB);
            PG8_WAIT_V(6); PG8_BAR; PG8_MMA(1, 1, At, B1); PG8_BAR;
            PG8_LDB(B0, 1, 0); PG8_SCHED; PG8_LDA(At, 1, 0); PG8_STAGE(PG8_SA(0, 1), a2 + hstep, voffA);
            PG8_WAIT_L(8); PG8_BAR; PG8_WAIT_L(0); PG8_MMA(0, 0, At, B0); PG8_BAR; PG8_SCHED;
            PG8_LDB(B1, 1, 1); PG8_STAGE(PG8_SB(1, 0), b3, voffB);
            PG8_BAR; PG8_WAIT_L(0); PG8_MMA(0, 1, At, B1); PG8_BAR;
            PG8_LDA(At, 1, 1); PG8_STAGE(PG8_SA(1, 0), a3, voffA);
            PG8_BAR; PG8_WAIT_L(0); PG8_MMA(1, 0, At, B0); PG8_BAR; PG8_SCHED;
            PG8_STAGE(PG8_SB(1, 1), b3 + hstep, voffB);
            PG8_WAIT_V(6); PG8_BAR; PG8_MMA(1, 1, At, B1); PG8_BAR;
            }
        }
        if constexpr (ALIGN_EPI) { if (wr == 0) PG8_BAR; }
        if constexpr (!Epi::AFTER_DRAIN) { E(acc, cur, wr, wc, fr, fq); S.done(cur); }
        if (!has_next) break;
#pragma unroll
        for (int a = 0; a < 2; ++a)
#pragma unroll
            for (int b = 0; b < 2; ++b)
#pragma unroll
                for (int m = 0; m < 4; ++m)
#pragma unroll
                    for (int n = 0; n < 2; ++n) acc[a][b][m][n] = (f32x4){0.f, 0.f, 0.f, 0.f};
        cur = nxt; cA = nA; cB = nB; ++ui;
        if constexpr (ALIGN_EPI) { if (wr == 1) PG8_BAR; }
    }
    PG8_WAIT_V(0);
    if constexpr (!ALIGN_EPI) { if (wr == 0) PG8_BAR; }
    PG8_BAR;
    if constexpr (Epi::AFTER_DRAIN) { E.fused(acc, cur, wr, wc, fr, fq, lds, wid, lane); S.done(cur); }
#undef PG8_SA
#undef PG8_SB
#undef PG8_STAGE
#undef PG8_LDA
#undef PG8_LDB
#undef PG8_MMA
#undef PG8_WAIT_V
#undef PG8_WAIT_L
#undef PG8_BAR
#undef PG8_SCHED
}
}

#define LAS __attribute__((address_space(3)))
typedef unsigned short bf16_t;
typedef _Float16 bf16x8 __attribute__((ext_vector_type(8)));
typedef float f32x4 __attribute__((ext_vector_type(4)));
typedef float f32x2 __attribute__((ext_vector_type(2)));
typedef unsigned u32x4 __attribute__((ext_vector_type(4)));
typedef unsigned u32x2 __attribute__((ext_vector_type(2)));

constexpr int S = 8192, DM = 2048, NL = 4, HD = 128, DIN = 5656, DINP = 5888, DFF = 5632, NCMP = 511;
constexpr float EPS = 1e-6f;
constexpr float SCALE = 0.08838834764831845f;
constexpr int NWAVES = 8, NTHREADS = 512;
constexpr int LDS_BYTES = 147456;
constexpr int RING_BYTES = 131072, MISC_OFF = RING_BYTES + 320;

constexpr size_t MiB = 1u << 20;
constexpr size_t WS_CTL = 0, CTL_ZERO_BYTES = 1 * MiB;
constexpr size_t WS_ROPE = 1 * MiB;
constexpr size_t WS_CBP = WS_ROPE + 1024 * 1024;
constexpr size_t WS_KC = 2 * MiB + 512 * 1024;
constexpr size_t WS_VC = WS_KC + 256 * 1024;
constexpr size_t WS_SEL = 3 * MiB;
constexpr size_t WS_GATES = 4 * MiB;
constexpr size_t WS_W = 8 * MiB;
constexpr size_t W_IN = 0, W_OUT = 23 * MiB, W_GU = 31 * MiB, W_DN = 75 * MiB, W_C1 = 97 * MiB, W_C2 = 101 * MiB, W_LAYER = 102 * MiB;
constexpr size_t WS_H = WS_W + NL * W_LAYER;
constexpr size_t WS_XN = WS_H + 64 * MiB;
constexpr size_t WS_O = WS_XN + 32 * MiB;
constexpr size_t WS_OCMP = WS_O + 32 * MiB;
constexpr size_t WS_PROJ = WS_OCMP + 32 * MiB;
constexpr size_t WS_ACT = WS_PROJ;
constexpr size_t WS_END = WS_PROJ + 88 * MiB;
static_assert((size_t)DINP * DM * 2 == 23 * MiB && (size_t)2 * DFF * DM * 2 == 44 * MiB && (size_t)DM * DFF * 2 == 22 * MiB, "weight map");

struct Params { const float* in[17]; float* out; unsigned char* ws; };

struct Ctx {
    LAS unsigned char* lds;
    int tid, lane, wave, gw, ngw;
};

__device__ __forceinline__ float bf2f(unsigned b) { return (float)__builtin_bit_cast(_Float16, (unsigned short)b); }
__device__ __forceinline__ unsigned f2bf(float f) { return (unsigned)__builtin_bit_cast(unsigned short, (_Float16)f); }
__device__ __forceinline__ unsigned pk2(float lo, float hi) { return f2bf(lo) | (f2bf(hi) << 16); }
__device__ __forceinline__ float wave_sum(float v) {
#pragma unroll
    for (int o = 1; o < 64; o <<= 1) v += __shfl_xor(v, o);
    return v;
}
__device__ __forceinline__ float wave_max(float v) {
#pragma unroll
    for (int o = 1; o < 64; o <<= 1) v = fmaxf(v, __shfl_xor(v, o));
    return v;
}
__device__ __forceinline__ float rope_inv(int i) {
    switch (i) {
        case 0: return 1.0f;
        case 1: return 0.44036659598350525f;
        case 2: return 0.1939227432012558f;
        case 3: return 0.08539710193872452f;
        case 4: return 0.03760603070259094f;
        case 5: return 0.016560440883040428f;
        case 6: return 0.007292664609849453f;
        case 7: return 0.0032114461064338684f;
        case 8: return 0.0014142135623842478f;
        case 9: return 0.0006227724370546639f;
        case 10: return 0.00027424818836152554f;
        case 11: return 0.00012076973507646471f;
        case 12: return 5.3182957344688475e-05f;
        case 13: return 2.34199997066753e-05f;
        case 14: return 1.0313385246263351e-05f;
        default: return 4.541670477919979e-06f;
    }
}
__device__ __forceinline__ void sincos_d(float ang, float& c, float& s) {
    const double x = (double)ang;
    const double q = rint(x * 0.63661977236758134308);
    const double r = fma(-q, 1.57079632679489661923, x) - q * 6.123233995736766e-17;
    const double r2 = r * r;
    double cs = 1.0 / 479001600.0; cs = cs * r2 - 1.0 / 3628800.0; cs = cs * r2 + 1.0 / 40320.0; cs = cs * r2 - 1.0 / 720.0; cs = cs * r2 + 1.0 / 24.0; cs = cs * r2 - 0.5; cs = cs * r2 + 1.0;
    double sn = 1.0 / 6227020800.0; sn = sn * r2 - 1.0 / 39916800.0; sn = sn * r2 + 1.0 / 362880.0; sn = sn * r2 - 1.0 / 5040.0; sn = sn * r2 + 1.0 / 120.0; sn = sn * r2 - 1.0 / 6.0; sn = sn * r2 + 1.0; sn *= r;
    const int qi = ((int)(long long)q) & 3;
    double cc, ss;
    if (qi == 0) { cc = cs; ss = sn; } else if (qi == 1) { cc = -sn; ss = cs; } else if (qi == 2) { cc = -cs; ss = -sn; } else { cc = sn; ss = -cs; }
    c = (float)cc; s = (float)ss;
}
__device__ __forceinline__ float gelu_tanh(float x) {
    const float y = 0.7978845608028654f * (x + 0.044715f * x * x * x);
    const float e = __expf(2.0f * y);
    const float th = 1.0f - 2.0f / (e + 1.0f);
    return 0.5f * x * (1.0f + th);
}
__device__ __forceinline__ float sigmoidf_(float x) { return 1.0f / (1.0f + __expf(-x)); }

__device__ __forceinline__ bf16_t* w_ptr(const Params& p, int l, size_t off) { return (bf16_t*)(p.ws + WS_W + (size_t)l * W_LAYER + off); }

__device__ __forceinline__ void conv_item(const float* W, int N, int k0, int src_col0, int nvalid, bf16_t* WT, int dst_row0, int dstK, LAS float* scr, int lane) {
    const int c = lane & 31;
#pragma unroll 8
    for (int i = 0; i < 32; ++i) { const int kk = 2 * i + (lane >> 5); scr[kk * 33 + c] = (c < nvalid) ? W[(size_t)(k0 + kk) * N + src_col0 + c] : 0.f; }
    asm volatile("s_waitcnt lgkmcnt(0)" ::: "memory");
    const int c8 = lane & 7;
#pragma unroll
    for (int j = 0; j < 4; ++j) { const int n = (lane >> 3) + 8 * j; const LAS float* s = scr + (8 * c8) * 33 + n;
        u32x4 o; o.x = pk2(s[0 * 33], s[1 * 33]); o.y = pk2(s[2 * 33], s[3 * 33]); o.z = pk2(s[4 * 33], s[5 * 33]); o.w = pk2(s[6 * 33], s[7 * 33]);
        *(u32x4*)(WT + (size_t)(dst_row0 + n) * dstK + k0 + 8 * c8) = o; }
    asm volatile("s_waitcnt lgkmcnt(0)" ::: "memory");
}
constexpr int I_IN = 32 * 184, I_OUT = 32 * 64, I_GU = 32 * 352, I_DN = 88 * 64, I_C1 = 1024, I_C2 = 32;
constexpr int I_LAYER = I_IN + I_OUT + I_GU + I_DN + I_C1 + I_C2;

__device__ __forceinline__ void phase_conv(const Params& p, const Ctx& c) {
    LAS float* scr = (LAS float*)(c.lds + c.wave * 8704);
    for (int it = c.gw; it < NL * I_LAYER; it += c.ngw) {
        const int l = it / I_LAYER; int r = it - l * I_LAYER;
        if (r < I_IN) { const int kb = r / 184, nb = r % 184, n0 = 32 * nb; int sc, nv;
            if (n0 < 2560) { sc = n0; nv = 32; } else if (n0 < 5632) { sc = n0 + 24; nv = 32; } else if (n0 == 5632) { sc = 2560; nv = 24; } else { sc = 0; nv = 0; }
            conv_item(p.in[3] + (size_t)l * DM * DIN, DIN, 64 * kb, sc, nv, w_ptr(p, l, W_IN), n0, DM, scr, c.lane); continue; }
        r -= I_IN;
        if (r < I_OUT) { const int kb = r / 64, nb = r % 64;
            conv_item(p.in[11] + (size_t)l * DM * DM, DM, 64 * kb, 32 * nb, 32, w_ptr(p, l, W_OUT), 32 * nb, DM, scr, c.lane); continue; }
        r -= I_OUT;
        if (r < I_GU) { const int kb = r / 352, nb = r % 352, r0 = 32 * nb, pn = r0 >> 8, w = r0 & 255;
            const float* src = (w < 128 ? p.in[13] : p.in[14]) + (size_t)l * DM * DFF;
            conv_item(src, DFF, 64 * kb, 128 * pn + (w & 127), 32, w_ptr(p, l, W_GU), r0, DM, scr, c.lane); continue; }
        r -= I_GU;
        if (r < I_DN) { const int kb = r / 64, nb = r % 64;
            conv_item(p.in[15] + (size_t)l * DFF * DM, DM, 64 * kb, 32 * nb, 32, w_ptr(p, l, W_DN), 32 * nb, DFF, scr, c.lane); continue; }
        r -= I_DN;
        if (r < I_C1) { const int kv = r / 512, rr = r % 512, kb = rr / 8, nb = rr % 8;
            conv_item(p.in[kv ? 8 : 6] + (size_t)l * 4096 * 256, 256, 64 * kb, 32 * nb, 32, w_ptr(p, l, W_C1) + (size_t)kv * 256 * 4096, 32 * nb, 4096, scr, c.lane); continue; }
        r -= I_C1;
        { const int kv = r / 16, rr = r % 16, kb = rr / 4, nb = rr % 4;
            conv_item(p.in[kv ? 9 : 7] + (size_t)l * 256 * 128, 128, 64 * kb, 32 * nb, 32, w_ptr(p, l, W_C2) + (size_t)kv * 128 * 256, 32 * nb, 256, scr, c.lane); }
    }
    { const int* pos = (const int*)p.in[1]; float* tab = (float*)(p.ws + WS_ROPE);
      for (int idx = c.gw * 64 + c.lane; idx < S * 16; idx += c.ngw * 64) { const int t = idx >> 4, i = idx & 15;
          const float ang = (float)pos[t] * rope_inv(i); float cs, sn; sincos_d(ang, cs, sn); tab[t * 32 + i] = cs; tab[t * 32 + 16 + i] = sn; } }
    { float* cbp = (float*)(p.ws + WS_CBP);
      for (int task = c.gw; task < NL * 2 * 4 * 8; task += c.ngw) { const int ic = task & 7, jg = (task >> 3) & 3, kv = (task >> 5) & 1, l = task >> 6;
          const float* w1 = p.in[kv ? 8 : 6] + (size_t)l * 4096 * 256; const float* cp = p.in[5] + (size_t)l * 4096; const int j = 64 * jg + c.lane;
          float s = 0.f;
          for (int i = 512 * ic; i < 512 * ic + 512; ++i) s += cp[i] * w1[(size_t)i * 256 + j];
          cbp[((l * 2 + kv) * 8 + ic) * 256 + j] = s; } }
}

template <bool OUT_F32>
__device__ __forceinline__ void phase_norm(const Ctx& c, const float* src, const float* gain, void* dst) {
    for (int m = c.gw; m < S; m += c.ngw) {
        const f32x4* xr = (const f32x4*)(src + (size_t)m * DM) + c.lane; const f32x4* gr = (const f32x4*)gain + c.lane;
        f32x4 v[8]; float ss = 0.f;
#pragma unroll
        for (int j = 0; j < 8; ++j) { v[j] = xr[64 * j]; ss += (v[j].x * v[j].x + v[j].y * v[j].y) + (v[j].z * v[j].z + v[j].w * v[j].w); }
        ss = wave_sum(ss);
        const float rstd = 1.0f / sqrtf(ss * (1.0f / DM) + EPS);
#pragma unroll
        for (int j = 0; j < 8; ++j) { const f32x4 g = gr[64 * j]; const f32x4 o = v[j] * rstd * g;
            if (OUT_F32) ((f32x4*)((float*)dst + (size_t)m * DM))[c.lane + 64 * j] = o;
            else { u32x2 w; w.x = pk2(o.x, o.y); w.y = pk2(o.z, o.w); ((u32x2*)((bf16_t*)dst + (size_t)m * DM))[c.lane + 64 * j] = w; } }
    }
}

struct EpiProj {
    static constexpr bool PERM = true, AFTER_DRAIN = false;
    bf16_t* proj; float* gates; const float* rope; const float* bg;
    __device__ __forceinline__ void operator()(const pg8::f32x4 (&acc)[2][2][4][2], const pg8::Unit& u, int wr, int wc, int fr, int fq) const {
        const int row0 = u.pm * 256 + wr * 64 + fr;
        if (u.pn < 22) {
#pragma unroll
            for (int bj = 0; bj < 2; ++bj) {
                const int head = 2 * u.pn + bj;
                const bool rp = (head < 8) || head == 12 || head == 13 || head == 16 || head == 17;
                bf16_t* base = proj + (size_t)head * S * HD + wc * 32 + 8 * fq;
#pragma unroll
                for (int ai = 0; ai < 2; ++ai)
#pragma unroll
                    for (int m = 0; m < 4; ++m) {
                        const int r = row0 + ai * 128 + m * 16;
                        f32x4 v0 = acc[ai][bj][m][0], v1 = acc[ai][bj][m][1];
                        if (rp && wc == 0) {
                            f32x4 q0, q1;
#pragma unroll
                            for (int j = 0; j < 4; ++j) { q0[j] = __shfl_xor(v0[j], 32); q1[j] = __shfl_xor(v1[j], 32); }
                            const float* cs = rope + (size_t)r * 32 + (fq & 1) * 8;
                            const f32x4 c0 = *(const f32x4*)cs, c1 = *(const f32x4*)(cs + 4), s0 = *(const f32x4*)(cs + 16), s1 = *(const f32x4*)(cs + 20);
                            if (fq < 2) { v0 = v0 * c0 - q0 * s0; v1 = v1 * c1 - q1 * s1; }
                            else { v0 = v0 * c0 + q0 * s0; v1 = v1 * c1 + q1 * s1; }
                        }
                        u32x4 w; w.x = pk2(v0[0], v0[1]); w.y = pk2(v0[2], v0[3]); w.z = pk2(v1[0], v1[1]); w.w = pk2(v1[2], v1[3]);
                        *(u32x4*)(base + (size_t)r * HD) = w;
                    }
            }
        } else {
            if (wc == 0 && fq < 3) {
#pragma unroll
                for (int ai = 0; ai < 2; ++ai)
#pragma unroll
                    for (int m = 0; m < 4; ++m) {
                        const int r = row0 + ai * 128 + m * 16;
#pragma unroll
                        for (int n = 0; n < 2; ++n)
#pragma unroll
                            for (int j = 0; j < 4; ++j) { const int cc = 8 * fq + 4 * n + j; gates[(size_t)r * 24 + cc] = sigmoidf_(acc[ai][0][m][n][j] + bg[cc]); }
                    }
            }
        }
    }
};
struct EpiResid {
    static constexpr bool PERM = false, AFTER_DRAIN = false;
    const float* hin; float* hout;
    __device__ __forceinline__ void operator()(const pg8::f32x4 (&acc)[2][2][4][2], const pg8::Unit& u, int wr, int wc, int fr, int fq) const {
        const int row0 = u.pm * 256 + wr * 64 + fr, col0 = u.pn * 256 + wc * 32 + 4 * fq;
#pragma unroll
        for (int ai = 0; ai < 2; ++ai)
#pragma unroll
            for (int m = 0; m < 4; ++m) { const size_t off = (size_t)(row0 + ai * 128 + m * 16) * DM + col0;
#pragma unroll
                for (int bj = 0; bj < 2; ++bj)
#pragma unroll
                    for (int n = 0; n < 2; ++n) { const size_t o = off + bj * 128 + n * 16; *(f32x4*)(hout + o) = *(const f32x4*)(hin + o) + acc[ai][bj][m][n]; } }
    }
};
struct EpiSwiGLU {
    static constexpr bool PERM = true, AFTER_DRAIN = false;
    bf16_t* act;
    __device__ __forceinline__ void operator()(const pg8::f32x4 (&acc)[2][2][4][2], const pg8::Unit& u, int wr, int wc, int fr, int fq) const {
        const int row0 = u.pm * 256 + wr * 64 + fr, col0 = u.pn * 128 + wc * 32 + 8 * fq;
#pragma unroll
        for (int ai = 0; ai < 2; ++ai)
#pragma unroll
            for (int m = 0; m < 4; ++m) {
                const f32x4 g0 = acc[ai][0][m][0], g1 = acc[ai][0][m][1], u0 = acc[ai][1][m][0], u1 = acc[ai][1][m][1];
                f32x4 o0, o1;
#pragma unroll
                for (int j = 0; j < 4; ++j) { o0[j] = g0[j] * sigmoidf_(g0[j]) * u0[j]; o1[j] = g1[j] * sigmoidf_(g1[j]) * u1[j]; }
                u32x4 w; w.x = pk2(o0[0], o0[1]); w.y = pk2(o0[2], o0[3]); w.z = pk2(o1[0], o1[1]); w.w = pk2(o1[2], o1[3]);
                *(u32x4*)(act + (size_t)(row0 + ai * 128 + m * 16) * DFF + col0) = w;
            }
    }
};

__device__ __forceinline__ void phase_cmpr(const Params& p, const Ctx& c, int l) {
    const bf16_t* proj = (const bf16_t*)(p.ws + WS_PROJ); const float* rope = (const float*)(p.ws + WS_ROPE); const float* cbp = (const float*)(p.ws + WS_CBP);
    LAS bf16_t* hid = (LAS bf16_t*)c.lds;
    const int lane = c.lane, w = c.wave, l15 = lane & 15, q4 = lane >> 4;
    for (int u = blockIdx.x; u < 128; u += gridDim.x) {
        const int kv = u >> 6, g = (u >> 5) & 1, rb = u & 31, n0 = 16 * rb;
        const bf16_t* src = proj + (size_t)((kv ? 10 : 8) + g) * S * HD;
        int na = n0 + l15; if (na > 510) na = 510;
        const bf16_t* ap = src + (size_t)(16 * na) * HD + 8 * q4;
        const bf16_t* b0p = w_ptr(p, l, W_C1) + (size_t)kv * 256 * 4096 + (size_t)(32 * w + l15) * 4096 + 8 * q4;
        const bf16_t* b1p = b0p + 16 * 4096;
        f32x4 acc0 = {0.f, 0.f, 0.f, 0.f}, acc1 = {0.f, 0.f, 0.f, 0.f};
#pragma unroll 4
        for (int k0 = 0; k0 < 4096; k0 += 32) {
            const bf16x8 a = *(const bf16x8*)(ap + k0), b0 = *(const bf16x8*)(b0p + k0), b1 = *(const bf16x8*)(b1p + k0);
            acc0 = __builtin_amdgcn_mfma_f32_16x16x32_f16(a, b0, acc0, 0, 0, 0);
            acc1 = __builtin_amdgcn_mfma_f32_16x16x32_f16(a, b1, acc1, 0, 0, 0);
        }
        { const int col = 32 * w + l15; float bs0 = 0.f, bs1 = 0.f;
#pragma unroll
          for (int ic = 0; ic < 8; ++ic) { bs0 += cbp[((l * 2 + kv) * 8 + ic) * 256 + col]; bs1 += cbp[((l * 2 + kv) * 8 + ic) * 256 + col + 16]; }
#pragma unroll
          for (int j = 0; j < 4; ++j) { const int row = q4 * 4 + j; hid[row * 264 + col] = (bf16_t)f2bf(gelu_tanh(acc0[j] + bs0)); hid[row * 264 + col + 16] = (bf16_t)f2bf(gelu_tanh(acc1[j] + bs1)); } }
        __syncthreads();
        f32x4 o = {0.f, 0.f, 0.f, 0.f};
        const int ocol = (w < 2) ? ((l15 < 8) ? 8 * w + l15 : 16 + 8 * w + (l15 - 8)) : 16 * w + l15;
        const bf16_t* w2 = w_ptr(p, l, W_C2) + (size_t)kv * 128 * 256 + (size_t)ocol * 256 + 8 * q4;
#pragma unroll
        for (int k0 = 0; k0 < 256; k0 += 32) {
            const bf16x8 a = *(const LAS bf16x8*)(hid + l15 * 264 + k0 + 8 * q4), b = *(const bf16x8*)(w2 + k0);
            o = __builtin_amdgcn_mfma_f32_16x16x32_f16(a, b, o, 0, 0, 0);
        }
        bf16_t* dst = (bf16_t*)(p.ws + (kv ? WS_VC : WS_KC)) + (size_t)g * 512 * HD;
#pragma unroll
        for (int j = 0; j < 4; ++j) {
            const int n = n0 + q4 * 4 + j; float v = o[j];
            if (kv == 0 && w < 2) {
                const float pr = __shfl_xor(v, 8);
                int ti = 16 * n + 31; if (ti > S - 1) ti = S - 1;
                const int fi = 8 * w + (l15 & 7);
                const float cs = rope[ti * 32 + fi], sn = rope[ti * 32 + 16 + fi];
                v = (l15 < 8) ? v * cs - pr * sn : v * cs + pr * sn;
            }
            if (n > 510) v = 0.f;
            dst[(size_t)n * HD + ocol] = (bf16_t)f2bf(v);
        }
        __syncthreads();
    }
}

__device__ __forceinline__ void load_q4(const bf16_t* proj, int head0, int t, LAS float* qs, int lane, float mul) {
#pragma unroll
    for (int h = 0; h < 4; ++h) { const unsigned q2 = *(const unsigned*)(proj + (size_t)(head0 + h) * S * HD + (size_t)t * HD + 2 * lane);
        qs[h * 128 + 2 * lane] = bf2f(q2 & 0xffffu) * mul; qs[h * 128 + 2 * lane + 1] = bf2f(q2 >> 16) * mul; }
}
__device__ __forceinline__ void dot4(const bf16_t* krow, const LAS float* qs, float& s0, float& s1, float& s2, float& s3) {
    s0 = s1 = s2 = s3 = 0.f;
#pragma unroll 4
    for (int d8 = 0; d8 < 16; ++d8) {
        const u32x4 kk = *(const u32x4*)(krow + d8 * 8);
        float kf[8]; kf[0] = bf2f(kk.x & 0xffffu); kf[1] = bf2f(kk.x >> 16); kf[2] = bf2f(kk.y & 0xffffu); kf[3] = bf2f(kk.y >> 16);
        kf[4] = bf2f(kk.z & 0xffffu); kf[5] = bf2f(kk.z >> 16); kf[6] = bf2f(kk.w & 0xffffu); kf[7] = bf2f(kk.w >> 16);
#pragma unroll
        for (int e = 0; e < 8; ++e) { const int d = d8 * 8 + e; s0 += qs[d] * kf[e]; s1 += qs[128 + d] * kf[e]; s2 += qs[256 + d] * kf[e]; s3 += qs[384 + d] * kf[e]; }
    }
}
__device__ __forceinline__ void phase_cmpa_naive(const Params& p, const Ctx& c) {
    const bf16_t* proj = (const bf16_t*)(p.ws + WS_PROJ);
    const bf16_t* kc = (const bf16_t*)(p.ws + WS_KC); const bf16_t* vc = (const bf16_t*)(p.ws + WS_VC);
    float* ocmp = (float*)(p.ws + WS_OCMP); unsigned* sel = (unsigned*)(p.ws + WS_SEL);
    LAS float* wl = (LAS float*)(c.lds + c.wave * 12288);
    LAS float* ps = wl;
    LAS float* qs = wl + 2048;
    LAS float* pim = wl + 2560;
    const int lane = c.lane;
    for (int task = c.gw; task < 2 * S; task += c.ngw) {
        const int t = task >> 1, g = task & 1;
        int nv = t >= 31 ? (t - 31) / 16 + 1 : 0; if (nv > NCMP) nv = NCMP;
        load_q4(proj, 4 * g, t, qs, lane, SCALE);
        const float NEG = -__builtin_inff();
        for (int jj = 0; jj < 8; ++jj) {
            const int n = lane + 64 * jj; float s0 = NEG, s1 = NEG, s2 = NEG, s3 = NEG;
            if (64 * jj < nv) { if (n < nv) dot4(kc + (size_t)(g * 512 + n) * HD, qs, s0, s1, s2, s3); else { s0 = s1 = s2 = s3 = NEG; } }
            ps[n] = s0; ps[512 + n] = s1; ps[1024 + n] = s2; ps[1536 + n] = s3;
        }
        for (int h = 0; h < 4; ++h) {
            float m = -1e30f;
            for (int jj = 0; jj < 8; ++jj) m = fmaxf(m, ps[h * 512 + lane + 64 * jj]);
            m = wave_max(m);
            float sum = 0.f;
            for (int jj = 0; jj < 8; ++jj) { const float e = __expf(ps[h * 512 + lane + 64 * jj] - m); ps[h * 512 + lane + 64 * jj] = e; sum += e; }
            sum = wave_sum(sum);
            const float inv = nv > 0 ? 1.0f / sum : 0.f;
            for (int jj = 0; jj < 8; ++jj) { const int n = lane + 64 * jj; ps[h * 512 + n] = (n < nv) ? ps[h * 512 + n] * inv : 0.f; }
        }
        { float o00 = 0.f, o01 = 0.f, o10 = 0.f, o11 = 0.f, o20 = 0.f, o21 = 0.f, o30 = 0.f, o31 = 0.f;
          for (int n = 0; n < nv; ++n) { const unsigned v2 = *(const unsigned*)(vc + (size_t)(g * 512 + n) * HD + 2 * lane); const float vx = bf2f(v2 & 0xffffu), vy = bf2f(v2 >> 16);
              const float p0 = ps[n], p1 = ps[512 + n], p2 = ps[1024 + n], p3 = ps[1536 + n];
              o00 += p0 * vx; o01 += p0 * vy; o10 += p1 * vx; o11 += p1 * vy; o20 += p2 * vx; o21 += p2 * vy; o30 += p3 * vx; o31 += p3 * vy; }
          float* ob = ocmp + (size_t)(4 * g) * S * HD + (size_t)t * HD + 2 * lane;
          *(f32x2*)(ob) = (f32x2){o00, o01}; *(f32x2*)(ob + (size_t)S * HD) = (f32x2){o10, o11}; *(f32x2*)(ob + (size_t)2 * S * HD) = (f32x2){o20, o21}; *(f32x2*)(ob + (size_t)3 * S * HD) = (f32x2){o30, o31}; }
        for (int jj = 0; jj < 8; ++jj) { const int n = lane + 64 * jj; pim[n] = ((ps[n] + ps[512 + n]) + ps[1024 + n]) + ps[1536 + n]; }
        const int blk = t >> 6;
        float c0, c1; bool sel0 = false, sel1 = false;
        { const int j0 = lane, j1 = lane + 64;
          const float a0 = (j0 > 0 ? pim[4 * j0 - 1] : 0.f) + 2.f * ((pim[4 * j0] + pim[4 * j0 + 1]) + pim[4 * j0 + 2]) + pim[4 * j0 + 3];
          const float a1 = pim[4 * j1 - 1] + 2.f * ((pim[4 * j1] + pim[4 * j1 + 1]) + pim[4 * j1 + 2]) + pim[4 * j1 + 3];
          const bool f0 = (j0 == 0) || (j0 == blk) || (j0 == blk - 1), f1 = (j1 == blk) || (j1 == blk - 1);
          sel0 = f0 && j0 <= blk; sel1 = f1 && j1 <= blk;
          c0 = (!f0 && j0 >= 1 && j0 <= blk - 2) ? a0 : -1.f; c1 = (!f1 && j1 <= blk - 2) ? a1 : -1.f; }
        const int ncand = blk - 2 > 0 ? blk - 2 : 0;
        const int ksel = 16 - (blk >= 2 ? 3 : blk + 1);
        if (ncand <= ksel) { if (c0 >= 0.f) sel0 = true; if (c1 >= 0.f) sel1 = true; }
        else {
            for (int it = 0; it < ksel; ++it) {
                const float m = wave_max(fmaxf(c0, c1));
                const unsigned long long b0 = __ballot(c0 == m);
                if (b0) { const int first = __ffsll((long long)b0) - 1; if (lane == first) { c0 = -1.f; sel0 = true; } }
                else { const unsigned long long b1 = __ballot(c1 == m); const int first = __ffsll((long long)b1) - 1; if (lane == first) { c1 = -1.f; sel1 = true; } }
            }
        }
        { const unsigned long long m0 = __ballot(sel0), m1 = __ballot(sel1);
          if (lane == 0) { u32x4 w; w.x = (unsigned)m0; w.y = (unsigned)(m0 >> 32); w.z = (unsigned)m1; w.w = (unsigned)(m1 >> 32); *(u32x4*)(sel + ((size_t)g * S + t) * 4) = w; } }
    }
}

struct Acc4 { float m[4], l[4], o[4][2]; };
__device__ __forceinline__ void chunk4(const bf16_t* K, const bf16_t* V, int key_base, int kmin, int kmax, const LAS float* qs, LAS float* pw, int lane,
                                       float& m0, float& m1, float& m2, float& m3, float& l0, float& l1, float& l2, float& l3,
                                       float& o00, float& o01, float& o10, float& o11, float& o20, float& o21, float& o30, float& o31) {
    const int key = key_base + lane; const bool valid = key >= kmin && key <= kmax;
    const float NEG = -__builtin_inff();
    float s0 = NEG, s1 = NEG, s2 = NEG, s3 = NEG;
    if (valid) dot4(K + (size_t)key * HD, qs, s0, s1, s2, s3);
    const float n0 = fmaxf(m0, wave_max(s0)), n1 = fmaxf(m1, wave_max(s1)), n2 = fmaxf(m2, wave_max(s2)), n3 = fmaxf(m3, wave_max(s3));
    const float a0 = __expf(m0 - n0), a1 = __expf(m1 - n1), a2 = __expf(m2 - n2), a3 = __expf(m3 - n3);
    const float p0 = __expf(s0 - n0), p1 = __expf(s1 - n1), p2 = __expf(s2 - n2), p3 = __expf(s3 - n3);
    l0 = l0 * a0 + wave_sum(p0); l1 = l1 * a1 + wave_sum(p1); l2 = l2 * a2 + wave_sum(p2); l3 = l3 * a3 + wave_sum(p3);
    m0 = n0; m1 = n1; m2 = n2; m3 = n3;
    o00 *= a0; o01 *= a0; o10 *= a1; o11 *= a1; o20 *= a2; o21 *= a2; o30 *= a3; o31 *= a3;
    pw[lane] = p0; pw[64 + lane] = p1; pw[128 + lane] = p2; pw[192 + lane] = p3;
    int k_lo = kmin - key_base; if (k_lo < 0) k_lo = 0; int k_hi = kmax - key_base; if (k_hi > 63) k_hi = 63;
    for (int kk = k_lo; kk <= k_hi; ++kk) {
        const unsigned v2 = *(const unsigned*)(V + (size_t)(key_base + kk) * HD + 2 * lane); const float vx = bf2f(v2 & 0xffffu), vy = bf2f(v2 >> 16);
        const float q0 = pw[kk], q1 = pw[64 + kk], q2 = pw[128 + kk], q3 = pw[192 + kk];
        o00 += q0 * vx; o01 += q0 * vy; o10 += q1 * vx; o11 += q1 * vy; o20 += q2 * vx; o21 += q2 * vy; o30 += q3 * vx; o31 += q3 * vy;
    }
}
__device__ __forceinline__ void phase_nsa_naive(const Params& p, const Ctx& c, int l) {
    const bf16_t* proj = (const bf16_t*)(p.ws + WS_PROJ);
    const float* ocmp = (const float*)(p.ws + WS_OCMP); const unsigned* sel = (const unsigned*)(p.ws + WS_SEL); const float* gates = (const float*)(p.ws + WS_GATES);
    const float* ggrp = p.in[10] + (size_t)l * DM; bf16_t* O = (bf16_t*)(p.ws + WS_O);
    LAS float* wl = (LAS float*)(c.lds + c.wave * 4096);
    LAS float* qs = wl; LAS float* pw = wl + 512;
    const int lane = c.lane;
    for (int task = c.gw; task < 2 * S; task += c.ngw) {
        const int t = task >> 1, g = task & 1;
        load_q4(proj, 4 * g, t, qs, lane, SCALE);
        const bf16_t* Ks = proj + (size_t)(12 + g) * S * HD; const bf16_t* Vs = proj + (size_t)(14 + g) * S * HD;
        const bf16_t* Kw = proj + (size_t)(16 + g) * S * HD; const bf16_t* Vw = proj + (size_t)(18 + g) * S * HD;
        float m0 = -1e30f, m1 = -1e30f, m2 = -1e30f, m3 = -1e30f, l0 = 0.f, l1 = 0.f, l2 = 0.f, l3 = 0.f;
        float o00 = 0.f, o01 = 0.f, o10 = 0.f, o11 = 0.f, o20 = 0.f, o21 = 0.f, o30 = 0.f, o31 = 0.f;
        const u32x4 sw = *(const u32x4*)(sel + ((size_t)g * S + t) * 4);
        for (int j = 0; j <= (t >> 6); ++j) {
            const unsigned word = j < 32 ? sw.x : j < 64 ? sw.y : j < 96 ? sw.z : sw.w;
            if ((word >> (j & 31)) & 1u) chunk4(Ks, Vs, 64 * j, 0, t, qs, pw, lane, m0, m1, m2, m3, l0, l1, l2, l3, o00, o01, o10, o11, o20, o21, o30, o31);
        }
        const float is0 = 1.f / l0, is1 = 1.f / l1, is2 = 1.f / l2, is3 = 1.f / l3;
        const float s00 = o00 * is0, s01 = o01 * is0, s10 = o10 * is1, s11 = o11 * is1, s20 = o20 * is2, s21 = o21 * is2, s30 = o30 * is3, s31 = o31 * is3;
        m0 = m1 = m2 = m3 = -1e30f; l0 = l1 = l2 = l3 = 0.f; o00 = o01 = o10 = o11 = o20 = o21 = o30 = o31 = 0.f;
        for (int cc = 0; cc < 8; ++cc) { const int kb = t - 511 + 64 * cc; if (kb + 63 < 0) continue;
            chunk4(Kw, Vw, kb, 0, t, qs, pw, lane, m0, m1, m2, m3, l0, l1, l2, l3, o00, o01, o10, o11, o20, o21, o30, o31); }
        const float iw0 = 1.f / l0, iw1 = 1.f / l1, iw2 = 1.f / l2, iw3 = 1.f / l3;
        float r[4][2];
        r[0][0] = o00 * iw0; r[0][1] = o01 * iw0; r[1][0] = o10 * iw1; r[1][1] = o11 * iw1; r[2][0] = o20 * iw2; r[2][1] = o21 * iw2; r[3][0] = o30 * iw3; r[3][1] = o31 * iw3;
        float sl[4][2]; sl[0][0] = s00; sl[0][1] = s01; sl[1][0] = s10; sl[1][1] = s11; sl[2][0] = s20; sl[2][1] = s21; sl[3][0] = s30; sl[3][1] = s31;
#pragma unroll
        for (int h = 0; h < 4; ++h) {
            const int H = 4 * g + h;
            const f32x2 oc = *(const f32x2*)(ocmp + (size_t)H * S * HD + (size_t)t * HD + 2 * lane);
            const float g0 = gates[(size_t)t * 24 + H], g1 = gates[(size_t)t * 24 + 8 + H], g2 = gates[(size_t)t * 24 + 16 + H];
            const float x = g0 * oc.x + g1 * sl[h][0] + g2 * r[h][0], y = g0 * oc.y + g1 * sl[h][1] + g2 * r[h][1];
            const float ms = wave_sum(x * x + y * y) * (1.0f / HD);
            const float rs = 1.0f / sqrtf(ms + EPS);
            const f32x2 gg = *(const f32x2*)(ggrp + H * HD + 2 * lane);
            *(unsigned*)(O + (size_t)t * DM + H * HD + 2 * lane) = pk2(x * rs * gg.x, y * rs * gg.y);
        }
    }
}

__device__ __forceinline__ void phase_sb_naive(const Params& p, const Ctx& c, int l) {
    const bf16_t* proj = (const bf16_t*)(p.ws + WS_PROJ);
    const float* ggrp = p.in[10] + (size_t)l * DM; bf16_t* O = (bf16_t*)(p.ws + WS_O);
    LAS float* wl = (LAS float*)(c.lds + c.wave * 4096);
    LAS float* qs = wl; LAS float* pw = wl + 512;
    const int lane = c.lane;
    for (int task = c.gw; task < 8 * S; task += c.ngw) {
        const int t = task >> 3, h = task & 7;
        { const unsigned q2 = *(const unsigned*)(proj + (size_t)(20 + h) * S * HD + (size_t)t * HD + 2 * lane);
          qs[2 * lane] = bf2f(q2 & 0xffffu) * SCALE; qs[2 * lane + 1] = bf2f(q2 >> 16) * SCALE; }
        const bf16_t* K = proj + (size_t)(28 + h) * S * HD; const bf16_t* V = proj + (size_t)(36 + h) * S * HD;
        float carry = 0.f, ox = 0.f, oy = 0.f;
        for (int cb = 0; cb < t; cb += 64) {
            const int key = t - 1 - cb - lane; const bool valid = key >= 0;
            float z = 0.f;
            if (valid) { const bf16_t* kr = K + (size_t)key * HD;
#pragma unroll 4
                for (int d8 = 0; d8 < 16; ++d8) { const u32x4 kk = *(const u32x4*)(kr + d8 * 8);
                    z += qs[d8 * 8 + 0] * bf2f(kk.x & 0xffffu) + qs[d8 * 8 + 1] * bf2f(kk.x >> 16) + qs[d8 * 8 + 2] * bf2f(kk.y & 0xffffu) + qs[d8 * 8 + 3] * bf2f(kk.y >> 16)
                       + qs[d8 * 8 + 4] * bf2f(kk.z & 0xffffu) + qs[d8 * 8 + 5] * bf2f(kk.z >> 16) + qs[d8 * 8 + 6] * bf2f(kk.w & 0xffffu) + qs[d8 * 8 + 7] * bf2f(kk.w >> 16); } }
            const float sp = fmaxf(z, 0.f) + log1pf(__expf(-fabsf(z)));
            const float L = valid ? -sp : 0.f;
            float incl = L;
#pragma unroll
            for (int o = 1; o < 64; o <<= 1) { const float u = __shfl_up(incl, o); if (lane >= o) incl += u; }
            const float a = valid ? __expf(z + L + carry + (incl - L)) : 0.f;
            carry += __shfl(incl, 63);
            pw[lane] = a;
            int kmax = t - 1 - cb; if (kmax > 63) kmax = 63;
            for (int kk = 0; kk <= kmax; ++kk) { const unsigned v2 = *(const unsigned*)(V + (size_t)(t - 1 - cb - kk) * HD + 2 * lane); const float w = pw[kk]; ox += w * bf2f(v2 & 0xffffu); oy += w * bf2f(v2 >> 16); }
        }
        const float ms = wave_sum(ox * ox + oy * oy) * (1.0f / HD);
        const float rs = 1.0f / sqrtf(ms + EPS);
        const f32x2 gg = *(const f32x2*)(ggrp + (8 + h) * HD + 2 * lane);
        *(unsigned*)(O + (size_t)t * DM + (8 + h) * HD + 2 * lane) = pk2(ox * rs * gg.x, oy * rs * gg.y);
    }
}

__device__ __forceinline__ Ctx make_ctx(unsigned char* lds) {
    Ctx c; c.lds = (LAS unsigned char*)lds; c.tid = threadIdx.x; c.lane = c.tid & 63; c.wave = __builtin_amdgcn_readfirstlane(c.tid >> 6);
    c.gw = blockIdx.x * NWAVES + c.wave; c.ngw = gridDim.x * NWAVES; return c;
}
#define KHEAD extern __shared__ __attribute__((aligned(16))) unsigned char lds_raw[]; const Ctx c = make_ctx(lds_raw);
__global__ void __launch_bounds__(NTHREADS, 2) k_conv(Params p) { KHEAD phase_conv(p, c); }
__global__ void __launch_bounds__(NTHREADS, 2) k_norm(Params p, const float* src, const float* gain) { KHEAD phase_norm<false>(c, src, gain, p.ws + WS_XN); }
__global__ void __launch_bounds__(NTHREADS, 2) k_norm_final(Params p, const float* src, const float* gain) { KHEAD phase_norm<true>(c, src, gain, p.out); }
__global__ void __launch_bounds__(NTHREADS, 2) k_gemm_in(Params p, int l) { KHEAD
    pg8::Gemm g{(const bf16_t*)(p.ws + WS_XN), w_ptr(p, l, W_IN), S, DINP, DM}; pg8::StaticOrder so; so.init(S, DINP, gridDim.x, blockIdx.x);
    EpiProj E{(bf16_t*)(p.ws + WS_PROJ), (float*)(p.ws + WS_GATES), (const float*)(p.ws + WS_ROPE), p.in[4] + 24 * l};
    pg8::gemm_phase<EpiProj, pg8::StaticOrder, true, true>(c.lds, g, so, E); }
__global__ void __launch_bounds__(NTHREADS, 2) k_gemm_out(Params p, int l, const float* hin) { KHEAD
    pg8::Gemm g{(const bf16_t*)(p.ws + WS_O), w_ptr(p, l, W_OUT), S, DM, DM}; pg8::StaticOrder so; so.init(S, DM, gridDim.x, blockIdx.x);
    EpiResid E{hin, (float*)(p.ws + WS_H)};
    pg8::gemm_phase<EpiResid, pg8::StaticOrder, true, true>(c.lds, g, so, E); }
__global__ void __launch_bounds__(NTHREADS, 2) k_gemm_gu(Params p, int l) { KHEAD
    pg8::Gemm g{(const bf16_t*)(p.ws + WS_XN), w_ptr(p, l, W_GU), S, 2 * DFF, DM}; pg8::StaticOrder so; so.init(S, 2 * DFF, gridDim.x, blockIdx.x);
    EpiSwiGLU E{(bf16_t*)(p.ws + WS_ACT)};
    pg8::gemm_phase<EpiSwiGLU, pg8::StaticOrder, true, true>(c.lds, g, so, E); }
__global__ void __launch_bounds__(NTHREADS, 2) k_gemm_dn(Params p, int l) { KHEAD
    pg8::Gemm g{(const bf16_t*)(p.ws + WS_ACT), w_ptr(p, l, W_DN), S, DM, DFF}; pg8::StaticOrder so; so.init(S, DM, gridDim.x, blockIdx.x);
    EpiResid E{(const float*)(p.ws + WS_H), (float*)(p.ws + WS_H)};
    pg8::gemm_phase<EpiResid, pg8::StaticOrder, true, true>(c.lds, g, so, E); }
__global__ void __launch_bounds__(NTHREADS, 2) k_cmpr(Params p, int l) { KHEAD phase_cmpr(p, c, l); }
__global__ void __launch_bounds__(NTHREADS, 2) k_cmpa(Params p) { KHEAD phase_cmpa_naive(p, c); }
__global__ void __launch_bounds__(NTHREADS, 2) k_nsa(Params p, int l) { KHEAD phase_nsa_naive(p, c, l); }
__global__ void __launch_bounds__(NTHREADS, 2) k_sb(Params p, int l) { KHEAD phase_sb_naive(p, c, l); }

extern "C" void kernel_launch(void* const* d_in, const int* in_sizes, int n_in, void* d_out, int out_size, void* d_ws, size_t ws_size, hipStream_t stream) {
    static int grid = 0;
    if (grid == 0) {
        if (n_in != 17 || out_size != S * DM || ws_size < WS_END) { fprintf(stderr, "kernel_launch: unexpected shapes (n_in %d, out %d, ws %zu)\n", n_in, out_size, ws_size); grid = -1; return; }
        int dev = 0, cus = 0; (void)hipGetDevice(&dev); (void)hipDeviceGetAttribute(&cus, hipDeviceAttributeMultiprocessorCount, dev); if (cus <= 0) cus = 256;
        const void* ks[] = {(const void*)k_conv, (const void*)k_norm, (const void*)k_norm_final, (const void*)k_gemm_in, (const void*)k_gemm_out, (const void*)k_gemm_gu, (const void*)k_gemm_dn,
                            (const void*)k_cmpr, (const void*)k_cmpa, (const void*)k_nsa, (const void*)k_sb};
        for (const void* k : ks) (void)hipFuncSetAttribute(k, hipFuncAttributeMaxDynamicSharedMemorySize, LDS_BYTES);
        grid = cus;
    }
    if (grid < 0) return;
    Params p{};
    for (int i = 0; i < 17; ++i) p.in[i] = (const float*)d_in[i];
    p.out = (float*)d_out; p.ws = (unsigned char*)d_ws;
    const dim3 G(grid), B(NTHREADS);
    float* h = (float*)((unsigned char*)d_ws + WS_H);
    hipLaunchKernelGGL(k_conv, G, B, LDS_BYTES, stream, p);
    for (int l = 0; l < NL; ++l) {
        const float* hin = l == 0 ? p.in[0] : h;
        hipLaunchKernelGGL(k_norm, G, B, LDS_BYTES, stream, p, hin, p.in[2] + (size_t)l * DM);
        hipLaunchKernelGGL(k_gemm_in, G, B, LDS_BYTES, stream, p, l);
        hipLaunchKernelGGL(k_cmpr, G, B, LDS_BYTES, stream, p, l);
        hipLaunchKernelGGL(k_cmpa, G, B, LDS_BYTES, stream, p);
        hipLaunchKernelGGL(k_nsa, G, B, LDS_BYTES, stream, p, l);
        hipLaunchKernelGGL(k_sb, G, B, LDS_BYTES, stream, p, l);
        hipLaunchKernelGGL(k_gemm_out, G, B, LDS_BYTES, stream, p, l, hin);
        hipLaunchKernelGGL(k_norm, G, B, LDS_BYTES, stream, p, (const float*)h, p.in[12] + (size_t)l * DM);
        hipLaunchKernelGGL(k_gemm_gu, G, B, LDS_BYTES, stream, p, l);
        hipLaunchKernelGGL(k_gemm_dn, G, B, LDS_BYTES, stream, p, l);
    }
    hipLaunchKernelGGL(k_norm_final, G, B, LDS_BYTES, stream, p, (const float*)h, p.in[16]);
}
```

```cpp
#include <hip/hip_runtime.h>
#include <cstdio>
#include <cstdint>
namespace pg8 {
#define PG8_LAS __attribute__((address_space(3)))
typedef unsigned short bf16_t;
typedef _Float16 bf16x8 __attribute__((ext_vector_type(8)));
typedef float f32x4 __attribute__((ext_vector_type(4)));
typedef unsigned u32x4 __attribute__((ext_vector_type(4)));
constexpr int BM = 256, BK = 64, HALF = 128, HTB = HALF * BK * 2  , STAGE_BYTES = 8 * HTB, NXCD = 8, WGM = 8;

__host__ __device__ __forceinline__ int lds_byte(int r, int c) { const int st = (r >> 4) * 2 + (c >> 5), rr = r & 15, cc = c & 31, ob = rr * 64 + cc * 2; return st * 1024 + (ob ^ (((ob >> 9) & 1) << 5)); }
__host__ __device__ __forceinline__ void stage_rc(int b, int& R, int& C) { const int st = b / 1024, sb = b % 1024, swz = sb ^ (((sb >> 9) & 1) << 5); R = (st >> 1) * 16 + swz / 64; C = (st & 1) * 32 + (swz % 64) / 2; }
__host__ __device__ __forceinline__ int perm32(int rho) { const int n = rho >> 4, i = rho & 15; return 8 * (i >> 2) + 4 * n + (i & 3); }

struct Unit { int pm, pn, ord; };
struct Gemm { const bf16_t* A; const bf16_t* Bt; int M, N, K; };

struct StaticOrder {
    int nM, nN, nwg, G, c;
    __host__ __device__ void init(int M, int N, int G_, int c_) { nM = M / BM; nN = N / BM; nwg = nM * nN; G = G_; c = c_; }
    __host__ __device__ bool next(int i, Unit& u) const {
        const long L = (long)i * G + c; if (L >= nwg) return false;
        int wgid = (int)L; { const int q = nwg / NXCD, r = nwg % NXCD, xcd = wgid % NXCD, off = wgid / NXCD; wgid = (xcd < r ? xcd * (q + 1) : r * (q + 1) + (xcd - r) * q) + off; }
        const int nig = WGM * nN, gid = wgid / nig, fm = gid * WGM, gsz = (nM - fm) < WGM ? (nM - fm) : WGM;
        u.pm = fm + ((wgid % nig) % gsz); u.pn = (wgid % nig) / gsz; u.ord = i; return true;
    }
    __device__ __forceinline__ void a_ready(const Unit&) const {}
    __device__ __forceinline__ void done(const Unit&) const {}
};
__device__ __forceinline__ unsigned cvt_pk_bf16(float lo, float hi) { unsigned r; asm volatile("v_cvt_pk_bf16_f32 %0, %1, %2" : "=v"(r) : "v"(lo), "v"(hi)); return r; }
typedef float f32x2 __attribute__((ext_vector_type(2)));
struct NoPre { __device__ __forceinline__ void operator()() const {} };
typedef int i32x8 __attribute__((ext_vector_type(8)));
typedef int i32x4 __attribute__((ext_vector_type(4)));
template <class Epi, class Sched, bool ALIGN_EPI = false, bool SP2 = false, class Pre = NoPre, int F8 = 0>
__device__ __forceinline__ void gemm_phase(PG8_LAS unsigned char* lds, const Gemm g, const Sched& S, const Epi& E, int tid_in, const Pre& pre = Pre()) {
    int tid_ = tid_in; asm volatile("" : "+v"(tid_));
    const int tid = tid_, wid = __builtin_amdgcn_readfirstlane(tid >> 6), lane = tid & 63, wr = wid >> 2, wc = wid & 3, fr = lane & 15, fq = lane >> 4;
    const int K = g.K, nt = K / BK;
    unsigned voffA[2], voffB[2];
#pragma unroll
    for (int i = 0; i < 2; ++i) { int R, C; stage_rc(tid * 16 + i * 8192, R, C); const int Rb = Epi::PERM ? ((R & ~31) + perm32(R & 31)) : R;
        voffA[i] = (unsigned)(R * K + C) * 2u; voffB[i] = (unsigned)(Rb * K + C) * 2u; }
    const size_t kstep = (size_t)(BK * 2);
    const size_t hstep = (size_t)HALF * K * 2;
    const size_t tstep = 2 * hstep;
    const unsigned ldsw = (unsigned)wid * 1024u;
    const int aoff = lds_byte(wr * 64 + fr, fq * 8), boff = lds_byte(wc * 32 + fr, fq * 8);
#define PG8_SA(b, h) (((b) * 2 + (h)) * HTB)
#define PG8_SB(b, h) ((4 + (b) * 2 + (h)) * HTB)
#define PG8_STAGE(bufoff, gbase, voff) do { _Pragma("unroll") for (int _i = 0; _i < 2; ++_i) \
        __builtin_amdgcn_global_load_lds((const unsigned*)((const char*)(gbase) + (voff)[_i]), (PG8_LAS unsigned*)(lds + (bufoff) + ldsw + _i * 8192), 16, 0, 0); } while (0)
#define PG8_LDA(dst, b, h) do { _Pragma("unroll") for (int m = 0; m < 4; ++m) _Pragma("unroll") for (int k = 0; k < 2; ++k) dst[m][k] = *(const PG8_LAS bf16x8*)(lds + PG8_SA(b, h) + aoff + m * 2048 + k * 1024); } while (0)
#define PG8_LDB(dst, b, h) do { _Pragma("unroll") for (int n = 0; n < 2; ++n) _Pragma("unroll") for (int k = 0; k < 2; ++k) dst[n][k] = *(const PG8_LAS bf16x8*)(lds + PG8_SB(b, h) + boff + n * 2048 + k * 1024); } while (0)
#define PG8_F8FRAG(X) __builtin_shufflevector(__builtin_bit_cast(i32x4, (X)[0]), __builtin_bit_cast(i32x4, (X)[1]), 0, 1, 2, 3, 4, 5, 6, 7)
#define PG8_MMA(ai, bj, At, Bt) do { __builtin_amdgcn_s_setprio(1); \
        if constexpr (F8 == 2) { _Pragma("unroll") for (int m = 0; m < 4; ++m) _Pragma("unroll") for (int n = 0; n < 2; ++n) _Pragma("unroll") for (int k = 0; k < 2; ++k) \
            acc[ai][bj][m][n] = __builtin_bit_cast(f32x4, __builtin_amdgcn_mfma_i32_16x16x64_i8(__builtin_bit_cast(i32x4, Bt[n][k]), __builtin_bit_cast(i32x4, At[m][k]), __builtin_bit_cast(i32x4, acc[ai][bj][m][n]), 0, 0, 0)); } \
        else if constexpr (F8 == 1) { _Pragma("unroll") for (int m = 0; m < 4; ++m) _Pragma("unroll") for (int n = 0; n < 2; ++n) \
            { const i32x8 a8_ = PG8_F8FRAG(Bt[n]), b8_ = PG8_F8FRAG(At[m]); asm volatile("v_mfma_f32_16x16x128_f8f6f4 %0, %1, %2, %0" : "+v"(acc[ai][bj][m][n]) : "v"(a8_), "v"(b8_)); } } \
        else { _Pragma("unroll") for (int m = 0; m < 4; ++m) _Pragma("unroll") for (int n = 0; n < 2; ++n) _Pragma("unroll") for (int k = 0; k < 2; ++k) \
            acc[ai][bj][m][n] = __builtin_amdgcn_mfma_f32_16x16x32_f16(Bt[n][k], At[m][k], acc[ai][bj][m][n], 0, 0, 0); } \
        __builtin_amdgcn_s_setprio(0); } while (0)
#define PG8_WAIT_V(n) asm volatile("s_waitcnt vmcnt(" #n ")" ::: "memory")
#define PG8_WAIT_L(n) asm volatile("s_waitcnt lgkmcnt(" #n ")" ::: "memory")
#define PG8_BAR __builtin_amdgcn_s_barrier()
#define PG8_SCHED __builtin_amdgcn_sched_barrier(0)
    Unit cur, nxt; int ui = 0;
    if (!S.next(0, cur)) return;
    f32x4 acc[2][2][4][2];
#pragma unroll
    for (int a = 0; a < 2; ++a)
#pragma unroll
        for (int b = 0; b < 2; ++b)
#pragma unroll
            for (int m = 0; m < 4; ++m)
#pragma unroll
                for (int n = 0; n < 2; ++n) acc[a][b][m][n] = (f32x4){0.f, 0.f, 0.f, 0.f};
    bf16x8 At[4][2], B0[2][2], B1[2][2];
    const char* cA = (const char*)g.A + (size_t)cur.pm * tstep; const char* cB = (const char*)g.Bt + (size_t)cur.pn * tstep;
    S.a_ready(cur);
    if constexpr (SP2) {
        PG8_STAGE(PG8_SB(0, 0), cB, voffB); PG8_STAGE(PG8_SB(0, 1), cB + hstep, voffB); PG8_STAGE(PG8_SA(0, 0), cA, voffA); PG8_STAGE(PG8_SA(0, 1), cA + hstep, voffA);
        pre();
        if (wr == 1) PG8_BAR;
        PG8_WAIT_V(2); PG8_BAR;
        PG8_STAGE(PG8_SB(1, 0), cB + kstep, voffB); PG8_STAGE(PG8_SA(1, 0), cA + kstep, voffA); PG8_STAGE(PG8_SB(1, 1), cB + hstep + kstep, voffB);
        PG8_WAIT_V(6); PG8_BAR;
    } else {
        PG8_STAGE(PG8_SB(0, 0), cB, voffB); PG8_STAGE(PG8_SA(0, 0), cA, voffA); PG8_STAGE(PG8_SB(0, 1), cB + hstep, voffB); PG8_STAGE(PG8_SA(0, 1), cA + hstep, voffA);
        if (wr == 1) PG8_BAR;
        PG8_WAIT_V(4); PG8_BAR;
        PG8_STAGE(PG8_SB(1, 0), cB + kstep, voffB); PG8_STAGE(PG8_SA(1, 0), cA + kstep, voffA); PG8_STAGE(PG8_SB(1, 1), cB + hstep + kstep, voffB);
        PG8_WAIT_V(6); PG8_BAR;
    }
    for (;;) {
        const bool has_next = S.next(ui + 1, nxt);
        const char* nA = has_next ? (const char*)g.A + (size_t)nxt.pm * tstep : cA; const char* nB = has_next ? (const char*)g.Bt + (size_t)nxt.pn * tstep : cB;
        for (int t = 0; t < nt; t += 2) {
            const bool last = (t == nt - 2);
            const char* a1 = cA + (size_t)(t + 1) * kstep;
            const char* a2 = last ? nA : cA + (size_t)(t + 2) * kstep; const char* b2 = last ? nB : cB + (size_t)(t + 2) * kstep;
            const char* a3 = a2 + kstep; const char* b3 = b2 + kstep;
            if (last && has_next) S.a_ready(nxt);
            if constexpr (SP2) {
            PG8_LDB(B0, 0, 0); PG8_LDB(B1, 0, 1); PG8_SCHED; PG8_LDA(At, 0, 0); PG8_STAGE(PG8_SA(1, 1), a1 + hstep, voffA);
            PG8_WAIT_V(8); PG8_WAIT_L(0); PG8_BAR; PG8_MMA(0, 0, At, B0); PG8_MMA(0, 1, At, B1); PG8_BAR; PG8_SCHED;
            PG8_LDA(At, 0, 1); PG8_STAGE(PG8_SB(0, 0), b2, voffB); PG8_STAGE(PG8_SB(0, 1), b2 + hstep, voffB); PG8_STAGE(PG8_SA(0, 0), a2, voffA);
            PG8_WAIT_V(8); PG8_WAIT_L(0); PG8_BAR; PG8_MMA(1, 0, At, B0); PG8_MMA(1, 1, At, B1); PG8_BAR; PG8_SCHED;
            PG8_LDB(B0, 1, 0); PG8_LDB(B1, 1, 1); PG8_SCHED; PG8_LDA(At, 1, 0); PG8_STAGE(PG8_SA(0, 1), a2 + hstep, voffA);
            PG8_WAIT_V(8); PG8_WAIT_L(0); PG8_BAR; PG8_MMA(0, 0, At, B0); PG8_MMA(0, 1, At, B1); PG8_BAR; PG8_SCHED;
            PG8_LDA(At, 1, 1); PG8_STAGE(PG8_SB(1, 0), b3, voffB); PG8_STAGE(PG8_SB(1, 1), b3 + hstep, voffB); PG8_STAGE(PG8_SA(1, 0), a3, voffA);
            PG8_WAIT_V(8); PG8_WAIT_L(0); PG8_BAR; PG8_MMA(1, 0, At, B0); PG8_MMA(1, 1, At, B1); PG8_BAR; PG8_SCHED;
            } else {
            PG8_LDB(B0, 0, 0); PG8_SCHED; PG8_LDA(At, 0, 0); PG8_STAGE(PG8_SA(1, 1), a1 + hstep, voffA);
            PG8_WAIT_L(8); PG8_BAR; PG8_WAIT_L(0); PG8_MMA(0, 0, At, B0); PG8_BAR; PG8_SCHED;
            PG8_LDB(B1, 0, 1); PG8_STAGE(PG8_SB(0, 0), b2, voffB);
            PG8_BAR; PG8_WAIT_L(0); PG8_MMA(0, 1, At, B1); PG8_BAR;
            PG8_LDA(At, 0, 1); PG8_STAGE(PG8_SA(0, 0), a2, voffA);
            PG8_BAR; PG8_WAIT_L(0); PG8_MMA(1, 0, At, B0); PG8_BAR; PG8_SCHED;
            PG8_STAGE(PG8_SB(0, 1), b2 + hstep, voffB);
            PG8_WAIT_V(6); PG8_BAR; PG8_MMA(1, 1, At, B1); PG8_BAR;
            PG8_LDB(B0, 1, 0); PG8_SCHED; PG8_LDA(At, 1, 0); PG8_STAGE(PG8_SA(0, 1), a2 + hstep, voffA);
            PG8_WAIT_L(8); PG8_BAR; PG8_WAIT_L(0); PG8_MMA(0, 0, At, B0); PG8_BAR; PG8_SCHED;
            PG8_LDB(B1, 1, 1); PG8_STAGE(PG8_SB(1, 0), b3, voffB);
            PG8_BAR; PG8_WAIT_L(0); PG8_MMA(0, 1, At, B1); PG8_BAR;
            PG8_LDA(At, 1, 1); PG8_STAGE(PG8_SA(1, 0), a3, voffA);
            PG8_BAR; PG8_WAIT_L(0); PG8_MMA(1, 0, At, B0); PG8_BAR; PG8_SCHED;
            PG8_STAGE(PG8_SB(1, 1), b3 + hstep, voffB);
            PG8_WAIT_V(6); PG8_BAR; PG8_MMA(1, 1, At, B1); PG8_BAR;
            }
        }
        if constexpr (F8) asm volatile("s_nop 15\n\ts_nop 15" ::: "memory");
        if constexpr (ALIGN_EPI) { if (wr == 0) PG8_BAR; }
        if constexpr (!Epi::AFTER_DRAIN) { E(acc, cur, wr, wc, fr, fq); S.done(cur); }
        if (!has_next) break;
#pragma unroll
        for (int a = 0; a < 2; ++a)
#pragma unroll
            for (int b = 0; b < 2; ++b)
#pragma unroll
                for (int m = 0; m < 4; ++m)
#pragma unroll
                    for (int n = 0; n < 2; ++n) acc[a][b][m][n] = (f32x4){0.f, 0.f, 0.f, 0.f};
        cur = nxt; cA = nA; cB = nB; ++ui;
        if constexpr (ALIGN_EPI) { if (wr == 1) PG8_BAR; }
    }
    PG8_WAIT_V(0);
    if constexpr (!ALIGN_EPI) { if (wr == 0) PG8_BAR; }
    PG8_BAR;
    if constexpr (Epi::AFTER_DRAIN) { E.fused(acc, cur, wr, wc, fr, fq, lds, wid, lane); S.done(cur); }
#undef PG8_SA
#undef PG8_SB
#undef PG8_STAGE
#undef PG8_LDA
#undef PG8_LDB
#undef PG8_MMA
#undef PG8_WAIT_V
#undef PG8_WAIT_L
#undef PG8_BAR
#undef PG8_SCHED
}
}
#define LAS __attribute__((address_space(3)))
#define XB_TMO      128
#define XB_XCNT(j)  (256  + 64 * (j))
#define XB_XSUB(j)  (1280 + 64 * (j))
#define XB_XGEN(j)  (2304 + 64 * (j))
#define XB_TOP      3328
#define XB_TOPGEN   3392
#define XCD_BAR_WORDS 3456
#define XB_SPIN_CAP (1u << 18)

__device__ __forceinline__ unsigned xb_ld(unsigned* p)              { return __hip_atomic_load(p, __ATOMIC_RELAXED, __HIP_MEMORY_SCOPE_AGENT); }
__device__ __forceinline__ unsigned xb_add(unsigned* p, unsigned v) { return __hip_atomic_fetch_add(p, v, __ATOMIC_RELAXED, __HIP_MEMORY_SCOPE_AGENT); }
__device__ __forceinline__ unsigned xb_xcc_id() { return (unsigned)__builtin_amdgcn_s_getreg((3 << 11) | 20) & 0xFu; }
#define XB_SPIN(cond, bar) do { unsigned _sp = 0; while (cond) { __builtin_amdgcn_s_sleep(1); \
    if ((++_sp & 255u) == 0u) { if (xb_ld(&(bar)[XB_TMO])) break; if (_sp > XB_SPIN_CAP) { atomicAdd(&(bar)[XB_TMO], 1u); break; } } } } while (0)

struct XcdBarrier {
    unsigned* bar; unsigned x;
    volatile LAS unsigned* st;
    bool leader;
};

__device__ __forceinline__ XcdBarrier xcd_barrier_post(unsigned* bar, volatile LAS unsigned* st, bool leader) {
    XcdBarrier b; b.bar = bar; b.x = xb_xcc_id(); b.st = st; b.leader = leader;
    if (leader) (void)xb_add(&bar[XB_XCNT(b.x)], 1u);
    return b;
}
__device__ __forceinline__ void xcd_barrier_complete(unsigned* bar, unsigned x, unsigned& nloc, unsigned& nx) {
    const unsigned G = gridDim.x * gridDim.y * gridDim.z;
    unsigned sum, cnt, mine, sp = 0u;
    for (;;) {
        sum = 0u; cnt = 0u; mine = 0u;
#pragma unroll
        for (unsigned j = 0; j < 16; ++j) { const unsigned c = xb_ld(&bar[XB_XCNT(j)]); sum += c; cnt += (c > 0u) ? 1u : 0u; mine = (j == x) ? c : mine; }
        if (sum == G) break;
        __builtin_amdgcn_s_sleep(1);
        if ((++sp & 255u) == 0u) { if (xb_ld(&bar[XB_TMO])) break; if (sp > XB_SPIN_CAP) { atomicAdd(&bar[XB_TMO], 1u); break; } }
    }
    nloc = mine > 0u ? mine : 1u; nx = cnt > 0u ? cnt : 1u;
}

__device__ __forceinline__ void xcd_barrier(const XcdBarrier& b) {
    asm volatile("s_waitcnt vmcnt(0)" ::: "memory");
    __syncthreads();
    if (b.leader) {
        unsigned* bar = b.bar;
        __builtin_amdgcn_s_waitcnt(0);
        unsigned nloc = b.st[0], nx = b.st[1];
        if (nloc == 0u) { xcd_barrier_complete(bar, b.x, nloc, nx); b.st[0] = nloc; b.st[1] = nx; }
        const unsigned old = xb_add(&bar[XB_XSUB(b.x)], 1u);
        const unsigned gen = old / nloc;
        if (old + 1u == (gen + 1u) * nloc) {
            __builtin_amdgcn_fence(__ATOMIC_RELEASE, "agent");
            asm volatile("s_waitcnt vmcnt(0)" ::: "memory");
            const unsigned og = xb_add(&bar[XB_TOP], 1u);
            const unsigned tg = og / nx;
            if (og + 1u == (tg + 1u) * nx) xb_add(&bar[XB_TOPGEN], 1u);
            else XB_SPIN(xb_ld(&bar[XB_TOPGEN]) == tg, bar);
            __builtin_amdgcn_fence(__ATOMIC_ACQUIRE, "agent");
            xb_add(&bar[XB_XGEN(b.x)], 1u);
            asm volatile("s_waitcnt vmcnt(0)" ::: "memory");
        } else {
            XB_SPIN(xb_ld(&bar[XB_XGEN(b.x)]) == gen, bar);
            __builtin_amdgcn_fence(__ATOMIC_ACQUIRE, "agent");
            asm volatile("s_waitcnt vmcnt(0)" ::: "memory");
        }
    }
    __syncthreads();
}

#ifndef LAS
#define LAS __attribute__((address_space(3)))
#endif
typedef unsigned short bf16_t;
typedef _Float16 bf16x8 __attribute__((ext_vector_type(8)));
typedef float f32x4 __attribute__((ext_vector_type(4)));
typedef float f32x2 __attribute__((ext_vector_type(2)));
typedef unsigned u32x4 __attribute__((ext_vector_type(4)));
typedef unsigned u32x2 __attribute__((ext_vector_type(2)));

constexpr int S = 8192, DM = 2048, NL = 4, HD = 128, DIN = 5656, DINP = 5888, DFF = 5632, NCMP = 511;
constexpr float EPS = 1e-6f;
constexpr float SCALE = 0.08838834764831845f;
constexpr int NWAVES = 8, NTHREADS = 512;
constexpr int LDS_BYTES = 147456;
constexpr int RING_BYTES = 131072, MISC_OFF = LDS_BYTES - 64;

constexpr size_t MiB = 1u << 20;
constexpr float W8_SCALE = 64.0f, A8_SCALE = 8.0f;
constexpr size_t WS_CTL = 0, CTL_ZERO_BYTES = 1 * MiB;
constexpr size_t WS_ROPE = 1 * MiB;
constexpr size_t WS_CBP = WS_ROPE + 1024 * 1024;
constexpr size_t WS_ROPEH = 5 * MiB + 512 * 1024;
constexpr size_t WS_CBF = 3 * MiB + 512 * 1024;
constexpr size_t WS_KC = 2 * MiB + 512 * 1024;
constexpr size_t WS_VC = WS_KC + 256 * 1024;
constexpr size_t WS_SEL = 3 * MiB;
constexpr size_t WS_GATES = 4 * MiB;
constexpr size_t WS_SSQ = 5 * MiB;
constexpr size_t WS_W = 8 * MiB;
constexpr size_t W_IN = 0, W_OUT = 23 * MiB, W_GU = 31 * MiB, W_DN = 75 * MiB, W_C1 = 97 * MiB, W_C2 = 101 * MiB, W_LAYER = 102 * MiB;
constexpr size_t WS_H = WS_W + NL * W_LAYER;
constexpr size_t WS_XN8 = WS_H;
constexpr size_t WS_XN = WS_H + 64 * MiB;
constexpr size_t WS_O = WS_XN + 32 * MiB;
constexpr size_t WS_OCMP = WS_O + 32 * MiB;
constexpr size_t WS_PROJ = WS_OCMP + 32 * MiB;
constexpr size_t WS_ACT = WS_PROJ;
constexpr size_t WS_PART = WS_PROJ + 88 * MiB;
constexpr size_t PART_SLOT = 131072 + 2048;
constexpr size_t WS_W8 = 688 * MiB;
constexpr size_t WS_WSC = WS_W8 + NL * 22 * MiB;
constexpr size_t WS_ASC = WS_WSC + 1 * MiB;
constexpr size_t WS_WI8 = WS_ASC + 1 * MiB;
constexpr size_t WS_WISC = WS_WI8 + NL * 12 * MiB;
constexpr size_t WS_END = WS_WISC + 1 * MiB;
static_assert(WS_PART + 128 * PART_SLOT <= WS_W8, "ws map");
constexpr size_t WS_CPART = 6 * MiB;
constexpr int CW_CFLAG = 32768;
constexpr int CW_NSAFLAG = 16384;
static_assert((size_t)DINP * DM * 2 == 23 * MiB && (size_t)2 * DFF * DM * 2 == 44 * MiB && (size_t)DM * DFF * 2 == 22 * MiB, "weight map");

struct Params { const float* in[17]; float* out; unsigned char* ws; };

struct Ctx {
    LAS unsigned char* lds;
    int tid, lane, wave, gw, ngw, bx;
};

__device__ __forceinline__ float bf2f(unsigned b) { return (float)__builtin_bit_cast(_Float16, (unsigned short)b); }
__device__ __forceinline__ unsigned f2bf(float f) { return (unsigned)__builtin_bit_cast(unsigned short, (_Float16)f); }
typedef _Float16 h2_t __attribute__((ext_vector_type(2)));
__device__ __forceinline__ unsigned pk2(float lo, float hi) { const h2_t v = {(_Float16)lo, (_Float16)hi}; return __builtin_bit_cast(unsigned, v); }
#define DPP_F(old_, src_, ctrl_, rmask_) __builtin_bit_cast(float, __builtin_amdgcn_update_dpp(__builtin_bit_cast(int, (old_)), __builtin_bit_cast(int, (src_)), (ctrl_), (rmask_), 0xf, false))
__device__ __forceinline__ float wave_sum(float v) {
    v += DPP_F(0.f, v, 0x111, 0xf); v += DPP_F(0.f, v, 0x112, 0xf); v += DPP_F(0.f, v, 0x114, 0xf); v += DPP_F(0.f, v, 0x118, 0xf);
    v += DPP_F(0.f, v, 0x142, 0xa); v += DPP_F(0.f, v, 0x143, 0xc);
    return __builtin_bit_cast(float, __builtin_amdgcn_readlane(__builtin_bit_cast(int, v), 63));
}
__device__ __forceinline__ float wave_max_u(float v) {
    v = fmaxf(v, DPP_F(0.f, v, 0x111, 0xf)); v = fmaxf(v, DPP_F(0.f, v, 0x112, 0xf)); v = fmaxf(v, DPP_F(0.f, v, 0x114, 0xf)); v = fmaxf(v, DPP_F(0.f, v, 0x118, 0xf));
    v = fmaxf(v, DPP_F(0.f, v, 0x142, 0xa)); v = fmaxf(v, DPP_F(0.f, v, 0x143, 0xc));
    return __builtin_bit_cast(float, __builtin_amdgcn_readlane(__builtin_bit_cast(int, v), 63));
}
__device__ __forceinline__ float rope_inv(int i) {
    switch (i) {
        case 0: return 1.0f;
        case 1: return 0.44036659598350525f;
        case 2: return 0.1939227432012558f;
        case 3: return 0.08539710193872452f;
        case 4: return 0.03760603070259094f;
        case 5: return 0.016560440883040428f;
        case 6: return 0.007292664609849453f;
        case 7: return 0.0032114461064338684f;
        case 8: return 0.0014142135623842478f;
        case 9: return 0.0006227724370546639f;
        case 10: return 0.00027424818836152554f;
        case 11: return 0.00012076973507646471f;
        case 12: return 5.3182957344688475e-05f;
        case 13: return 2.34199997066753e-05f;
        case 14: return 1.0313385246263351e-05f;
        default: return 4.541670477919979e-06f;
    }
}
__device__ __forceinline__ void sincos_d(float ang, float& c, float& s) {
    const double x = (double)ang;
    const double q = rint(x * 0.63661977236758134308);
    const double r = fma(-q, 1.57079632679489661923, x) - q * 6.123233995736766e-17;
    const double r2 = r * r;
    double cs = 1.0 / 479001600.0; cs = cs * r2 - 1.0 / 3628800.0; cs = cs * r2 + 1.0 / 40320.0; cs = cs * r2 - 1.0 / 720.0; cs = cs * r2 + 1.0 / 24.0; cs = cs * r2 - 0.5; cs = cs * r2 + 1.0;
    double sn = 1.0 / 6227020800.0; sn = sn * r2 - 1.0 / 39916800.0; sn = sn * r2 + 1.0 / 362880.0; sn = sn * r2 - 1.0 / 5040.0; sn = sn * r2 + 1.0 / 120.0; sn = sn * r2 - 1.0 / 6.0; sn = sn * r2 + 1.0; sn *= r;
    const int qi = ((int)(long long)q) & 3;
    double cc, ss;
    if (qi == 0) { cc = cs; ss = sn; } else if (qi == 1) { cc = -sn; ss = cs; } else if (qi == 2) { cc = -cs; ss = -sn; } else { cc = sn; ss = -cs; }
    c = (float)cc; s = (float)ss;
}
__device__ __forceinline__ float gelu_tanh(float x) {
    const float y = 0.7978845608028654f * (x + 0.044715f * x * x * x);
    const float e = __expf(2.0f * y);
    const float th = 1.0f - 2.0f / (e + 1.0f);
    return 0.5f * x * (1.0f + th);
}
__device__ __forceinline__ float partner32(float x, int hi) { auto rr = __builtin_amdgcn_permlane32_swap(__float_as_uint(x), __float_as_uint(x), false, false); return __uint_as_float(hi ? rr[0] : rr[1]); }
__device__ __forceinline__ float sigmoidf_(float x) { return __builtin_amdgcn_rcpf(1.0f + __builtin_amdgcn_exp2f(x * -1.4426950408889634f)); }

__device__ __forceinline__ bf16_t* w_ptr(const Params& p, int l, size_t off) { return (bf16_t*)(p.ws + WS_W + (size_t)l * W_LAYER + off); }

struct ConvItem { const float* W; const float* gain; bf16_t* WT; int N, k0, sc, nv, drow, dK, frag, f8; };
constexpr int I_IN = 32 * 184, I_OUT = 32 * 64, I_GU = 32 * 352, I_DN = 88 * 64, I_C1 = 1024, I_C2 = 32;
constexpr int I_LAYER = I_OUT + I_DN + I_C1 + I_C2;
__device__ __forceinline__ ConvItem conv_desc(const Params& p, int it) {
    const int l = it / I_LAYER; int r = it - l * I_LAYER; ConvItem d; d.frag = 0; d.f8 = 0;
    if (r < I_OUT) { const int kb = r / 64, nb = r % 64;
        d.W = p.in[11] + (size_t)l * DM * DM; d.N = DM; d.k0 = 64 * kb; d.sc = 32 * nb; d.nv = 32; d.WT = w_ptr(p, l, W_OUT); d.drow = 32 * nb; d.dK = DM; d.gain = nullptr; return d; }
    r -= I_OUT;
    if (r < I_DN) { const int kb = r / 64, nb = r % 64;
        d.W = p.in[15] + (size_t)l * DFF * DM; d.N = DM; d.k0 = 64 * kb; d.sc = 32 * nb; d.nv = 32; d.WT = w_ptr(p, l, W_DN); d.drow = 32 * nb; d.dK = DFF; d.gain = nullptr; d.f8 = 1; return d; }
    r -= I_DN;
    if (r < I_C1) { const int kv = r / 512, rr = r % 512, kb = rr / 8, nb = rr % 8;
        d.W = p.in[kv ? 8 : 6] + (size_t)l * 4096 * 256; d.N = 256; d.k0 = 64 * kb; d.sc = 32 * nb; d.nv = 32; d.WT = w_ptr(p, l, W_C1) + (size_t)kv * 256 * 4096; d.drow = 32 * nb; d.dK = 4096; d.gain = nullptr; d.frag = 1; return d; }
    r -= I_C1;
    { const int kv = r / 16, rr = r % 16, kb = rr / 4, nb = rr % 4;
        d.W = p.in[kv ? 9 : 7] + (size_t)l * 256 * 128; d.N = 128; d.k0 = 64 * kb; d.sc = 32 * nb; d.nv = 32; d.WT = w_ptr(p, l, W_C2) + (size_t)kv * 128 * 256; d.drow = 32 * nb; d.dK = 256; d.gain = nullptr; return d; }
}
#define CONV_LOAD(d, tv) do { const int c_ = lane & 31; const float* wp_ = (d).W + (size_t)((d).k0 + (lane >> 5)) * (d).N + (d).sc + (c_ < (d).nv ? c_ : 0); \
        _Pragma("unroll") for (int i = 0; i < 32; ++i) tv[i] = wp_[(size_t)(2 * i) * (d).N]; } while (0)
#define CONV_STORE(d, tv) do { const int c_ = lane & 31; const bool ok_ = c_ < (d).nv; _Pragma("unroll") for (int i = 0; i < 32; ++i) { const int kk = 2 * i + (lane >> 5); scr[kk * 33 + c_] = ok_ ? tv[i] : 0.f; } \
        asm volatile("s_waitcnt lgkmcnt(0)" ::: "memory"); \
        const int c8 = lane & 7; f32x4 ga = {1.f, 1.f, 1.f, 1.f}, gb = {1.f, 1.f, 1.f, 1.f}; \
        if ((d).gain) { ga = *(const f32x4*)((d).gain + (d).k0 + 8 * c8); gb = *(const f32x4*)((d).gain + (d).k0 + 8 * c8 + 4); } \
        _Pragma("unroll") for (int j = 0; j < 4; ++j) { const int n = (lane >> 3) + 8 * j; const LAS float* s = scr + (8 * c8) * 33 + n; \
            u32x4 o; o.x = pk2(s[0 * 33] * ga.x, s[1 * 33] * ga.y); o.y = pk2(s[2 * 33] * ga.z, s[3 * 33] * ga.w); o.z = pk2(s[4 * 33] * gb.x, s[5 * 33] * gb.y); o.w = pk2(s[6 * 33] * gb.z, s[7 * 33] * gb.w); \
            const int na_ = (d).drow + n, ka_ = (d).k0 + 8 * c8; \
            const size_t off_ = (d).frag ? (size_t)((((na_ >> 4) * 128 + (ka_ >> 5)) * 64 + (((ka_ >> 3) & 3) * 16 + (na_ & 15))) * 8) : (size_t)na_ * (d).dK + ka_; \
            if ((d).f8) { int w0_ = 0, w1_ = 0; \
                w0_ = __builtin_amdgcn_cvt_pk_fp8_f32(s[0 * 33] * ga.x * W8_SCALE, s[1 * 33] * ga.y * W8_SCALE, w0_, false); w0_ = __builtin_amdgcn_cvt_pk_fp8_f32(s[2 * 33] * ga.z * W8_SCALE, s[3 * 33] * ga.w * W8_SCALE, w0_, true); \
                w1_ = __builtin_amdgcn_cvt_pk_fp8_f32(s[4 * 33] * gb.x * W8_SCALE, s[5 * 33] * gb.y * W8_SCALE, w1_, false); w1_ = __builtin_amdgcn_cvt_pk_fp8_f32(s[6 * 33] * gb.z * W8_SCALE, s[7 * 33] * gb.w * W8_SCALE, w1_, true); \
                u32x2 o8_; o8_.x = (unsigned)w0_; o8_.y = (unsigned)w1_; *(u32x2*)((unsigned char*)(d).WT + off_) = o8_; } \
            else *(u32x4*)((d).WT + off_) = o; } \
        asm volatile("s_waitcnt lgkmcnt(0)" ::: "memory"); } while (0)

constexpr int STRIP_RS = 4100, N_STRIPS_L = 184 + 352;
static_assert(32 * STRIP_RS <= MISC_OFF, "LDS map");
struct StripDesc { const float* W; const float* gain; unsigned char* dst; float* dsc; int N, sc, nv, drow; };
__device__ __forceinline__ StripDesc strip_desc(const Params& p, int s) {
    const int l = s / N_STRIPS_L, r = s - l * N_STRIPS_L; StripDesc d;
    if (r < 184) { const int n0 = 32 * r; int sc, nv;
        if (n0 < 2560) { sc = n0; nv = 32; } else if (n0 < 5632) { sc = n0 + 24; nv = 32; } else if (n0 == 5632) { sc = 2560; nv = 24; } else { sc = 0; nv = 0; }
        d.W = p.in[3] + (size_t)l * DM * DIN; d.N = DIN; d.sc = sc; d.nv = nv; d.gain = p.in[2] + (size_t)l * DM;
        d.dst = p.ws + WS_WI8 + (size_t)l * 12 * MiB; d.dsc = (float*)(p.ws + WS_WISC) + l * DINP; d.drow = n0; }
    else { const int r0 = 32 * (r - 184), pn = r0 >> 8, w = r0 & 255;
        d.W = (w < 128 ? p.in[13] : p.in[14]) + (size_t)l * DM * DFF; d.N = DFF; d.sc = 128 * pn + (w & 127); d.nv = 32; d.gain = p.in[12] + (size_t)l * DM;
        d.dst = p.ws + WS_W8 + (size_t)l * 22 * MiB; d.dsc = (float*)(p.ws + WS_WSC) + l * 2 * DFF; d.drow = r0; }
    return d;
}
#define STRIP_LOAD(d, k0, tv) do { const int c_ = lane & 31; const float* wp_ = (d).W + (size_t)((k0) + (lane >> 5)) * (d).N + (d).sc + (c_ < (d).nv ? c_ : 0); \
        _Pragma("unroll") for (int i = 0; i < 32; ++i) tv[i] = wp_[(size_t)(2 * i) * (d).N]; } while (0)
#define STRIP_PUT(d, k0, tv) do { const int c_ = lane & 31, hi_ = lane >> 5; const bool ok_ = c_ < (d).nv; \
        _Pragma("unroll") for (int pp = 0; pp < 16; ++pp) { \
            auto sw_ = __builtin_amdgcn_permlane32_swap(__float_as_uint(tv[2 * pp]), __float_as_uint(tv[2 * pp + 1]), false, false); \
            const float v0_ = __uint_as_float(sw_[0]), v1_ = __uint_as_float(sw_[1]);         \
            const f32x4 g_ = *(const f32x4*)((d).gain + (k0) + 4 * pp); \
            const float g0_ = hi_ ? g_.z : g_.x, g1_ = hi_ ? g_.w : g_.y; \
            *(LAS unsigned*)(c.lds + c_ * STRIP_RS + ((k0) + 4 * pp + 2 * hi_) * 2) = ok_ ? pk2(v0_ * g0_, v1_ * g1_) : 0u; } } while (0)
__device__ __forceinline__ void conv_strips(const Params& p, const Ctx& c) {
    const int lane = c.lane, w = c.wave, total = NL * N_STRIPS_L, step = c.ngw / NWAVES;
    int s = c.bx; float ta[32], tb[32]; StripDesc d{}, d1{};
    if (s < total) { d = strip_desc(p, s); STRIP_LOAD(d, 256 * w, ta); }
    while (s < total) {
        STRIP_LOAD(d, 256 * w + 64, tb);  STRIP_PUT(d, 256 * w, ta);
        STRIP_LOAD(d, 256 * w + 128, ta); STRIP_PUT(d, 256 * w + 64, tb);
        STRIP_LOAD(d, 256 * w + 192, tb); STRIP_PUT(d, 256 * w + 128, ta);
        const int s1 = s + step;
        if (s1 < total) { d1 = strip_desc(p, s1); STRIP_LOAD(d1, 256 * w, ta); }
        STRIP_PUT(d, 256 * w + 192, tb);
        __syncthreads();
#pragma unroll 1
        for (int q = 0; q < 4; ++q) { const int n = w + 8 * q;
            bf16x8 v[4];
#pragma unroll
            for (int j = 0; j < 4; ++j) { const LAS unsigned* q_ = (const LAS unsigned*)(c.lds + n * STRIP_RS + (lane + 64 * j) * 16); u32x4 t_; t_.x = q_[0]; t_.y = q_[1]; t_.z = q_[2]; t_.w = q_[3]; v[j] = __builtin_bit_cast(bf16x8, t_); }
            float mx = 0.f;
#pragma unroll
            for (int j = 0; j < 4; ++j)
#pragma unroll
                for (int e = 0; e < 8; ++e) mx = fmaxf(mx, fabsf((float)v[j][e]));
            mx = wave_max_u(mx);
            const float inv = mx > 0.f ? 127.0f / mx : 0.f;
#pragma unroll
            for (int j = 0; j < 4; ++j) { unsigned ww[2];
#pragma unroll
                for (int h = 0; h < 2; ++h) { unsigned u = 0u;
#pragma unroll
                    for (int e = 0; e < 4; ++e) { const int qv = (int)__builtin_rintf((float)v[j][4 * h + e] * inv); u |= ((unsigned)qv & 0xFFu) << (8 * e); }
                    ww[h] = u; }
                u32x2 o; o.x = ww[0]; o.y = ww[1]; ((u32x2*)(d.dst + (size_t)(d.drow + n) * DM))[lane + 64 * j] = o; }
            if (lane == 0) d.dsc[d.drow + n] = mx * (1.0f / 127.0f); }
        __syncthreads();
        d = d1; s = s1;
    }
}
__device__ __forceinline__ void phase_conv(const Params& p, const Ctx& c) {
    LAS float* scr = (LAS float*)(c.lds + c.wave * 8704);
    const int lane = c.lane;
    { float* cbp = (float*)(p.ws + WS_CBP);
      for (int task = c.gw; task < NL * 2 * 4 * 64; task += c.ngw) { const int ic = task & 63, jg = (task >> 6) & 3, kv = (task >> 8) & 1, l = task >> 9;
          const float* w1 = p.in[kv ? 8 : 6] + (size_t)l * 4096 * 256 + (size_t)(64 * ic) * 256 + 64 * jg + c.lane; const float* cp = p.in[5] + (size_t)l * 4096 + 64 * ic;
          float s = 0.f;
#pragma unroll
          for (int b = 0; b < 4; ++b) { float wv[16];
#pragma unroll
              for (int i = 0; i < 16; ++i) wv[i] = w1[(size_t)(16 * b + i) * 256];
#pragma unroll
              for (int i = 0; i < 16; ++i) s += cp[16 * b + i] * wv[i]; }
          cbp[((l * 2 + kv) * 64 + ic) * 256 + 64 * jg + c.lane] = s; } }
    { const int total = NL * I_LAYER; int it = c.gw;
      float ta[32], tb[32]; ConvItem da, db;
      if (it < total) { da = conv_desc(p, it); CONV_LOAD(da, ta); }
      while (it < total) {
          const int i1 = it + c.ngw;
          if (i1 < total) { db = conv_desc(p, i1); CONV_LOAD(db, tb); }
          CONV_STORE(da, ta);
          if (i1 >= total) break;
          const int i2 = i1 + c.ngw;
          if (i2 < total) { da = conv_desc(p, i2); CONV_LOAD(da, ta); }
          CONV_STORE(db, tb);
          it = i2;
      } }
    __syncthreads();
    conv_strips(p, c);
    { bf16_t* hb = (bf16_t*)(p.ws + WS_XN); float* ssq = (float*)(p.ws + WS_SSQ);
      for (int m = c.gw; m < S; m += c.ngw) {
          const f32x4* xr = (const f32x4*)(p.in[0] + (size_t)m * DM) + c.lane; float ss = 0.f; f32x4 xv[8];
#pragma unroll
          for (int j = 0; j < 8; ++j) xv[j] = xr[64 * j];
#pragma unroll
          for (int j = 0; j < 8; ++j) { const f32x4 v = xv[j]; ss += (v.x * v.x + v.y * v.y) + (v.z * v.z + v.w * v.w);
              u32x2 w; w.x = pk2(v.x, v.y); w.y = pk2(v.z, v.w); ((u32x2*)(hb + (size_t)m * DM))[c.lane + 64 * j] = w; }
          ss = wave_sum(ss);
          if (c.lane < 8) ssq[(size_t)m * 8 + c.lane] = c.lane == 0 ? ss : 0.f; } }
    { const int* pos = (const int*)p.in[1]; float* tab = (float*)(p.ws + WS_ROPE); bf16_t* tabh = (bf16_t*)(p.ws + WS_ROPEH);
      for (int idx = c.gw * 64 + c.lane; idx < S * 16; idx += c.ngw * 64) { const int t = idx >> 4, i = idx & 15;
          const float ang = (float)pos[t] * rope_inv(i); float cs, sn; sincos_d(ang, cs, sn); tab[t * 32 + i] = cs; tab[t * 32 + 16 + i] = sn; tabh[t * 32 + i] = (bf16_t)f2bf(cs); tabh[t * 32 + 16 + i] = (bf16_t)f2bf(sn); } }
}

__device__ __forceinline__ void cbias_reduce(const Params& p, const Ctx& c) {
    const float* cbp = (const float*)(p.ws + WS_CBP); float* cbf = (float*)(p.ws + WS_CBF);
    for (int o = c.gw; o < NL * 2 * 256; o += c.ngw) { const int col = o & 255, lk = o >> 8;
        const float v = wave_sum(cbp[(size_t)(lk * 64 + c.lane) * 256 + col]); if (c.lane == 0) cbf[o] = v; }
}

__device__ __forceinline__ void phase_final_norm(const Ctx& c, const bf16_t* hb, const float* ssq, const float* gain, float* dst) {
    f32x4 g[4][2];
#pragma unroll
    for (int j = 0; j < 4; ++j) { g[j][0] = ((const f32x4*)gain)[2 * (c.lane + 64 * j)]; g[j][1] = ((const f32x4*)gain)[2 * (c.lane + 64 * j) + 1]; }
    for (int m = c.gw; m < S; m += c.ngw) {
        const f32x4* q = (const f32x4*)(ssq + (size_t)m * 8); const f32x4 a = q[0], b = q[1];
        bf16x8 v[4];
#pragma unroll
        for (int j = 0; j < 4; ++j) v[j] = ((const bf16x8*)(hb + (size_t)m * DM))[c.lane + 64 * j];
        const float rstd = __builtin_amdgcn_rsqf((((a.x + a.y) + (a.z + a.w)) + ((b.x + b.y) + (b.z + b.w))) * (1.0f / DM) + EPS);
#pragma unroll
        for (int j = 0; j < 4; ++j) { f32x4 o0, o1;
#pragma unroll
            for (int e = 0; e < 4; ++e) { o0[e] = (float)v[j][e] * rstd * g[j][0][e]; o1[e] = (float)v[j][4 + e] * rstd * g[j][1][e]; }
            f32x4* d = (f32x4*)(dst + (size_t)m * DM) + 2 * (c.lane + 64 * j); d[0] = o0; d[1] = o1; }
    }
}

__device__ __forceinline__ void quant_rows(const Ctx& c, const bf16_t* src, unsigned char* dst, float* scale, int R, float fixed = 0.f) {
    for (int r = c.gw; r < R; r += c.ngw) {
        bf16x8 v[4];
#pragma unroll
        for (int j = 0; j < 4; ++j) v[j] = ((const bf16x8*)(src + (size_t)r * DM))[c.lane + 64 * j];
        float mx = 0.f;
#pragma unroll
        for (int j = 0; j < 4; ++j)
#pragma unroll
            for (int e = 0; e < 8; ++e) mx = fmaxf(mx, fabsf((float)v[j][e]));
        mx = wave_max_u(mx);
        if (fixed > 0.f) mx = fixed;
        const float inv = mx > 0.f ? 127.0f / mx : 0.f;
#pragma unroll
        for (int j = 0; j < 4; ++j) { unsigned w[2];
#pragma unroll
            for (int h = 0; h < 2; ++h) { unsigned u = 0u;
#pragma unroll
                for (int e = 0; e < 4; ++e) { int q = (int)__builtin_rintf((float)v[j][4 * h + e] * inv); q = q > 127 ? 127 : (q < -127 ? -127 : q); u |= ((unsigned)q & 0xFFu) << (8 * e); }
                w[h] = u; }
            u32x2 o; o.x = w[0]; o.y = w[1]; ((u32x2*)(dst + (size_t)r * DM))[c.lane + 64 * j] = o; }
        if (c.lane == 0) scale[r] = mx * (1.0f / 127.0f);
    }
}

constexpr int RSTD_OFF = RING_BYTES, RSTD_MAX_UNITS = 8;
constexpr int CSC_OFF = RSTD_OFF + RSTD_MAX_UNITS * 1024, CSC_MAX_UNITS = 6;
static_assert(CSC_OFF + CSC_MAX_UNITS * 1024 <= MISC_OFF, "LDS map");
__device__ __forceinline__ void prep_rstd(const Ctx& c, const pg8::StaticOrder& so, const float* ssq, const float* asc = nullptr, const float* wsc = nullptr) {
    LAS float* tab = (LAS float*)(c.lds + RSTD_OFF); LAS float* ctab = (LAS float*)(c.lds + CSC_OFF);
    const int half = c.tid >> 8, t = c.tid & 255;
    for (int i = half; i < RSTD_MAX_UNITS; i += 2) { pg8::Unit u; if (!so.next(i, u)) break;
        const f32x4* q = (const f32x4*)(ssq + (size_t)(u.pm * 256 + t) * 8); const f32x4 a = q[0], b = q[1];
        float rs = __builtin_amdgcn_rsqf((((a.x + a.y) + (a.z + a.w)) + ((b.x + b.y) + (b.z + b.w))) * (1.0f / DM) + EPS);
        if (asc) { rs *= asc[u.pm * 256 + t]; if (i < CSC_MAX_UNITS) ctab[i * 256 + t] = wsc[u.pn * 256 + t]; }
        tab[i * 256 + t] = rs; }
}
struct PrepRstd { const Ctx& c; const pg8::StaticOrder& so; const float* ssq; const float* asc; const float* wsc; __device__ __forceinline__ void operator()() const { prep_rstd(c, so, ssq, asc, wsc); } };
struct EpiProj {
    static constexpr bool PERM = true, AFTER_DRAIN = false;
    bf16_t* proj; float* gates; const bf16_t* ropeh; const float* bg; const LAS float* rtab; const LAS float* ctab;
    __device__ __forceinline__ void operator()(pg8::f32x4 (&acc)[2][2][4][2], const pg8::Unit& u, int wr, int wc, int fr, int fq) const {
        const int row0 = u.pm * 256 + wr * 64 + fr;
        {
            const LAS f32x4* cs = (const LAS f32x4*)(ctab + u.ord * 256 + wc * 32 + 8 * fq);
#pragma unroll
            for (int bj = 0; bj < 2; ++bj) { const f32x4 c0 = cs[32 * bj], c1 = cs[32 * bj + 1];
#pragma unroll
                for (int ai = 0; ai < 2; ++ai)
#pragma unroll
                    for (int m = 0; m < 4; ++m) { const pg8::i32x4 i0 = __builtin_bit_cast(pg8::i32x4, acc[ai][bj][m][0]), i1 = __builtin_bit_cast(pg8::i32x4, acc[ai][bj][m][1]);
#pragma unroll
                        for (int j = 0; j < 4; ++j) { acc[ai][bj][m][0][j] = (float)i0[j] * c0[j]; acc[ai][bj][m][1][j] = (float)i1[j] * c1[j]; } } }
        }
        float rstd[2][4];
#pragma unroll
        for (int ai = 0; ai < 2; ++ai)
#pragma unroll
            for (int m = 0; m < 4; ++m) rstd[ai][m] = rtab[u.ord * 256 + ai * 128 + wr * 64 + m * 16 + fr];
        const bool rp = (u.pn < 4 || u.pn == 6 || u.pn == 8) && wc == 0;
        if (rp) {
#pragma unroll
            for (int ai = 0; ai < 2; ++ai) {
                bf16x8 rc[4], rsn[4];
#pragma unroll
                for (int m = 0; m < 4; ++m) { const bf16_t* cs = ropeh + (size_t)(row0 + ai * 128 + m * 16) * 32 + (fq & 1) * 8; rc[m] = *(const bf16x8*)cs; rsn[m] = *(const bf16x8*)(cs + 16); }
#pragma unroll
                for (int m = 0; m < 4; ++m) {
                    f32x4 c0, c1, s0, s1;
#pragma unroll
                    for (int j = 0; j < 4; ++j) { c0[j] = (float)rc[m][j]; c1[j] = (float)rc[m][4 + j]; s0[j] = (float)rsn[m][j]; s1[j] = (float)rsn[m][4 + j]; }
                    if (fq < 2) { s0 = -s0; s1 = -s1; }
#pragma unroll
                    for (int bj = 0; bj < 2; ++bj) {
                        const f32x4 v0 = acc[ai][bj][m][0] * rstd[ai][m], v1 = acc[ai][bj][m][1] * rstd[ai][m]; f32x4 q0, q1;
#pragma unroll
                        for (int j = 0; j < 4; ++j) { q0[j] = partner32(v0[j], fq >> 1); q1[j] = partner32(v1[j], fq >> 1); }
                        acc[ai][bj][m][0] = v0 * c0 + q0 * s0; acc[ai][bj][m][1] = v1 * c1 + q1 * s1;
                    }
                }
            }
        }
        if (u.pn < 22) {
#pragma unroll
            for (int bj = 0; bj < 2; ++bj) {
                bf16_t* base = proj + (size_t)(2 * u.pn + bj) * S * HD + wc * 32 + 8 * fq;
#pragma unroll
                for (int ai = 0; ai < 2; ++ai)
#pragma unroll
                    for (int m = 0; m < 4; ++m) {
                        const float rs = rp ? 1.0f : rstd[ai][m];
                        const f32x4 v0 = acc[ai][bj][m][0] * rs, v1 = acc[ai][bj][m][1] * rs;
                        u32x4 w; w.x = pk2(v0[0], v0[1]); w.y = pk2(v0[2], v0[3]); w.z = pk2(v1[0], v1[1]); w.w = pk2(v1[2], v1[3]);
                        { bf16_t* sp_ = base + (size_t)(row0 + ai * 128 + m * 16) * HD; asm volatile("global_store_dwordx4 %0, %1, off sc1\n\ts_nop 1" :: "v"(sp_), "v"(w) : "memory"); }
                    }
            }
        } else {
            if (wc == 0 && fq < 3) {
                const f32x4 b0 = *(const f32x4*)(bg + 8 * fq), b1 = *(const f32x4*)(bg + 8 * fq + 4);
#pragma unroll
                for (int ai = 0; ai < 2; ++ai)
#pragma unroll
                    for (int m = 0; m < 4; ++m) {
                        f32x4 g0 = acc[ai][0][m][0] * rstd[ai][m] + b0, g1 = acc[ai][0][m][1] * rstd[ai][m] + b1;
#pragma unroll
                        for (int j = 0; j < 4; ++j) { g0[j] = sigmoidf_(g0[j]); g1[j] = sigmoidf_(g1[j]); }
                        f32x4* d = (f32x4*)(gates + (size_t)(row0 + ai * 128 + m * 16) * 24 + 8 * fq); d[0] = g0; d[1] = g1;
                    }
            }
        }
    }
};
struct EpiResid {
    static constexpr bool PERM = false, AFTER_DRAIN = false;
    const float* hin; float* hout;
    __device__ __forceinline__ void operator()(const pg8::f32x4 (&acc)[2][2][4][2], const pg8::Unit& u, int wr, int wc, int fr, int fq) const {
        const int row0 = u.pm * 256 + wr * 64 + fr, col0 = u.pn * 256 + wc * 32 + 4 * fq;
#pragma unroll
        for (int ai = 0; ai < 2; ++ai)
#pragma unroll
            for (int m = 0; m < 4; ++m) { const size_t off = (size_t)(row0 + ai * 128 + m * 16) * DM + col0;
#pragma unroll
                for (int bj = 0; bj < 2; ++bj)
#pragma unroll
                    for (int n = 0; n < 2; ++n) { const size_t o = off + bj * 128 + n * 16; *(f32x4*)(hout + o) = *(const f32x4*)(hin + o) + acc[ai][bj][m][n]; } }
    }
};
struct EpiResidH {
    static constexpr bool PERM = true, AFTER_DRAIN = true;
    bf16_t* hb; float* ssq; unsigned char* h8; float mult;
    __device__ __forceinline__ void fused(pg8::f32x4 (&acc)[2][2][4][2], const pg8::Unit& u, int wr, int wc, int fr, int fq, PG8_LAS unsigned char* lds, int wid, int lane) const {
        const int row0 = u.pm * 256 + wr * 64 + fr, col0 = u.pn * 256 + wc * 32 + 8 * fq;
        PG8_LAS float* P = (PG8_LAS float*)lds;
#pragma unroll
        for (int ai = 0; ai < 2; ++ai) {
            bf16x8 hv[2][4][2];
#pragma unroll
            for (int m = 0; m < 4; ++m)
#pragma unroll
                for (int bj = 0; bj < 2; ++bj) hv[ai][m][bj] = *(const bf16x8*)(hb + (size_t)(row0 + ai * 128 + m * 16) * DM + col0 + bj * 128);
#pragma unroll
            for (int m = 0; m < 4; ++m) { const size_t off = (size_t)(row0 + ai * 128 + m * 16) * DM + col0; float ss = 0.f;
#pragma unroll
                for (int bj = 0; bj < 2; ++bj) { f32x4 v0 = acc[ai][bj][m][0] * mult, v1 = acc[ai][bj][m][1] * mult;
#pragma unroll
                    for (int e = 0; e < 4; ++e) { v0[e] += (float)hv[ai][m][bj][e]; v1[e] += (float)hv[ai][m][bj][4 + e]; }
                    u32x4 w; w.x = pk2(v0.x, v0.y); w.y = pk2(v0.z, v0.w); w.z = pk2(v1.x, v1.y); w.w = pk2(v1.z, v1.w); *(u32x4*)(hb + off + bj * 128) = w;
                    if (h8) { int w0 = 0, w1 = 0;
                        w0 = __builtin_amdgcn_cvt_pk_fp8_f32(v0.x * A8_SCALE, v0.y * A8_SCALE, w0, false); w0 = __builtin_amdgcn_cvt_pk_fp8_f32(v0.z * A8_SCALE, v0.w * A8_SCALE, w0, true);
                        w1 = __builtin_amdgcn_cvt_pk_fp8_f32(v1.x * A8_SCALE, v1.y * A8_SCALE, w1, false); w1 = __builtin_amdgcn_cvt_pk_fp8_f32(v1.z * A8_SCALE, v1.w * A8_SCALE, w1, true);
                        u32x2 w8; w8.x = (unsigned)w0; w8.y = (unsigned)w1; *(u32x2*)(h8 + off + bj * 128) = w8; }
                    ss += ((v0.x * v0.x + v0.y * v0.y) + (v0.z * v0.z + v0.w * v0.w)) + ((v1.x * v1.x + v1.y * v1.y) + (v1.z * v1.z + v1.w * v1.w)); }
                ss += __builtin_bit_cast(float, __builtin_amdgcn_ds_swizzle(__builtin_bit_cast(int, ss), 0x401F)); ss += partner32(ss, fq >> 1);
                if (fq == 0) P[(ai * 128 + wr * 64 + m * 16 + fr) * 4 + wc] = ss;
                asm volatile("" ::: "memory"); } }
        asm volatile("s_waitcnt lgkmcnt(0)" ::: "memory"); __builtin_amdgcn_s_barrier(); asm volatile("" ::: "memory");
        const int t = wid * 64 + lane;
        if (t < 256) { const PG8_LAS float* q = P + t * 4; ssq[(size_t)(u.pm * 256 + t) * 8 + u.pn] = (q[0] + q[1]) + (q[2] + q[3]); }
    }
};
struct EpiSwiGLU {
    static constexpr bool PERM = true, AFTER_DRAIN = false;
    unsigned char* act; const LAS float* rtab; const LAS float* ctab;
    __device__ __forceinline__ void operator()(const pg8::f32x4 (&acc)[2][2][4][2], const pg8::Unit& u, int wr, int wc, int fr, int fq) const {
        const int row0 = u.pm * 256 + wr * 64 + fr, col0 = u.pn * 128 + wc * 32 + 8 * fq;
        const LAS f32x4* cs = (const LAS f32x4*)(ctab + u.ord * 256 + wc * 32 + 8 * fq);
        const f32x4 cg0 = cs[0], cg1 = cs[1], cu0 = cs[32], cu1 = cs[33];
#pragma unroll
        for (int ai = 0; ai < 2; ++ai)
#pragma unroll
            for (int m = 0; m < 4; ++m) {
                const float rs = rtab[u.ord * 256 + ai * 128 + wr * 64 + m * 16 + fr];
                f32x4 g0, g1, u0, u1;
                const pg8::i32x4 ig0 = __builtin_bit_cast(pg8::i32x4, acc[ai][0][m][0]), ig1 = __builtin_bit_cast(pg8::i32x4, acc[ai][0][m][1]);
                const pg8::i32x4 iu0 = __builtin_bit_cast(pg8::i32x4, acc[ai][1][m][0]), iu1 = __builtin_bit_cast(pg8::i32x4, acc[ai][1][m][1]);
#pragma unroll
                for (int j = 0; j < 4; ++j) {
                    g0[j] = (float)ig0[j] * (rs * cg0[j]); g1[j] = (float)ig1[j] * (rs * cg1[j]);
                    u0[j] = (float)iu0[j] * (rs * cu0[j]); u1[j] = (float)iu1[j] * (rs * cu1[j]); }
                f32x4 o0, o1;
#pragma unroll
                for (int j = 0; j < 4; ++j) { o0[j] = g0[j] * sigmoidf_(g0[j]) * u0[j]; o1[j] = g1[j] * sigmoidf_(g1[j]) * u1[j]; }
                int w0 = 0, w1 = 0;
                w0 = __builtin_amdgcn_cvt_pk_fp8_f32(o0[0] * A8_SCALE, o0[1] * A8_SCALE, w0, false); w0 = __builtin_amdgcn_cvt_pk_fp8_f32(o0[2] * A8_SCALE, o0[3] * A8_SCALE, w0, true);
                w1 = __builtin_amdgcn_cvt_pk_fp8_f32(o1[0] * A8_SCALE, o1[1] * A8_SCALE, w1, false); w1 = __builtin_amdgcn_cvt_pk_fp8_f32(o1[2] * A8_SCALE, o1[3] * A8_SCALE, w1, true);
                u32x2 w; w.x = (unsigned)w0; w.y = (unsigned)w1;
                { unsigned char* sp_ = act + (size_t)(row0 + ai * 128 + m * 16) * DFF + col0; asm volatile("global_store_dwordx2 %0, %1, off sc1\n\ts_nop 1" :: "v"(sp_), "v"(w) : "memory"); }
            }
    }
};

constexpr int CMPR_A_BYTES = 272 * 256 + 17 * 16, CMPR_HID = 70144;
__device__ __forceinline__ void phase_cmpr(const Params& p, const Ctx& c, int l) {
    const bf16_t* proj = (const bf16_t*)(p.ws + WS_PROJ); const float* rope = (const float*)(p.ws + WS_ROPE); const float* cbf = (const float*)(p.ws + WS_CBF);
    LAS bf16_t* hid = (LAS bf16_t*)(c.lds + CMPR_HID);
    const int lane = c.lane, w = c.wave, l15 = lane & 15, q4 = lane >> 4;
    const int u = c.bx >> 1, hh = c.bx & 1;
    const int kv = u >> 6, g = (u >> 5) & 1, rb = u & 31, n0 = 16 * rb;
    { bf16x8 sv[9];
      const bf16_t* src = proj + (size_t)((kv ? 10 : 8) + g) * S * HD;
#pragma unroll
      for (int i = 0; i < 9; ++i) { int ci = c.tid + NTHREADS * i; if (ci > 272 * 16 - 1) ci = 272 * 16 - 1; const int tk = ci >> 4, ch = ci & 15; int ta = 16 * n0 + tk; if (ta > S - 1) ta = S - 1;
          sv[i] = *(const bf16x8*)(src + (size_t)ta * HD + ch * 8); }
#pragma unroll
      for (int i = 0; i < 9; ++i) { const int ci = c.tid + NTHREADS * i; const int tk = ci >> 4, ch = ci & 15;
          if (ci < 272 * 16) *(LAS bf16x8*)(c.lds + tk * 256 + (tk >> 4) * 16 + ch * 16) = sv[i]; } }
    __syncthreads();
    const int ct = 8 * hh + w;
    const bf16_t* bf = w_ptr(p, l, W_C1) + (size_t)kv * 256 * 4096 + (size_t)ct * 128 * 512 + lane * 8;
    const LAS unsigned char* abase = c.lds + l15 * (4096 + 16) + q4 * 16;
    f32x4 acc = {0.f, 0.f, 0.f, 0.f};
    {
        bf16x8 B0[8], B1[8];
#define CMPR_LD(B_, ks_) do { _Pragma("unroll") for (int i = 0; i < 8; ++i) B_[i] = *(const bf16x8*)(bf + (size_t)((ks_) + i) * 512); } while (0)
#define CMPR_MM(B_, ks_) do { _Pragma("unroll") for (int i = 0; i < 8; ++i) { const int k_ = 32 * ((ks_) + i); \
            const bf16x8 a_ = *(const LAS bf16x8*)(abase + (k_ >> 7) * 256 + ((k_ >> 7) >= 16 ? 16 : 0) + (k_ & 127) * 2); \
            acc = __builtin_amdgcn_mfma_f32_16x16x32_f16(a_, B_[i], acc, 0, 0, 0); } } while (0)
        CMPR_LD(B0, 0);
        for (int ks = 0; ks < 128; ks += 16) {
            CMPR_LD(B1, ks + 8);
            CMPR_MM(B0, ks);
            if (ks + 16 < 128) CMPR_LD(B0, ks + 16);
            CMPR_MM(B1, ks + 8);
        }
#undef CMPR_LD
#undef CMPR_MM
    }
    { const int col = 16 * ct + l15; const float bs = cbf[(l * 2 + kv) * 256 + col];
#pragma unroll
      for (int j = 0; j < 4; ++j) hid[(q4 * 4 + j) * 136 + 16 * w + l15] = (bf16_t)f2bf(gelu_tanh(acc[j] + bs)); }
    __syncthreads();
    f32x4 o = {0.f, 0.f, 0.f, 0.f};
    const int ocol = (w < 2) ? ((l15 < 8) ? 8 * w + l15 : 16 + 8 * w + (l15 - 8)) : 16 * w + l15;
    const bf16_t* w2 = w_ptr(p, l, W_C2) + (size_t)kv * 128 * 256 + (size_t)ocol * 256 + 128 * hh + 8 * q4;
#pragma unroll
    for (int k0 = 0; k0 < 128; k0 += 32) {
        const bf16x8 a = *(const LAS bf16x8*)(hid + l15 * 136 + k0 + 8 * q4), b = *(const bf16x8*)(w2 + k0);
        o = __builtin_amdgcn_mfma_f32_16x16x32_f16(a, b, o, 0, 0, 0);
    }
    float* part = (float*)(p.ws + WS_CPART) + (size_t)u * 2048; unsigned* flag = (unsigned*)(p.ws + WS_CTL) + CW_CFLAG + 64 * u;
    if (hh == 1) {
#pragma unroll
        for (int j = 0; j < 4; ++j) __hip_atomic_store(part + (q4 * 4 + j) * 128 + 16 * w + l15, o[j], __ATOMIC_RELAXED, __HIP_MEMORY_SCOPE_AGENT);
        asm volatile("s_waitcnt vmcnt(0)" ::: "memory");
        __syncthreads();
        if (c.tid == 0) __hip_atomic_store(flag, (unsigned)(l + 1), __ATOMIC_RELAXED, __HIP_MEMORY_SCOPE_AGENT);
    } else {
        if (c.tid == 0) { unsigned spins = 0; while (__hip_atomic_load(flag, __ATOMIC_RELAXED, __HIP_MEMORY_SCOPE_AGENT) != (unsigned)(l + 1) && ++spins < (1u << 22)) __builtin_amdgcn_s_sleep(2); }
        __syncthreads();
        __builtin_amdgcn_fence(__ATOMIC_ACQUIRE, "agent");
        asm volatile("s_waitcnt vmcnt(0)" ::: "memory");
        bf16_t* dst = (bf16_t*)(p.ws + (kv ? WS_VC : WS_KC)) + (size_t)g * 512 * HD;
        float pv[4], cs[4], sn[4];
#pragma unroll
        for (int j = 0; j < 4; ++j) { pv[j] = part[(q4 * 4 + j) * 128 + 16 * w + l15]; cs[j] = 1.f; sn[j] = 0.f;
            if (kv == 0 && w < 2) { int ti = 16 * (n0 + q4 * 4 + j) + 31; if (ti > S - 1) ti = S - 1; const int fi = 8 * w + (l15 & 7); cs[j] = rope[ti * 32 + fi]; sn[j] = rope[ti * 32 + 16 + fi]; } }
#pragma unroll
        for (int j = 0; j < 4; ++j) {
            const int n = n0 + q4 * 4 + j; float v = o[j] + pv[j];
            if (kv == 0 && w < 2) { const float pr = DPP_F(0.f, v, 0x128, 0xf);     v = (l15 < 8) ? v * cs[j] - pr * sn[j] : v * cs[j] + pr * sn[j]; }
            if (n > 510) v = 0.f;
            dst[(size_t)n * HD + ocol] = (bf16_t)f2bf(v);
        }
    }
    __syncthreads();
}
typedef float f32x16 __attribute__((ext_vector_type(16)));
typedef _Float16 h4_t __attribute__((ext_vector_type(4)));
#define KSWZ(row, colB) ((row) * 256 + ((colB) ^ (((row) & 7) << 4)))
__device__ __forceinline__ int v_st(int k, int c) { const int kk = (k & ~0xC) | ((k & 4) << 1) | ((k & 8) >> 1); return ((kk >> 3) * 4 + (c >> 5)) * 512 + ((kk & 7) * 32 + (c & 31)) * 2; }
__device__ __forceinline__ int v_rd_base(int lane) { return ((lane & 3) << 3) | (((lane >> 2) & 3) << 6) | (((lane >> 4) & 1) << 5) | (((lane >> 5) & 1) << 8); }
constexpr int v_rd_off(int d0, int ks, int half) { return d0 * 512 + ks * 4096 + half * 2048; }
__device__ __forceinline__ int crow(int r, int hi) { return (r & 3) + 8 * (r >> 2) + 4 * hi; }
__device__ __forceinline__ void qkt(f32x16& p0, f32x16& p1, const LAS char* K_lds, int r32, int hi, const bf16x8* qr) {
#pragma unroll
    for (int r = 0; r < 16; ++r) { p0[r] = 0.f; p1[r] = 0.f; }
    int base = r32 * 256 + ((hi * 16) ^ ((r32 & 7) << 4));
    asm volatile("" : "+v"(base));
#pragma unroll
    for (int d0 = 0; d0 < 8; ++d0) { const LAS char* a = K_lds + (base ^ ((d0 & 3) << 5)) + (d0 >> 2) * 128;
        const bf16x8 b0 = *(const LAS bf16x8*)a, b1 = *(const LAS bf16x8*)(a + 32 * 256);
        p0 = __builtin_amdgcn_mfma_f32_32x32x16_f16(b0, qr[d0], p0, 0, 0, 0);
        p1 = __builtin_amdgcn_mfma_f32_32x32x16_f16(b1, qr[d0], p1, 0, 0, 0);
        if (d0 == 3) __builtin_amdgcn_sched_barrier(0); }
}
__device__ __forceinline__ void pack_p(const f32x16& p0, const f32x16& p1, bf16x8& pa0, bf16x8& pa1, bf16x8& pa2, bf16x8& pa3) {
#define PK4(P, B_, OUT) do { const unsigned a0 = pk2(P[B_ + 0], P[B_ + 1]), a1 = pk2(P[B_ + 2], P[B_ + 3]), b0 = pk2(P[B_ + 4], P[B_ + 5]), b1 = pk2(P[B_ + 6], P[B_ + 7]); \
        auto r0 = __builtin_amdgcn_permlane32_swap(a0, b0, false, false); auto r1 = __builtin_amdgcn_permlane32_swap(a1, b1, false, false); \
        u32x4 w = {r0[0], r1[0], r0[1], r1[1]}; OUT = __builtin_bit_cast(bf16x8, w); } while (0)
    PK4(p0, 0, pa0); PK4(p0, 8, pa1); PK4(p1, 0, pa2); PK4(p1, 8, pa3);
#undef PK4
}
__device__ __forceinline__ void pv_tile(f32x16* o, int vb0, bf16x8 pa0, bf16x8 pa1, bf16x8 pa2, bf16x8 pa3) {
#define TRRD(dst, off) asm volatile("ds_read_b64_tr_b16 %0, %1 offset:%2" : "=&v"(dst) : "v"(vb0), "i"(off) : "memory")
#define PV_D0(d0) do { h4_t l0, l1, l2, l3, h0, h1, h2, h3; constexpr int b_ = v_rd_off(d0, 0, 0); \
        TRRD(l0, b_); TRRD(h0, b_ + 2048); TRRD(l1, b_ + 4096); TRRD(h1, b_ + 6144); TRRD(l2, b_ + 8192); TRRD(h2, b_ + 10240); TRRD(l3, b_ + 12288); TRRD(h3, b_ + 14336); \
        asm volatile("s_waitcnt lgkmcnt(0)" ::: "memory"); __builtin_amdgcn_sched_barrier(0); \
        o[d0] = __builtin_amdgcn_mfma_f32_32x32x16_f16(pa0, (bf16x8){l0[0], l0[1], l0[2], l0[3], h0[0], h0[1], h0[2], h0[3]}, o[d0], 0, 0, 0); \
        o[d0] = __builtin_amdgcn_mfma_f32_32x32x16_f16(pa1, (bf16x8){l1[0], l1[1], l1[2], l1[3], h1[0], h1[1], h1[2], h1[3]}, o[d0], 0, 0, 0); \
        o[d0] = __builtin_amdgcn_mfma_f32_32x32x16_f16(pa2, (bf16x8){l2[0], l2[1], l2[2], l2[3], h2[0], h2[1], h2[2], h2[3]}, o[d0], 0, 0, 0); \
        o[d0] = __builtin_amdgcn_mfma_f32_32x32x16_f16(pa3, (bf16x8){l3[0], l3[1], l3[2], l3[3], h3[0], h3[1], h3[2], h3[3]}, o[d0], 0, 0, 0); } while (0)
    PV_D0(0); PV_D0(1); PV_D0(2); PV_D0(3);
#undef PV_D0
#undef TRRD
}

__device__ __forceinline__ void qkt_half(f32x16& ph, const LAS char* K_lds, int half, int r32, int hi, const bf16x8* qr) {
#pragma unroll
    for (int r = 0; r < 16; ++r) ph[r] = 0.f;
    int base = r32 * 256 + ((hi * 16) ^ ((r32 & 7) << 4)) + half * 8192;
    asm volatile("" : "+v"(base));
    __builtin_amdgcn_s_setprio(1);
#pragma unroll
    for (int d0 = 0; d0 < 8; ++d0) { const LAS char* a = K_lds + (base ^ ((d0 & 3) << 5)) + (d0 >> 2) * 128;
        const bf16x8 b0 = *(const LAS bf16x8*)a;
        ph = __builtin_amdgcn_mfma_f32_32x32x16_f16(b0, qr[d0], ph, 0, 0, 0); }
    __builtin_amdgcn_s_setprio(0);
}
__device__ __forceinline__ void pack_half(const f32x16& ph, bf16x8& pa0, bf16x8& pa1) {
#define PK4(P, B_, OUT) do { const unsigned a0 = pk2(P[B_ + 0], P[B_ + 1]), a1 = pk2(P[B_ + 2], P[B_ + 3]), b0 = pk2(P[B_ + 4], P[B_ + 5]), b1 = pk2(P[B_ + 6], P[B_ + 7]); \
        auto r0 = __builtin_amdgcn_permlane32_swap(a0, b0, false, false); auto r1 = __builtin_amdgcn_permlane32_swap(a1, b1, false, false); \
        u32x4 w = {r0[0], r1[0], r0[1], r1[1]}; OUT = __builtin_bit_cast(bf16x8, w); } while (0)
    PK4(ph, 0, pa0); PK4(ph, 8, pa1);
#undef PK4
}
__device__ __forceinline__ void pv_half(f32x16* o, int vbh, bf16x8 pa0, bf16x8 pa1) {
#define TRRD(dst, off) asm volatile("ds_read_b64_tr_b16 %0, %1 offset:%2" : "=&v"(dst) : "v"(vbh), "i"(off) : "memory")
    h4_t l0[4], h0[4], l1[4], h1[4];
#define PV_RD(d0) do { constexpr int b_ = v_rd_off(d0, 0, 0); TRRD(l0[d0], b_); TRRD(h0[d0], b_ + 2048); TRRD(l1[d0], b_ + 4096); TRRD(h1[d0], b_ + 6144); } while (0)
    PV_RD(0); PV_RD(1); PV_RD(2); PV_RD(3);
    asm volatile("s_waitcnt lgkmcnt(0)" ::: "memory"); __builtin_amdgcn_sched_barrier(0);
    __builtin_amdgcn_s_setprio(1);
#pragma unroll
    for (int d0 = 0; d0 < 4; ++d0) {
        o[d0] = __builtin_amdgcn_mfma_f32_32x32x16_f16(pa0, (bf16x8){l0[d0][0], l0[d0][1], l0[d0][2], l0[d0][3], h0[d0][0], h0[d0][1], h0[d0][2], h0[d0][3]}, o[d0], 0, 0, 0);
        o[d0] = __builtin_amdgcn_mfma_f32_32x32x16_f16(pa1, (bf16x8){l1[d0][0], l1[d0][1], l1[d0][2], l1[d0][3], h1[d0][0], h1[d0][1], h1[d0][2], h1[d0][3]}, o[d0], 0, 0, 0); }
    __builtin_amdgcn_s_setprio(0);
#undef PV_RD
#undef TRRD
}

__device__ __forceinline__ float wave_max_dpp(float v) {
    v = fmaxf(v, DPP_F(v, v, 0x111, 0xf)); v = fmaxf(v, DPP_F(v, v, 0x112, 0xf)); v = fmaxf(v, DPP_F(v, v, 0x114, 0xf)); v = fmaxf(v, DPP_F(v, v, 0x118, 0xf));
    v = fmaxf(v, DPP_F(v, v, 0x142, 0xa)); v = fmaxf(v, DPP_F(v, v, 0x143, 0xc));
    return __builtin_bit_cast(float, __builtin_amdgcn_readlane(__builtin_bit_cast(int, v), 63));
}
__device__ __forceinline__ float half_sum_dpp(float v, int hi) {
    v += DPP_F(0.f, v, 0x111, 0xf); v += DPP_F(0.f, v, 0x112, 0xf); v += DPP_F(0.f, v, 0x114, 0xf); v += DPP_F(0.f, v, 0x118, 0xf);
    v += DPP_F(0.f, v, 0x142, 0xa);
    const float lo = __builtin_bit_cast(float, __builtin_amdgcn_readlane(__builtin_bit_cast(int, v), 31)), hs = __builtin_bit_cast(float, __builtin_amdgcn_readlane(__builtin_bit_cast(int, v), 63));
    return hi ? hs : lo;
}

__device__ __forceinline__ float quad_swap1(float x) { return __int_as_float(__builtin_amdgcn_update_dpp(0, __float_as_int(x), 0xB1, 0xF, 0xF, true)); }
__device__ __forceinline__ void store_row4(bf16_t* orow_e  , float v0, float v1, float v2, float v3, int odd) {
    { const float y = quad_swap1(odd ? v0 : v1); *(unsigned*)(orow_e + (odd ? 32 : 0)) = odd ? pk2(y, v1) : pk2(v0, y); }
    { const float y = quad_swap1(odd ? v2 : v3); *(unsigned*)(orow_e + (odd ? 96 : 64)) = odd ? pk2(y, v3) : pk2(v2, y); }
}
__device__ __forceinline__ void store_head_rows(const f32x16* o, const float* ggrp_h, bf16_t* Obase  , int r32, int hi) {
    float gg[4];
#pragma unroll
    for (int d0 = 0; d0 < 4; ++d0) gg[d0] = ggrp_h[d0 * 32 + r32];
    const int odd = r32 & 1;
#pragma unroll
    for (int r = 0; r < 16; ++r) {
        const float ss = half_sum_dpp((o[0][r] * o[0][r] + o[1][r] * o[1][r]) + (o[2][r] * o[2][r] + o[3][r] * o[3][r]), hi);
        const float rs = __builtin_amdgcn_rsqf(ss * (1.0f / HD) + EPS);
        store_row4(Obase + (size_t)crow(r, hi) * DM + (r32 & ~1), o[0][r] * rs * gg[0], o[1][r] * rs * gg[1], o[2][r] * rs * gg[2], o[3][r] * rs * gg[3], odd);
    }
}


enum { M_CSTAT = 0, M_CIMP = 1, M_SLC = 2, M_CPV = 3, M_WSTAT = 4, M_WPV = 5, M_SB = 6 };
constexpr int ATT_WS = 0, ATT_FLAGS = 2048, NSA_SEL = 2112, NSA_WUNI = 3136, ATT_V0 = 4096, ATT_K0 = ATT_V0 + 3 * 16384, NSA_P = ATT_V0  ;
constexpr int ATT_END = ATT_K0 + 4 * 16384;
constexpr int TNONE = 128;
static_assert(ATT_END <= MISC_OFF, "LDS map");
__device__ __forceinline__ int next_bit(unsigned m0, unsigned m1, unsigned m2, unsigned m3, int from) {
    if (from < 32) { const unsigned w = m0 & (~0u << from); if (w) return __builtin_ctz(w); from = 32; }
    if (from < 64) { const unsigned w = m1 & (~0u << (from - 32)); if (w) return 32 + __builtin_ctz(w); from = 64; }
    if (from < 96) { const unsigned w = m2 & (~0u << (from - 64)); if (w) return 64 + __builtin_ctz(w); from = 96; }
    if (from < 128) { const unsigned w = m3 & (~0u << (from - 96)); if (w) return 96 + __builtin_ctz(w); }
    return 128;
}
__device__ __forceinline__ unsigned bit_of(unsigned m0, unsigned m1, unsigned m2, unsigned m3, int j) { const unsigned w = j < 32 ? m0 : j < 64 ? m1 : j < 96 ? m2 : m3; return (w >> (j & 31)) & 1u; }
__device__ __forceinline__ float quad_sum(float x) {
    x += __builtin_bit_cast(float, __builtin_amdgcn_update_dpp(0, __builtin_bit_cast(int, x), 0xB1, 0xf, 0xf, true));
    x += __builtin_bit_cast(float, __builtin_amdgcn_update_dpp(0, __builtin_bit_cast(int, x), 0x4E, 0xf, 0xf, true));
    return x;
}
struct PassArgs {
    const bf16_t* Kp; const bf16_t* Vp;
    unsigned tm0, tm1, tm2, tm3;
    unsigned wm0, wm1, wm2, wm3;
    unsigned sw0, sw1, sw2, sw3;
    int tok, nvr, b, nvmin;
    int jtop, tw0;
    float f;
};
template <int MODE>
__device__ __forceinline__ void attn_pass(const Ctx& c, const bf16x8 (&qr)[8], f32x16 (&o)[4], float& m, float& l, const PassArgs& a) {
    constexpr bool SB = (MODE == M_SB);
    constexpr bool HASV = (MODE == M_SLC || MODE == M_CPV || MODE == M_WPV || SB);
    constexpr bool CMP = (MODE == M_CSTAT || MODE == M_CIMP || MODE == M_CPV);
    constexpr bool WIN = (MODE == M_WSTAT || MODE == M_WPV);
    constexpr int HA = SB ? 1 : 0, HB = SB ? 0 : 1;
    constexpr float C2 = SCALE * 1.4426950408889634f;
    const int lane = c.lane, w = c.wave, r32 = lane & 31, hi = lane >> 5;
    LAS char* V_lds = (LAS char*)c.lds + ATT_V0; LAS char* K_lds = (LAS char*)c.lds + ATT_K0;
    LAS float* wsf = (LAS float*)(c.lds + ATT_WS) + w * 64;
    volatile LAS unsigned* flags = (volatile LAS unsigned*)(c.lds + ATT_FLAGS);
    unsigned kg0, kg1, vg0, vg1;
    { const int A0 = 16 * (64 * w + lane), A1 = A0 + 8192;
      { const int row = A0 >> 8, cB = (A0 & 255) ^ ((row & 7) << 4); kg0 = (unsigned)(row * HD * 2 + cB); }
      { const int row = A1 >> 8, cB = (A1 & 255) ^ ((row & 7) << 4); kg1 = (unsigned)(row * HD * 2 + cB); }
      { const int st = A0 >> 9, wi = A0 & 511, kk = (st >> 2) * 8 + (wi >> 6), cc = (st & 3) * 32 + ((wi & 63) >> 1), k = (kk & ~0xC) | ((kk & 4) << 1) | ((kk & 8) >> 1); vg0 = (unsigned)((k * HD + cc) * 2); }
      { const int st = A1 >> 9, wi = A1 & 511, kk = (st >> 2) * 8 + (wi >> 6), cc = (st & 3) * 32 + ((wi & 63) >> 1), k = (kk & ~0xC) | ((kk & 4) << 1) | ((kk & 8) >> 1); vg1 = (unsigned)((k * HD + cc) * 2); } }
    const int vb0 = (int)(unsigned)(size_t)V_lds + v_rd_base(lane);
    const float NEG = -__builtin_inff();
    bool done = false;
#define AP_NEXT(j_) (SB ? ((j_) > 0 ? (j_) - 1 : TNONE) : next_bit(a.tm0, a.tm1, a.tm2, a.tm3, (j_) + 1))
#define AP_ACT(j_) (SB ? (!done && 64 * (j_) <= a.tw0 + 30) : (bit_of(a.wm0, a.wm1, a.wm2, a.wm3, (j_)) != 0u))
#define AP_DMAK(j_, buf) do { const bf16_t* g_ = a.Kp + (size_t)(64 * (j_)) * HD; \
        __builtin_amdgcn_global_load_lds((const unsigned*)((const char*)g_ + kg0), (LAS unsigned*)(K_lds + (buf) * 16384 + w * 1024), 16, 0, 0); \
        __builtin_amdgcn_global_load_lds((const unsigned*)((const char*)g_ + kg1), (LAS unsigned*)(K_lds + (buf) * 16384 + 8192 + w * 1024), 16, 0, 0); } while (0)
#define AP_DMAV(j_, buf) do { if (HASV) { const bf16_t* g_ = a.Vp + (size_t)(64 * (j_)) * HD; \
        __builtin_amdgcn_global_load_lds((const unsigned*)((const char*)g_ + vg0), (LAS unsigned*)(V_lds + (buf) * 16384 + w * 1024), 16, 0, 0); \
        __builtin_amdgcn_global_load_lds((const unsigned*)((const char*)g_ + vg1), (LAS unsigned*)(V_lds + (buf) * 16384 + 8192 + w * 1024), 16, 0, 0); } } while (0)
#define AP_WAITN(full) do { if (full) { if (HASV) asm volatile("s_waitcnt vmcnt(4)" ::: "memory"); else asm volatile("s_waitcnt vmcnt(2)" ::: "memory"); } \
                            else asm volatile("s_waitcnt vmcnt(0)" ::: "memory"); } while (0)
    int j0 = SB ? a.jtop : next_bit(a.tm0, a.tm1, a.tm2, a.tm3, 0);
    if (j0 >= TNONE) return;
    int j1 = AP_NEXT(j0), j2 = j1 < TNONE ? AP_NEXT(j1) : TNONE, j3 = j2 < TNONE ? AP_NEXT(j2) : TNONE;
    int kc = 0, vc = 0;
    f32x16 pX, pY;
    bf16x8 kf[4];
    float carry = 0.f;
    __syncthreads();
    AP_DMAK(j0, 0); AP_DMAV(j0, 0);
    if (j1 < TNONE) AP_DMAK(j1, 1);
    bool full = j2 < TNONE;
    if (j2 < TNONE) AP_DMAK(j2, 2);
    if (j1 < TNONE) AP_DMAV(j1, 1);
    AP_WAITN(full); __syncthreads();
    if (AP_ACT(j0)) qkt_half(pX, K_lds, HA, r32, hi, qr);
#define AP_SB_EL(P, HF, r) do { const float y = P[r] * C2; \
                const float sp = fmaxf(y, 0.f) + __builtin_amdgcn_logf(1.0f + __builtin_amdgcn_exp2f(-fabsf(y))); \
                float Lr = -sp, br = y - sp; \
                if (needmask) { const bool ok = (dq - 32 * (HF) - (((r) & 3) + 8 * ((r) >> 2))) >= 0; Lr = ok ? Lr : 0.f; br = ok ? br : NEG; } \
                Lv[r] = Lr; P[r] = br; } while (0)
#define AP_KADDR(KT, QH, d_) ((KT) + (kb_ ^ (((d_) & 3) << 5)) + ((d_) >> 2) * 128)
#define AP_QMFMA(PN, c_, KT, QH) do { if ((c_) == 0) { f32x16 z_; _Pragma("unroll") for (int q_ = 0; q_ < 16; ++q_) z_[q_] = 0.f; PN = __builtin_amdgcn_mfma_f32_32x32x16_f16(kf[0], qr[0], z_, 0, 0, 0); } \
        else PN = __builtin_amdgcn_mfma_f32_32x32x16_f16(kf[(c_) & 3], qr[c_], PN, 0, 0, 0); \
        if ((c_) + 4 < 8) kf[(c_) & 3] = *(const LAS bf16x8*)AP_KADDR(KT, QH, (c_) + 4);        \
        __builtin_amdgcn_sched_barrier(0); } while (0)
#define AP_QPIN(KT, QH) int kb_ = r32 * 256 + ((hi * 16) ^ ((r32 & 7) << 4)) + (QH) * 8192; asm volatile("" : "+v"(kb_)); \
        _Pragma("unroll") for (int d_ = 0; d_ < 4; ++d_) kf[d_] = *(const LAS bf16x8*)AP_KADDR(KT, QH, d_); \
        __builtin_amdgcn_sched_barrier(0)
#define AP_PROCH(P, J, HF, VB, DOQ, PN, KT, QH) do { \
        if (SB) { \
            const int key0 = 64 * (J); const bool needmask = key0 + 63 >= a.tw0; const int dq = a.tok - 1 - key0 - 4 * hi; float run = carry; \
            float Lv[16]; \
            if (DOQ) { AP_QPIN(KT, QH); _Pragma("unroll") for (int c_ = 0; c_ < 8; ++c_) { AP_SB_EL(P, HF, 2 * c_); AP_SB_EL(P, HF, 2 * c_ + 1); AP_QMFMA(PN, c_, KT, QH); } } \
            else { _Pragma("unroll") for (int r = 0; r < 16; ++r) AP_SB_EL(P, HF, r); } \
            float g[4], pg[4]; \
            _Pragma("unroll") for (int i = 0; i < 4; ++i) { g[i] = (Lv[4 * i] + Lv[4 * i + 1]) + (Lv[4 * i + 2] + Lv[4 * i + 3]); pg[i] = partner32(g[i], hi); } \
            _Pragma("unroll") for (int i = 3; i >= 0; --i) { float aft = run + (hi ? 0.f : pg[i]); run += g[i] + pg[i]; \
                P[4 * i + 3] = __builtin_amdgcn_exp2f(P[4 * i + 3] + aft); aft += Lv[4 * i + 3]; \
                P[4 * i + 2] = __builtin_amdgcn_exp2f(P[4 * i + 2] + aft); aft += Lv[4 * i + 2]; \
                P[4 * i + 1] = __builtin_amdgcn_exp2f(P[4 * i + 1] + aft); aft += Lv[4 * i + 1]; \
                P[4 * i + 0] = __builtin_amdgcn_exp2f(P[4 * i + 0] + aft); } \
            carry = run; \
            bf16x8 pa0, pa1; pack_half(P, pa0, pa1); pv_half(o, vb0 + (VB) * 16384 + (HF) * 8192, pa0, pa1); \
            if ((HF) == HB) done = __all(carry <= -151.0f); \
        } else { \
            if (CMP) { if (64 * (J) + 32 * (HF) + 32 > a.nvmin) { const int dq = a.nvr - 1 - 64 * (J) - 32 * (HF) - 4 * hi;     \
                _Pragma("unroll") for (int r = 0; r < 16; ++r) { const int cr = (r & 3) + 8 * (r >> 2); if (dq - cr < 0) P[r] = NEG; } } } \
            if (WIN) { if ((J) == a.b || (J) == a.b - 8) { const int dq = a.tok - 64 * (J) - 32 * (HF) - 4 * hi; \
                _Pragma("unroll") for (int r = 0; r < 16; ++r) { const int cr = (r & 3) + 8 * (r >> 2); if ((unsigned)(dq - cr) >= 512u) P[r] = NEG; } } } \
            if (MODE == M_SLC) { if ((J) == a.b) { const int dq = a.tok - 64 * (J) - 32 * (HF) - 4 * hi; \
                _Pragma("unroll") for (int r = 0; r < 16; ++r) { const int cr = (r & 3) + 8 * (r >> 2); if (dq - cr < 0) P[r] = NEG; } } } \
            if (MODE == M_CSTAT || MODE == M_WSTAT || MODE == M_SLC) { \
                float pmax = P[0]; \
                _Pragma("unroll") for (int r = 1; r < 16; ++r) pmax = fmaxf(pmax, P[r]); \
                bool selr = true; \
                if (MODE == M_SLC) { selr = bit_of(a.sw0, a.sw1, a.sw2, a.sw3, (J)) != 0u; pmax = selr ? pmax : NEG; } \
                pmax = fmaxf(pmax, partner32(pmax, hi)); \
                  \
                const bool keep = (MODE == M_SLC) && __all((pmax - m) * C2 <= 8.0f); \
                const float mn = keep ? m : fmaxf(m, pmax); \
                const float alpha = keep ? 1.0f : __builtin_amdgcn_exp2f((m - mn) * C2); \
                m = mn; \
                const float mnL = selr ? -mn * C2 : NEG; \
                float ps = 0.f; \
                if (DOQ) { AP_QPIN(KT, QH); _Pragma("unroll") for (int c_ = 0; c_ < 8; ++c_) { \
                        P[2 * c_] = __builtin_amdgcn_exp2f(fmaf(P[2 * c_], C2, mnL)); P[2 * c_ + 1] = __builtin_amdgcn_exp2f(fmaf(P[2 * c_ + 1], C2, mnL)); ps += P[2 * c_] + P[2 * c_ + 1]; AP_QMFMA(PN, c_, KT, QH); } } \
                else { _Pragma("unroll") for (int r = 0; r < 16; ++r) { P[r] = __builtin_amdgcn_exp2f(fmaf(P[r], C2, mnL)); ps += P[r]; } } \
                ps += partner32(ps, hi); \
                l = l * alpha + ps; \
                if (MODE == M_SLC) { \
                    if (!keep && __any(alpha < 1.f)) { \
                        if (hi == 0) wsf[r32] = alpha; \
                        asm volatile("s_waitcnt lgkmcnt(0)" ::: "memory"); \
                        _Pragma("unroll") for (int r = 0; r < 16; ++r) { const float al = wsf[crow(r, hi)]; \
                            _Pragma("unroll") for (int d0 = 0; d0 < 4; ++d0) o[d0][r] *= al; } \
                    } \
                    bf16x8 pa0, pa1; pack_half(P, pa0, pa1); pv_half(o, vb0 + (VB) * 16384 + (HF) * 8192, pa0, pa1); \
                } \
            } else { \
                const float mL = -m * C2; \
                if (DOQ) { AP_QPIN(KT, QH); _Pragma("unroll") for (int c_ = 0; c_ < 8; ++c_) { \
                        P[2 * c_] = __builtin_amdgcn_exp2f(fmaf(P[2 * c_], C2, mL)) * a.f; P[2 * c_ + 1] = __builtin_amdgcn_exp2f(fmaf(P[2 * c_ + 1], C2, mL)) * a.f; AP_QMFMA(PN, c_, KT, QH); } } \
                else { _Pragma("unroll") for (int r = 0; r < 16; ++r) P[r] = __builtin_amdgcn_exp2f(fmaf(P[r], C2, mL)) * a.f; } \
                if (MODE == M_CIMP) { \
                      \
                    LAS float* PT = (LAS float*)(c.lds + NSA_P) + (8 * w + (r32 >> 2)) * 128; \
                    float s3v[4], av[4]; \
                    _Pragma("unroll") for (int i = 0; i < 4; ++i) { \
                        const float s0 = quad_sum(P[4 * i]), s1 = quad_sum(P[4 * i + 1]), s2 = quad_sum(P[4 * i + 2]); s3v[i] = quad_sum(P[4 * i + 3]); \
                        av[i] = 2.f * ((s0 + s1) + s2) + s3v[i]; } \
                    float ps3[4]; \
                    _Pragma("unroll") for (int i = 0; i < 4; ++i) ps3[i] = partner32(s3v[i], hi); \
                    _Pragma("unroll") for (int i = 0; i < 4; ++i) { \
                        const int Jb = 16 * (J) + 8 * (HF) + 2 * i + hi; \
                        const float prev = hi ? ps3[i] : (i == 0 ? carry : ps3[i > 0 ? i - 1 : 0]); \
                        if ((r32 & 3) == 0) PT[Jb] = av[i] + prev; } \
                    carry = ps3[3];      \
                } else { bf16x8 pa0, pa1; pack_half(P, pa0, pa1); pv_half(o, vb0 + (VB) * 16384 + (HF) * 8192, pa0, pa1); } \
            } \
        } } while (0)
    for (;;) {
        if (SB) { if (lane == 0) flags[w] = done ? 1u : 0u; }
        AP_WAITN(full); __syncthreads();
        if (SB) { unsigned all = 1u;
#pragma unroll
            for (int i = 0; i < NWAVES; ++i) all &= flags[i];
            if (all) break; }
        full = j3 < TNONE;
        if (j3 < TNONE) AP_DMAK(j3, (kc + 3) & 3);
        if (j2 < TNONE) AP_DMAV(j2, vc == 0 ? 2 : vc - 1);
        const bool act0 = AP_ACT(j0);
        const bool actq = (j1 < TNONE) && AP_ACT(j1);
        if (act0) AP_PROCH(pX, j0, HA, vc, true, pY, K_lds + kc * 16384, HB);
        if (actq) qkt_half(pX, K_lds + ((kc + 1) & 3) * 16384, HA, r32, hi, qr);
        if (act0) AP_PROCH(pY, j0, HB, vc, false, pX, K_lds, HA);
        if (j1 >= TNONE) break;
        j0 = j1; j1 = j2; j2 = j3; j3 = j3 < TNONE ? AP_NEXT(j3) : TNONE;
        kc = (kc + 1) & 3; vc = vc == 2 ? 0 : vc + 1;
    }
    asm volatile("s_waitcnt vmcnt(0)" ::: "memory");
#undef AP_PROCH
#undef AP_QMFMA
#undef AP_QPIN
#undef AP_KADDR
#undef AP_SB_EL
#undef AP_NEXT
#undef AP_ACT
#undef AP_DMAK
#undef AP_DMAV
#undef AP_WAITN
}

__device__ __forceinline__ void sb_unit(const Params& p, const Ctx& c, int l, int h, int qb) {
    const bf16_t* proj = (const bf16_t*)(p.ws + WS_PROJ);
    const bf16_t* Q = proj + (size_t)(20 + h) * S * HD;
    int lane_; asm volatile("v_mbcnt_lo_u32_b32 %0, -1, 0\n\tv_mbcnt_hi_u32_b32 %0, -1, %0" : "=v"(lane_));
    const int lane = lane_, w = c.wave, r32 = lane & 31, hi = lane >> 5;
    const int t0 = 256 * qb, tw0 = t0 + 32 * w, tq = tw0 + r32;
    bf16x8 qr[8];
#pragma unroll
    for (int d0 = 0; d0 < 8; ++d0) qr[d0] = *(const bf16x8*)(Q + (size_t)tq * HD + d0 * 16 + hi * 8);
    f32x16 o[4];
#pragma unroll
    for (int d0 = 0; d0 < 4; ++d0)
#pragma unroll
        for (int r = 0; r < 16; ++r) o[d0][r] = 0.f;
    PassArgs a{}; a.Kp = proj + (size_t)(28 + h) * S * HD; a.Vp = proj + (size_t)(36 + h) * S * HD; a.tok = tq; a.jtop = (t0 + 254) >> 6; a.tw0 = tw0;
    float m = 0.f, lsum = 0.f;
    attn_pass<M_SB>(c, qr, o, m, lsum, a);
    store_head_rows(o, p.in[10] + (size_t)l * DM + (8 + h) * HD, (bf16_t*)(p.ws + WS_O) + (size_t)tw0 * DM + (8 + h) * HD, r32, hi);
}

template <int role>
__device__ __forceinline__ void nsa_unit(const Params& p, const Ctx& c, int l, int g, int b) {
    const bf16_t* proj = (const bf16_t*)(p.ws + WS_PROJ);
    const bf16_t* kc = (const bf16_t*)(p.ws + WS_KC) + (size_t)g * 512 * HD; const bf16_t* vc = (const bf16_t*)(p.ws + WS_VC) + (size_t)g * 512 * HD;
    const float* gates = (const float*)(p.ws + WS_GATES);
    const int lane = c.lane, w = c.wave, r32 = lane & 31, hi = lane >> 5;
    const int t0 = 64 * b, tl = 8 * w + (r32 >> 2), tok = t0 + tl, H = 4 * g + (r32 & 3);
    bf16x8 qr[8];
#pragma unroll
    for (int d0 = 0; d0 < 8; ++d0) qr[d0] = *(const bf16x8*)(proj + (size_t)H * S * HD + (size_t)tok * HD + d0 * 16 + hi * 8);
    const float g0 = gates[(size_t)tok * 24 + H], g1 = gates[(size_t)tok * 24 + 8 + H], g2 = gates[(size_t)tok * 24 + 16 + H];
    f32x16 o[4];
    __syncthreads();
    { LAS f32x4* za = (LAS f32x4*)(c.lds + NSA_P);
      for (int i = c.tid; i < 32768 / 16; i += NTHREADS) za[i] = (f32x4){0.f, 0.f, 0.f, 0.f}; }
    PassArgs a{}; a.tok = tok; a.b = b;
    a.nvr = tok >= 31 ? (tok - 31) / 16 + 1 : 0; if (a.nvr > NCMP) a.nvr = NCMP;
    { const int tmin = t0 + 8 * w; a.nvmin = tmin >= 31 ? (tmin - 31) / 16 + 1 : 0; if (a.nvmin > NCMP) a.nvmin = NCMP; }
    int nvmax = (t0 + 63 - 31) / 16 + 1; if (nvmax > NCMP) nvmax = NCMP;
    const unsigned cm0 = (1u << ((nvmax + 63) >> 6)) - 1u;
    float mc = -1e30f, lc = 0.f;
    a.Kp = kc; a.Vp = vc; a.tm0 = cm0; a.wm0 = cm0;
    attn_pass<M_CSTAT>(c, qr, o, mc, lc, a);
    const float ilc = lc > 0.f ? 1.0f / lc : 0.f;
    a.f = ilc;
    attn_pass<M_CIMP>(c, qr, o, mc, lc, a);
    __syncthreads();
    { const LAS float* PTb = (const LAS float*)(c.lds + NSA_P);
      LAS unsigned* selw = (LAS unsigned*)(c.lds + NSA_SEL); LAS unsigned* wuni = (LAS unsigned*)(c.lds + NSA_WUNI);
      unsigned long long u0 = 0ull, u1 = 0ull;
      for (int tt = 0; tt < 8; ++tt) {
          const int tk = 8 * w + tt; const int j0 = lane, j1 = lane + 64;
          const float a0 = PTb[tk * 128 + j0], a1 = PTb[tk * 128 + j1];
          const bool f0 = (j0 == 0) || (j0 == b) || (j0 == b - 1), f1 = (j1 == b) || (j1 == b - 1);
          bool sel0 = f0 && j0 <= b, sel1 = f1 && j1 <= b;
          float c0 = (!f0 && j0 >= 1 && j0 <= b - 2) ? a0 : -1.f, c1 = (!f1 && j1 <= b - 2) ? a1 : -1.f;
          const int ncand = b - 2 > 0 ? b - 2 : 0, ksel = 16 - (b >= 2 ? 3 : b + 1);
          if (ncand <= ksel) { if (c0 >= 0.f) sel0 = true; if (c1 >= 0.f) sel1 = true; }
          else { for (int it = 0; it < ksel; ++it) {
                     const float mx = wave_max_dpp(fmaxf(c0, c1));
                     const unsigned long long b0 = __ballot(c0 == mx);
                     if (b0) { const int first = __ffsll((long long)b0) - 1; if (lane == first) { c0 = -1.f; sel0 = true; } }
                     else { const unsigned long long b1 = __ballot(c1 == mx); const int first = __ffsll((long long)b1) - 1; if (lane == first) { c1 = -1.f; sel1 = true; } } } }
          const unsigned long long m0 = __ballot(sel0), m1 = __ballot(sel1);
          u0 |= m0; u1 |= m1;
          if (lane == 0) { selw[tk * 4 + 0] = (unsigned)m0; selw[tk * 4 + 1] = (unsigned)(m0 >> 32); selw[tk * 4 + 2] = (unsigned)m1; selw[tk * 4 + 3] = (unsigned)(m1 >> 32); }
      }
      if (lane == 0) { wuni[w * 4 + 0] = (unsigned)u0; wuni[w * 4 + 1] = (unsigned)(u0 >> 32); wuni[w * 4 + 2] = (unsigned)u1; wuni[w * 4 + 3] = (unsigned)(u1 >> 32); }
      __syncthreads();
      unsigned gu0 = 0u, gu1 = 0u, gu2 = 0u, gu3 = 0u;
#pragma unroll
      for (int i = 0; i < NWAVES; ++i) { gu0 |= wuni[i * 4 + 0]; gu1 |= wuni[i * 4 + 1]; gu2 |= wuni[i * 4 + 2]; gu3 |= wuni[i * 4 + 3]; }
      a.tm0 = __builtin_amdgcn_readfirstlane(gu0); a.tm1 = __builtin_amdgcn_readfirstlane(gu1); a.tm2 = __builtin_amdgcn_readfirstlane(gu2); a.tm3 = __builtin_amdgcn_readfirstlane(gu3);
      a.wm0 = (unsigned)u0; a.wm1 = (unsigned)(u0 >> 32); a.wm2 = (unsigned)u1; a.wm3 = (unsigned)(u1 >> 32);
      a.sw0 = selw[tl * 4 + 0]; a.sw1 = selw[tl * 4 + 1]; a.sw2 = selw[tl * 4 + 2]; a.sw3 = selw[tl * 4 + 3];
      if (role != 0) {
          const int n = b - 63; const unsigned lo0 = n >= 32 ? ~0u : ((1u << n) - 1u), lo1 = n >= 64 ? ~0u : (n > 32 ? ((1u << (n - 32)) - 1u) : 0u);
          if (role == 2) { a.tm0 &= lo0; a.tm1 &= lo1; a.tm2 = 0u; a.tm3 = 0u; a.wm0 &= lo0; a.wm1 &= lo1; a.wm2 = 0u; a.wm3 = 0u; }
          else { a.tm0 &= ~lo0; a.tm1 &= ~lo1; a.wm0 &= ~lo0; a.wm1 &= ~lo1; } }
    }
#pragma unroll
    for (int d0 = 0; d0 < 4; ++d0)
#pragma unroll
        for (int r = 0; r < 16; ++r) o[d0][r] = 0.f;
    { float ms = -1e30f, ls = 0.f;
      a.Kp = proj + (size_t)(12 + g) * S * HD; a.Vp = proj + (size_t)(14 + g) * S * HD;
      attn_pass<M_SLC>(c, qr, o, ms, ls, a);
      LAS float* wsf = (LAS float*)(c.lds + ATT_WS) + w * 64;
      constexpr float C2 = SCALE * 1.4426950408889634f;
      if (role != 0) {
          int lane_; asm volatile("v_mbcnt_lo_u32_b32 %0, -1, 0\n\tv_mbcnt_hi_u32_b32 %0, -1, %0" : "=v"(lane_));
          const int lane = lane_, r32 = lane & 31, hi = lane >> 5;
          float* part = (float*)(p.ws + WS_PART + (size_t)(g * 64 + (b - 64)) * PART_SLOT); float* pml = part + 32768 + w * 64;
          unsigned* flag = (unsigned*)(p.ws + WS_CTL) + CW_NSAFLAG + 64 * (g * 64 + (b - 64));
          if (role == 2) {
#pragma unroll
              for (int r = 0; r < 16; ++r) *(f32x4*)(part + (size_t)(w * 16 + r) * 256 + lane * 4) = (f32x4){o[0][r], o[1][r], o[2][r], o[3][r]};
              if (hi == 0) { pml[r32] = ms; pml[32 + r32] = ls; }
              asm volatile("s_waitcnt vmcnt(0)" ::: "memory");
              __syncthreads();
              if (c.tid == 0) { __builtin_amdgcn_fence(__ATOMIC_RELEASE, "agent"); asm volatile("s_waitcnt vmcnt(0)" ::: "memory");
                  __hip_atomic_store(flag, (unsigned)(l + 1), __ATOMIC_RELAXED, __HIP_MEMORY_SCOPE_AGENT); }
              return;
          }
          if (c.tid == 0) { unsigned spins = 0; while (__hip_atomic_load(flag, __ATOMIC_RELAXED, __HIP_MEMORY_SCOPE_AGENT) != (unsigned)(l + 1) && ++spins < (1u << 22)) __builtin_amdgcn_s_sleep(4); }
          __syncthreads();
          __builtin_amdgcn_fence(__ATOMIC_ACQUIRE, "agent");
          asm volatile("s_waitcnt vmcnt(0)" ::: "memory");
          const float m1 = pml[r32], l1 = pml[32 + r32];
          f32x4 qa[4];
#pragma unroll
          for (int i = 0; i < 4; ++i) qa[i] = *(const f32x4*)(part + (size_t)(w * 16 + i) * 256 + lane * 4);
          const float mm = fmaxf(m1, ms), f1 = __builtin_amdgcn_exp2f((m1 - mm) * C2), f2 = __builtin_amdgcn_exp2f((ms - mm) * C2);
          ls = l1 * f1 + ls * f2;
          if (hi == 0) { wsf[r32] = f1; wsf[32 + r32] = f2; }
          asm volatile("s_waitcnt lgkmcnt(0)" ::: "memory");
#pragma unroll
          for (int hb = 0; hb < 4; ++hb) {
#pragma unroll
              for (int i = 0; i < 4; ++i) { const int r = hb * 4 + i; const float a1 = wsf[crow(r, hi)], a2 = wsf[32 + crow(r, hi)];
#pragma unroll
                  for (int d0 = 0; d0 < 4; ++d0) o[d0][r] = qa[i][d0] * a1 + o[d0][r] * a2; }
              asm volatile("" : "+v"(o[0][4 * hb]), "+v"(o[1][4 * hb]), "+v"(o[2][4 * hb]), "+v"(o[3][4 * hb]), "+v"(o[0][4 * hb + 1]), "+v"(o[1][4 * hb + 1]), "+v"(o[2][4 * hb + 1]), "+v"(o[3][4 * hb + 1]),
                               "+v"(o[0][4 * hb + 2]), "+v"(o[1][4 * hb + 2]), "+v"(o[2][4 * hb + 2]), "+v"(o[3][4 * hb + 2]), "+v"(o[0][4 * hb + 3]), "+v"(o[1][4 * hb + 3]), "+v"(o[2][4 * hb + 3]), "+v"(o[3][4 * hb + 3]) :: "memory");
              if (hb < 3) {
#pragma unroll
                  for (int i = 0; i < 4; ++i) qa[i] = *(const f32x4*)(part + (size_t)(w * 16 + 4 * (hb + 1) + i) * 256 + lane * 4); }
          }
          asm volatile("s_waitcnt lgkmcnt(0)" ::: "memory");
      }
      if (hi == 0) wsf[r32] = g1 / ls;
      asm volatile("s_waitcnt lgkmcnt(0)" ::: "memory");
#pragma unroll
      for (int r = 0; r < 16; ++r) { const float al = wsf[crow(r, hi)];
#pragma unroll
          for (int d0 = 0; d0 < 4; ++d0) o[d0][r] *= al; } }
    a.Kp = kc; a.Vp = vc; a.tm0 = cm0; a.tm1 = a.tm2 = a.tm3 = 0u; a.wm0 = cm0; a.wm1 = a.wm2 = a.wm3 = 0u; a.f = g0 * ilc;
    attn_pass<M_CPV>(c, qr, o, mc, lc, a);
    { unsigned wt0 = 0u, wt1 = 0u, wt2 = 0u, wt3 = 0u;
      for (int j = (b - 8 > 0 ? b - 8 : 0); j <= b; ++j) { const unsigned bit = 1u << (j & 31); if (j < 32) wt0 |= bit; else if (j < 64) wt1 |= bit; else if (j < 96) wt2 |= bit; else wt3 |= bit; }
      float mw = -1e30f, lw = 0.f;
      a.Kp = proj + (size_t)(16 + g) * S * HD; a.Vp = proj + (size_t)(18 + g) * S * HD;
      a.tm0 = wt0; a.tm1 = wt1; a.tm2 = wt2; a.tm3 = wt3; a.wm0 = wt0; a.wm1 = wt1; a.wm2 = wt2; a.wm3 = wt3; a.f = 0.f;
      attn_pass<M_WSTAT>(c, qr, o, mw, lw, a);
      a.f = g2 / lw;
      attn_pass<M_WPV>(c, qr, o, mw, lw, a); }
    { const float* ggrp = p.in[10] + (size_t)l * DM; bf16_t* O = (bf16_t*)(p.ws + WS_O);
      int lane_; asm volatile("v_mbcnt_lo_u32_b32 %0, -1, 0\n\tv_mbcnt_hi_u32_b32 %0, -1, %0" : "=v"(lane_));
      const int r32 = lane_ & 31, hi = lane_ >> 5, odd = lane_ & 1;
      float gg[4][4];
#pragma unroll
      for (int hh = 0; hh < 4; ++hh)
#pragma unroll
          for (int d0 = 0; d0 < 4; ++d0) gg[hh][d0] = ggrp[(4 * g + hh) * HD + d0 * 32 + r32];
#pragma unroll
      for (int r = 0; r < 16; ++r) {
          const float ss = half_sum_dpp((o[0][r] * o[0][r] + o[1][r] * o[1][r]) + (o[2][r] * o[2][r] + o[3][r] * o[3][r]), hi);
          const float rs = __builtin_amdgcn_rsqf(ss * (1.0f / HD) + EPS);
          const int rr = crow(r, hi), Hh = 4 * g + (r & 3); const int tk = t0 + 8 * w + (rr >> 2);
          store_row4(O + (size_t)tk * DM + Hh * HD + (r32 & ~1), o[0][r] * rs * gg[r & 3][0], o[1][r] * rs * gg[r & 3][1], o[2][r] * rs * gg[r & 3][2], o[3][r] * rs * gg[r & 3][3], odd);
      } }
}
__device__ __forceinline__ void phase_nsa(const Params& p, const Ctx& c, int l) {
    const int u0 = c.bx, g = u0 & 1, rk = u0 >> 1;
    if (rk < 64) { nsa_unit<2>(p, c, l, g, 127 - rk); nsa_unit<0>(p, c, l, g, rk); }
    else nsa_unit<1>(p, c, l, g, rk);
    __syncthreads();
}
__device__ __forceinline__ void phase_cmpr_sb(const Params& p, const Ctx& c, int l) {
    phase_cmpr(p, c, l);
    sb_unit(p, c, l, c.bx & 7, 31 - (c.bx >> 3));
    __syncthreads();
}
__device__ __forceinline__ Ctx make_ctx(unsigned char* lds, int wave) {
    Ctx c; c.lds = (LAS unsigned char*)lds; int ln_; asm volatile("v_mbcnt_lo_u32_b32 %0, -1, 0\n\tv_mbcnt_hi_u32_b32 %0, -1, %0" : "=v"(ln_));
    int wv_ = wave; asm volatile("" : "+s"(wv_));
    c.lane = ln_; c.wave = wv_; c.tid = wv_ * 64 + ln_;
    int bx_ = blockIdx.x; asm volatile("" : "+s"(bx_)); c.bx = bx_;
    c.gw = bx_ * NWAVES + c.wave; c.ngw = gridDim.x * NWAVES; return c;
}
#define AS4 __attribute__((address_space(4)))
__device__ __forceinline__ Params load_params() {
    unsigned long long v = (unsigned long long)(const AS4 void*)__builtin_amdgcn_kernarg_segment_ptr();
    asm volatile("" : "+s"(v));
    const AS4 Params* q = (const AS4 Params*)v; Params r;
#pragma unroll
    for (int i = 0; i < 17; ++i) r.in[i] = q->in[i];
    r.out = q->out; r.ws = q->ws; return r;
}
constexpr int CW_BAR = 4096;
#ifndef MEGA
#define MEGA 1
#endif
__global__ void __launch_bounds__(NTHREADS, 2) k_mega(Params p_arg) {
    extern __shared__ __attribute__((aligned(16))) unsigned char lds_raw[];
#define PCTX const Ctx c = make_ctx(lds_raw, wave0); const Params p = load_params()
    const int wave0 = __builtin_amdgcn_readfirstlane((int)threadIdx.x >> 6);
    volatile LAS unsigned* misc = (volatile LAS unsigned*)((LAS unsigned char*)lds_raw + MISC_OFF);
    if (threadIdx.x < 8) misc[threadIdx.x] = 0u;
    __syncthreads();
    { const Params p = load_params(); (void)xcd_barrier_post((unsigned*)(p.ws + WS_CTL) + CW_BAR, misc, threadIdx.x == 0); }
#define GBAR() do { const Params p = load_params(); XcdBarrier b_; b_.bar = (unsigned*)(p.ws + WS_CTL) + CW_BAR; b_.x = xb_xcc_id(); b_.st = misc; { int ln__; asm volatile("v_mbcnt_lo_u32_b32 %0, -1, 0\n\tv_mbcnt_hi_u32_b32 %0, -1, %0" : "=v"(ln__)); b_.leader = (wave0 == 0) && (ln__ == 0); } xcd_barrier(b_); } while (0)
    { PCTX; phase_conv(p, c); }
    GBAR();
    for (int l = 0; l < NL; ++l) {
        { PCTX; quant_rows(c, (const bf16_t*)(p.ws + WS_XN), p.ws + WS_XN8, (float*)(p.ws + WS_ASC), S); if (l == 0) cbias_reduce(p, c); }
        GBAR();
        { PCTX; pg8::Gemm g{(const bf16_t*)(p.ws + WS_XN8), (const bf16_t*)(p.ws + WS_WI8 + (size_t)l * 12 * MiB), S, DINP, DM / 2}; pg8::StaticOrder so; so.init(S, DINP, gridDim.x, c.bx);
          EpiProj E{(bf16_t*)(p.ws + WS_PROJ), (float*)(p.ws + WS_GATES), (const bf16_t*)(p.ws + WS_ROPEH), p.in[4] + 24 * l, (const LAS float*)(c.lds + RSTD_OFF), (const LAS float*)(c.lds + CSC_OFF)};
          pg8::gemm_phase<EpiProj, pg8::StaticOrder, true, true, PrepRstd, 2>(c.lds, g, so, E, c.tid, PrepRstd{c, so, (const float*)(p.ws + WS_SSQ), (const float*)(p.ws + WS_ASC), (const float*)(p.ws + WS_WISC) + l * DINP});
        }
        GBAR();
        { PCTX; phase_cmpr_sb(p, c, l); }
        GBAR();
        { PCTX; phase_nsa(p, c, l); }
        GBAR();
        { PCTX; pg8::Gemm g{(const bf16_t*)(p.ws + WS_O), w_ptr(p, l, W_OUT), S, DM, DM}; pg8::StaticOrder so; so.init(S, DM, gridDim.x, c.bx);
          EpiResidH E{(bf16_t*)(p.ws + WS_XN), (float*)(p.ws + WS_SSQ), nullptr, 1.0f};
          pg8::gemm_phase<EpiResidH, pg8::StaticOrder, false, true>(c.lds, g, so, E, c.tid); }
        GBAR();
        { PCTX; quant_rows(c, (const bf16_t*)(p.ws + WS_XN), p.ws + WS_XN8, (float*)(p.ws + WS_ASC), S); }
        GBAR();
        { PCTX; pg8::Gemm g{(const bf16_t*)(p.ws + WS_XN8), (const bf16_t*)(p.ws + WS_W8 + (size_t)l * 22 * MiB), S, 2 * DFF, DM / 2}; pg8::StaticOrder so; so.init(S, 2 * DFF, gridDim.x, c.bx);
          EpiSwiGLU E{p.ws + WS_ACT, (const LAS float*)(c.lds + RSTD_OFF), (const LAS float*)(c.lds + CSC_OFF)};
          pg8::gemm_phase<EpiSwiGLU, pg8::StaticOrder, true, true, PrepRstd, 2>(c.lds, g, so, E, c.tid, PrepRstd{c, so, (const float*)(p.ws + WS_SSQ), (const float*)(p.ws + WS_ASC), (const float*)(p.ws + WS_WSC) + l * 2 * DFF});
        }
        GBAR();
        { PCTX; pg8::Gemm g{(const bf16_t*)(p.ws + WS_ACT), w_ptr(p, l, W_DN), S, DM, DFF / 2}; pg8::StaticOrder so; so.init(S, DM, gridDim.x, c.bx);
          EpiResidH E{(bf16_t*)(p.ws + WS_XN), (float*)(p.ws + WS_SSQ), nullptr, 1.0f / (A8_SCALE * W8_SCALE)};
          pg8::gemm_phase<EpiResidH, pg8::StaticOrder, false, true, pg8::NoPre, 1>(c.lds, g, so, E, c.tid); }
        GBAR();
    }
    { PCTX; phase_final_norm(c, (const bf16_t*)(p.ws + WS_XN), (const float*)(p.ws + WS_SSQ), p.in[16], (float*)p.out); }
}

extern "C" void kernel_launch(void* const* d_in, const int* in_sizes, int n_in, void* d_out, int out_size, void* d_ws, size_t ws_size, hipStream_t stream) {
    static int grid = 0;
    if (grid == 0) {
        if (n_in != 17 || out_size != S * DM || ws_size < WS_END) { fprintf(stderr, "kernel_launch: unexpected shapes (n_in %d, out %d, ws %zu)\n", n_in, out_size, ws_size); grid = -1; return; }
        int dev = 0, cus = 0; (void)hipGetDevice(&dev); (void)hipDeviceGetAttribute(&cus, hipDeviceAttributeMultiprocessorCount, dev); if (cus <= 0) cus = 256;
#if MEGA
        if (hipFuncSetAttribute((const void*)k_mega, hipFuncAttributeMaxDynamicSharedMemorySize, LDS_BYTES) != hipSuccess) { fprintf(stderr, "kernel_launch: hipFuncSetAttribute failed\n"); grid = -1; return; }
        int per_cu = 0;
        if (hipOccupancyMaxActiveBlocksPerMultiprocessor(&per_cu, (const void*)k_mega, NTHREADS, LDS_BYTES) != hipSuccess || per_cu < 1) { fprintf(stderr, "kernel_launch: occupancy query says %d\n", per_cu); per_cu = 1; }
        (void)hipGetLastError();
        if (cus < 256) fprintf(stderr, "kernel_launch: this kernel's static unit schedules need 256 resident workgroups; the device reports %d CUs\n", cus);
        grid = 256;
#endif
    }
    if (grid < 0) return;
    Params p{};
    for (int i = 0; i < 17; ++i) p.in[i] = (const float*)d_in[i];
    p.out = (float*)d_out; p.ws = (unsigned char*)d_ws;
    const dim3 G(grid), B(NTHREADS);
#if MEGA
    (void)hipMemsetAsync((unsigned char*)d_ws + WS_CTL, 0, CTL_ZERO_BYTES, stream);
    hipLaunchKernelGGL(k_mega, G, B, LDS_BYTES, stream, p);
#endif
}
```

```cpp
#include <hip/hip_runtime.h>
#include <cstdio>
#include <cstdint>
namespace pg8 {
#define PG8_LAS __attribute__((address_space(3)))
typedef unsigned short bf16_t;
typedef _Float16 bf16x8 __attribute__((ext_vector_type(8)));
typedef float f32x4 __attribute__((ext_vector_type(4)));
typedef unsigned u32x4 __attribute__((ext_vector_type(4)));
constexpr int BM = 256, BK = 64, HALF = 128, HTB = HALF * BK * 2  , STAGE_BYTES = 8 * HTB, NXCD = 8, WGM = 8;

__host__ __device__ __forceinline__ int lds_byte(int r, int c) { const int st = (r >> 4) * 2 + (c >> 5), rr = r & 15, cc = c & 31, ob = rr * 64 + cc * 2; return st * 1024 + (ob ^ (((ob >> 9) & 1) << 5)); }
__host__ __device__ __forceinline__ void stage_rc(int b, int& R, int& C) { const int st = b / 1024, sb = b % 1024, swz = sb ^ (((sb >> 9) & 1) << 5); R = (st >> 1) * 16 + swz / 64; C = (st & 1) * 32 + (swz % 64) / 2; }
__host__ __device__ __forceinline__ int perm32(int rho) { const int n = rho >> 4, i = rho & 15; return 8 * (i >> 2) + 4 * n + (i & 3); }

struct Unit { int pm, pn, ord; };
struct Gemm { const bf16_t* A; const bf16_t* Bt; int M, N, K; };

struct StaticOrder {
    int nM, nN, nwg, G, c;
    __host__ __device__ void init(int M, int N, int G_, int c_) { nM = M / BM; nN = N / BM; nwg = nM * nN; G = G_; c = c_; }
    __host__ __device__ bool next(int i, Unit& u) const {
        const long L = (long)i * G + c; if (L >= nwg) return false;
        int wgid = (int)L; { const int q = nwg / NXCD, r = nwg % NXCD, xcd = wgid % NXCD, off = wgid / NXCD; wgid = (xcd < r ? xcd * (q + 1) : r * (q + 1) + (xcd - r) * q) + off; }
        const int nig = WGM * nN, gid = wgid / nig, fm = gid * WGM, gsz = (nM - fm) < WGM ? (nM - fm) : WGM;
        u.pm = fm + ((wgid % nig) % gsz); u.pn = (wgid % nig) / gsz; u.ord = i; return true;
    }
    __device__ __forceinline__ void a_ready(const Unit&) const {}
    __device__ __forceinline__ void done(const Unit&) const {}
};
__device__ __forceinline__ unsigned cvt_pk_bf16(float lo, float hi) { unsigned r; asm volatile("v_cvt_pk_bf16_f32 %0, %1, %2" : "=v"(r) : "v"(lo), "v"(hi)); return r; }
typedef float f32x2 __attribute__((ext_vector_type(2)));
struct NoPre { __device__ __forceinline__ void operator()() const {} };
typedef int i32x8 __attribute__((ext_vector_type(8)));
typedef int i32x4 __attribute__((ext_vector_type(4)));
template <class Epi, class Sched, bool ALIGN_EPI = false, bool SP2 = false, class Pre = NoPre, int F8 = 0>
__device__ __forceinline__ void gemm_phase(PG8_LAS unsigned char* lds, const Gemm g, const Sched& S, const Epi& E, int tid_in, const Pre& pre = Pre()) {
    int tid_ = tid_in; asm volatile("" : "+v"(tid_));
    const int tid = tid_, wid = __builtin_amdgcn_readfirstlane(tid >> 6), lane = tid & 63, wr = wid >> 2, wc = wid & 3, fr = lane & 15, fq = lane >> 4;
    const int K = g.K, nt = K / BK;
    unsigned voffA[2], voffB[2];
#pragma unroll
    for (int i = 0; i < 2; ++i) { int R, C; stage_rc(tid * 16 + i * 8192, R, C); const int Rb = Epi::PERM ? ((R & ~31) + perm32(R & 31)) : R;
        voffA[i] = (unsigned)(R * K + C) * 2u; voffB[i] = (unsigned)(Rb * K + C) * 2u; }
    const size_t kstep = (size_t)(BK * 2);
    const size_t hstep = (size_t)HALF * K * 2;
    const size_t tstep = 2 * hstep;
    const unsigned ldsw = (unsigned)wid * 1024u;
    const int aoff = lds_byte(wr * 64 + fr, fq * 8), boff = lds_byte(wc * 32 + fr, fq * 8);
#define PG8_SA(b, h) (((b) * 2 + (h)) * HTB)
#define PG8_SB(b, h) ((4 + (b) * 2 + (h)) * HTB)
#define PG8_STAGE(bufoff, gbase, voff) do { _Pragma("unroll") for (int _i = 0; _i < 2; ++_i) \
        __builtin_amdgcn_global_load_lds((const unsigned*)((const char*)(gbase) + (voff)[_i]), (PG8_LAS unsigned*)(lds + (bufoff) + ldsw + _i * 8192), 16, 0, 0); } while (0)
#define PG8_LDA(dst, b, h) do { _Pragma("unroll") for (int m = 0; m < 4; ++m) _Pragma("unroll") for (int k = 0; k < 2; ++k) dst[m][k] = *(const PG8_LAS bf16x8*)(lds + PG8_SA(b, h) + aoff + m * 2048 + k * 1024); } while (0)
#define PG8_LDB(dst, b, h) do { _Pragma("unroll") for (int n = 0; n < 2; ++n) _Pragma("unroll") for (int k = 0; k < 2; ++k) dst[n][k] = *(const PG8_LAS bf16x8*)(lds + PG8_SB(b, h) + boff + n * 2048 + k * 1024); } while (0)
#define PG8_F8FRAG(X) __builtin_shufflevector(__builtin_bit_cast(i32x4, (X)[0]), __builtin_bit_cast(i32x4, (X)[1]), 0, 1, 2, 3, 4, 5, 6, 7)
#define PG8_MMA(ai, bj, At, Bt) do { __builtin_amdgcn_s_setprio(1); \
        if constexpr (F8 == 2) { _Pragma("unroll") for (int m = 0; m < 4; ++m) _Pragma("unroll") for (int n = 0; n < 2; ++n) _Pragma("unroll") for (int k = 0; k < 2; ++k) \
            acc[ai][bj][m][n] = __builtin_bit_cast(f32x4, __builtin_amdgcn_mfma_i32_16x16x64_i8(__builtin_bit_cast(i32x4, Bt[n][k]), __builtin_bit_cast(i32x4, At[m][k]), __builtin_bit_cast(i32x4, acc[ai][bj][m][n]), 0, 0, 0)); } \
        else if constexpr (F8 == 1) { _Pragma("unroll") for (int m = 0; m < 4; ++m) _Pragma("unroll") for (int n = 0; n < 2; ++n) \
            { const i32x8 a8_ = PG8_F8FRAG(Bt[n]), b8_ = PG8_F8FRAG(At[m]); asm volatile("v_mfma_f32_16x16x128_f8f6f4 %0, %1, %2, %0" : "+v"(acc[ai][bj][m][n]) : "v"(a8_), "v"(b8_)); } } \
        else { _Pragma("unroll") for (int m = 0; m < 4; ++m) _Pragma("unroll") for (int n = 0; n < 2; ++n) _Pragma("unroll") for (int k = 0; k < 2; ++k) \
            acc[ai][bj][m][n] = __builtin_amdgcn_mfma_f32_16x16x32_f16(Bt[n][k], At[m][k], acc[ai][bj][m][n], 0, 0, 0); } \
        __builtin_amdgcn_s_setprio(0); } while (0)
#define PG8_WAIT_V(n) asm volatile("s_waitcnt vmcnt(" #n ")" ::: "memory")
#define PG8_WAIT_L(n) asm volatile("s_waitcnt lgkmcnt(" #n ")" ::: "memory")
#define PG8_BAR __builtin_amdgcn_s_barrier()
#define PG8_SCHED __builtin_amdgcn_sched_barrier(0)
    Unit cur, nxt; int ui = 0;
    if (!S.next(0, cur)) return;
    f32x4 acc[2][2][4][2];
#pragma unroll
    for (int a = 0; a < 2; ++a)
#pragma unroll
        for (int b = 0; b < 2; ++b)
#pragma unroll
            for (int m = 0; m < 4; ++m)
#pragma unroll
                for (int n = 0; n < 2; ++n) acc[a][b][m][n] = (f32x4){0.f, 0.f, 0.f, 0.f};
    bf16x8 At[4][2], B0[2][2], B1[2][2];
    const char* cA = (const char*)g.A + (size_t)cur.pm * tstep; const char* cB = (const char*)g.Bt + (size_t)cur.pn * tstep;
    S.a_ready(cur);
    if constexpr (SP2) {
        PG8_STAGE(PG8_SB(0, 0), cB, voffB); PG8_STAGE(PG8_SB(0, 1), cB + hstep, voffB); PG8_STAGE(PG8_SA(0, 0), cA, voffA); PG8_STAGE(PG8_SA(0, 1), cA + hstep, voffA);
        pre();
        if (wr == 1) PG8_BAR;
        PG8_WAIT_V(2); PG8_BAR;
        PG8_STAGE(PG8_SB(1, 0), cB + kstep, voffB); PG8_STAGE(PG8_SA(1, 0), cA + kstep, voffA); PG8_STAGE(PG8_SB(1, 1), cB + hstep + kstep, voffB);
        PG8_WAIT_V(6); PG8_BAR;
    } else {
        PG8_STAGE(PG8_SB(0, 0), cB, voffB); PG8_STAGE(PG8_SA(0, 0), cA, voffA); PG8_STAGE(PG8_SB(0, 1), cB + hstep, voffB); PG8_STAGE(PG8_SA(0, 1), cA + hstep, voffA);
        if (wr == 1) PG8_BAR;
        PG8_WAIT_V(4); PG8_BAR;
        PG8_STAGE(PG8_SB(1, 0), cB + kstep, voffB); PG8_STAGE(PG8_SA(1, 0), cA + kstep, voffA); PG8_STAGE(PG8_SB(1, 1), cB + hstep + kstep, voffB);
        PG8_WAIT_V(6); PG8_BAR;
    }
    for (;;) {
        const bool has_next = S.next(ui + 1, nxt);
        const char* nA = has_next ? (const char*)g.A + (size_t)nxt.pm * tstep : cA; const char* nB = has_next ? (const char*)g.Bt + (size_t)nxt.pn * tstep : cB;
        for (int t = 0; t < nt; t += 2) {
            const bool last = (t == nt - 2);
            const char* a1 = cA + (size_t)(t + 1) * kstep;
            const char* a2 = last ? nA : cA + (size_t)(t + 2) * kstep; const char* b2 = last ? nB : cB + (size_t)(t + 2) * kstep;
            const char* a3 = a2 + kstep; const char* b3 = b2 + kstep;
            if (last && has_next) S.a_ready(nxt);
            if constexpr (SP2) {
            PG8_LDB(B0, 0, 0); PG8_LDB(B1, 0, 1); PG8_SCHED; PG8_LDA(At, 0, 0); PG8_STAGE(PG8_SA(1, 1), a1 + hstep, voffA);
            PG8_WAIT_V(8); PG8_WAIT_L(0); PG8_BAR; PG8_MMA(0, 0, At, B0); PG8_MMA(0, 1, At, B1); PG8_BAR; PG8_SCHED;
            PG8_LDA(At, 0, 1); PG8_STAGE(PG8_SB(0, 0), b2, voffB); PG8_STAGE(PG8_SB(0, 1), b2 + hstep, voffB); PG8_STAGE(PG8_SA(0, 0), a2, voffA);
            PG8_WAIT_V(8); PG8_WAIT_L(0); PG8_BAR; PG8_MMA(1, 0, At, B0); PG8_MMA(1, 1, At, B1); PG8_BAR; PG8_SCHED;
            PG8_LDB(B0, 1, 0); PG8_LDB(B1, 1, 1); PG8_SCHED; PG8_LDA(At, 1, 0); PG8_STAGE(PG8_SA(0, 1), a2 + hstep, voffA);
            PG8_WAIT_V(8); PG8_WAIT_L(0); PG8_BAR; PG8_MMA(0, 0, At, B0); PG8_MMA(0, 1, At, B1); PG8_BAR; PG8_SCHED;
            PG8_LDA(At, 1, 1); PG8_STAGE(PG8_SB(1, 0), b3, voffB); PG8_STAGE(PG8_SB(1, 1), b3 + hstep, voffB); PG8_STAGE(PG8_SA(1, 0), a3, voffA);
            PG8_WAIT_V(8); PG8_WAIT_L(0); PG8_BAR; PG8_MMA(1, 0, At, B0); PG8_MMA(1, 1, At, B1); PG8_BAR; PG8_SCHED;
            } else {
            PG8_LDB(B0, 0, 0); PG8_SCHED; PG8_LDA(At, 0, 0); PG8_STAGE(PG8_SA(1, 1), a1 + hstep, voffA);
            PG8_WAIT_L(8); PG8_BAR; PG8_WAIT_L(0); PG8_MMA(0, 0, At, B0); PG8_BAR; PG8_SCHED;
            PG8_LDB(B1, 0, 1); PG8_STAGE(PG8_SB(0, 0), b2, voffB);
            PG8_BAR; PG8_WAIT_L(0); PG8_MMA(0, 1, At, B1); PG8_BAR;
            PG8_LDA(At, 0, 1); PG8_STAGE(PG8_SA(0, 0), a2, voffA);
            PG8_BAR; PG8_WAIT_L(0); PG8_MMA(1, 0, At, B0); PG8_BAR; PG8_SCHED;
            PG8_STAGE(PG8_SB(0, 1), b2 + hstep, voffB);
            PG8_WAIT_V(6); PG8_BAR; PG8_MMA(1, 1, At, B1); PG8_BAR;
            PG8_LDB(B0, 1, 0); PG8_SCHED; PG8_LDA(At, 1, 0); PG8_STAGE(PG8_SA(0, 1), a2 + hstep, voffA);
            PG8_WAIT_L(8); PG8_BAR; PG8_WAIT_L(0); PG8_MMA(0, 0, At, B0); PG8_BAR; PG8_SCHED;
            PG8_LDB(B1, 1, 1); PG8_STAGE(PG8_SB(1, 0), b3, voffB);
            PG8_BAR; PG8_WAIT_L(0); PG8_MMA(0, 1, At, B1); PG8_BAR;
            PG8_LDA(At, 1, 1); PG8_STAGE(PG8_SA(1, 0), a3, voffA);
            PG8_BAR; PG8_WAIT_L(0); PG8_MMA(1, 0, At, B0); PG8_BAR; PG8_SCHED;
            PG8_STAGE(PG8_SB(1, 1), b3 + hstep, voffB);
            PG8_WAIT_V(6); PG8_BAR; PG8_MMA(1, 1, At, B1); PG8_BAR;
            }
        }
        if constexpr (F8) asm volatile("s_nop 15\n\ts_nop 15" ::: "memory");
        if constexpr (ALIGN_EPI) { if (wr == 0) PG8_BAR; }
        if constexpr (!Epi::AFTER_DRAIN) { E(acc, cur, wr, wc, fr, fq); S.done(cur); }
        if (!has_next) break;
#pragma unroll
        for (int a = 0; a < 2; ++a)
#pragma unroll
            for (int b = 0; b < 2; ++b)
#pragma unroll
                for (int m = 0; m < 4; ++m)
#pragma unroll
                    for (int n = 0; n < 2; ++n) acc[a][b][m][n] = (f32x4){0.f, 0.f, 0.f, 0.f};
        cur = nxt; cA = nA; cB = nB; ++ui;
        if constexpr (ALIGN_EPI) { if (wr == 1) PG8_BAR; }
    }
    PG8_WAIT_V(0);
    if constexpr (!ALIGN_EPI) { if (wr == 0) PG8_BAR; }
    PG8_BAR;
    if constexpr (Epi::AFTER_DRAIN) { E.fused(acc, cur, wr, wc, fr, fq, lds, wid, lane); S.done(cur); }
#undef PG8_SA
#undef PG8_SB
#undef PG8_STAGE
#undef PG8_LDA
#undef PG8_LDB
#undef PG8_MMA
#undef PG8_WAIT_V
#undef PG8_WAIT_L
#undef PG8_BAR
#undef PG8_SCHED
}
}
#define LAS __attribute__((address_space(3)))
#define XB_TMO      128
#define XB_XCNT(j)  (256  + 64 * (j))
#define XB_XSUB(j)  (1280 + 64 * (j))
#define XB_XGEN(j)  (2304 + 64 * (j))
#define XB_TOP      3328
#define XB_TOPGEN   3392
#define XCD_BAR_WORDS 3456
#define XB_SPIN_CAP (1u << 18)

__device__ __forceinline__ unsigned xb_ld(unsigned* p)              { return __hip_atomic_load(p, __ATOMIC_RELAXED, __HIP_MEMORY_SCOPE_AGENT); }
__device__ __forceinline__ unsigned xb_add(unsigned* p, unsigned v) { return __hip_atomic_fetch_add(p, v, __ATOMIC_RELAXED, __HIP_MEMORY_SCOPE_AGENT); }
__device__ __forceinline__ unsigned xb_xcc_id() { return (unsigned)__builtin_amdgcn_s_getreg((3 << 11) | 20) & 0xFu; }
#define XB_SPIN(cond, bar) do { unsigned _sp = 0; while (cond) { __builtin_amdgcn_s_sleep(1); \
    if ((++_sp & 255u) == 0u) { if (xb_ld(&(bar)[XB_TMO])) break; if (_sp > XB_SPIN_CAP) { atomicAdd(&(bar)[XB_TMO], 1u); break; } } } } while (0)

struct XcdBarrier {
    unsigned* bar; unsigned x;
    volatile LAS unsigned* st;
    bool leader;
};

__device__ __forceinline__ XcdBarrier xcd_barrier_post(unsigned* bar, volatile LAS unsigned* st, bool leader) {
    XcdBarrier b; b.bar = bar; b.x = xb_xcc_id(); b.st = st; b.leader = leader;
    if (leader) (void)xb_add(&bar[XB_XCNT(b.x)], 1u);
    return b;
}
__device__ __forceinline__ void xcd_barrier_complete(unsigned* bar, unsigned x, unsigned& nloc, unsigned& nx) {
    const unsigned G = gridDim.x * gridDim.y * gridDim.z;
    unsigned sum, cnt, mine, sp = 0u;
    for (;;) {
        sum = 0u; cnt = 0u; mine = 0u;
#pragma unroll
        for (unsigned j = 0; j < 16; ++j) { const unsigned c = xb_ld(&bar[XB_XCNT(j)]); sum += c; cnt += (c > 0u) ? 1u : 0u; mine = (j == x) ? c : mine; }
        if (sum == G) break;
        __builtin_amdgcn_s_sleep(1);
        if ((++sp & 255u) == 0u) { if (xb_ld(&bar[XB_TMO])) break; if (sp > XB_SPIN_CAP) { atomicAdd(&bar[XB_TMO], 1u); break; } }
    }
    nloc = mine > 0u ? mine : 1u; nx = cnt > 0u ? cnt : 1u;
}

__device__ __forceinline__ void xcd_barrier(const XcdBarrier& b) {
    asm volatile("s_waitcnt vmcnt(0)" ::: "memory");
    __syncthreads();
    if (b.leader) {
        unsigned* bar = b.bar;
        __builtin_amdgcn_s_waitcnt(0);
        unsigned nloc = b.st[0], nx = b.st[1];
        if (nloc == 0u) { xcd_barrier_complete(bar, b.x, nloc, nx); b.st[0] = nloc; b.st[1] = nx; }
        const unsigned old = xb_add(&bar[XB_XSUB(b.x)], 1u);
        const unsigned gen = old / nloc;
        if (old + 1u == (gen + 1u) * nloc) {
            __builtin_amdgcn_fence(__ATOMIC_RELEASE, "agent");
            asm volatile("s_waitcnt vmcnt(0)" ::: "memory");
            const unsigned og = xb_add(&bar[XB_TOP], 1u);
            const unsigned tg = og / nx;
            if (og + 1u == (tg + 1u) * nx) xb_add(&bar[XB_TOPGEN], 1u);
            else XB_SPIN(xb_ld(&bar[XB_TOPGEN]) == tg, bar);
            __builtin_amdgcn_fence(__ATOMIC_ACQUIRE, "agent");
            xb_add(&bar[XB_XGEN(b.x)], 1u);
            asm volatile("s_waitcnt vmcnt(0)" ::: "memory");
        } else {
            XB_SPIN(xb_ld(&bar[XB_XGEN(b.x)]) == gen, bar);
            __builtin_amdgcn_fence(__ATOMIC_ACQUIRE, "agent");
            asm volatile("s_waitcnt vmcnt(0)" ::: "memory");
        }
    }
    __syncthreads();
}

#ifndef LAS
#define LAS __attribute__((address_space(3)))
#endif
typedef unsigned short bf16_t;
typedef _Float16 bf16x8 __attribute__((ext_vector_type(8)));
typedef float f32x4 __attribute__((ext_vector_type(4)));
typedef float f32x2 __attribute__((ext_vector_type(2)));
typedef unsigned u32x4 __attribute__((ext_vector_type(4)));
typedef unsigned u32x2 __attribute__((ext_vector_type(2)));

constexpr int S = 8192, DM = 2048, NL = 4, HD = 128, DIN = 5656, DINP = 5888, DFF = 5632, NCMP = 511;
constexpr float EPS = 1e-6f;
constexpr float SCALE = 0.08838834764831845f;
constexpr int NWAVES = 8, NTHREADS = 512;
constexpr int LDS_BYTES = 147456;
constexpr int RING_BYTES = 131072, MISC_OFF = LDS_BYTES - 64;

constexpr size_t MiB = 1u << 20;
constexpr float W8_SCALE = 64.0f, A8_SCALE = 8.0f;
constexpr size_t WS_CTL = 0, CTL_ZERO_BYTES = 1 * MiB;
constexpr size_t WS_ROPE = 1 * MiB;
constexpr size_t WS_CBP = WS_ROPE + 1024 * 1024;
constexpr size_t WS_ROPEH = 5 * MiB + 512 * 1024;
constexpr size_t WS_CBF = 3 * MiB + 512 * 1024;
constexpr size_t WS_KC = 2 * MiB + 512 * 1024;
constexpr size_t WS_VC = WS_KC + 256 * 1024;
constexpr size_t WS_SEL = 3 * MiB;
constexpr size_t WS_GATES = 4 * MiB;
constexpr size_t WS_SSQ = 5 * MiB;
constexpr size_t WS_W = 8 * MiB;
constexpr size_t W_IN = 0, W_OUT = 23 * MiB, W_GU = 31 * MiB, W_DN = 75 * MiB, W_C1 = 97 * MiB, W_C2 = 101 * MiB, W_LAYER = 102 * MiB;
constexpr size_t WS_H = WS_W + NL * W_LAYER;
constexpr size_t WS_XN8 = WS_H;
constexpr size_t WS_XSLAB = WS_H + 32 * MiB;
constexpr size_t WS_XN = WS_H + 64 * MiB;
constexpr size_t WS_O = WS_XN + 32 * MiB;
constexpr size_t WS_OCMP = WS_O + 32 * MiB;
constexpr size_t WS_PROJ = WS_OCMP + 32 * MiB;
constexpr size_t WS_ACT = WS_PROJ;
constexpr size_t WS_PART = WS_PROJ + 88 * MiB;
constexpr size_t PART_SLOT = 131072 + 2048;
constexpr size_t WS_W8 = 688 * MiB;
constexpr size_t WS_WSC = WS_W8 + NL * 22 * MiB;
constexpr size_t WS_ASC = WS_WSC + 1 * MiB;
constexpr size_t WS_WI8 = WS_ASC + 1 * MiB;
constexpr size_t WS_WISC = WS_WI8 + NL * 12 * MiB;
constexpr size_t WS_END = WS_WISC + 1 * MiB;
static_assert(WS_PART + 128 * PART_SLOT <= WS_W8, "ws map");
constexpr size_t WS_CPART = 6 * MiB;
constexpr int CW_CFLAG = 32768;
constexpr int CW_XCNT = 49152;
constexpr int CW_NSAFLAG = 16384;
static_assert((size_t)DINP * DM * 2 == 23 * MiB && (size_t)2 * DFF * DM * 2 == 44 * MiB && (size_t)DM * DFF * 2 == 22 * MiB, "weight map");

struct Params { const float* in[17]; float* out; unsigned char* ws; };

struct Ctx {
    LAS unsigned char* lds;
    int tid, lane, wave, gw, ngw, bx;
};

__device__ __forceinline__ float bf2f(unsigned b) { return (float)__builtin_bit_cast(_Float16, (unsigned short)b); }
__device__ __forceinline__ unsigned f2bf(float f) { return (unsigned)__builtin_bit_cast(unsigned short, (_Float16)f); }
typedef _Float16 h2_t __attribute__((ext_vector_type(2)));
__device__ __forceinline__ unsigned pk2(float lo, float hi) { const h2_t v = {(_Float16)lo, (_Float16)hi}; return __builtin_bit_cast(unsigned, v); }
#define DPP_F(old_, src_, ctrl_, rmask_) __builtin_bit_cast(float, __builtin_amdgcn_update_dpp(__builtin_bit_cast(int, (old_)), __builtin_bit_cast(int, (src_)), (ctrl_), (rmask_), 0xf, false))
__device__ __forceinline__ float wave_sum(float v) {
    v += DPP_F(0.f, v, 0x111, 0xf); v += DPP_F(0.f, v, 0x112, 0xf); v += DPP_F(0.f, v, 0x114, 0xf); v += DPP_F(0.f, v, 0x118, 0xf);
    v += DPP_F(0.f, v, 0x142, 0xa); v += DPP_F(0.f, v, 0x143, 0xc);
    return __builtin_bit_cast(float, __builtin_amdgcn_readlane(__builtin_bit_cast(int, v), 63));
}
__device__ __forceinline__ float wave_max_u(float v) {
    v = fmaxf(v, DPP_F(0.f, v, 0x111, 0xf)); v = fmaxf(v, DPP_F(0.f, v, 0x112, 0xf)); v = fmaxf(v, DPP_F(0.f, v, 0x114, 0xf)); v = fmaxf(v, DPP_F(0.f, v, 0x118, 0xf));
    v = fmaxf(v, DPP_F(0.f, v, 0x142, 0xa)); v = fmaxf(v, DPP_F(0.f, v, 0x143, 0xc));
    return __builtin_bit_cast(float, __builtin_amdgcn_readlane(__builtin_bit_cast(int, v), 63));
}
__device__ __forceinline__ float rope_inv(int i) {
    switch (i) {
        case 0: return 1.0f;
        case 1: return 0.44036659598350525f;
        case 2: return 0.1939227432012558f;
        case 3: return 0.08539710193872452f;
        case 4: return 0.03760603070259094f;
        case 5: return 0.016560440883040428f;
        case 6: return 0.007292664609849453f;
        case 7: return 0.0032114461064338684f;
        case 8: return 0.0014142135623842478f;
        case 9: return 0.0006227724370546639f;
        case 10: return 0.00027424818836152554f;
        case 11: return 0.00012076973507646471f;
        case 12: return 5.3182957344688475e-05f;
        case 13: return 2.34199997066753e-05f;
        case 14: return 1.0313385246263351e-05f;
        default: return 4.541670477919979e-06f;
    }
}
__device__ __forceinline__ void sincos_d(float ang, float& c, float& s) {
    const double x = (double)ang;
    const double q = rint(x * 0.63661977236758134308);
    const double r = fma(-q, 1.57079632679489661923, x) - q * 6.123233995736766e-17;
    const double r2 = r * r;
    double cs = 1.0 / 479001600.0; cs = cs * r2 - 1.0 / 3628800.0; cs = cs * r2 + 1.0 / 40320.0; cs = cs * r2 - 1.0 / 720.0; cs = cs * r2 + 1.0 / 24.0; cs = cs * r2 - 0.5; cs = cs * r2 + 1.0;
    double sn = 1.0 / 6227020800.0; sn = sn * r2 - 1.0 / 39916800.0; sn = sn * r2 + 1.0 / 362880.0; sn = sn * r2 - 1.0 / 5040.0; sn = sn * r2 + 1.0 / 120.0; sn = sn * r2 - 1.0 / 6.0; sn = sn * r2 + 1.0; sn *= r;
    const int qi = ((int)(long long)q) & 3;
    double cc, ss;
    if (qi == 0) { cc = cs; ss = sn; } else if (qi == 1) { cc = -sn; ss = cs; } else if (qi == 2) { cc = -cs; ss = -sn; } else { cc = sn; ss = -cs; }
    c = (float)cc; s = (float)ss;
}
__device__ __forceinline__ float gelu_tanh(float x) {
    const float y = 0.7978845608028654f * (x + 0.044715f * x * x * x);
    const float e = __expf(2.0f * y);
    const float th = 1.0f - 2.0f / (e + 1.0f);
    return 0.5f * x * (1.0f + th);
}
__device__ __forceinline__ float partner32(float x, int hi) { auto rr = __builtin_amdgcn_permlane32_swap(__float_as_uint(x), __float_as_uint(x), false, false); return __uint_as_float(hi ? rr[0] : rr[1]); }
__device__ __forceinline__ float sigmoidf_(float x) { return __builtin_amdgcn_rcpf(1.0f + __builtin_amdgcn_exp2f(x * -1.4426950408889634f)); }

__device__ __forceinline__ bf16_t* w_ptr(const Params& p, int l, size_t off) { return (bf16_t*)(p.ws + WS_W + (size_t)l * W_LAYER + off); }

struct ConvItem { const float* W; const float* gain; bf16_t* WT; int N, k0, sc, nv, drow, dK, frag, f8; };
constexpr int I_IN = 32 * 184, I_OUT = 32 * 64, I_GU = 32 * 352, I_DN = 88 * 64, I_C1 = 1024, I_C2 = 32;
constexpr int I_LAYER = I_OUT + I_DN + I_C1 + I_C2;
__device__ __forceinline__ ConvItem conv_desc(const Params& p, int it) {
    const int l = it / I_LAYER; int r = it - l * I_LAYER; ConvItem d; d.frag = 0; d.f8 = 0;
    if (r < I_OUT) { const int kb = r / 64, nb = r % 64;
        d.W = p.in[11] + (size_t)l * DM * DM; d.N = DM; d.k0 = 64 * kb; d.sc = 32 * nb; d.nv = 32; d.WT = w_ptr(p, l, W_OUT); d.drow = 32 * nb; d.dK = DM; d.gain = nullptr; return d; }
    r -= I_OUT;
    if (r < I_DN) { const int kb = r / 64, nb = r % 64;
        d.W = p.in[15] + (size_t)l * DFF * DM; d.N = DM; d.k0 = 64 * kb; d.sc = 32 * nb; d.nv = 32; d.WT = w_ptr(p, l, W_DN); d.drow = 32 * nb; d.dK = DFF; d.gain = nullptr; d.f8 = 1; return d; }
    r -= I_DN;
    if (r < I_C1) { const int kv = r / 512, rr = r % 512, kb = rr / 8, nb = rr % 8;
        d.W = p.in[kv ? 8 : 6] + (size_t)l * 4096 * 256; d.N = 256; d.k0 = 64 * kb; d.sc = 32 * nb; d.nv = 32; d.WT = w_ptr(p, l, W_C1) + (size_t)kv * 256 * 4096; d.drow = 32 * nb; d.dK = 4096; d.gain = nullptr; d.frag = 1; return d; }
    r -= I_C1;
    { const int kv = r / 16, rr = r % 16, kb = rr / 4, nb = rr % 4;
        d.W = p.in[kv ? 9 : 7] + (size_t)l * 256 * 128; d.N = 128; d.k0 = 64 * kb; d.sc = 32 * nb; d.nv = 32; d.WT = w_ptr(p, l, W_C2) + (size_t)kv * 128 * 256; d.drow = 32 * nb; d.dK = 256; d.gain = nullptr; return d; }
}
#define CONV_LOAD(d, tv) do { const int c_ = lane & 31; const float* wp_ = (d).W + (size_t)((d).k0 + (lane >> 5)) * (d).N + (d).sc + (c_ < (d).nv ? c_ : 0); \
        _Pragma("unroll") for (int i = 0; i < 32; ++i) tv[i] = wp_[(size_t)(2 * i) * (d).N]; } while (0)
#define CONV_STORE(d, tv) do { const int c_ = lane & 31; const bool ok_ = c_ < (d).nv; _Pragma("unroll") for (int i = 0; i < 32; ++i) { const int kk = 2 * i + (lane >> 5); scr[kk * 33 + c_] = ok_ ? tv[i] : 0.f; } \
        asm volatile("s_waitcnt lgkmcnt(0)" ::: "memory"); \
        const int c8 = lane & 7; f32x4 ga = {1.f, 1.f, 1.f, 1.f}, gb = {1.f, 1.f, 1.f, 1.f}; \
        if ((d).gain) { ga = *(const f32x4*)((d).gain + (d).k0 + 8 * c8); gb = *(const f32x4*)((d).gain + (d).k0 + 8 * c8 + 4); } \
        _Pragma("unroll") for (int j = 0; j < 4; ++j) { const int n = (lane >> 3) + 8 * j; const LAS float* s = scr + (8 * c8) * 33 + n; \
            u32x4 o; o.x = pk2(s[0 * 33] * ga.x, s[1 * 33] * ga.y); o.y = pk2(s[2 * 33] * ga.z, s[3 * 33] * ga.w); o.z = pk2(s[4 * 33] * gb.x, s[5 * 33] * gb.y); o.w = pk2(s[6 * 33] * gb.z, s[7 * 33] * gb.w); \
            const int na_ = (d).drow + n, ka_ = (d).k0 + 8 * c8; \
            const size_t off_ = (d).frag ? (size_t)((((na_ >> 4) * 128 + (ka_ >> 5)) * 64 + (((ka_ >> 3) & 3) * 16 + (na_ & 15))) * 8) : (size_t)na_ * (d).dK + ka_; \
            if ((d).f8) { int w0_ = 0, w1_ = 0; \
                w0_ = __builtin_amdgcn_cvt_pk_fp8_f32(s[0 * 33] * ga.x * W8_SCALE, s[1 * 33] * ga.y * W8_SCALE, w0_, false); w0_ = __builtin_amdgcn_cvt_pk_fp8_f32(s[2 * 33] * ga.z * W8_SCALE, s[3 * 33] * ga.w * W8_SCALE, w0_, true); \
                w1_ = __builtin_amdgcn_cvt_pk_fp8_f32(s[4 * 33] * gb.x * W8_SCALE, s[5 * 33] * gb.y * W8_SCALE, w1_, false); w1_ = __builtin_amdgcn_cvt_pk_fp8_f32(s[6 * 33] * gb.z * W8_SCALE, s[7 * 33] * gb.w * W8_SCALE, w1_, true); \
                u32x2 o8_; o8_.x = (unsigned)w0_; o8_.y = (unsigned)w1_; *(u32x2*)((unsigned char*)(d).WT + off_) = o8_; } \
            else *(u32x4*)((d).WT + off_) = o; } \
        asm volatile("s_waitcnt lgkmcnt(0)" ::: "memory"); } while (0)

constexpr int STRIP_RS = 4100, N_STRIPS_L = 184 + 352;
static_assert(32 * STRIP_RS <= MISC_OFF, "LDS map");
struct StripDesc { const float* W; const float* gain; unsigned char* dst; float* dsc; int N, sc, nv, drow; };
__device__ __forceinline__ StripDesc strip_desc(const Params& p, int s) {
    const int l = s / N_STRIPS_L, r = s - l * N_STRIPS_L; StripDesc d;
    if (r < 184) { const int n0 = 32 * r; int sc, nv;
        if (n0 < 2560) { sc = n0; nv = 32; } else if (n0 < 5632) { sc = n0 + 24; nv = 32; } else if (n0 == 5632) { sc = 2560; nv = 24; } else { sc = 0; nv = 0; }
        d.W = p.in[3] + (size_t)l * DM * DIN; d.N = DIN; d.sc = sc; d.nv = nv; d.gain = p.in[2] + (size_t)l * DM;
        d.dst = p.ws + WS_WI8 + (size_t)l * 12 * MiB; d.dsc = (float*)(p.ws + WS_WISC) + l * DINP; d.drow = n0; }
    else { const int r0 = 32 * (r - 184), pn = r0 >> 8, w = r0 & 255;
        d.W = (w < 128 ? p.in[13] : p.in[14]) + (size_t)l * DM * DFF; d.N = DFF; d.sc = 128 * pn + (w & 127); d.nv = 32; d.gain = p.in[12] + (size_t)l * DM;
        d.dst = p.ws + WS_W8 + (size_t)l * 22 * MiB; d.dsc = (float*)(p.ws + WS_WSC) + l * 2 * DFF; d.drow = r0; }
    return d;
}
#define STRIP_LOAD(d, k0, tv) do { const int c_ = lane & 31; const float* wp_ = (d).W + (size_t)((k0) + (lane >> 5)) * (d).N + (d).sc + (c_ < (d).nv ? c_ : 0); \
        _Pragma("unroll") for (int i = 0; i < 32; ++i) tv[i] = wp_[(size_t)(2 * i) * (d).N]; } while (0)
#define STRIP_PUT(d, k0, tv) do { const int c_ = lane & 31, hi_ = lane >> 5; const bool ok_ = c_ < (d).nv; \
        _Pragma("unroll") for (int pp = 0; pp < 16; ++pp) { \
            auto sw_ = __builtin_amdgcn_permlane32_swap(__float_as_uint(tv[2 * pp]), __float_as_uint(tv[2 * pp + 1]), false, false); \
            const float v0_ = __uint_as_float(sw_[0]), v1_ = __uint_as_float(sw_[1]);         \
            const f32x4 g_ = *(const f32x4*)((d).gain + (k0) + 4 * pp); \
            const float g0_ = hi_ ? g_.z : g_.x, g1_ = hi_ ? g_.w : g_.y; \
            *(LAS unsigned*)(c.lds + c_ * STRIP_RS + ((k0) + 4 * pp + 2 * hi_) * 2) = ok_ ? pk2(v0_ * g0_, v1_ * g1_) : 0u; } } while (0)
__device__ __forceinline__ void conv_strips(const Params& p, const Ctx& c) {
    const int lane = c.lane, w = c.wave, total = NL * N_STRIPS_L, step = c.ngw / NWAVES;
    int s = c.bx; float ta[32], tb[32]; StripDesc d{}, d1{};
    if (s < total) { d = strip_desc(p, s); STRIP_LOAD(d, 256 * w, ta); }
    while (s < total) {
        STRIP_LOAD(d, 256 * w + 64, tb);  STRIP_PUT(d, 256 * w, ta);
        STRIP_LOAD(d, 256 * w + 128, ta); STRIP_PUT(d, 256 * w + 64, tb);
        STRIP_LOAD(d, 256 * w + 192, tb); STRIP_PUT(d, 256 * w + 128, ta);
        const int s1 = s + step;
        if (s1 < total) { d1 = strip_desc(p, s1); STRIP_LOAD(d1, 256 * w, ta); }
        STRIP_PUT(d, 256 * w + 192, tb);
        __syncthreads();
#pragma unroll 1
        for (int q = 0; q < 4; ++q) { const int n = w + 8 * q;
            bf16x8 v[4];
#pragma unroll
            for (int j = 0; j < 4; ++j) { const LAS unsigned* q_ = (const LAS unsigned*)(c.lds + n * STRIP_RS + (lane + 64 * j) * 16); u32x4 t_; t_.x = q_[0]; t_.y = q_[1]; t_.z = q_[2]; t_.w = q_[3]; v[j] = __builtin_bit_cast(bf16x8, t_); }
            float mx = 0.f;
#pragma unroll
            for (int j = 0; j < 4; ++j)
#pragma unroll
                for (int e = 0; e < 8; ++e) mx = fmaxf(mx, fabsf((float)v[j][e]));
            mx = wave_max_u(mx);
            const float inv = mx > 0.f ? 127.0f / mx : 0.f;
#pragma unroll
            for (int j = 0; j < 4; ++j) { unsigned ww[2];
#pragma unroll
                for (int h = 0; h < 2; ++h) { unsigned u = 0u;
#pragma unroll
                    for (int e = 0; e < 4; ++e) { const int qv = (int)__builtin_rintf((float)v[j][4 * h + e] * inv); u |= ((unsigned)qv & 0xFFu) << (8 * e); }
                    ww[h] = u; }
                u32x2 o; o.x = ww[0]; o.y = ww[1]; ((u32x2*)(d.dst + (size_t)(d.drow + n) * DM))[lane + 64 * j] = o; }
            if (lane == 0) d.dsc[d.drow + n] = mx * (1.0f / 127.0f); }
        __syncthreads();
        d = d1; s = s1;
    }
}
__device__ __forceinline__ void phase_conv(const Params& p, const Ctx& c) {
    LAS float* scr = (LAS float*)(c.lds + c.wave * 8704);
    const int lane = c.lane;
    { float* cbp = (float*)(p.ws + WS_CBP);
      for (int task = c.gw; task < NL * 2 * 4 * 64; task += c.ngw) { const int ic = task & 63, jg = (task >> 6) & 3, kv = (task >> 8) & 1, l = task >> 9;
          const float* w1 = p.in[kv ? 8 : 6] + (size_t)l * 4096 * 256 + (size_t)(64 * ic) * 256 + 64 * jg + c.lane; const float* cp = p.in[5] + (size_t)l * 4096 + 64 * ic;
          float s = 0.f;
#pragma unroll
          for (int b = 0; b < 4; ++b) { float wv[16];
#pragma unroll
              for (int i = 0; i < 16; ++i) wv[i] = w1[(size_t)(16 * b + i) * 256];
#pragma unroll
              for (int i = 0; i < 16; ++i) s += cp[16 * b + i] * wv[i]; }
          cbp[((l * 2 + kv) * 64 + ic) * 256 + 64 * jg + c.lane] = s; } }
    { const int total = NL * I_LAYER; int it = c.gw;
      float ta[32], tb[32]; ConvItem da, db;
      if (it < total) { da = conv_desc(p, it); CONV_LOAD(da, ta); }
      while (it < total) {
          const int i1 = it + c.ngw;
          if (i1 < total) { db = conv_desc(p, i1); CONV_LOAD(db, tb); }
          CONV_STORE(da, ta);
          if (i1 >= total) break;
          const int i2 = i1 + c.ngw;
          if (i2 < total) { da = conv_desc(p, i2); CONV_LOAD(da, ta); }
          CONV_STORE(db, tb);
          it = i2;
      } }
    __syncthreads();
    conv_strips(p, c);
    { bf16_t* hb = (bf16_t*)(p.ws + WS_XN); float* ssq = (float*)(p.ws + WS_SSQ);
      for (int m = c.gw; m < S; m += c.ngw) {
          const f32x4* xr = (const f32x4*)(p.in[0] + (size_t)m * DM) + c.lane; float ss = 0.f; f32x4 xv[8];
#pragma unroll
          for (int j = 0; j < 8; ++j) xv[j] = xr[64 * j];
#pragma unroll
          for (int j = 0; j < 8; ++j) { const f32x4 v = xv[j]; ss += (v.x * v.x + v.y * v.y) + (v.z * v.z + v.w * v.w);
              u32x2 w; w.x = pk2(v.x, v.y); w.y = pk2(v.z, v.w); ((u32x2*)(hb + (size_t)m * DM))[c.lane + 64 * j] = w; }
          ss = wave_sum(ss);
          if (c.lane < 8) ssq[(size_t)m * 8 + c.lane] = c.lane == 0 ? ss : 0.f; } }
    { const int* pos = (const int*)p.in[1]; float* tab = (float*)(p.ws + WS_ROPE); bf16_t* tabh = (bf16_t*)(p.ws + WS_ROPEH);
      for (int idx = c.gw * 64 + c.lane; idx < S * 16; idx += c.ngw * 64) { const int t = idx >> 4, i = idx & 15;
          const float ang = (float)pos[t] * rope_inv(i); float cs, sn; sincos_d(ang, cs, sn); tab[t * 32 + i] = cs; tab[t * 32 + 16 + i] = sn; tabh[t * 32 + i] = (bf16_t)f2bf(cs); tabh[t * 32 + 16 + i] = (bf16_t)f2bf(sn); } }
}

__device__ __forceinline__ void cbias_reduce(const Params& p, const Ctx& c) {
    const float* cbp = (const float*)(p.ws + WS_CBP); float* cbf = (float*)(p.ws + WS_CBF);
    for (int o = c.gw; o < NL * 2 * 256; o += c.ngw) { const int col = o & 255, lk = o >> 8;
        const float v = wave_sum(cbp[(size_t)(lk * 64 + c.lane) * 256 + col]); if (c.lane == 0) cbf[o] = v; }
}

__device__ __forceinline__ void phase_final_norm(const Ctx& c, const bf16_t* hb, const float* ssq, const float* gain, float* dst) {
    f32x4 g[4][2];
#pragma unroll
    for (int j = 0; j < 4; ++j) { g[j][0] = ((const f32x4*)gain)[2 * (c.lane + 64 * j)]; g[j][1] = ((const f32x4*)gain)[2 * (c.lane + 64 * j) + 1]; }
    for (int m = c.gw; m < S; m += c.ngw) {
        const f32x4* q = (const f32x4*)(ssq + (size_t)m * 8); const f32x4 a = q[0], b = q[1];
        bf16x8 v[4];
#pragma unroll
        for (int j = 0; j < 4; ++j) v[j] = ((const bf16x8*)(hb + (size_t)m * DM))[c.lane + 64 * j];
        const float rstd = __builtin_amdgcn_rsqf((((a.x + a.y) + (a.z + a.w)) + ((b.x + b.y) + (b.z + b.w))) * (1.0f / DM) + EPS);
#pragma unroll
        for (int j = 0; j < 4; ++j) { f32x4 o0, o1;
#pragma unroll
            for (int e = 0; e < 4; ++e) { o0[e] = (float)v[j][e] * rstd * g[j][0][e]; o1[e] = (float)v[j][4 + e] * rstd * g[j][1][e]; }
            f32x4* d = (f32x4*)(dst + (size_t)m * DM) + 2 * (c.lane + 64 * j); d[0] = o0; d[1] = o1; }
    }
}

__device__ __forceinline__ void quant_rows(const Ctx& c, const bf16_t* src, unsigned char* dst, float* scale, int R, float fixed = 0.f) {
    for (int r = c.gw; r < R; r += c.ngw) {
        bf16x8 v[4];
#pragma unroll
        for (int j = 0; j < 4; ++j) v[j] = ((const bf16x8*)(src + (size_t)r * DM))[c.lane + 64 * j];
        float mx = 0.f;
#pragma unroll
        for (int j = 0; j < 4; ++j)
#pragma unroll
            for (int e = 0; e < 8; ++e) mx = fmaxf(mx, fabsf((float)v[j][e]));
        mx = wave_max_u(mx);
        if (fixed > 0.f) mx = fixed;
        const float inv = mx > 0.f ? 127.0f / mx : 0.f;
#pragma unroll
        for (int j = 0; j < 4; ++j) { unsigned w[2];
#pragma unroll
            for (int h = 0; h < 2; ++h) { unsigned u = 0u;
#pragma unroll
                for (int e = 0; e < 4; ++e) { int q = (int)__builtin_rintf((float)v[j][4 * h + e] * inv); q = q > 127 ? 127 : (q < -127 ? -127 : q); u |= ((unsigned)q & 0xFFu) << (8 * e); }
                w[h] = u; }
            u32x2 o; o.x = w[0]; o.y = w[1]; ((u32x2*)(dst + (size_t)r * DM))[c.lane + 64 * j] = o; }
        if (c.lane == 0) scale[r] = mx * (1.0f / 127.0f);
    }
}

constexpr int RSTD_OFF = RING_BYTES, RSTD_MAX_UNITS = 8;
constexpr int CSC_OFF = RSTD_OFF + RSTD_MAX_UNITS * 1024, CSC_MAX_UNITS = 6;
static_assert(CSC_OFF + CSC_MAX_UNITS * 1024 <= MISC_OFF, "LDS map");
__device__ __forceinline__ void prep_rstd(const Ctx& c, const pg8::StaticOrder& so, const float* ssq, const float* asc = nullptr, const float* wsc = nullptr) {
    LAS float* tab = (LAS float*)(c.lds + RSTD_OFF); LAS float* ctab = (LAS float*)(c.lds + CSC_OFF);
    const int half = c.tid >> 8, t = c.tid & 255;
    for (int i = half; i < RSTD_MAX_UNITS; i += 2) { pg8::Unit u; if (!so.next(i, u)) break;
        const f32x4* q = (const f32x4*)(ssq + (size_t)(u.pm * 256 + t) * 8); const f32x4 a = q[0], b = q[1];
        float rs = __builtin_amdgcn_rsqf((((a.x + a.y) + (a.z + a.w)) + ((b.x + b.y) + (b.z + b.w))) * (1.0f / DM) + EPS);
        if (asc) { rs *= asc[u.pm * 256 + t]; if (i < CSC_MAX_UNITS) ctab[i * 256 + t] = wsc[u.pn * 256 + t]; }
        tab[i * 256 + t] = rs; }
}
struct PrepRstd { const Ctx& c; const pg8::StaticOrder& so; const float* ssq; const float* asc; const float* wsc; __device__ __forceinline__ void operator()() const { prep_rstd(c, so, ssq, asc, wsc); } };
struct EpiProj {
    static constexpr bool PERM = true, AFTER_DRAIN = false;
    bf16_t* proj; float* gates; const bf16_t* ropeh; const float* bg; const LAS float* rtab; const LAS float* ctab;
    __device__ __forceinline__ void operator()(pg8::f32x4 (&acc)[2][2][4][2], const pg8::Unit& u, int wr, int wc, int fr, int fq) const {
        const int row0 = u.pm * 256 + wr * 64 + fr;
        {
            const LAS f32x4* cs = (const LAS f32x4*)(ctab + u.ord * 256 + wc * 32 + 8 * fq);
#pragma unroll
            for (int bj = 0; bj < 2; ++bj) { const f32x4 c0 = cs[32 * bj], c1 = cs[32 * bj + 1];
#pragma unroll
                for (int ai = 0; ai < 2; ++ai)
#pragma unroll
                    for (int m = 0; m < 4; ++m) { const pg8::i32x4 i0 = __builtin_bit_cast(pg8::i32x4, acc[ai][bj][m][0]), i1 = __builtin_bit_cast(pg8::i32x4, acc[ai][bj][m][1]);
#pragma unroll
                        for (int j = 0; j < 4; ++j) { acc[ai][bj][m][0][j] = (float)i0[j] * c0[j]; acc[ai][bj][m][1][j] = (float)i1[j] * c1[j]; } } }
        }
        float rstd[2][4];
#pragma unroll
        for (int ai = 0; ai < 2; ++ai)
#pragma unroll
            for (int m = 0; m < 4; ++m) rstd[ai][m] = rtab[u.ord * 256 + ai * 128 + wr * 64 + m * 16 + fr];
        const bool rp = (u.pn < 4 || u.pn == 6 || u.pn == 8) && wc == 0;
        if (rp) {
#pragma unroll
            for (int ai = 0; ai < 2; ++ai) {
                bf16x8 rc[4], rsn[4];
#pragma unroll
                for (int m = 0; m < 4; ++m) { const bf16_t* cs = ropeh + (size_t)(row0 + ai * 128 + m * 16) * 32 + (fq & 1) * 8; rc[m] = *(const bf16x8*)cs; rsn[m] = *(const bf16x8*)(cs + 16); }
#pragma unroll
                for (int m = 0; m < 4; ++m) {
                    f32x4 c0, c1, s0, s1;
#pragma unroll
                    for (int j = 0; j < 4; ++j) { c0[j] = (float)rc[m][j]; c1[j] = (float)rc[m][4 + j]; s0[j] = (float)rsn[m][j]; s1[j] = (float)rsn[m][4 + j]; }
                    if (fq < 2) { s0 = -s0; s1 = -s1; }
#pragma unroll
                    for (int bj = 0; bj < 2; ++bj) {
                        const f32x4 v0 = acc[ai][bj][m][0] * rstd[ai][m], v1 = acc[ai][bj][m][1] * rstd[ai][m]; f32x4 q0, q1;
#pragma unroll
                        for (int j = 0; j < 4; ++j) { q0[j] = partner32(v0[j], fq >> 1); q1[j] = partner32(v1[j], fq >> 1); }
                        acc[ai][bj][m][0] = v0 * c0 + q0 * s0; acc[ai][bj][m][1] = v1 * c1 + q1 * s1;
                    }
                }
            }
        }
        if (u.pn < 22) {
#pragma unroll
            for (int bj = 0; bj < 2; ++bj) {
                bf16_t* base = proj + (size_t)(2 * u.pn + bj) * S * HD + wc * 32 + 8 * fq;
#pragma unroll
                for (int ai = 0; ai < 2; ++ai)
#pragma unroll
                    for (int m = 0; m < 4; ++m) {
                        const float rs = rp ? 1.0f : rstd[ai][m];
                        const f32x4 v0 = acc[ai][bj][m][0] * rs, v1 = acc[ai][bj][m][1] * rs;
                        u32x4 w; w.x = pk2(v0[0], v0[1]); w.y = pk2(v0[2], v0[3]); w.z = pk2(v1[0], v1[1]); w.w = pk2(v1[2], v1[3]);
                        *(u32x4*)(base + (size_t)(row0 + ai * 128 + m * 16) * HD) = w;
                    }
            }
        } else {
            if (wc == 0 && fq < 3) {
                const f32x4 b0 = *(const f32x4*)(bg + 8 * fq), b1 = *(const f32x4*)(bg + 8 * fq + 4);
#pragma unroll
                for (int ai = 0; ai < 2; ++ai)
#pragma unroll
                    for (int m = 0; m < 4; ++m) {
                        f32x4 g0 = acc[ai][0][m][0] * rstd[ai][m] + b0, g1 = acc[ai][0][m][1] * rstd[ai][m] + b1;
#pragma unroll
                        for (int j = 0; j < 4; ++j) { g0[j] = sigmoidf_(g0[j]); g1[j] = sigmoidf_(g1[j]); }
                        f32x4* d = (f32x4*)(gates + (size_t)(row0 + ai * 128 + m * 16) * 24 + 8 * fq); d[0] = g0; d[1] = g1;
                    }
            }
        }
    }
};
struct EpiResid {
    static constexpr bool PERM = false, AFTER_DRAIN = false;
    const float* hin; float* hout;
    __device__ __forceinline__ void operator()(const pg8::f32x4 (&acc)[2][2][4][2], const pg8::Unit& u, int wr, int wc, int fr, int fq) const {
        const int row0 = u.pm * 256 + wr * 64 + fr, col0 = u.pn * 256 + wc * 32 + 4 * fq;
#pragma unroll
        for (int ai = 0; ai < 2; ++ai)
#pragma unroll
            for (int m = 0; m < 4; ++m) { const size_t off = (size_t)(row0 + ai * 128 + m * 16) * DM + col0;
#pragma unroll
                for (int bj = 0; bj < 2; ++bj)
#pragma unroll
                    for (int n = 0; n < 2; ++n) { const size_t o = off + bj * 128 + n * 16; *(f32x4*)(hout + o) = *(const f32x4*)(hin + o) + acc[ai][bj][m][n]; } }
    }
};
struct EpiResidH {
    static constexpr bool PERM = true, AFTER_DRAIN = true;
    bf16_t* hb; float* ssq; float mult;
    unsigned char* q8; float* qsc; float* xslab; unsigned* xcnt; unsigned target;
    __device__ __forceinline__ void fused(pg8::f32x4 (&acc)[2][2][4][2], const pg8::Unit& u, int wr, int wc, int fr, int fq, PG8_LAS unsigned char* lds, int wid, int lane) const {
        const int row0 = u.pm * 256 + wr * 64 + fr, col0 = u.pn * 256 + wc * 32 + 8 * fq;
        PG8_LAS float* P = (PG8_LAS float*)lds;
        PG8_LAS float* PM = (PG8_LAS float*)(lds + 4096);
        PG8_LAS float* INV = (PG8_LAS float*)(lds + 8192);
#pragma unroll
        for (int ai = 0; ai < 2; ++ai) {
            bf16x8 hv[4][2];
#pragma unroll
            for (int m = 0; m < 4; ++m)
#pragma unroll
                for (int bj = 0; bj < 2; ++bj) hv[m][bj] = *(const bf16x8*)(hb + (size_t)(row0 + ai * 128 + m * 16) * DM + col0 + bj * 128);
#pragma unroll
            for (int m = 0; m < 4; ++m) { const size_t off = (size_t)(row0 + ai * 128 + m * 16) * DM + col0; float ss = 0.f, am = 0.f;
#pragma unroll
                for (int bj = 0; bj < 2; ++bj) { f32x4 v0 = acc[ai][bj][m][0] * mult, v1 = acc[ai][bj][m][1] * mult;
#pragma unroll
                    for (int e = 0; e < 4; ++e) { v0[e] += (float)hv[m][bj][e]; v1[e] += (float)hv[m][bj][4 + e]; }
                    u32x4 w; w.x = pk2(v0.x, v0.y); w.y = pk2(v0.z, v0.w); w.z = pk2(v1.x, v1.y); w.w = pk2(v1.z, v1.w); *(u32x4*)(hb + off + bj * 128) = w;
                    acc[ai][bj][m][0] = v0; acc[ai][bj][m][1] = v1;
#pragma unroll
                    for (int e = 0; e < 4; ++e) am = fmaxf(am, fmaxf(fabsf(v0[e]), fabsf(v1[e])));
                    ss += ((v0.x * v0.x + v0.y * v0.y) + (v0.z * v0.z + v0.w * v0.w)) + ((v1.x * v1.x + v1.y * v1.y) + (v1.z * v1.z + v1.w * v1.w)); }
                ss += __builtin_bit_cast(float, __builtin_amdgcn_ds_swizzle(__builtin_bit_cast(int, ss), 0x401F)); ss += partner32(ss, fq >> 1);
                am = fmaxf(am, __builtin_bit_cast(float, __builtin_amdgcn_ds_swizzle(__builtin_bit_cast(int, am), 0x401F))); am = fmaxf(am, partner32(am, fq >> 1));
                if (fq == 0) { P[(ai * 128 + wr * 64 + m * 16 + fr) * 4 + wc] = ss; PM[(ai * 128 + wr * 64 + m * 16 + fr) * 4 + wc] = am; }
                asm volatile("" ::: "memory"); } }
        asm volatile("s_waitcnt lgkmcnt(0)" ::: "memory"); __builtin_amdgcn_s_barrier(); asm volatile("" ::: "memory");
        const int t = wid * 64 + lane;
        if (q8) {
            if (t < 256) { const PG8_LAS float* q = PM + t * 4; __hip_atomic_store(xslab + (size_t)(u.pm * 8 + u.pn) * 256 + t, fmaxf(fmaxf(q[0], q[1]), fmaxf(q[2], q[3])), __ATOMIC_RELAXED, __HIP_MEMORY_SCOPE_AGENT); }
            asm volatile("s_waitcnt vmcnt(0)" ::: "memory");
        }
        if (t < 256) { const PG8_LAS float* q = P + t * 4; ssq[(size_t)(u.pm * 256 + t) * 8 + u.pn] = (q[0] + q[1]) + (q[2] + q[3]); }
        if (q8) {
            __syncthreads();
            if (t == 0) { (void)__hip_atomic_fetch_add(xcnt + 64 * u.pm, 1u, __ATOMIC_RELAXED, __HIP_MEMORY_SCOPE_AGENT);
                unsigned spins = 0; while (__hip_atomic_load(xcnt + 64 * u.pm, __ATOMIC_RELAXED, __HIP_MEMORY_SCOPE_AGENT) < target && ++spins < (1u << 22)) __builtin_amdgcn_s_sleep(1); }
            __syncthreads();
            if (t < 256) { float pm8[8];
#pragma unroll
                for (int j = 0; j < 8; ++j) pm8[j] = __hip_atomic_load(xslab + (size_t)(u.pm * 8 + j) * 256 + t, __ATOMIC_RELAXED, __HIP_MEMORY_SCOPE_AGENT);
                const float mx = fmaxf(fmaxf(fmaxf(pm8[0], pm8[1]), fmaxf(pm8[2], pm8[3])), fmaxf(fmaxf(pm8[4], pm8[5]), fmaxf(pm8[6], pm8[7])));
                INV[t] = mx > 0.f ? 127.0f / mx : 0.f;
                if (u.pn == 0) qsc[u.pm * 256 + t] = mx * (1.0f / 127.0f); }
            asm volatile("s_waitcnt lgkmcnt(0)" ::: "memory"); __builtin_amdgcn_s_barrier(); asm volatile("" ::: "memory");
#pragma unroll
            for (int ai = 0; ai < 2; ++ai)
#pragma unroll
                for (int m = 0; m < 4; ++m) { const float inv = INV[ai * 128 + wr * 64 + m * 16 + fr]; const size_t off = (size_t)(row0 + ai * 128 + m * 16) * DM + col0;
#pragma unroll
                    for (int bj = 0; bj < 2; ++bj) { unsigned w[2];
#pragma unroll
                        for (int n = 0; n < 2; ++n) { const f32x4 v = acc[ai][bj][m][n]; unsigned uu = 0u;
#pragma unroll
                            for (int e = 0; e < 4; ++e) { int q = (int)__builtin_rintf(v[e] * inv); q = q > 127 ? 127 : (q < -127 ? -127 : q); uu |= ((unsigned)q & 0xFFu) << (8 * e); }
                            w[n] = uu; }
                        u32x2 o; o.x = w[0]; o.y = w[1]; *(u32x2*)(q8 + off + bj * 128) = o; } }
        }
    }
};

struct EpiSwiGLU {
    static constexpr bool PERM = true, AFTER_DRAIN = false;
    unsigned char* act; const LAS float* rtab; const LAS float* ctab;
    __device__ __forceinline__ void operator()(const pg8::f32x4 (&acc)[2][2][4][2], const pg8::Unit& u, int wr, int wc, int fr, int fq) const {
        const int row0 = u.pm * 256 + wr * 64 + fr, col0 = u.pn * 128 + wc * 32 + 8 * fq;
        const LAS f32x4* cs = (const LAS f32x4*)(ctab + u.ord * 256 + wc * 32 + 8 * fq);
        const f32x4 cg0 = cs[0], cg1 = cs[1], cu0 = cs[32], cu1 = cs[33];
#pragma unroll
        for (int ai = 0; ai < 2; ++ai)
#pragma unroll
            for (int m = 0; m < 4; ++m) {
                const float rs = rtab[u.ord * 256 + ai * 128 + wr * 64 + m * 16 + fr];
                f32x4 g0, g1, u0, u1;
                const pg8::i32x4 ig0 = __builtin_bit_cast(pg8::i32x4, acc[ai][0][m][0]), ig1 = __builtin_bit_cast(pg8::i32x4, acc[ai][0][m][1]);
                const pg8::i32x4 iu0 = __builtin_bit_cast(pg8::i32x4, acc[ai][1][m][0]), iu1 = __builtin_bit_cast(pg8::i32x4, acc[ai][1][m][1]);
#pragma unroll
                for (int j = 0; j < 4; ++j) {
                    g0[j] = (float)ig0[j] * (rs * cg0[j]); g1[j] = (float)ig1[j] * (rs * cg1[j]);
                    u0[j] = (float)iu0[j] * (rs * cu0[j]); u1[j] = (float)iu1[j] * (rs * cu1[j]); }
                f32x4 o0, o1;
#pragma unroll
                for (int j = 0; j < 4; ++j) { o0[j] = g0[j] * sigmoidf_(g0[j]) * u0[j]; o1[j] = g1[j] * sigmoidf_(g1[j]) * u1[j]; }
                int w0 = 0, w1 = 0;
                w0 = __builtin_amdgcn_cvt_pk_fp8_f32(o0[0] * A8_SCALE, o0[1] * A8_SCALE, w0, false); w0 = __builtin_amdgcn_cvt_pk_fp8_f32(o0[2] * A8_SCALE, o0[3] * A8_SCALE, w0, true);
                w1 = __builtin_amdgcn_cvt_pk_fp8_f32(o1[0] * A8_SCALE, o1[1] * A8_SCALE, w1, false); w1 = __builtin_amdgcn_cvt_pk_fp8_f32(o1[2] * A8_SCALE, o1[3] * A8_SCALE, w1, true);
                u32x2 w; w.x = (unsigned)w0; w.y = (unsigned)w1;
                *(u32x2*)(act + (size_t)(row0 + ai * 128 + m * 16) * DFF + col0) = w;
            }
    }
};

constexpr int CMPR_A_BYTES = 272 * 256 + 17 * 16, CMPR_HID = 70144;
__device__ __forceinline__ void phase_cmpr(const Params& p, const Ctx& c, int l) {
    const bf16_t* proj = (const bf16_t*)(p.ws + WS_PROJ); const float* rope = (const float*)(p.ws + WS_ROPE); const float* cbf = (const float*)(p.ws + WS_CBF);
    LAS bf16_t* hid = (LAS bf16_t*)(c.lds + CMPR_HID);
    const int lane = c.lane, w = c.wave, l15 = lane & 15, q4 = lane >> 4;
    const int u = c.bx >> 1, hh = c.bx & 1;
    const int kv = u >> 6, g = (u >> 5) & 1, rb = u & 31, n0 = 16 * rb;
    { bf16x8 sv[9];
      const bf16_t* src = proj + (size_t)((kv ? 10 : 8) + g) * S * HD;
#pragma unroll
      for (int i = 0; i < 9; ++i) { int ci = c.tid + NTHREADS * i; if (ci > 272 * 16 - 1) ci = 272 * 16 - 1; const int tk = ci >> 4, ch = ci & 15; int ta = 16 * n0 + tk; if (ta > S - 1) ta = S - 1;
          sv[i] = *(const bf16x8*)(src + (size_t)ta * HD + ch * 8); }
#pragma unroll
      for (int i = 0; i < 9; ++i) { const int ci = c.tid + NTHREADS * i; const int tk = ci >> 4, ch = ci & 15;
          if (ci < 272 * 16) *(LAS bf16x8*)(c.lds + tk * 256 + (tk >> 4) * 16 + ch * 16) = sv[i]; } }
    __syncthreads();
    const int ct = 8 * hh + w;
    const bf16_t* bf = w_ptr(p, l, W_C1) + (size_t)kv * 256 * 4096 + (size_t)ct * 128 * 512 + lane * 8;
    const LAS unsigned char* abase = c.lds + l15 * (4096 + 16) + q4 * 16;
    f32x4 acc = {0.f, 0.f, 0.f, 0.f};
    {
        bf16x8 B0[8], B1[8];
#define CMPR_LD(B_, ks_) do { _Pragma("unroll") for (int i = 0; i < 8; ++i) B_[i] = *(const bf16x8*)(bf + (size_t)((ks_) + i) * 512); } while (0)
#define CMPR_MM(B_, ks_) do { _Pragma("unroll") for (int i = 0; i < 8; ++i) { const int k_ = 32 * ((ks_) + i); \
            const bf16x8 a_ = *(const LAS bf16x8*)(abase + (k_ >> 7) * 256 + ((k_ >> 7) >= 16 ? 16 : 0) + (k_ & 127) * 2); \
            acc = __builtin_amdgcn_mfma_f32_16x16x32_f16(a_, B_[i], acc, 0, 0, 0); } } while (0)
        CMPR_LD(B0, 0);
        for (int ks = 0; ks < 128; ks += 16) {
            CMPR_LD(B1, ks + 8);
            CMPR_MM(B0, ks);
            if (ks + 16 < 128) CMPR_LD(B0, ks + 16);
            CMPR_MM(B1, ks + 8);
        }
#undef CMPR_LD
#undef CMPR_MM
    }
    { const int col = 16 * ct + l15; const float bs = cbf[(l * 2 + kv) * 256 + col];
#pragma unroll
      for (int j = 0; j < 4; ++j) hid[(q4 * 4 + j) * 136 + 16 * w + l15] = (bf16_t)f2bf(gelu_tanh(acc[j] + bs)); }
    __syncthreads();
    f32x4 o = {0.f, 0.f, 0.f, 0.f};
    const int ocol = (w < 2) ? ((l15 < 8) ? 8 * w + l15 : 16 + 8 * w + (l15 - 8)) : 16 * w + l15;
    const bf16_t* w2 = w_ptr(p, l, W_C2) + (size_t)kv * 128 * 256 + (size_t)ocol * 256 + 128 * hh + 8 * q4;
#pragma unroll
    for (int k0 = 0; k0 < 128; k0 += 32) {
        const bf16x8 a = *(const LAS bf16x8*)(hid + l15 * 136 + k0 + 8 * q4), b = *(const bf16x8*)(w2 + k0);
        o = __builtin_amdgcn_mfma_f32_16x16x32_f16(a, b, o, 0, 0, 0);
    }
    float* part = (float*)(p.ws + WS_CPART) + (size_t)u * 2048; unsigned* flag = (unsigned*)(p.ws + WS_CTL) + CW_CFLAG + 64 * u;
    if (hh == 1) {
#pragma unroll
        for (int j = 0; j < 4; ++j) __hip_atomic_store(part + (q4 * 4 + j) * 128 + 16 * w + l15, o[j], __ATOMIC_RELAXED, __HIP_MEMORY_SCOPE_AGENT);
        asm volatile("s_waitcnt vmcnt(0)" ::: "memory");
        __syncthreads();
        if (c.tid == 0) __hip_atomic_store(flag, (unsigned)(l + 1), __ATOMIC_RELAXED, __HIP_MEMORY_SCOPE_AGENT);
    } else {
        if (c.tid == 0) { unsigned spins = 0; while (__hip_atomic_load(flag, __ATOMIC_RELAXED, __HIP_MEMORY_SCOPE_AGENT) != (unsigned)(l + 1) && ++spins < (1u << 22)) __builtin_amdgcn_s_sleep(2); }
        __syncthreads();
        __builtin_amdgcn_fence(__ATOMIC_ACQUIRE, "agent");
        asm volatile("s_waitcnt vmcnt(0)" ::: "memory");
        bf16_t* dst = (bf16_t*)(p.ws + (kv ? WS_VC : WS_KC)) + (size_t)g * 512 * HD;
        float pv[4], cs[4], sn[4];
#pragma unroll
        for (int j = 0; j < 4; ++j) { pv[j] = part[(q4 * 4 + j) * 128 + 16 * w + l15]; cs[j] = 1.f; sn[j] = 0.f;
            if (kv == 0 && w < 2) { int ti = 16 * (n0 + q4 * 4 + j) + 31; if (ti > S - 1) ti = S - 1; const int fi = 8 * w + (l15 & 7); cs[j] = rope[ti * 32 + fi]; sn[j] = rope[ti * 32 + 16 + fi]; } }
#pragma unroll
        for (int j = 0; j < 4; ++j) {
            const int n = n0 + q4 * 4 + j; float v = o[j] + pv[j];
            if (kv == 0 && w < 2) { const float pr = DPP_F(0.f, v, 0x128, 0xf);     v = (l15 < 8) ? v * cs[j] - pr * sn[j] : v * cs[j] + pr * sn[j]; }
            if (n > 510) v = 0.f;
            dst[(size_t)n * HD + ocol] = (bf16_t)f2bf(v);
        }
    }
    __syncthreads();
}
typedef float f32x16 __attribute__((ext_vector_type(16)));
typedef _Float16 h4_t __attribute__((ext_vector_type(4)));
#define KSWZ(row, colB) ((row) * 256 + ((colB) ^ (((row) & 7) << 4)))
__device__ __forceinline__ int v_st(int k, int c) { const int kk = (k & ~0xC) | ((k & 4) << 1) | ((k & 8) >> 1); return ((kk >> 3) * 4 + (c >> 5)) * 512 + ((kk & 7) * 32 + (c & 31)) * 2; }
__device__ __forceinline__ int v_rd_base(int lane) { return ((lane & 3) << 3) | (((lane >> 2) & 3) << 6) | (((lane >> 4) & 1) << 5) | (((lane >> 5) & 1) << 8); }
constexpr int v_rd_off(int d0, int ks, int half) { return d0 * 512 + ks * 4096 + half * 2048; }
__device__ __forceinline__ int crow(int r, int hi) { return (r & 3) + 8 * (r >> 2) + 4 * hi; }
__device__ __forceinline__ void qkt(f32x16& p0, f32x16& p1, const LAS char* K_lds, int r32, int hi, const bf16x8* qr) {
#pragma unroll
    for (int r = 0; r < 16; ++r) { p0[r] = 0.f; p1[r] = 0.f; }
    int base = r32 * 256 + ((hi * 16) ^ ((r32 & 7) << 4));
    asm volatile("" : "+v"(base));
#pragma unroll
    for (int d0 = 0; d0 < 8; ++d0) { const LAS char* a = K_lds + (base ^ ((d0 & 3) << 5)) + (d0 >> 2) * 128;
        const bf16x8 b0 = *(const LAS bf16x8*)a, b1 = *(const LAS bf16x8*)(a + 32 * 256);
        p0 = __builtin_amdgcn_mfma_f32_32x32x16_f16(b0, qr[d0], p0, 0, 0, 0);
        p1 = __builtin_amdgcn_mfma_f32_32x32x16_f16(b1, qr[d0], p1, 0, 0, 0);
        if (d0 == 3) __builtin_amdgcn_sched_barrier(0); }
}
__device__ __forceinline__ void pack_p(const f32x16& p0, const f32x16& p1, bf16x8& pa0, bf16x8& pa1, bf16x8& pa2, bf16x8& pa3) {
#define PK4(P, B_, OUT) do { const unsigned a0 = pk2(P[B_ + 0], P[B_ + 1]), a1 = pk2(P[B_ + 2], P[B_ + 3]), b0 = pk2(P[B_ + 4], P[B_ + 5]), b1 = pk2(P[B_ + 6], P[B_ + 7]); \
        auto r0 = __builtin_amdgcn_permlane32_swap(a0, b0, false, false); auto r1 = __builtin_amdgcn_permlane32_swap(a1, b1, false, false); \
        u32x4 w = {r0[0], r1[0], r0[1], r1[1]}; OUT = __builtin_bit_cast(bf16x8, w); } while (0)
    PK4(p0, 0, pa0); PK4(p0, 8, pa1); PK4(p1, 0, pa2); PK4(p1, 8, pa3);
#undef PK4
}
__device__ __forceinline__ void pv_tile(f32x16* o, int vb0, bf16x8 pa0, bf16x8 pa1, bf16x8 pa2, bf16x8 pa3) {
#define TRRD(dst, off) asm volatile("ds_read_b64_tr_b16 %0, %1 offset:%2" : "=&v"(dst) : "v"(vb0), "i"(off) : "memory")
#define PV_D0(d0) do { h4_t l0, l1, l2, l3, h0, h1, h2, h3; constexpr int b_ = v_rd_off(d0, 0, 0); \
        TRRD(l0, b_); TRRD(h0, b_ + 2048); TRRD(l1, b_ + 4096); TRRD(h1, b_ + 6144); TRRD(l2, b_ + 8192); TRRD(h2, b_ + 10240); TRRD(l3, b_ + 12288); TRRD(h3, b_ + 14336); \
        asm volatile("s_waitcnt lgkmcnt(0)" ::: "memory"); __builtin_amdgcn_sched_barrier(0); \
        o[d0] = __builtin_amdgcn_mfma_f32_32x32x16_f16(pa0, (bf16x8){l0[0], l0[1], l0[2], l0[3], h0[0], h0[1], h0[2], h0[3]}, o[d0], 0, 0, 0); \
        o[d0] = __builtin_amdgcn_mfma_f32_32x32x16_f16(pa1, (bf16x8){l1[0], l1[1], l1[2], l1[3], h1[0], h1[1], h1[2], h1[3]}, o[d0], 0, 0, 0); \
        o[d0] = __builtin_amdgcn_mfma_f32_32x32x16_f16(pa2, (bf16x8){l2[0], l2[1], l2[2], l2[3], h2[0], h2[1], h2[2], h2[3]}, o[d0], 0, 0, 0); \
        o[d0] = __builtin_amdgcn_mfma_f32_32x32x16_f16(pa3, (bf16x8){l3[0], l3[1], l3[2], l3[3], h3[0], h3[1], h3[2], h3[3]}, o[d0], 0, 0, 0); } while (0)
    PV_D0(0); PV_D0(1); PV_D0(2); PV_D0(3);
#undef PV_D0
#undef TRRD
}

__device__ __forceinline__ void qkt_half(f32x16& ph, const LAS char* K_lds, int half, int r32, int hi, const bf16x8* qr) {
#pragma unroll
    for (int r = 0; r < 16; ++r) ph[r] = 0.f;
    int base = r32 * 256 + ((hi * 16) ^ ((r32 & 7) << 4)) + half * 8192;
    asm volatile("" : "+v"(base));
    __builtin_amdgcn_s_setprio(1);
#pragma unroll
    for (int d0 = 0; d0 < 8; ++d0) { const LAS char* a = K_lds + (base ^ ((d0 & 3) << 5)) + (d0 >> 2) * 128;
        const bf16x8 b0 = *(const LAS bf16x8*)a;
        ph = __builtin_amdgcn_mfma_f32_32x32x16_f16(b0, qr[d0], ph, 0, 0, 0); }
    __builtin_amdgcn_s_setprio(0);
}
__device__ __forceinline__ void pack_half(const f32x16& ph, bf16x8& pa0, bf16x8& pa1) {
#define PK4(P, B_, OUT) do { const unsigned a0 = pk2(P[B_ + 0], P[B_ + 1]), a1 = pk2(P[B_ + 2], P[B_ + 3]), b0 = pk2(P[B_ + 4], P[B_ + 5]), b1 = pk2(P[B_ + 6], P[B_ + 7]); \
        auto r0 = __builtin_amdgcn_permlane32_swap(a0, b0, false, false); auto r1 = __builtin_amdgcn_permlane32_swap(a1, b1, false, false); \
        u32x4 w = {r0[0], r1[0], r0[1], r1[1]}; OUT = __builtin_bit_cast(bf16x8, w); } while (0)
    PK4(ph, 0, pa0); PK4(ph, 8, pa1);
#undef PK4
}
__device__ __forceinline__ void pv_half(f32x16* o, int vbh, bf16x8 pa0, bf16x8 pa1) {
#define TRRD(dst, off) asm volatile("ds_read_b64_tr_b16 %0, %1 offset:%2" : "=&v"(dst) : "v"(vbh), "i"(off) : "memory")
    h4_t l0[4], h0[4], l1[4], h1[4];
#define PV_RD(d0) do { constexpr int b_ = v_rd_off(d0, 0, 0); TRRD(l0[d0], b_); TRRD(h0[d0], b_ + 2048); TRRD(l1[d0], b_ + 4096); TRRD(h1[d0], b_ + 6144); } while (0)
    PV_RD(0); PV_RD(1); PV_RD(2); PV_RD(3);
    asm volatile("s_waitcnt lgkmcnt(0)" ::: "memory"); __builtin_amdgcn_sched_barrier(0);
    __builtin_amdgcn_s_setprio(1);
#pragma unroll
    for (int d0 = 0; d0 < 4; ++d0) {
        o[d0] = __builtin_amdgcn_mfma_f32_32x32x16_f16(pa0, (bf16x8){l0[d0][0], l0[d0][1], l0[d0][2], l0[d0][3], h0[d0][0], h0[d0][1], h0[d0][2], h0[d0][3]}, o[d0], 0, 0, 0);
        o[d0] = __builtin_amdgcn_mfma_f32_32x32x16_f16(pa1, (bf16x8){l1[d0][0], l1[d0][1], l1[d0][2], l1[d0][3], h1[d0][0], h1[d0][1], h1[d0][2], h1[d0][3]}, o[d0], 0, 0, 0); }
    __builtin_amdgcn_s_setprio(0);
#undef PV_RD
#undef TRRD
}

__device__ __forceinline__ float wave_max_dpp(float v) {
    v = fmaxf(v, DPP_F(v, v, 0x111, 0xf)); v = fmaxf(v, DPP_F(v, v, 0x112, 0xf)); v = fmaxf(v, DPP_F(v, v, 0x114, 0xf)); v = fmaxf(v, DPP_F(v, v, 0x118, 0xf));
    v = fmaxf(v, DPP_F(v, v, 0x142, 0xa)); v = fmaxf(v, DPP_F(v, v, 0x143, 0xc));
    return __builtin_bit_cast(float, __builtin_amdgcn_readlane(__builtin_bit_cast(int, v), 63));
}
__device__ __forceinline__ float half_sum_dpp(float v, int hi) {
    v += DPP_F(0.f, v, 0x111, 0xf); v += DPP_F(0.f, v, 0x112, 0xf); v += DPP_F(0.f, v, 0x114, 0xf); v += DPP_F(0.f, v, 0x118, 0xf);
    v += DPP_F(0.f, v, 0x142, 0xa);
    const float lo = __builtin_bit_cast(float, __builtin_amdgcn_readlane(__builtin_bit_cast(int, v), 31)), hs = __builtin_bit_cast(float, __builtin_amdgcn_readlane(__builtin_bit_cast(int, v), 63));
    return hi ? hs : lo;
}

__device__ __forceinline__ float quad_swap1(float x) { return __int_as_float(__builtin_amdgcn_update_dpp(0, __float_as_int(x), 0xB1, 0xF, 0xF, true)); }
__device__ __forceinline__ void store_row4(bf16_t* orow_e  , float v0, float v1, float v2, float v3, int odd) {
    { const float y = quad_swap1(odd ? v0 : v1); *(unsigned*)(orow_e + (odd ? 32 : 0)) = odd ? pk2(y, v1) : pk2(v0, y); }
    { const float y = quad_swap1(odd ? v2 : v3); *(unsigned*)(orow_e + (odd ? 96 : 64)) = odd ? pk2(y, v3) : pk2(v2, y); }
}
__device__ __forceinline__ void store_head_rows(const f32x16* o, const float* ggrp_h, bf16_t* Obase  , int r32, int hi) {
    float gg[4];
#pragma unroll
    for (int d0 = 0; d0 < 4; ++d0) gg[d0] = ggrp_h[d0 * 32 + r32];
    const int odd = r32 & 1;
#pragma unroll
    for (int r = 0; r < 16; ++r) {
        const float ss = half_sum_dpp((o[0][r] * o[0][r] + o[1][r] * o[1][r]) + (o[2][r] * o[2][r] + o[3][r] * o[3][r]), hi);
        const float rs = __builtin_amdgcn_rsqf(ss * (1.0f / HD) + EPS);
        store_row4(Obase + (size_t)crow(r, hi) * DM + (r32 & ~1), o[0][r] * rs * gg[0], o[1][r] * rs * gg[1], o[2][r] * rs * gg[2], o[3][r] * rs * gg[3], odd);
    }
}


enum { M_CSTAT = 0, M_CIMP = 1, M_SLC = 2, M_CPV = 3, M_WSTAT = 4, M_WPV = 5, M_SB = 6 };
constexpr int ATT_WS = 0, ATT_FLAGS = 2048, NSA_SEL = 2112, NSA_WUNI = 3136, ATT_V0 = 4096, ATT_K0 = ATT_V0 + 3 * 16384, NSA_P = ATT_V0  ;
constexpr int ATT_END = ATT_K0 + 4 * 16384;
constexpr int TNONE = 128;
static_assert(ATT_END <= MISC_OFF, "LDS map");
__device__ __forceinline__ int next_bit(unsigned m0, unsigned m1, unsigned m2, unsigned m3, int from) {
    if (from < 32) { const unsigned w = m0 & (~0u << from); if (w) return __builtin_ctz(w); from = 32; }
    if (from < 64) { const unsigned w = m1 & (~0u << (from - 32)); if (w) return 32 + __builtin_ctz(w); from = 64; }
    if (from < 96) { const unsigned w = m2 & (~0u << (from - 64)); if (w) return 64 + __builtin_ctz(w); from = 96; }
    if (from < 128) { const unsigned w = m3 & (~0u << (from - 96)); if (w) return 96 + __builtin_ctz(w); }
    return 128;
}
__device__ __forceinline__ unsigned bit_of(unsigned m0, unsigned m1, unsigned m2, unsigned m3, int j) { const unsigned w = j < 32 ? m0 : j < 64 ? m1 : j < 96 ? m2 : m3; return (w >> (j & 31)) & 1u; }
__device__ __forceinline__ float quad_sum(float x) {
    x += __builtin_bit_cast(float, __builtin_amdgcn_update_dpp(0, __builtin_bit_cast(int, x), 0xB1, 0xf, 0xf, true));
    x += __builtin_bit_cast(float, __builtin_amdgcn_update_dpp(0, __builtin_bit_cast(int, x), 0x4E, 0xf, 0xf, true));
    return x;
}
struct PassArgs {
    const bf16_t* Kp; const bf16_t* Vp;
    unsigned tm0, tm1, tm2, tm3;
    unsigned wm0, wm1, wm2, wm3;
    unsigned sw0, sw1, sw2, sw3;
    int tok, nvr, b, nvmin;
    int jtop, tw0;
    float f;
};
template <int MODE>
__device__ __forceinline__ void attn_pass(const Ctx& c, const bf16x8 (&qr)[8], f32x16 (&o)[4], float& m, float& l, const PassArgs& a) {
    constexpr bool SB = (MODE == M_SB);
    constexpr bool HASV = (MODE == M_SLC || MODE == M_CPV || MODE == M_WPV || SB);
    constexpr bool CMP = (MODE == M_CSTAT || MODE == M_CIMP || MODE == M_CPV);
    constexpr bool WIN = (MODE == M_WSTAT || MODE == M_WPV);
    constexpr int HA = SB ? 1 : 0, HB = SB ? 0 : 1;
    constexpr float C2 = SCALE * 1.4426950408889634f;
    const int lane = c.lane, w = c.wave, r32 = lane & 31, hi = lane >> 5;
    LAS char* V_lds = (LAS char*)c.lds + ATT_V0; LAS char* K_lds = (LAS char*)c.lds + ATT_K0;
    LAS float* wsf = (LAS float*)(c.lds + ATT_WS) + w * 64;
    volatile LAS unsigned* flags = (volatile LAS unsigned*)(c.lds + ATT_FLAGS);
    unsigned kg0, kg1, vg0, vg1;
    { const int A0 = 16 * (64 * w + lane), A1 = A0 + 8192;
      { const int row = A0 >> 8, cB = (A0 & 255) ^ ((row & 7) << 4); kg0 = (unsigned)(row * HD * 2 + cB); }
      { const int row = A1 >> 8, cB = (A1 & 255) ^ ((row & 7) << 4); kg1 = (unsigned)(row * HD * 2 + cB); }
      { const int st = A0 >> 9, wi = A0 & 511, kk = (st >> 2) * 8 + (wi >> 6), cc = (st & 3) * 32 + ((wi & 63) >> 1), k = (kk & ~0xC) | ((kk & 4) << 1) | ((kk & 8) >> 1); vg0 = (unsigned)((k * HD + cc) * 2); }
      { const int st = A1 >> 9, wi = A1 & 511, kk = (st >> 2) * 8 + (wi >> 6), cc = (st & 3) * 32 + ((wi & 63) >> 1), k = (kk & ~0xC) | ((kk & 4) << 1) | ((kk & 8) >> 1); vg1 = (unsigned)((k * HD + cc) * 2); } }
    const int vb0 = (int)(unsigned)(size_t)V_lds + v_rd_base(lane);
    const float NEG = -__builtin_inff();
    bool done = false;
#define AP_NEXT(j_) (SB ? ((j_) > 0 ? (j_) - 1 : TNONE) : next_bit(a.tm0, a.tm1, a.tm2, a.tm3, (j_) + 1))
#define AP_ACT(j_) (SB ? (!done && 64 * (j_) <= a.tw0 + 30) : (bit_of(a.wm0, a.wm1, a.wm2, a.wm3, (j_)) != 0u))
#define AP_DMAK(j_, buf) do { const bf16_t* g_ = a.Kp + (size_t)(64 * (j_)) * HD; \
        __builtin_amdgcn_global_load_lds((const unsigned*)((const char*)g_ + kg0), (LAS unsigned*)(K_lds + (buf) * 16384 + w * 1024), 16, 0, 0); \
        __builtin_amdgcn_global_load_lds((const unsigned*)((const char*)g_ + kg1), (LAS unsigned*)(K_lds + (buf) * 16384 + 8192 + w * 1024), 16, 0, 0); } while (0)
#define AP_DMAV(j_, buf) do { if (HASV) { const bf16_t* g_ = a.Vp + (size_t)(64 * (j_)) * HD; \
        __builtin_amdgcn_global_load_lds((const unsigned*)((const char*)g_ + vg0), (LAS unsigned*)(V_lds + (buf) * 16384 + w * 1024), 16, 0, 0); \
        __builtin_amdgcn_global_load_lds((const unsigned*)((const char*)g_ + vg1), (LAS unsigned*)(V_lds + (buf) * 16384 + 8192 + w * 1024), 16, 0, 0); } } while (0)
#define AP_WAITN(full) do { if (full) { if (HASV) asm volatile("s_waitcnt vmcnt(4)" ::: "memory"); else asm volatile("s_waitcnt vmcnt(2)" ::: "memory"); } \
                            else asm volatile("s_waitcnt vmcnt(0)" ::: "memory"); } while (0)
    int j0 = SB ? a.jtop : next_bit(a.tm0, a.tm1, a.tm2, a.tm3, 0);
    if (j0 >= TNONE) return;
    int j1 = AP_NEXT(j0), j2 = j1 < TNONE ? AP_NEXT(j1) : TNONE, j3 = j2 < TNONE ? AP_NEXT(j2) : TNONE;
    int kc = 0, vc = 0;
    f32x16 pX, pY;
    bf16x8 kf[4];
    float carry = 0.f;
    __syncthreads();
    AP_DMAK(j0, 0); AP_DMAV(j0, 0);
    if (j1 < TNONE) AP_DMAK(j1, 1);
    bool full = j2 < TNONE;
    if (j2 < TNONE) AP_DMAK(j2, 2);
    if (j1 < TNONE) AP_DMAV(j1, 1);
    AP_WAITN(full); __syncthreads();
    if (AP_ACT(j0)) qkt_half(pX, K_lds, HA, r32, hi, qr);
#define AP_SB_EL(P, HF, r) do { const float y = P[r] * C2; \
                const float sp = fmaxf(y, 0.f) + __builtin_amdgcn_logf(1.0f + __builtin_amdgcn_exp2f(-fabsf(y))); \
                float Lr = -sp, br = y - sp; \
                if (needmask) { const bool ok = (dq - 32 * (HF) - (((r) & 3) + 8 * ((r) >> 2))) >= 0; Lr = ok ? Lr : 0.f; br = ok ? br : NEG; } \
                Lv[r] = Lr; P[r] = br; } while (0)
#define AP_KADDR(KT, QH, d_) ((KT) + (kb_ ^ (((d_) & 3) << 5)) + ((d_) >> 2) * 128)
#define AP_QMFMA(PN, c_, KT, QH) do { if ((c_) == 0) { f32x16 z_; _Pragma("unroll") for (int q_ = 0; q_ < 16; ++q_) z_[q_] = 0.f; PN = __builtin_amdgcn_mfma_f32_32x32x16_f16(kf[0], qr[0], z_, 0, 0, 0); } \
        else PN = __builtin_amdgcn_mfma_f32_32x32x16_f16(kf[(c_) & 3], qr[c_], PN, 0, 0, 0); \
        if ((c_) + 4 < 8) kf[(c_) & 3] = *(const LAS bf16x8*)AP_KADDR(KT, QH, (c_) + 4);        \
        __builtin_amdgcn_sched_barrier(0); } while (0)
#define AP_QPIN(KT, QH) int kb_ = r32 * 256 + ((hi * 16) ^ ((r32 & 7) << 4)) + (QH) * 8192; asm volatile("" : "+v"(kb_)); \
        _Pragma("unroll") for (int d_ = 0; d_ < 4; ++d_) kf[d_] = *(const LAS bf16x8*)AP_KADDR(KT, QH, d_); \
        __builtin_amdgcn_sched_barrier(0)
#define AP_PROCH(P, J, HF, VB, DOQ, PN, KT, QH) do { \
        if (SB) { \
            const int key0 = 64 * (J); const bool needmask = key0 + 63 >= a.tw0; const int dq = a.tok - 1 - key0 - 4 * hi; float run = carry; \
            float Lv[16]; \
            if (DOQ) { AP_QPIN(KT, QH); _Pragma("unroll") for (int c_ = 0; c_ < 8; ++c_) { AP_SB_EL(P, HF, 2 * c_); AP_SB_EL(P, HF, 2 * c_ + 1); AP_QMFMA(PN, c_, KT, QH); } } \
            else { _Pragma("unroll") for (int r = 0; r < 16; ++r) AP_SB_EL(P, HF, r); } \
            float g[4], pg[4]; \
            _Pragma("unroll") for (int i = 0; i < 4; ++i) { g[i] = (Lv[4 * i] + Lv[4 * i + 1]) + (Lv[4 * i + 2] + Lv[4 * i + 3]); pg[i] = partner32(g[i], hi); } \
            _Pragma("unroll") for (int i = 3; i >= 0; --i) { float aft = run + (hi ? 0.f : pg[i]); run += g[i] + pg[i]; \
                P[4 * i + 3] = __builtin_amdgcn_exp2f(P[4 * i + 3] + aft); aft += Lv[4 * i + 3]; \
                P[4 * i + 2] = __builtin_amdgcn_exp2f(P[4 * i + 2] + aft); aft += Lv[4 * i + 2]; \
                P[4 * i + 1] = __builtin_amdgcn_exp2f(P[4 * i + 1] + aft); aft += Lv[4 * i + 1]; \
                P[4 * i + 0] = __builtin_amdgcn_exp2f(P[4 * i + 0] + aft); } \
            carry = run; \
            bf16x8 pa0, pa1; pack_half(P, pa0, pa1); pv_half(o, vb0 + (VB) * 16384 + (HF) * 8192, pa0, pa1); \
            if ((HF) == HB) done = __all(carry <= -151.0f); \
        } else { \
            if (CMP) { if (64 * (J) + 32 * (HF) + 32 > a.nvmin) { const int dq = a.nvr - 1 - 64 * (J) - 32 * (HF) - 4 * hi;     \
                _Pragma("unroll") for (int r = 0; r < 16; ++r) { const int cr = (r & 3) + 8 * (r >> 2); if (dq - cr < 0) P[r] = NEG; } } } \
            if (WIN) { if ((J) == a.b || (J) == a.b - 8) { const int dq = a.tok - 64 * (J) - 32 * (HF) - 4 * hi; \
                _Pragma("unroll") for (int r = 0; r < 16; ++r) { const int cr = (r & 3) + 8 * (r >> 2); if ((unsigned)(dq - cr) >= 512u) P[r] = NEG; } } } \
            if (MODE == M_SLC) { if ((J) == a.b) { const int dq = a.tok - 64 * (J) - 32 * (HF) - 4 * hi; \
                _Pragma("unroll") for (int r = 0; r < 16; ++r) { const int cr = (r & 3) + 8 * (r >> 2); if (dq - cr < 0) P[r] = NEG; } } } \
            if (MODE == M_CSTAT || MODE == M_WSTAT || MODE == M_SLC) { \
                float pmax = P[0]; \
                _Pragma("unroll") for (int r = 1; r < 16; ++r) pmax = fmaxf(pmax, P[r]); \
                bool selr = true; \
                if (MODE == M_SLC) { selr = bit_of(a.sw0, a.sw1, a.sw2, a.sw3, (J)) != 0u; pmax = selr ? pmax : NEG; } \
                pmax = fmaxf(pmax, partner32(pmax, hi)); \
                  \
                const bool keep = (MODE == M_SLC) && __all((pmax - m) * C2 <= 8.0f); \
                const float mn = keep ? m : fmaxf(m, pmax); \
                const float alpha = keep ? 1.0f : __builtin_amdgcn_exp2f((m - mn) * C2); \
                m = mn; \
                const float mnL = selr ? -mn * C2 : NEG; \
                float ps = 0.f; \
                if (DOQ) { AP_QPIN(KT, QH); _Pragma("unroll") for (int c_ = 0; c_ < 8; ++c_) { \
                        P[2 * c_] = __builtin_amdgcn_exp2f(fmaf(P[2 * c_], C2, mnL)); P[2 * c_ + 1] = __builtin_amdgcn_exp2f(fmaf(P[2 * c_ + 1], C2, mnL)); ps += P[2 * c_] + P[2 * c_ + 1]; AP_QMFMA(PN, c_, KT, QH); } } \
                else { _Pragma("unroll") for (int r = 0; r < 16; ++r) { P[r] = __builtin_amdgcn_exp2f(fmaf(P[r], C2, mnL)); ps += P[r]; } } \
                ps += partner32(ps, hi); \
                l = l * alpha + ps; \
                if (MODE == M_SLC) { \
                    if (!keep && __any(alpha < 1.f)) { \
                        if (hi == 0) wsf[r32] = alpha; \
                        asm volatile("s_waitcnt lgkmcnt(0)" ::: "memory"); \
                        _Pragma("unroll") for (int r = 0; r < 16; ++r) { const float al = wsf[crow(r, hi)]; \
                            _Pragma("unroll") for (int d0 = 0; d0 < 4; ++d0) o[d0][r] *= al; } \
                    } \
                    bf16x8 pa0, pa1; pack_half(P, pa0, pa1); pv_half(o, vb0 + (VB) * 16384 + (HF) * 8192, pa0, pa1); \
                } \
            } else { \
                const float mL = -m * C2; \
                if (DOQ) { AP_QPIN(KT, QH); _Pragma("unroll") for (int c_ = 0; c_ < 8; ++c_) { \
                        P[2 * c_] = __builtin_amdgcn_exp2f(fmaf(P[2 * c_], C2, mL)) * a.f; P[2 * c_ + 1] = __builtin_amdgcn_exp2f(fmaf(P[2 * c_ + 1], C2, mL)) * a.f; AP_QMFMA(PN, c_, KT, QH); } } \
                else { _Pragma("unroll") for (int r = 0; r < 16; ++r) P[r] = __builtin_amdgcn_exp2f(fmaf(P[r], C2, mL)) * a.f; } \
                if (MODE == M_CIMP) { \
                      \
                    LAS float* PT = (LAS float*)(c.lds + NSA_P) + (8 * w + (r32 >> 2)) * 128; \
                    float s3v[4], av[4]; \
                    _Pragma("unroll") for (int i = 0; i < 4; ++i) { \
                        const float s0 = quad_sum(P[4 * i]), s1 = quad_sum(P[4 * i + 1]), s2 = quad_sum(P[4 * i + 2]); s3v[i] = quad_sum(P[4 * i + 3]); \
                        av[i] = 2.f * ((s0 + s1) + s2) + s3v[i]; } \
                    float ps3[4]; \
                    _Pragma("unroll") for (int i = 0; i < 4; ++i) ps3[i] = partner32(s3v[i], hi); \
                    _Pragma("unroll") for (int i = 0; i < 4; ++i) { \
                        const int Jb = 16 * (J) + 8 * (HF) + 2 * i + hi; \
                        const float prev = hi ? ps3[i] : (i == 0 ? carry : ps3[i > 0 ? i - 1 : 0]); \
                        if ((r32 & 3) == 0) PT[Jb] = av[i] + prev; } \
                    carry = ps3[3];      \
                } else { bf16x8 pa0, pa1; pack_half(P, pa0, pa1); pv_half(o, vb0 + (VB) * 16384 + (HF) * 8192, pa0, pa1); } \
            } \
        } } while (0)
    for (;;) {
        if (SB) { if (lane == 0) flags[w] = done ? 1u : 0u; }
        AP_WAITN(full); __syncthreads();
        if (SB) { unsigned all = 1u;
#pragma unroll
            for (int i = 0; i < NWAVES; ++i) all &= flags[i];
            if (all) break; }
        full = j3 < TNONE;
        if (j3 < TNONE) AP_DMAK(j3, (kc + 3) & 3);
        if (j2 < TNONE) AP_DMAV(j2, vc == 0 ? 2 : vc - 1);
        const bool act0 = AP_ACT(j0);
        const bool actq = (j1 < TNONE) && AP_ACT(j1);
        if (act0) AP_PROCH(pX, j0, HA, vc, true, pY, K_lds + kc * 16384, HB);
        if (actq) qkt_half(pX, K_lds + ((kc + 1) & 3) * 16384, HA, r32, hi, qr);
        if (act0) AP_PROCH(pY, j0, HB, vc, false, pX, K_lds, HA);
        if (j1 >= TNONE) break;
        j0 = j1; j1 = j2; j2 = j3; j3 = j3 < TNONE ? AP_NEXT(j3) : TNONE;
        kc = (kc + 1) & 3; vc = vc == 2 ? 0 : vc + 1;
    }
    asm volatile("s_waitcnt vmcnt(0)" ::: "memory");
#undef AP_PROCH
#undef AP_QMFMA
#undef AP_QPIN
#undef AP_KADDR
#undef AP_SB_EL
#undef AP_NEXT
#undef AP_ACT
#undef AP_DMAK
#undef AP_DMAV
#undef AP_WAITN
}

__device__ __forceinline__ void sb_unit(const Params& p, const Ctx& c, int l, int h, int qb) {
    const bf16_t* proj = (const bf16_t*)(p.ws + WS_PROJ);
    const bf16_t* Q = proj + (size_t)(20 + h) * S * HD;
    int lane_; asm volatile("v_mbcnt_lo_u32_b32 %0, -1, 0\n\tv_mbcnt_hi_u32_b32 %0, -1, %0" : "=v"(lane_));
    const int lane = lane_, w = c.wave, r32 = lane & 31, hi = lane >> 5;
    const int t0 = 256 * qb, tw0 = t0 + 32 * w, tq = tw0 + r32;
    bf16x8 qr[8];
#pragma unroll
    for (int d0 = 0; d0 < 8; ++d0) qr[d0] = *(const bf16x8*)(Q + (size_t)tq * HD + d0 * 16 + hi * 8);
    f32x16 o[4];
#pragma unroll
    for (int d0 = 0; d0 < 4; ++d0)
#pragma unroll
        for (int r = 0; r < 16; ++r) o[d0][r] = 0.f;
    PassArgs a{}; a.Kp = proj + (size_t)(28 + h) * S * HD; a.Vp = proj + (size_t)(36 + h) * S * HD; a.tok = tq; a.jtop = (t0 + 254) >> 6; a.tw0 = tw0;
    float m = 0.f, lsum = 0.f;
    attn_pass<M_SB>(c, qr, o, m, lsum, a);
    store_head_rows(o, p.in[10] + (size_t)l * DM + (8 + h) * HD, (bf16_t*)(p.ws + WS_O) + (size_t)tw0 * DM + (8 + h) * HD, r32, hi);
}

template <int role>
__device__ __forceinline__ void nsa_unit(const Params& p, const Ctx& c, int l, int g, int b) {
    const bf16_t* proj = (const bf16_t*)(p.ws + WS_PROJ);
    const bf16_t* kc = (const bf16_t*)(p.ws + WS_KC) + (size_t)g * 512 * HD; const bf16_t* vc = (const bf16_t*)(p.ws + WS_VC) + (size_t)g * 512 * HD;
    const float* gates = (const float*)(p.ws + WS_GATES);
    const int lane = c.lane, w = c.wave, r32 = lane & 31, hi = lane >> 5;
    const int t0 = 64 * b, tl = 8 * w + (r32 >> 2), tok = t0 + tl, H = 4 * g + (r32 & 3);
    bf16x8 qr[8];
#pragma unroll
    for (int d0 = 0; d0 < 8; ++d0) qr[d0] = *(const bf16x8*)(proj + (size_t)H * S * HD + (size_t)tok * HD + d0 * 16 + hi * 8);
    const float g0 = gates[(size_t)tok * 24 + H], g1 = gates[(size_t)tok * 24 + 8 + H], g2 = gates[(size_t)tok * 24 + 16 + H];
    f32x16 o[4];
    __syncthreads();
    { LAS f32x4* za = (LAS f32x4*)(c.lds + NSA_P);
      for (int i = c.tid; i < 32768 / 16; i += NTHREADS) za[i] = (f32x4){0.f, 0.f, 0.f, 0.f}; }
    PassArgs a{}; a.tok = tok; a.b = b;
    a.nvr = tok >= 31 ? (tok - 31) / 16 + 1 : 0; if (a.nvr > NCMP) a.nvr = NCMP;
    { const int tmin = t0 + 8 * w; a.nvmin = tmin >= 31 ? (tmin - 31) / 16 + 1 : 0; if (a.nvmin > NCMP) a.nvmin = NCMP; }
    int nvmax = (t0 + 63 - 31) / 16 + 1; if (nvmax > NCMP) nvmax = NCMP;
    const unsigned cm0 = (1u << ((nvmax + 63) >> 6)) - 1u;
    float mc = -1e30f, lc = 0.f;
    a.Kp = kc; a.Vp = vc; a.tm0 = cm0; a.wm0 = cm0;
    attn_pass<M_CSTAT>(c, qr, o, mc, lc, a);
    const float ilc = lc > 0.f ? 1.0f / lc : 0.f;
    a.f = ilc;
    attn_pass<M_CIMP>(c, qr, o, mc, lc, a);
    __syncthreads();
    { const LAS float* PTb = (const LAS float*)(c.lds + NSA_P);
      LAS unsigned* selw = (LAS unsigned*)(c.lds + NSA_SEL); LAS unsigned* wuni = (LAS unsigned*)(c.lds + NSA_WUNI);
      unsigned long long u0 = 0ull, u1 = 0ull;
      for (int tt = 0; tt < 8; ++tt) {
          const int tk = 8 * w + tt; const int j0 = lane, j1 = lane + 64;
          const float a0 = PTb[tk * 128 + j0], a1 = PTb[tk * 128 + j1];
          const bool f0 = (j0 == 0) || (j0 == b) || (j0 == b - 1), f1 = (j1 == b) || (j1 == b - 1);
          bool sel0 = f0 && j0 <= b, sel1 = f1 && j1 <= b;
          float c0 = (!f0 && j0 >= 1 && j0 <= b - 2) ? a0 : -1.f, c1 = (!f1 && j1 <= b - 2) ? a1 : -1.f;
          const int ncand = b - 2 > 0 ? b - 2 : 0, ksel = 16 - (b >= 2 ? 3 : b + 1);
          if (ncand <= ksel) { if (c0 >= 0.f) sel0 = true; if (c1 >= 0.f) sel1 = true; }
          else { for (int it = 0; it < ksel; ++it) {
                     const float mx = wave_max_dpp(fmaxf(c0, c1));
                     const unsigned long long b0 = __ballot(c0 == mx);
                     if (b0) { const int first = __ffsll((long long)b0) - 1; if (lane == first) { c0 = -1.f; sel0 = true; } }
                     else { const unsigned long long b1 = __ballot(c1 == mx); const int first = __ffsll((long long)b1) - 1; if (lane == first) { c1 = -1.f; sel1 = true; } } } }
          const unsigned long long m0 = __ballot(sel0), m1 = __ballot(sel1);
          u0 |= m0; u1 |= m1;
          if (lane == 0) { selw[tk * 4 + 0] = (unsigned)m0; selw[tk * 4 + 1] = (unsigned)(m0 >> 32); selw[tk * 4 + 2] = (unsigned)m1; selw[tk * 4 + 3] = (unsigned)(m1 >> 32); }
      }
      if (lane == 0) { wuni[w * 4 + 0] = (unsigned)u0; wuni[w * 4 + 1] = (unsigned)(u0 >> 32); wuni[w * 4 + 2] = (unsigned)u1; wuni[w * 4 + 3] = (unsigned)(u1 >> 32); }
      __syncthreads();
      unsigned gu0 = 0u, gu1 = 0u, gu2 = 0u, gu3 = 0u;
#pragma unroll
      for (int i = 0; i < NWAVES; ++i) { gu0 |= wuni[i * 4 + 0]; gu1 |= wuni[i * 4 + 1]; gu2 |= wuni[i * 4 + 2]; gu3 |= wuni[i * 4 + 3]; }
      a.tm0 = __builtin_amdgcn_readfirstlane(gu0); a.tm1 = __builtin_amdgcn_readfirstlane(gu1); a.tm2 = __builtin_amdgcn_readfirstlane(gu2); a.tm3 = __builtin_amdgcn_readfirstlane(gu3);
      a.wm0 = (unsigned)u0; a.wm1 = (unsigned)(u0 >> 32); a.wm2 = (unsigned)u1; a.wm3 = (unsigned)(u1 >> 32);
      a.sw0 = selw[tl * 4 + 0]; a.sw1 = selw[tl * 4 + 1]; a.sw2 = selw[tl * 4 + 2]; a.sw3 = selw[tl * 4 + 3];
      if (role != 0) {
          const int n = b - 63; const unsigned lo0 = n >= 32 ? ~0u : ((1u << n) - 1u), lo1 = n >= 64 ? ~0u : (n > 32 ? ((1u << (n - 32)) - 1u) : 0u);
          if (role == 2) { a.tm0 &= lo0; a.tm1 &= lo1; a.tm2 = 0u; a.tm3 = 0u; a.wm0 &= lo0; a.wm1 &= lo1; a.wm2 = 0u; a.wm3 = 0u; }
          else { a.tm0 &= ~lo0; a.tm1 &= ~lo1; a.wm0 &= ~lo0; a.wm1 &= ~lo1; } }
    }
#pragma unroll
    for (int d0 = 0; d0 < 4; ++d0)
#pragma unroll
        for (int r = 0; r < 16; ++r) o[d0][r] = 0.f;
    { float ms = -1e30f, ls = 0.f;
      a.Kp = proj + (size_t)(12 + g) * S * HD; a.Vp = proj + (size_t)(14 + g) * S * HD;
      attn_pass<M_SLC>(c, qr, o, ms, ls, a);
      LAS float* wsf = (LAS float*)(c.lds + ATT_WS) + w * 64;
      constexpr float C2 = SCALE * 1.4426950408889634f;
      if (role != 0) {
          int lane_; asm volatile("v_mbcnt_lo_u32_b32 %0, -1, 0\n\tv_mbcnt_hi_u32_b32 %0, -1, %0" : "=v"(lane_));
          const int lane = lane_, r32 = lane & 31, hi = lane >> 5;
          float* part = (float*)(p.ws + WS_PART + (size_t)(g * 64 + (b - 64)) * PART_SLOT); float* pml = part + 32768 + w * 64;
          unsigned* flag = (unsigned*)(p.ws + WS_CTL) + CW_NSAFLAG + 64 * (g * 64 + (b - 64));
          if (role == 2) {
#pragma unroll
              for (int r = 0; r < 16; ++r) *(f32x4*)(part + (size_t)(w * 16 + r) * 256 + lane * 4) = (f32x4){o[0][r], o[1][r], o[2][r], o[3][r]};
              if (hi == 0) { pml[r32] = ms; pml[32 + r32] = ls; }
              asm volatile("s_waitcnt vmcnt(0)" ::: "memory");
              __syncthreads();
              if (c.tid == 0) { __builtin_amdgcn_fence(__ATOMIC_RELEASE, "agent"); asm volatile("s_waitcnt vmcnt(0)" ::: "memory");
                  __hip_atomic_store(flag, (unsigned)(l + 1), __ATOMIC_RELAXED, __HIP_MEMORY_SCOPE_AGENT); }
              return;
          }
          if (c.tid == 0) { unsigned spins = 0; while (__hip_atomic_load(flag, __ATOMIC_RELAXED, __HIP_MEMORY_SCOPE_AGENT) != (unsigned)(l + 1) && ++spins < (1u << 22)) __builtin_amdgcn_s_sleep(4); }
          __syncthreads();
          __builtin_amdgcn_fence(__ATOMIC_ACQUIRE, "agent");
          asm volatile("s_waitcnt vmcnt(0)" ::: "memory");
          const float m1 = pml[r32], l1 = pml[32 + r32];
          f32x4 qa[4];
#pragma unroll
          for (int i = 0; i < 4; ++i) qa[i] = *(const f32x4*)(part + (size_t)(w * 16 + i) * 256 + lane * 4);
          const float mm = fmaxf(m1, ms), f1 = __builtin_amdgcn_exp2f((m1 - mm) * C2), f2 = __builtin_amdgcn_exp2f((ms - mm) * C2);
          ls = l1 * f1 + ls * f2;
          if (hi == 0) { wsf[r32] = f1; wsf[32 + r32] = f2; }
          asm volatile("s_waitcnt lgkmcnt(0)" ::: "memory");
#pragma unroll
          for (int hb = 0; hb < 4; ++hb) {
#pragma unroll
              for (int i = 0; i < 4; ++i) { const int r = hb * 4 + i; const float a1 = wsf[crow(r, hi)], a2 = wsf[32 + crow(r, hi)];
#pragma unroll
                  for (int d0 = 0; d0 < 4; ++d0) o[d0][r] = qa[i][d0] * a1 + o[d0][r] * a2; }
              asm volatile("" : "+v"(o[0][4 * hb]), "+v"(o[1][4 * hb]), "+v"(o[2][4 * hb]), "+v"(o[3][4 * hb]), "+v"(o[0][4 * hb + 1]), "+v"(o[1][4 * hb + 1]), "+v"(o[2][4 * hb + 1]), "+v"(o[3][4 * hb + 1]),
                               "+v"(o[0][4 * hb + 2]), "+v"(o[1][4 * hb + 2]), "+v"(o[2][4 * hb + 2]), "+v"(o[3][4 * hb + 2]), "+v"(o[0][4 * hb + 3]), "+v"(o[1][4 * hb + 3]), "+v"(o[2][4 * hb + 3]), "+v"(o[3][4 * hb + 3]) :: "memory");
              if (hb < 3) {
#pragma unroll
                  for (int i = 0; i < 4; ++i) qa[i] = *(const f32x4*)(part + (size_t)(w * 16 + 4 * (hb + 1) + i) * 256 + lane * 4); }
          }
          asm volatile("s_waitcnt lgkmcnt(0)" ::: "memory");
      }
      if (hi == 0) wsf[r32] = g1 / ls;
      asm volatile("s_waitcnt lgkmcnt(0)" ::: "memory");
#pragma unroll
      for (int r = 0; r < 16; ++r) { const float al = wsf[crow(r, hi)];
#pragma unroll
          for (int d0 = 0; d0 < 4; ++d0) o[d0][r] *= al; } }
    a.Kp = kc; a.Vp = vc; a.tm0 = cm0; a.tm1 = a.tm2 = a.tm3 = 0u; a.wm0 = cm0; a.wm1 = a.wm2 = a.wm3 = 0u; a.f = g0 * ilc;
    attn_pass<M_CPV>(c, qr, o, mc, lc, a);
    { unsigned wt0 = 0u, wt1 = 0u, wt2 = 0u, wt3 = 0u;
      for (int j = (b - 8 > 0 ? b - 8 : 0); j <= b; ++j) { const unsigned bit = 1u << (j & 31); if (j < 32) wt0 |= bit; else if (j < 64) wt1 |= bit; else if (j < 96) wt2 |= bit; else wt3 |= bit; }
      float mw = -1e30f, lw = 0.f;
      a.Kp = proj + (size_t)(16 + g) * S * HD; a.Vp = proj + (size_t)(18 + g) * S * HD;
      a.tm0 = wt0; a.tm1 = wt1; a.tm2 = wt2; a.tm3 = wt3; a.wm0 = wt0; a.wm1 = wt1; a.wm2 = wt2; a.wm3 = wt3; a.f = 0.f;
      attn_pass<M_WSTAT>(c, qr, o, mw, lw, a);
      a.f = g2 / lw;
      attn_pass<M_WPV>(c, qr, o, mw, lw, a); }
    { const float* ggrp = p.in[10] + (size_t)l * DM; bf16_t* O = (bf16_t*)(p.ws + WS_O);
      int lane_; asm volatile("v_mbcnt_lo_u32_b32 %0, -1, 0\n\tv_mbcnt_hi_u32_b32 %0, -1, %0" : "=v"(lane_));
      const int r32 = lane_ & 31, hi = lane_ >> 5, odd = lane_ & 1;
      float gg[4][4];
#pragma unroll
      for (int hh = 0; hh < 4; ++hh)
#pragma unroll
          for (int d0 = 0; d0 < 4; ++d0) gg[hh][d0] = ggrp[(4 * g + hh) * HD + d0 * 32 + r32];
#pragma unroll
      for (int r = 0; r < 16; ++r) {
          const float ss = half_sum_dpp((o[0][r] * o[0][r] + o[1][r] * o[1][r]) + (o[2][r] * o[2][r] + o[3][r] * o[3][r]), hi);
          const float rs = __builtin_amdgcn_rsqf(ss * (1.0f / HD) + EPS);
          const int rr = crow(r, hi), Hh = 4 * g + (r & 3); const int tk = t0 + 8 * w + (rr >> 2);
          store_row4(O + (size_t)tk * DM + Hh * HD + (r32 & ~1), o[0][r] * rs * gg[r & 3][0], o[1][r] * rs * gg[r & 3][1], o[2][r] * rs * gg[r & 3][2], o[3][r] * rs * gg[r & 3][3], odd);
      } }
}
__device__ __forceinline__ void phase_nsa(const Params& p, const Ctx& c, int l) {
    const int u0 = c.bx, g = u0 & 1, rk = u0 >> 1;
    if (rk < 64) { nsa_unit<2>(p, c, l, g, 127 - rk); nsa_unit<0>(p, c, l, g, rk); }
    else nsa_unit<1>(p, c, l, g, rk);
    __syncthreads();
}
__device__ __forceinline__ void phase_cmpr_sb(const Params& p, const Ctx& c, int l) {
    phase_cmpr(p, c, l);
    sb_unit(p, c, l, c.bx & 7, 31 - (c.bx >> 3));
    __syncthreads();
}
__device__ __forceinline__ Ctx make_ctx(unsigned char* lds, int wave) {
    Ctx c; c.lds = (LAS unsigned char*)lds; int ln_; asm volatile("v_mbcnt_lo_u32_b32 %0, -1, 0\n\tv_mbcnt_hi_u32_b32 %0, -1, %0" : "=v"(ln_));
    int wv_ = wave; asm volatile("" : "+s"(wv_));
    c.lane = ln_; c.wave = wv_; c.tid = wv_ * 64 + ln_;
    int bx_ = blockIdx.x; asm volatile("" : "+s"(bx_)); c.bx = bx_;
    c.gw = bx_ * NWAVES + c.wave; c.ngw = gridDim.x * NWAVES; return c;
}
#define AS4 __attribute__((address_space(4)))
__device__ __forceinline__ Params load_params() {
    unsigned long long v = (unsigned long long)(const AS4 void*)__builtin_amdgcn_kernarg_segment_ptr();
    asm volatile("" : "+s"(v));
    const AS4 Params* q = (const AS4 Params*)v; Params r;
#pragma unroll
    for (int i = 0; i < 17; ++i) r.in[i] = q->in[i];
    r.out = q->out; r.ws = q->ws; return r;
}
constexpr int CW_BAR = 4096;
#ifndef MEGA
#define MEGA 1
#endif
__global__ void __launch_bounds__(NTHREADS, 2) k_mega(Params p_arg) {
    extern __shared__ __attribute__((aligned(16))) unsigned char lds_raw[];
#define PCTX const Ctx c = make_ctx(lds_raw, wave0); const Params p = load_params()
    const int wave0 = __builtin_amdgcn_readfirstlane((int)threadIdx.x >> 6);
    volatile LAS unsigned* misc = (volatile LAS unsigned*)((LAS unsigned char*)lds_raw + MISC_OFF);
    if (threadIdx.x < 8) misc[threadIdx.x] = 0u;
    __syncthreads();
    { const Params p = load_params(); (void)xcd_barrier_post((unsigned*)(p.ws + WS_CTL) + CW_BAR, misc, threadIdx.x == 0); }
#define GBAR() do { const Params p = load_params(); XcdBarrier b_; b_.bar = (unsigned*)(p.ws + WS_CTL) + CW_BAR; b_.x = xb_xcc_id(); b_.st = misc; { int ln__; asm volatile("v_mbcnt_lo_u32_b32 %0, -1, 0\n\tv_mbcnt_hi_u32_b32 %0, -1, %0" : "=v"(ln__)); b_.leader = (wave0 == 0) && (ln__ == 0); } xcd_barrier(b_); } while (0)
    { PCTX; phase_conv(p, c); }
    GBAR();
    for (int l = 0; l < NL; ++l) {
        if (l == 0) { { PCTX; quant_rows(c, (const bf16_t*)(p.ws + WS_XN), p.ws + WS_XN8, (float*)(p.ws + WS_ASC), S); cbias_reduce(p, c); }
          GBAR(); }
        { PCTX; pg8::Gemm g{(const bf16_t*)(p.ws + WS_XN8), (const bf16_t*)(p.ws + WS_WI8 + (size_t)l * 12 * MiB), S, DINP, DM / 2}; pg8::StaticOrder so; so.init(S, DINP, gridDim.x, c.bx);
          EpiProj E{(bf16_t*)(p.ws + WS_PROJ), (float*)(p.ws + WS_GATES), (const bf16_t*)(p.ws + WS_ROPEH), p.in[4] + 24 * l, (const LAS float*)(c.lds + RSTD_OFF), (const LAS float*)(c.lds + CSC_OFF)};
          pg8::gemm_phase<EpiProj, pg8::StaticOrder, true, true, PrepRstd, 2>(c.lds, g, so, E, c.tid, PrepRstd{c, so, (const float*)(p.ws + WS_SSQ), (const float*)(p.ws + WS_ASC), (const float*)(p.ws + WS_WISC) + l * DINP});
        }
        GBAR();
        { PCTX; phase_cmpr_sb(p, c, l); }
        GBAR();
        { PCTX; phase_nsa(p, c, l); }
        GBAR();
        { PCTX; pg8::Gemm g{(const bf16_t*)(p.ws + WS_O), w_ptr(p, l, W_OUT), S, DM, DM}; pg8::StaticOrder so; so.init(S, DM, gridDim.x, c.bx);
          EpiResidH E{(bf16_t*)(p.ws + WS_XN), (float*)(p.ws + WS_SSQ), 1.0f, p.ws + WS_XN8, (float*)(p.ws + WS_ASC), (float*)(p.ws + WS_XSLAB), (unsigned*)(p.ws + WS_CTL) + CW_XCNT, 8u * (unsigned)(2 * l + 1)};
          pg8::gemm_phase<EpiResidH, pg8::StaticOrder, false, true>(c.lds, g, so, E, c.tid); }
        GBAR();
        { PCTX; pg8::Gemm g{(const bf16_t*)(p.ws + WS_XN8), (const bf16_t*)(p.ws + WS_W8 + (size_t)l * 22 * MiB), S, 2 * DFF, DM / 2}; pg8::StaticOrder so; so.init(S, 2 * DFF, gridDim.x, c.bx);
          EpiSwiGLU E{p.ws + WS_ACT, (const LAS float*)(c.lds + RSTD_OFF), (const LAS float*)(c.lds + CSC_OFF)};
          pg8::gemm_phase<EpiSwiGLU, pg8::StaticOrder, true, true, PrepRstd, 2>(c.lds, g, so, E, c.tid, PrepRstd{c, so, (const float*)(p.ws + WS_SSQ), (const float*)(p.ws + WS_ASC), (const float*)(p.ws + WS_WSC) + l * 2 * DFF});
        }
        GBAR();
        { PCTX; pg8::Gemm g{(const bf16_t*)(p.ws + WS_ACT), w_ptr(p, l, W_DN), S, DM, DFF / 2}; pg8::StaticOrder so; so.init(S, DM, gridDim.x, c.bx);
          EpiResidH E{(bf16_t*)(p.ws + WS_XN), (float*)(p.ws + WS_SSQ), 1.0f / (A8_SCALE * W8_SCALE), l + 1 < NL ? p.ws + WS_XN8 : nullptr, (float*)(p.ws + WS_ASC), (float*)(p.ws + WS_XSLAB), (unsigned*)(p.ws + WS_CTL) + CW_XCNT, 8u * (unsigned)(2 * l + 2)};
          pg8::gemm_phase<EpiResidH, pg8::StaticOrder, false, true, pg8::NoPre, 1>(c.lds, g, so, E, c.tid); }
        GBAR();
    }
    { PCTX; phase_final_norm(c, (const bf16_t*)(p.ws + WS_XN), (const float*)(p.ws + WS_SSQ), p.in[16], (float*)p.out); }
}

extern "C" void kernel_launch(void* const* d_in, const int* in_sizes, int n_in, void* d_out, int out_size, void* d_ws, size_t ws_size, hipStream_t stream) {
    static int grid = 0;
    if (grid == 0) {
        if (n_in != 17 || out_size != S * DM || ws_size < WS_END) { fprintf(stderr, "kernel_launch: unexpected shapes (n_in %d, out %d, ws %zu)\n", n_in, out_size, ws_size); grid = -1; return; }
        int dev = 0, cus = 0; (void)hipGetDevice(&dev); (void)hipDeviceGetAttribute(&cus, hipDeviceAttributeMultiprocessorCount, dev); if (cus <= 0) cus = 256;
#if MEGA
        if (hipFuncSetAttribute((const void*)k_mega, hipFuncAttributeMaxDynamicSharedMemorySize, LDS_BYTES) != hipSuccess) { fprintf(stderr, "kernel_launch: hipFuncSetAttribute failed\n"); grid = -1; return; }
        int per_cu = 0;
        if (hipOccupancyMaxActiveBlocksPerMultiprocessor(&per_cu, (const void*)k_mega, NTHREADS, LDS_BYTES) != hipSuccess || per_cu < 1) { fprintf(stderr, "kernel_launch: occupancy query says %d\n", per_cu); per_cu = 1; }
        (void)hipGetLastError();
        if (cus < 256) fprintf(stderr, "kernel_launch: this kernel's static unit schedules need 256 resident workgroups; the device reports %d CUs\n", cus);
        grid = 256;
#endif
    }
    if (grid < 0) return;
    Params p{};
    for (int i = 0; i < 17; ++i) p.in[i] = (const float*)d_in[i];
    p.out = (float*)d_out; p.ws = (unsigned char*)d_ws;
    const dim3 G(grid), B(NTHREADS);
#if MEGA
    (void)hipMemsetAsync((unsigned char*)d_ws + WS_CTL, 0, CTL_ZERO_BYTES, stream);
    hipLaunchKernelGGL(k_mega, G, B, LDS_BYTES, stream, p);
#endif
}
```

```cpp
#include <hip/hip_runtime.h>
#include <cstdio>
#include <cstdint>
namespace pg8 {
#define PG8_LAS __attribute__((address_space(3)))
typedef unsigned short bf16_t;
typedef _Float16 bf16x8 __attribute__((ext_vector_type(8)));
typedef float f32x4 __attribute__((ext_vector_type(4)));
typedef unsigned u32x4 __attribute__((ext_vector_type(4)));
constexpr int BM = 256, BK = 64, HALF = 128, HTB = HALF * BK * 2  , STAGE_BYTES = 8 * HTB, NXCD = 8, WGM = 8;

__host__ __device__ __forceinline__ int lds_byte(int r, int c) { const int st = (r >> 4) * 2 + (c >> 5), rr = r & 15, cc = c & 31, ob = rr * 64 + cc * 2; return st * 1024 + (ob ^ (((ob >> 9) & 1) << 5)); }
__host__ __device__ __forceinline__ void stage_rc(int b, int& R, int& C) { const int st = b / 1024, sb = b % 1024, swz = sb ^ (((sb >> 9) & 1) << 5); R = (st >> 1) * 16 + swz / 64; C = (st & 1) * 32 + (swz % 64) / 2; }
__host__ __device__ __forceinline__ int perm32(int rho) { const int n = rho >> 4, i = rho & 15; return 8 * (i >> 2) + 4 * n + (i & 3); }

struct Unit { int pm, pn, ord; };
struct Gemm { const bf16_t* A; const bf16_t* Bt; int M, N, K; };

struct StaticOrder {
    int nM, nN, nwg, G, c;
    __host__ __device__ void init(int M, int N, int G_, int c_) { nM = M / BM; nN = N / BM; nwg = nM * nN; G = G_; c = c_; }
    __host__ __device__ bool next(int i, Unit& u) const {
        const long L = (long)i * G + c; if (L >= nwg) return false;
        int wgid = (int)L; { const int q = nwg / NXCD, r = nwg % NXCD, xcd = wgid % NXCD, off = wgid / NXCD; wgid = (xcd < r ? xcd * (q + 1) : r * (q + 1) + (xcd - r) * q) + off; }
        const int nig = WGM * nN, gid = wgid / nig, fm = gid * WGM, gsz = (nM - fm) < WGM ? (nM - fm) : WGM;
        u.pm = fm + ((wgid % nig) % gsz); u.pn = (wgid % nig) / gsz; u.ord = i; return true;
    }
    __device__ __forceinline__ void a_ready(const Unit&) const {}
    __device__ __forceinline__ void done(const Unit&) const {}
};
__device__ __forceinline__ unsigned cvt_pk_bf16(float lo, float hi) { unsigned r; asm volatile("v_cvt_pk_bf16_f32 %0, %1, %2" : "=v"(r) : "v"(lo), "v"(hi)); return r; }
typedef float f32x2 __attribute__((ext_vector_type(2)));
struct NoPre { __device__ __forceinline__ void operator()() const {} };
typedef int i32x8 __attribute__((ext_vector_type(8)));
typedef int i32x4 __attribute__((ext_vector_type(4)));
template <class Epi, class Sched, bool ALIGN_EPI = false, bool SP2 = false, class Pre = NoPre, int F8 = 0>
__device__ __forceinline__ void gemm_phase(PG8_LAS unsigned char* lds, const Gemm g, const Sched& S, const Epi& E, int tid_in, const Pre& pre = Pre()) {
    int tid_ = tid_in; asm volatile("" : "+v"(tid_));
    const int tid = tid_, wid = __builtin_amdgcn_readfirstlane(tid >> 6), lane = tid & 63, wr = wid >> 2, wc = wid & 3, fr = lane & 15, fq = lane >> 4;
    const int K = g.K, nt = K / BK;
    unsigned voffA[2], voffB[2];
#pragma unroll
    for (int i = 0; i < 2; ++i) { int R, C; stage_rc(tid * 16 + i * 8192, R, C); const int Rb = Epi::PERM ? ((R & ~31) + perm32(R & 31)) : R;
        voffA[i] = (unsigned)(R * K + C) * 2u; voffB[i] = (unsigned)(Rb * K + C) * 2u; }
    const size_t kstep = (size_t)(BK * 2);
    const size_t hstep = (size_t)HALF * K * 2;
    const size_t tstep = 2 * hstep;
    const unsigned ldsw = (unsigned)wid * 1024u;
    const int aoff = lds_byte(wr * 64 + fr, fq * 8), boff = lds_byte(wc * 32 + fr, fq * 8);
#define PG8_SA(b, h) (((b) * 2 + (h)) * HTB)
#define PG8_SB(b, h) ((4 + (b) * 2 + (h)) * HTB)
#define PG8_STAGE(bufoff, gbase, voff) do { _Pragma("unroll") for (int _i = 0; _i < 2; ++_i) \
        __builtin_amdgcn_global_load_lds((const unsigned*)((const char*)(gbase) + (voff)[_i]), (PG8_LAS unsigned*)(lds + (bufoff) + ldsw + _i * 8192), 16, 0, 0); } while (0)
#define PG8_LDA(dst, b, h) do { _Pragma("unroll") for (int m = 0; m < 4; ++m) _Pragma("unroll") for (int k = 0; k < 2; ++k) dst[m][k] = *(const PG8_LAS bf16x8*)(lds + PG8_SA(b, h) + aoff + m * 2048 + k * 1024); } while (0)
#define PG8_LDB(dst, b, h) do { _Pragma("unroll") for (int n = 0; n < 2; ++n) _Pragma("unroll") for (int k = 0; k < 2; ++k) dst[n][k] = *(const PG8_LAS bf16x8*)(lds + PG8_SB(b, h) + boff + n * 2048 + k * 1024); } while (0)
#define PG8_F8FRAG(X) __builtin_shufflevector(__builtin_bit_cast(i32x4, (X)[0]), __builtin_bit_cast(i32x4, (X)[1]), 0, 1, 2, 3, 4, 5, 6, 7)
#define PG8_MMA(ai, bj, At, Bt) do { __builtin_amdgcn_s_setprio(1); \
        if constexpr (F8 == 2) { _Pragma("unroll") for (int m = 0; m < 4; ++m) _Pragma("unroll") for (int n = 0; n < 2; ++n) _Pragma("unroll") for (int k = 0; k < 2; ++k) \
            acc[ai][bj][m][n] = __builtin_bit_cast(f32x4, __builtin_amdgcn_mfma_i32_16x16x64_i8(__builtin_bit_cast(i32x4, Bt[n][k]), __builtin_bit_cast(i32x4, At[m][k]), __builtin_bit_cast(i32x4, acc[ai][bj][m][n]), 0, 0, 0)); } \
        else if constexpr (F8 == 1) { _Pragma("unroll") for (int m = 0; m < 4; ++m) _Pragma("unroll") for (int n = 0; n < 2; ++n) \
            { const i32x8 a8_ = PG8_F8FRAG(Bt[n]), b8_ = PG8_F8FRAG(At[m]); asm volatile("v_mfma_f32_16x16x128_f8f6f4 %0, %1, %2, %0" : "+v"(acc[ai][bj][m][n]) : "v"(a8_), "v"(b8_)); } } \
        else { _Pragma("unroll") for (int m = 0; m < 4; ++m) _Pragma("unroll") for (int n = 0; n < 2; ++n) _Pragma("unroll") for (int k = 0; k < 2; ++k) \
            acc[ai][bj][m][n] = __builtin_amdgcn_mfma_f32_16x16x32_f16(Bt[n][k], At[m][k], acc[ai][bj][m][n], 0, 0, 0); } \
        __builtin_amdgcn_s_setprio(0); } while (0)
#define PG8_WAIT_V(n) asm volatile("s_waitcnt vmcnt(" #n ")" ::: "memory")
#define PG8_WAIT_L(n) asm volatile("s_waitcnt lgkmcnt(" #n ")" ::: "memory")
#define PG8_BAR __builtin_amdgcn_s_barrier()
#define PG8_SCHED __builtin_amdgcn_sched_barrier(0)
    Unit cur, nxt; int ui = 0;
    if (!S.next(0, cur)) return;
    f32x4 acc[2][2][4][2];
#pragma unroll
    for (int a = 0; a < 2; ++a)
#pragma unroll
        for (int b = 0; b < 2; ++b)
#pragma unroll
            for (int m = 0; m < 4; ++m)
#pragma unroll
                for (int n = 0; n < 2; ++n) acc[a][b][m][n] = (f32x4){0.f, 0.f, 0.f, 0.f};
    bf16x8 At[4][2], B0[2][2], B1[2][2];
    const char* cA = (const char*)g.A + (size_t)cur.pm * tstep; const char* cB = (const char*)g.Bt + (size_t)cur.pn * tstep;
    S.a_ready(cur);
    if constexpr (SP2) {
        PG8_STAGE(PG8_SB(0, 0), cB, voffB); PG8_STAGE(PG8_SB(0, 1), cB + hstep, voffB); PG8_STAGE(PG8_SA(0, 0), cA, voffA); PG8_STAGE(PG8_SA(0, 1), cA + hstep, voffA);
        pre();
        if (wr == 1) PG8_BAR;
        PG8_WAIT_V(2); PG8_BAR;
        PG8_STAGE(PG8_SB(1, 0), cB + kstep, voffB); PG8_STAGE(PG8_SA(1, 0), cA + kstep, voffA); PG8_STAGE(PG8_SB(1, 1), cB + hstep + kstep, voffB);
        PG8_WAIT_V(6); PG8_BAR;
    } else {
        PG8_STAGE(PG8_SB(0, 0), cB, voffB); PG8_STAGE(PG8_SA(0, 0), cA, voffA); PG8_STAGE(PG8_SB(0, 1), cB + hstep, voffB); PG8_STAGE(PG8_SA(0, 1), cA + hstep, voffA);
        if (wr == 1) PG8_BAR;
        PG8_WAIT_V(4); PG8_BAR;
        PG8_STAGE(PG8_SB(1, 0), cB + kstep, voffB); PG8_STAGE(PG8_SA(1, 0), cA + kstep, voffA); PG8_STAGE(PG8_SB(1, 1), cB + hstep + kstep, voffB);
        PG8_WAIT_V(6); PG8_BAR;
    }
    for (;;) {
        const bool has_next = S.next(ui + 1, nxt);
        const char* nA = has_next ? (const char*)g.A + (size_t)nxt.pm * tstep : cA; const char* nB = has_next ? (const char*)g.Bt + (size_t)nxt.pn * tstep : cB;
        for (int t = 0; t < nt; t += 2) {
            const bool last = (t == nt - 2);
            const char* a1 = cA + (size_t)(t + 1) * kstep;
            const char* a2 = last ? nA : cA + (size_t)(t + 2) * kstep; const char* b2 = last ? nB : cB + (size_t)(t + 2) * kstep;
            const char* a3 = a2 + kstep; const char* b3 = b2 + kstep;
            if (last && has_next) S.a_ready(nxt);
            if constexpr (SP2) {
            PG8_LDB(B0, 0, 0); PG8_LDB(B1, 0, 1); PG8_SCHED; PG8_LDA(At, 0, 0); PG8_STAGE(PG8_SA(1, 1), a1 + hstep, voffA);
            PG8_WAIT_V(8); PG8_WAIT_L(0); PG8_BAR; PG8_MMA(0, 0, At, B0); PG8_MMA(0, 1, At, B1); PG8_BAR; PG8_SCHED;
            PG8_LDA(At, 0, 1); PG8_STAGE(PG8_SB(0, 0), b2, voffB); PG8_STAGE(PG8_SB(0, 1), b2 + hstep, voffB); PG8_STAGE(PG8_SA(0, 0), a2, voffA);
            PG8_WAIT_V(8); PG8_WAIT_L(0); PG8_BAR; PG8_MMA(1, 0, At, B0); PG8_MMA(1, 1, At, B1); PG8_BAR; PG8_SCHED;
            PG8_LDB(B0, 1, 0); PG8_LDB(B1, 1, 1); PG8_SCHED; PG8_LDA(At, 1, 0); PG8_STAGE(PG8_SA(0, 1), a2 + hstep, voffA);
            PG8_WAIT_V(8); PG8_WAIT_L(0); PG8_BAR; PG8_MMA(0, 0, At, B0); PG8_MMA(0, 1, At, B1); PG8_BAR; PG8_SCHED;
            PG8_LDA(At, 1, 1); PG8_STAGE(PG8_SB(1, 0), b3, voffB); PG8_STAGE(PG8_SB(1, 1), b3 + hstep, voffB); PG8_STAGE(PG8_SA(1, 0), a3, voffA);
            PG8_WAIT_V(8); PG8_WAIT_L(0); PG8_BAR; PG8_MMA(1, 0, At, B0); PG8_MMA(1, 1, At, B1); PG8_BAR; PG8_SCHED;
            } else {
            PG8_LDB(B0, 0, 0); PG8_SCHED; PG8_LDA(At, 0, 0); PG8_STAGE(PG8_SA(1, 1), a1 + hstep, voffA);
            PG8_WAIT_L(8); PG8_BAR; PG8_WAIT_L(0); PG8_MMA(0, 0, At, B0); PG8_BAR; PG8_SCHED;
            PG8_LDB(B1, 0, 1); PG8_STAGE(PG8_SB(0, 0), b2, voffB);
            PG8_BAR; PG8_WAIT_L(0); PG8_MMA(0, 1, At, B1); PG8_BAR;
            PG8_LDA(At, 0, 1); PG8_STAGE(PG8_SA(0, 0), a2, voffA);
            PG8_BAR; PG8_WAIT_L(0); PG8_MMA(1, 0, At, B0); PG8_BAR; PG8_SCHED;
            PG8_STAGE(PG8_SB(0, 1), b2 + hstep, voffB);
            PG8_WAIT_V(6); PG8_BAR; PG8_MMA(1, 1, At, B1); PG8_BAR;
            PG8_LDB(B0, 1, 0); PG8_SCHED; PG8_LDA(At, 1, 0); PG8_STAGE(PG8_SA(0, 1), a2 + hstep, voffA);
            PG8_WAIT_L(8); PG8_BAR; PG8_WAIT_L(0); PG8_MMA(0, 0, At, B0); PG8_BAR; PG8_SCHED;
            PG8_LDB(B1, 1, 1); PG8_STAGE(PG8_SB(1, 0), b3, voffB);
            PG8_BAR; PG8_WAIT_L(0); PG8_MMA(0, 1, At, B1); PG8_BAR;
            PG8_LDA(At, 1, 1); PG8_STAGE(PG8_SA(1, 0), a3, voffA);
            PG8_BAR; PG8_WAIT_L(0); PG8_MMA(1, 0, At, B0); PG8_BAR; PG8_SCHED;
            PG8_STAGE(PG8_SB(1, 1), b3 + hstep, voffB);
            PG8_WAIT_V(6); PG8_BAR; PG8_MMA(1, 1, At, B1); PG8_BAR;
            }
        }
        if constexpr (F8) asm volatile("s_nop 15\n\ts_nop 15" ::: "memory");
        if constexpr (ALIGN_EPI) { if (wr == 0) PG8_BAR; }
        if constexpr (!Epi::AFTER_DRAIN) { E(acc, cur, wr, wc, fr, fq); S.done(cur); }
        if (!has_next) break;
#pragma unroll
        for (int a = 0; a < 2; ++a)
#pragma unroll
            for (int b = 0; b < 2; ++b)
#pragma unroll
                for (int m = 0; m < 4; ++m)
#pragma unroll
                    for (int n = 0; n < 2; ++n) acc[a][b][m][n] = (f32x4){0.f, 0.f, 0.f, 0.f};
        cur = nxt; cA = nA; cB = nB; ++ui;
        if constexpr (ALIGN_EPI) { if (wr == 1) PG8_BAR; }
    }
    PG8_WAIT_V(0);
    if constexpr (!ALIGN_EPI) { if (wr == 0) PG8_BAR; }
    PG8_BAR;
    if constexpr (Epi::AFTER_DRAIN) { E.fused(acc, cur, wr, wc, fr, fq, lds, wid, lane); S.done(cur); }
#undef PG8_SA
#undef PG8_SB
#undef PG8_STAGE
#undef PG8_LDA
#undef PG8_LDB
#undef PG8_MMA
#undef PG8_WAIT_V
#undef PG8_WAIT_L
#undef PG8_BAR
#undef PG8_SCHED
}
}
#define LAS __attribute__((address_space(3)))
#define XB_TMO      128
#define XB_XCNT(j)  (256  + 64 * (j))
#define XB_XSUB(j)  (1280 + 64 * (j))
#define XB_XGEN(j)  (2304 + 64 * (j))
#define XB_TOP      3328
#define XB_TOPGEN   3392
#define XCD_BAR_WORDS 3456
#define XB_SPIN_CAP (1u << 18)

__device__ __forceinline__ unsigned xb_ld(unsigned* p)              { return __hip_atomic_load(p, __ATOMIC_RELAXED, __HIP_MEMORY_SCOPE_AGENT); }
__device__ __forceinline__ unsigned xb_add(unsigned* p, unsigned v) { return __hip_atomic_fetch_add(p, v, __ATOMIC_RELAXED, __HIP_MEMORY_SCOPE_AGENT); }
__device__ __forceinline__ unsigned xb_xcc_id() { return (unsigned)__builtin_amdgcn_s_getreg((3 << 11) | 20) & 0xFu; }
#define XB_SPIN(cond, bar) do { unsigned _sp = 0; while (cond) { __builtin_amdgcn_s_sleep(1); \
    if ((++_sp & 255u) == 0u) { if (xb_ld(&(bar)[XB_TMO])) break; if (_sp > XB_SPIN_CAP) { atomicAdd(&(bar)[XB_TMO], 1u); break; } } } } while (0)

struct XcdBarrier {
    unsigned* bar; unsigned x;
    volatile LAS unsigned* st;
    bool leader;
};

__device__ __forceinline__ XcdBarrier xcd_barrier_post(unsigned* bar, volatile LAS unsigned* st, bool leader) {
    XcdBarrier b; b.bar = bar; b.x = xb_xcc_id(); b.st = st; b.leader = leader;
    if (leader) (void)xb_add(&bar[XB_XCNT(b.x)], 1u);
    return b;
}
__device__ __forceinline__ void xcd_barrier_complete(unsigned* bar, unsigned x, unsigned& nloc, unsigned& nx) {
    const unsigned G = gridDim.x * gridDim.y * gridDim.z;
    unsigned sum, cnt, mine, sp = 0u;
    for (;;) {
        sum = 0u; cnt = 0u; mine = 0u;
#pragma unroll
        for (unsigned j = 0; j < 16; ++j) { const unsigned c = xb_ld(&bar[XB_XCNT(j)]); sum += c; cnt += (c > 0u) ? 1u : 0u; mine = (j == x) ? c : mine; }
        if (sum == G) break;
        __builtin_amdgcn_s_sleep(1);
        if ((++sp & 255u) == 0u) { if (xb_ld(&bar[XB_TMO])) break; if (sp > XB_SPIN_CAP) { atomicAdd(&bar[XB_TMO], 1u); break; } }
    }
    nloc = mine > 0u ? mine : 1u; nx = cnt > 0u ? cnt : 1u;
}

__device__ __forceinline__ void xcd_barrier(const XcdBarrier& b) {
    asm volatile("s_waitcnt vmcnt(0)" ::: "memory");
    __syncthreads();
    if (b.leader) {
        unsigned* bar = b.bar;
        __builtin_amdgcn_s_waitcnt(0);
        unsigned nloc = b.st[0], nx = b.st[1];
        if (nloc == 0u) { xcd_barrier_complete(bar, b.x, nloc, nx); b.st[0] = nloc; b.st[1] = nx; }
        const unsigned old = xb_add(&bar[XB_XSUB(b.x)], 1u);
        const unsigned gen = old / nloc;
        if (old + 1u == (gen + 1u) * nloc) {
            __builtin_amdgcn_fence(__ATOMIC_RELEASE, "agent");
            asm volatile("s_waitcnt vmcnt(0)" ::: "memory");
            const unsigned og = xb_add(&bar[XB_TOP], 1u);
            const unsigned tg = og / nx;
            if (og + 1u == (tg + 1u) * nx) xb_add(&bar[XB_TOPGEN], 1u);
            else XB_SPIN(xb_ld(&bar[XB_TOPGEN]) == tg, bar);
            __builtin_amdgcn_fence(__ATOMIC_ACQUIRE, "agent");
            xb_add(&bar[XB_XGEN(b.x)], 1u);
            asm volatile("s_waitcnt vmcnt(0)" ::: "memory");
        } else {
            XB_SPIN(xb_ld(&bar[XB_XGEN(b.x)]) == gen, bar);
            __builtin_amdgcn_fence(__ATOMIC_ACQUIRE, "agent");
            asm volatile("s_waitcnt vmcnt(0)" ::: "memory");
        }
    }
    __syncthreads();
}

#ifndef LAS
#define LAS __attribute__((address_space(3)))
#endif
typedef unsigned short bf16_t;
typedef _Float16 bf16x8 __attribute__((ext_vector_type(8)));
typedef float f32x4 __attribute__((ext_vector_type(4)));
typedef float f32x2 __attribute__((ext_vector_type(2)));
typedef unsigned u32x4 __attribute__((ext_vector_type(4)));
typedef unsigned u32x2 __attribute__((ext_vector_type(2)));

constexpr int S = 8192, DM = 2048, NL = 4, HD = 128, DIN = 5656, DINP = 5888, DFF = 5632, NCMP = 511;
constexpr float EPS = 1e-6f;
constexpr float SCALE = 0.08838834764831845f;
constexpr int NWAVES = 8, NTHREADS = 512;
constexpr int LDS_BYTES = 147456;
constexpr int RING_BYTES = 131072, MISC_OFF = LDS_BYTES - 64;

constexpr size_t MiB = 1u << 20;
constexpr float W8_SCALE = 64.0f, A8_SCALE = 8.0f;
constexpr size_t WS_CTL = 0, CTL_ZERO_BYTES = 1 * MiB;
constexpr size_t WS_ROPE = 1 * MiB;
constexpr size_t WS_CBP = WS_ROPE + 1024 * 1024;
constexpr size_t WS_ROPEH = 5 * MiB + 512 * 1024;
constexpr size_t WS_CBF = 3 * MiB + 512 * 1024;
constexpr size_t WS_KC = 2 * MiB + 512 * 1024;
constexpr size_t WS_VC = WS_KC + 256 * 1024;
constexpr size_t WS_SEL = 3 * MiB;
constexpr size_t WS_GATES = 4 * MiB;
constexpr size_t WS_SSQ = 5 * MiB;
constexpr size_t WS_W = 8 * MiB;
constexpr size_t W_IN = 0, W_OUT = 23 * MiB, W_GU = 31 * MiB, W_DN = 75 * MiB, W_C1 = 97 * MiB, W_C2 = 101 * MiB, W_LAYER = 102 * MiB;
constexpr size_t WS_H = WS_W + NL * W_LAYER;
constexpr size_t WS_XN8 = WS_H;
constexpr size_t WS_XSLAB = WS_H + 32 * MiB;
constexpr size_t WS_XN = WS_H + 64 * MiB;
constexpr size_t WS_O = WS_XN + 32 * MiB;
constexpr size_t WS_OCMP = WS_O + 32 * MiB;
constexpr size_t WS_PROJ = WS_OCMP + 32 * MiB;
constexpr size_t WS_ACT = WS_PROJ;
constexpr size_t WS_PART = WS_PROJ + 88 * MiB;
constexpr size_t PART_SLOT = 131072 + 2048;
constexpr size_t WS_W8 = 688 * MiB;
constexpr size_t WS_WSC = WS_W8 + NL * 22 * MiB;
constexpr size_t WS_ASC = WS_WSC + 1 * MiB;
constexpr size_t WS_WI8 = WS_ASC + 1 * MiB;
constexpr size_t WS_WISC = WS_WI8 + NL * 12 * MiB;
constexpr size_t WS_END = WS_WISC + 1 * MiB;
static_assert(WS_PART + 128 * PART_SLOT <= WS_W8, "ws map");
constexpr size_t WS_CPART = 6 * MiB;
constexpr int CW_CFLAG = 32768;
constexpr int CW_XCNT = 49152;
constexpr int CW_NSAFLAG = 16384;
static_assert((size_t)DINP * DM * 2 == 23 * MiB && (size_t)2 * DFF * DM * 2 == 44 * MiB && (size_t)DM * DFF * 2 == 22 * MiB, "weight map");

struct Params { const float* in[17]; float* out; unsigned char* ws; };

struct Ctx {
    LAS unsigned char* lds;
    int tid, lane, wave, gw, ngw, bx;
};

__device__ __forceinline__ float bf2f(unsigned b) { return (float)__builtin_bit_cast(_Float16, (unsigned short)b); }
__device__ __forceinline__ unsigned f2bf(float f) { return (unsigned)__builtin_bit_cast(unsigned short, (_Float16)f); }
typedef _Float16 h2_t __attribute__((ext_vector_type(2)));
__device__ __forceinline__ unsigned pk2(float lo, float hi) { const h2_t v = {(_Float16)lo, (_Float16)hi}; return __builtin_bit_cast(unsigned, v); }
#define DPP_F(old_, src_, ctrl_, rmask_) __builtin_bit_cast(float, __builtin_amdgcn_update_dpp(__builtin_bit_cast(int, (old_)), __builtin_bit_cast(int, (src_)), (ctrl_), (rmask_), 0xf, false))
__device__ __forceinline__ float wave_sum(float v) {
    v += DPP_F(0.f, v, 0x111, 0xf); v += DPP_F(0.f, v, 0x112, 0xf); v += DPP_F(0.f, v, 0x114, 0xf); v += DPP_F(0.f, v, 0x118, 0xf);
    v += DPP_F(0.f, v, 0x142, 0xa); v += DPP_F(0.f, v, 0x143, 0xc);
    return __builtin_bit_cast(float, __builtin_amdgcn_readlane(__builtin_bit_cast(int, v), 63));
}
__device__ __forceinline__ float wave_max_u(float v) {
    v = fmaxf(v, DPP_F(0.f, v, 0x111, 0xf)); v = fmaxf(v, DPP_F(0.f, v, 0x112, 0xf)); v = fmaxf(v, DPP_F(0.f, v, 0x114, 0xf)); v = fmaxf(v, DPP_F(0.f, v, 0x118, 0xf));
    v = fmaxf(v, DPP_F(0.f, v, 0x142, 0xa)); v = fmaxf(v, DPP_F(0.f, v, 0x143, 0xc));
    return __builtin_bit_cast(float, __builtin_amdgcn_readlane(__builtin_bit_cast(int, v), 63));
}
__device__ __forceinline__ float rope_inv(int i) {
    switch (i) {
        case 0: return 1.0f;
        case 1: return 0.44036659598350525f;
        case 2: return 0.1939227432012558f;
        case 3: return 0.08539710193872452f;
        case 4: return 0.03760603070259094f;
        case 5: return 0.016560440883040428f;
        case 6: return 0.007292664609849453f;
        case 7: return 0.0032114461064338684f;
        case 8: return 0.0014142135623842478f;
        case 9: return 0.0006227724370546639f;
        case 10: return 0.00027424818836152554f;
        case 11: return 0.00012076973507646471f;
        case 12: return 5.3182957344688475e-05f;
        case 13: return 2.34199997066753e-05f;
        case 14: return 1.0313385246263351e-05f;
        default: return 4.541670477919979e-06f;
    }
}
__device__ __forceinline__ void sincos_d(float ang, float& c, float& s) {
    const double x = (double)ang;
    const double q = rint(x * 0.63661977236758134308);
    const double r = fma(-q, 1.57079632679489661923, x) - q * 6.123233995736766e-17;
    const double r2 = r * r;
    double cs = 1.0 / 479001600.0; cs = cs * r2 - 1.0 / 3628800.0; cs = cs * r2 + 1.0 / 40320.0; cs = cs * r2 - 1.0 / 720.0; cs = cs * r2 + 1.0 / 24.0; cs = cs * r2 - 0.5; cs = cs * r2 + 1.0;
    double sn = 1.0 / 6227020800.0; sn = sn * r2 - 1.0 / 39916800.0; sn = sn * r2 + 1.0 / 362880.0; sn = sn * r2 - 1.0 / 5040.0; sn = sn * r2 + 1.0 / 120.0; sn = sn * r2 - 1.0 / 6.0; sn = sn * r2 + 1.0; sn *= r;
    const int qi = ((int)(long long)q) & 3;
    double cc, ss;
    if (qi == 0) { cc = cs; ss = sn; } else if (qi == 1) { cc = -sn; ss = cs; } else if (qi == 2) { cc = -cs; ss = -sn; } else { cc = sn; ss = -cs; }
    c = (float)cc; s = (float)ss;
}
__device__ __forceinline__ float gelu_tanh(float x) {
    const float y = 0.7978845608028654f * (x + 0.044715f * x * x * x);
    const float e = __expf(2.0f * y);
    const float th = 1.0f - 2.0f / (e + 1.0f);
    return 0.5f * x * (1.0f + th);
}
__device__ __forceinline__ float partner32(float x, int hi) { auto rr = __builtin_amdgcn_permlane32_swap(__float_as_uint(x), __float_as_uint(x), false, false); return __uint_as_float(hi ? rr[0] : rr[1]); }
__device__ __forceinline__ float sigmoidf_(float x) { return __builtin_amdgcn_rcpf(1.0f + __builtin_amdgcn_exp2f(x * -1.4426950408889634f)); }

__device__ __forceinline__ bf16_t* w_ptr(const Params& p, int l, size_t off) { return (bf16_t*)(p.ws + WS_W + (size_t)l * W_LAYER + off); }

struct ConvItem { const float* W; const float* gain; bf16_t* WT; int N, k0, sc, nv, drow, dK, frag, f8; };
constexpr int I_IN = 32 * 184, I_OUT = 32 * 64, I_GU = 32 * 352, I_DN = 88 * 64, I_C1 = 1024, I_C2 = 32;
constexpr int I_LAYER = I_OUT + I_DN + I_C1 + I_C2;
__device__ __forceinline__ ConvItem conv_desc(const Params& p, int it) {
    const int l = it / I_LAYER; int r = it - l * I_LAYER; ConvItem d; d.frag = 0; d.f8 = 0;
    if (r < I_OUT) { const int kb = r / 64, nb = r % 64;
        d.W = p.in[11] + (size_t)l * DM * DM; d.N = DM; d.k0 = 64 * kb; d.sc = 32 * nb; d.nv = 32; d.WT = w_ptr(p, l, W_OUT); d.drow = 32 * nb; d.dK = DM; d.gain = nullptr; return d; }
    r -= I_OUT;
    if (r < I_DN) { const int kb = r / 64, nb = r % 64;
        d.W = p.in[15] + (size_t)l * DFF * DM; d.N = DM; d.k0 = 64 * kb; d.sc = 32 * nb; d.nv = 32; d.WT = w_ptr(p, l, W_DN); d.drow = 32 * nb; d.dK = DFF; d.gain = nullptr; d.f8 = 1; return d; }
    r -= I_DN;
    if (r < I_C1) { const int kv = r / 512, rr = r % 512, kb = rr / 8, nb = rr % 8;
        d.W = p.in[kv ? 8 : 6] + (size_t)l * 4096 * 256; d.N = 256; d.k0 = 64 * kb; d.sc = 32 * nb; d.nv = 32; d.WT = w_ptr(p, l, W_C1) + (size_t)kv * 256 * 4096; d.drow = 32 * nb; d.dK = 4096; d.gain = nullptr; d.frag = 1; return d; }
    r -= I_C1;
    { const int kv = r / 16, rr = r % 16, kb = rr / 4, nb = rr % 4;
        d.W = p.in[kv ? 9 : 7] + (size_t)l * 256 * 128; d.N = 128; d.k0 = 64 * kb; d.sc = 32 * nb; d.nv = 32; d.WT = w_ptr(p, l, W_C2) + (size_t)kv * 128 * 256; d.drow = 32 * nb; d.dK = 256; d.gain = nullptr; return d; }
}
#define CONV_LOAD(d, tv) do { const int c_ = lane & 31; const float* wp_ = (d).W + (size_t)((d).k0 + (lane >> 5)) * (d).N + (d).sc + (c_ < (d).nv ? c_ : 0); \
        _Pragma("unroll") for (int i = 0; i < 32; ++i) tv[i] = wp_[(size_t)(2 * i) * (d).N]; } while (0)
#define CONV_STORE(d, tv) do { const int c_ = lane & 31; const bool ok_ = c_ < (d).nv; _Pragma("unroll") for (int i = 0; i < 32; ++i) { const int kk = 2 * i + (lane >> 5); scr[kk * 33 + c_] = ok_ ? tv[i] : 0.f; } \
        asm volatile("s_waitcnt lgkmcnt(0)" ::: "memory"); \
        const int c8 = lane & 7; f32x4 ga = {1.f, 1.f, 1.f, 1.f}, gb = {1.f, 1.f, 1.f, 1.f}; \
        if ((d).gain) { ga = *(const f32x4*)((d).gain + (d).k0 + 8 * c8); gb = *(const f32x4*)((d).gain + (d).k0 + 8 * c8 + 4); } \
        _Pragma("unroll") for (int j = 0; j < 4; ++j) { const int n = (lane >> 3) + 8 * j; const LAS float* s = scr + (8 * c8) * 33 + n; \
            u32x4 o; o.x = pk2(s[0 * 33] * ga.x, s[1 * 33] * ga.y); o.y = pk2(s[2 * 33] * ga.z, s[3 * 33] * ga.w); o.z = pk2(s[4 * 33] * gb.x, s[5 * 33] * gb.y); o.w = pk2(s[6 * 33] * gb.z, s[7 * 33] * gb.w); \
            const int na_ = (d).drow + n, ka_ = (d).k0 + 8 * c8; \
            const size_t off_ = (d).frag ? (size_t)((((na_ >> 4) * 128 + (ka_ >> 5)) * 64 + (((ka_ >> 3) & 3) * 16 + (na_ & 15))) * 8) : (size_t)na_ * (d).dK + ka_; \
            if ((d).f8) { int w0_ = 0, w1_ = 0; \
                w0_ = __builtin_amdgcn_cvt_pk_fp8_f32(s[0 * 33] * ga.x * W8_SCALE, s[1 * 33] * ga.y * W8_SCALE, w0_, false); w0_ = __builtin_amdgcn_cvt_pk_fp8_f32(s[2 * 33] * ga.z * W8_SCALE, s[3 * 33] * ga.w * W8_SCALE, w0_, true); \
                w1_ = __builtin_amdgcn_cvt_pk_fp8_f32(s[4 * 33] * gb.x * W8_SCALE, s[5 * 33] * gb.y * W8_SCALE, w1_, false); w1_ = __builtin_amdgcn_cvt_pk_fp8_f32(s[6 * 33] * gb.z * W8_SCALE, s[7 * 33] * gb.w * W8_SCALE, w1_, true); \
                u32x2 o8_; o8_.x = (unsigned)w0_; o8_.y = (unsigned)w1_; *(u32x2*)((unsigned char*)(d).WT + off_) = o8_; } \
            else *(u32x4*)((d).WT + off_) = o; } \
        asm volatile("s_waitcnt lgkmcnt(0)" ::: "memory"); } while (0)

constexpr int STRIP_RS = 4100, N_STRIPS_L = 184 + 352;
static_assert(32 * STRIP_RS <= MISC_OFF, "LDS map");
struct StripDesc { const float* W; const float* gain; unsigned char* dst; float* dsc; int N, sc, nv, drow; };
__device__ __forceinline__ StripDesc strip_desc(const Params& p, int s) {
    const int l = s / N_STRIPS_L, r = s - l * N_STRIPS_L; StripDesc d;
    if (r < 184) { const int n0 = 32 * r; int sc, nv;
        if (n0 < 2560) { sc = n0; nv = 32; } else if (n0 < 5632) { sc = n0 + 24; nv = 32; } else if (n0 == 5632) { sc = 2560; nv = 24; } else { sc = 0; nv = 0; }
        d.W = p.in[3] + (size_t)l * DM * DIN; d.N = DIN; d.sc = sc; d.nv = nv; d.gain = p.in[2] + (size_t)l * DM;
        d.dst = p.ws + WS_WI8 + (size_t)l * 12 * MiB; d.dsc = (float*)(p.ws + WS_WISC) + l * DINP; d.drow = n0; }
    else { const int r0 = 32 * (r - 184), pn = r0 >> 8, w = r0 & 255;
        d.W = (w < 128 ? p.in[13] : p.in[14]) + (size_t)l * DM * DFF; d.N = DFF; d.sc = 128 * pn + (w & 127); d.nv = 32; d.gain = p.in[12] + (size_t)l * DM;
        d.dst = p.ws + WS_W8 + (size_t)l * 22 * MiB; d.dsc = (float*)(p.ws + WS_WSC) + l * 2 * DFF; d.drow = r0; }
    return d;
}
#define STRIP_LOAD(d, k0, tv) do { const int c_ = lane & 31; const float* wp_ = (d).W + (size_t)((k0) + (lane >> 5)) * (d).N + (d).sc + (c_ < (d).nv ? c_ : 0); \
        _Pragma("unroll") for (int i = 0; i < 32; ++i) tv[i] = wp_[(size_t)(2 * i) * (d).N]; } while (0)
#define STRIP_PUT(d, k0, tv) do { const int c_ = lane & 31, hi_ = lane >> 5; const bool ok_ = c_ < (d).nv; \
        _Pragma("unroll") for (int pp = 0; pp < 16; ++pp) { \
            auto sw_ = __builtin_amdgcn_permlane32_swap(__float_as_uint(tv[2 * pp]), __float_as_uint(tv[2 * pp + 1]), false, false); \
            const float v0_ = __uint_as_float(sw_[0]), v1_ = __uint_as_float(sw_[1]);         \
            const f32x4 g_ = *(const f32x4*)((d).gain + (k0) + 4 * pp); \
            const float g0_ = hi_ ? g_.z : g_.x, g1_ = hi_ ? g_.w : g_.y; \
            *(LAS unsigned*)(c.lds + c_ * STRIP_RS + ((k0) + 4 * pp + 2 * hi_) * 2) = ok_ ? pk2(v0_ * g0_, v1_ * g1_) : 0u; } } while (0)
__device__ __forceinline__ void conv_strips(const Params& p, const Ctx& c) {
    const int lane = c.lane, w = c.wave, total = NL * N_STRIPS_L, step = c.ngw / NWAVES;
    int s = c.bx; float ta[32], tb[32]; StripDesc d{}, d1{};
    if (s < total) { d = strip_desc(p, s); STRIP_LOAD(d, 256 * w, ta); }
    while (s < total) {
        STRIP_LOAD(d, 256 * w + 64, tb);  STRIP_PUT(d, 256 * w, ta);
        STRIP_LOAD(d, 256 * w + 128, ta); STRIP_PUT(d, 256 * w + 64, tb);
        STRIP_LOAD(d, 256 * w + 192, tb); STRIP_PUT(d, 256 * w + 128, ta);
        const int s1 = s + step;
        if (s1 < total) { d1 = strip_desc(p, s1); STRIP_LOAD(d1, 256 * w, ta); }
        STRIP_PUT(d, 256 * w + 192, tb);
        __syncthreads();
#pragma unroll 1
        for (int q = 0; q < 4; ++q) { const int n = w + 8 * q;
            bf16x8 v[4];
#pragma unroll
            for (int j = 0; j < 4; ++j) { const LAS unsigned* q_ = (const LAS unsigned*)(c.lds + n * STRIP_RS + (lane + 64 * j) * 16); u32x4 t_; t_.x = q_[0]; t_.y = q_[1]; t_.z = q_[2]; t_.w = q_[3]; v[j] = __builtin_bit_cast(bf16x8, t_); }
            float mx = 0.f;
#pragma unroll
            for (int j = 0; j < 4; ++j)
#pragma unroll
                for (int e = 0; e < 8; ++e) mx = fmaxf(mx, fabsf((float)v[j][e]));
            mx = wave_max_u(mx);
            const float inv = mx > 0.f ? 127.0f / mx : 0.f;
#pragma unroll
            for (int j = 0; j < 4; ++j) { unsigned ww[2];
#pragma unroll
                for (int h = 0; h < 2; ++h) { unsigned u = 0u;
#pragma unroll
                    for (int e = 0; e < 4; ++e) { const int qv = (int)__builtin_rintf((float)v[j][4 * h + e] * inv); u |= ((unsigned)qv & 0xFFu) << (8 * e); }
                    ww[h] = u; }
                u32x2 o; o.x = ww[0]; o.y = ww[1]; ((u32x2*)(d.dst + (size_t)(d.drow + n) * DM))[lane + 64 * j] = o; }
            if (lane == 0) d.dsc[d.drow + n] = mx * (1.0f / 127.0f); }
        __syncthreads();
        d = d1; s = s1;
    }
}
__device__ __forceinline__ void phase_conv(const Params& p, const Ctx& c) {
    LAS float* scr = (LAS float*)(c.lds + c.wave * 8704);
    const int lane = c.lane;
    { float* cbp = (float*)(p.ws + WS_CBP);
      for (int task = c.gw; task < NL * 2 * 4 * 64; task += c.ngw) { const int ic = task & 63, jg = (task >> 6) & 3, kv = (task >> 8) & 1, l = task >> 9;
          const float* w1 = p.in[kv ? 8 : 6] + (size_t)l * 4096 * 256 + (size_t)(64 * ic) * 256 + 64 * jg + c.lane; const float* cp = p.in[5] + (size_t)l * 4096 + 64 * ic;
          float s = 0.f;
#pragma unroll
          for (int b = 0; b < 4; ++b) { float wv[16];
#pragma unroll
              for (int i = 0; i < 16; ++i) wv[i] = w1[(size_t)(16 * b + i) * 256];
#pragma unroll
              for (int i = 0; i < 16; ++i) s += cp[16 * b + i] * wv[i]; }
          cbp[((l * 2 + kv) * 64 + ic) * 256 + 64 * jg + c.lane] = s; } }
    { const int total = NL * I_LAYER; int it = c.gw;
      float ta[32], tb[32]; ConvItem da, db;
      if (it < total) { da = conv_desc(p, it); CONV_LOAD(da, ta); }
      while (it < total) {
          const int i1 = it + c.ngw;
          if (i1 < total) { db = conv_desc(p, i1); CONV_LOAD(db, tb); }
          CONV_STORE(da, ta);
          if (i1 >= total) break;
          const int i2 = i1 + c.ngw;
          if (i2 < total) { da = conv_desc(p, i2); CONV_LOAD(da, ta); }
          CONV_STORE(db, tb);
          it = i2;
      } }
    __syncthreads();
    conv_strips(p, c);
    { bf16_t* hb = (bf16_t*)(p.ws + WS_XN); float* ssq = (float*)(p.ws + WS_SSQ);
      for (int m = c.gw; m < S; m += c.ngw) {
          const f32x4* xr = (const f32x4*)(p.in[0] + (size_t)m * DM) + c.lane; float ss = 0.f; f32x4 xv[8];
#pragma unroll
          for (int j = 0; j < 8; ++j) xv[j] = xr[64 * j];
#pragma unroll
          for (int j = 0; j < 8; ++j) { const f32x4 v = xv[j]; ss += (v.x * v.x + v.y * v.y) + (v.z * v.z + v.w * v.w);
              u32x2 w; w.x = pk2(v.x, v.y); w.y = pk2(v.z, v.w); ((u32x2*)(hb + (size_t)m * DM))[c.lane + 64 * j] = w; }
          ss = wave_sum(ss);
          if (c.lane < 8) ssq[(size_t)m * 8 + c.lane] = c.lane == 0 ? ss : 0.f; } }
    { const int* pos = (const int*)p.in[1]; float* tab = (float*)(p.ws + WS_ROPE); bf16_t* tabh = (bf16_t*)(p.ws + WS_ROPEH);
      for (int idx = c.gw * 64 + c.lane; idx < S * 16; idx += c.ngw * 64) { const int t = idx >> 4, i = idx & 15;
          const float ang = (float)pos[t] * rope_inv(i); float cs, sn; sincos_d(ang, cs, sn); tab[t * 32 + i] = cs; tab[t * 32 + 16 + i] = sn; tabh[t * 32 + i] = (bf16_t)f2bf(cs); tabh[t * 32 + 16 + i] = (bf16_t)f2bf(sn); } }
}

__device__ __forceinline__ void cbias_reduce(const Params& p, const Ctx& c) {
    const float* cbp = (const float*)(p.ws + WS_CBP); float* cbf = (float*)(p.ws + WS_CBF);
    for (int o = c.gw; o < NL * 2 * 256; o += c.ngw) { const int col = o & 255, lk = o >> 8;
        const float v = wave_sum(cbp[(size_t)(lk * 64 + c.lane) * 256 + col]); if (c.lane == 0) cbf[o] = v; }
}

__device__ __forceinline__ void phase_final_norm(const Ctx& c, const bf16_t* hb, const float* ssq, const float* gain, float* dst) {
    f32x4 g[4][2];
#pragma unroll
    for (int j = 0; j < 4; ++j) { g[j][0] = ((const f32x4*)gain)[2 * (c.lane + 64 * j)]; g[j][1] = ((const f32x4*)gain)[2 * (c.lane + 64 * j) + 1]; }
    for (int m = c.gw; m < S; m += c.ngw) {
        const f32x4* q = (const f32x4*)(ssq + (size_t)m * 8); const f32x4 a = q[0], b = q[1];
        bf16x8 v[4];
#pragma unroll
        for (int j = 0; j < 4; ++j) v[j] = ((const bf16x8*)(hb + (size_t)m * DM))[c.lane + 64 * j];
        const float rstd = __builtin_amdgcn_rsqf((((a.x + a.y) + (a.z + a.w)) + ((b.x + b.y) + (b.z + b.w))) * (1.0f / DM) + EPS);
#pragma unroll
        for (int j = 0; j < 4; ++j) { f32x4 o0, o1;
#pragma unroll
            for (int e = 0; e < 4; ++e) { o0[e] = (float)v[j][e] * rstd * g[j][0][e]; o1[e] = (float)v[j][4 + e] * rstd * g[j][1][e]; }
            f32x4* d = (f32x4*)(dst + (size_t)m * DM) + 2 * (c.lane + 64 * j); d[0] = o0; d[1] = o1; }
    }
}

__device__ __forceinline__ void quant_rows(const Ctx& c, const bf16_t* src, unsigned char* dst, float* scale, int R, float fixed = 0.f) {
    for (int r = c.gw; r < R; r += c.ngw) {
        bf16x8 v[4];
#pragma unroll
        for (int j = 0; j < 4; ++j) v[j] = ((const bf16x8*)(src + (size_t)r * DM))[c.lane + 64 * j];
        float mx = 0.f;
#pragma unroll
        for (int j = 0; j < 4; ++j)
#pragma unroll
            for (int e = 0; e < 8; ++e) mx = fmaxf(mx, fabsf((float)v[j][e]));
        mx = wave_max_u(mx);
        if (fixed > 0.f) mx = fixed;
        const float inv = mx > 0.f ? 127.0f / mx : 0.f;
#pragma unroll
        for (int j = 0; j < 4; ++j) { unsigned w[2];
#pragma unroll
            for (int h = 0; h < 2; ++h) { unsigned u = 0u;
#pragma unroll
                for (int e = 0; e < 4; ++e) { int q = (int)__builtin_rintf((float)v[j][4 * h + e] * inv); q = q > 127 ? 127 : (q < -127 ? -127 : q); u |= ((unsigned)q & 0xFFu) << (8 * e); }
                w[h] = u; }
            u32x2 o; o.x = w[0]; o.y = w[1]; ((u32x2*)(dst + (size_t)r * DM))[c.lane + 64 * j] = o; }
        if (c.lane == 0) scale[r] = mx * (1.0f / 127.0f);
    }
}

constexpr int RSTD_OFF = RING_BYTES, RSTD_MAX_UNITS = 8;
constexpr int CSC_OFF = RSTD_OFF + RSTD_MAX_UNITS * 1024, CSC_MAX_UNITS = 6;
static_assert(CSC_OFF + CSC_MAX_UNITS * 1024 <= MISC_OFF, "LDS map");
__device__ __forceinline__ void prep_rstd(const Ctx& c, const pg8::StaticOrder& so, const float* ssq, const float* asc = nullptr, const float* wsc = nullptr) {
    LAS float* tab = (LAS float*)(c.lds + RSTD_OFF); LAS float* ctab = (LAS float*)(c.lds + CSC_OFF);
    const int half = c.tid >> 8, t = c.tid & 255;
    for (int i = half; i < RSTD_MAX_UNITS; i += 2) { pg8::Unit u; if (!so.next(i, u)) break;
        const f32x4* q = (const f32x4*)(ssq + (size_t)(u.pm * 256 + t) * 8); const f32x4 a = q[0], b = q[1];
        float rs = __builtin_amdgcn_rsqf((((a.x + a.y) + (a.z + a.w)) + ((b.x + b.y) + (b.z + b.w))) * (1.0f / DM) + EPS);
        if (asc) { rs *= asc[u.pm * 256 + t]; if (i < CSC_MAX_UNITS) ctab[i * 256 + t] = wsc[u.pn * 256 + t]; }
        tab[i * 256 + t] = rs; }
}
struct PrepRstd { const Ctx& c; const pg8::StaticOrder& so; const float* ssq; const float* asc; const float* wsc; __device__ __forceinline__ void operator()() const { prep_rstd(c, so, ssq, asc, wsc); } };
struct EpiProj {
    static constexpr bool PERM = true, AFTER_DRAIN = false;
    bf16_t* proj; float* gates; const bf16_t* ropeh; const float* bg; const LAS float* rtab; const LAS float* ctab;
    __device__ __forceinline__ void operator()(pg8::f32x4 (&acc)[2][2][4][2], const pg8::Unit& u, int wr, int wc, int fr, int fq) const {
        const int row0 = u.pm * 256 + wr * 64 + fr;
        {
            const LAS f32x4* cs = (const LAS f32x4*)(ctab + u.ord * 256 + wc * 32 + 8 * fq);
#pragma unroll
            for (int bj = 0; bj < 2; ++bj) { const f32x4 c0 = cs[32 * bj], c1 = cs[32 * bj + 1];
#pragma unroll
                for (int ai = 0; ai < 2; ++ai)
#pragma unroll
                    for (int m = 0; m < 4; ++m) { const pg8::i32x4 i0 = __builtin_bit_cast(pg8::i32x4, acc[ai][bj][m][0]), i1 = __builtin_bit_cast(pg8::i32x4, acc[ai][bj][m][1]);
#pragma unroll
                        for (int j = 0; j < 4; ++j) { acc[ai][bj][m][0][j] = (float)i0[j] * c0[j]; acc[ai][bj][m][1][j] = (float)i1[j] * c1[j]; } } }
        }
        float rstd[2][4];
#pragma unroll
        for (int ai = 0; ai < 2; ++ai)
#pragma unroll
            for (int m = 0; m < 4; ++m) rstd[ai][m] = rtab[u.ord * 256 + ai * 128 + wr * 64 + m * 16 + fr];
        const bool rp = (u.pn < 4 || u.pn == 6 || u.pn == 8) && wc == 0;
        if (rp) {
#pragma unroll
            for (int ai = 0; ai < 2; ++ai) {
                bf16x8 rc[4], rsn[4];
#pragma unroll
                for (int m = 0; m < 4; ++m) { const bf16_t* cs = ropeh + (size_t)(row0 + ai * 128 + m * 16) * 32 + (fq & 1) * 8; rc[m] = *(const bf16x8*)cs; rsn[m] = *(const bf16x8*)(cs + 16); }
#pragma unroll
                for (int m = 0; m < 4; ++m) {
                    f32x4 c0, c1, s0, s1;
#pragma unroll
                    for (int j = 0; j < 4; ++j) { c0[j] = (float)rc[m][j]; c1[j] = (float)rc[m][4 + j]; s0[j] = (float)rsn[m][j]; s1[j] = (float)rsn[m][4 + j]; }
                    if (fq < 2) { s0 = -s0; s1 = -s1; }
#pragma unroll
                    for (int bj = 0; bj < 2; ++bj) {
                        const f32x4 v0 = acc[ai][bj][m][0] * rstd[ai][m], v1 = acc[ai][bj][m][1] * rstd[ai][m]; f32x4 q0, q1;
#pragma unroll
                        for (int j = 0; j < 4; ++j) { q0[j] = partner32(v0[j], fq >> 1); q1[j] = partner32(v1[j], fq >> 1); }
                        acc[ai][bj][m][0] = v0 * c0 + q0 * s0; acc[ai][bj][m][1] = v1 * c1 + q1 * s1;
                    }
                }
            }
        }
        if (u.pn < 22) {
#pragma unroll
            for (int bj = 0; bj < 2; ++bj) {
                bf16_t* base = proj + (size_t)(2 * u.pn + bj) * S * HD + wc * 32 + 8 * fq;
#pragma unroll
                for (int ai = 0; ai < 2; ++ai)
#pragma unroll
                    for (int m = 0; m < 4; ++m) {
                        const float rs = rp ? 1.0f : rstd[ai][m];
                        const f32x4 v0 = acc[ai][bj][m][0] * rs, v1 = acc[ai][bj][m][1] * rs;
                        u32x4 w; w.x = pk2(v0[0], v0[1]); w.y = pk2(v0[2], v0[3]); w.z = pk2(v1[0], v1[1]); w.w = pk2(v1[2], v1[3]);
                        *(u32x4*)(base + (size_t)(row0 + ai * 128 + m * 16) * HD) = w;
                    }
            }
        } else {
            if (wc == 0 && fq < 3) {
                const f32x4 b0 = *(const f32x4*)(bg + 8 * fq), b1 = *(const f32x4*)(bg + 8 * fq + 4);
#pragma unroll
                for (int ai = 0; ai < 2; ++ai)
#pragma unroll
                    for (int m = 0; m < 4; ++m) {
                        f32x4 g0 = acc[ai][0][m][0] * rstd[ai][m] + b0, g1 = acc[ai][0][m][1] * rstd[ai][m] + b1;
#pragma unroll
                        for (int j = 0; j < 4; ++j) { g0[j] = sigmoidf_(g0[j]); g1[j] = sigmoidf_(g1[j]); }
                        f32x4* d = (f32x4*)(gates + (size_t)(row0 + ai * 128 + m * 16) * 24 + 8 * fq); d[0] = g0; d[1] = g1;
                    }
            }
        }
    }
};
struct EpiResid {
    static constexpr bool PERM = false, AFTER_DRAIN = false;
    const float* hin; float* hout;
    __device__ __forceinline__ void operator()(const pg8::f32x4 (&acc)[2][2][4][2], const pg8::Unit& u, int wr, int wc, int fr, int fq) const {
        const int row0 = u.pm * 256 + wr * 64 + fr, col0 = u.pn * 256 + wc * 32 + 4 * fq;
#pragma unroll
        for (int ai = 0; ai < 2; ++ai)
#pragma unroll
            for (int m = 0; m < 4; ++m) { const size_t off = (size_t)(row0 + ai * 128 + m * 16) * DM + col0;
#pragma unroll
                for (int bj = 0; bj < 2; ++bj)
#pragma unroll
                    for (int n = 0; n < 2; ++n) { const size_t o = off + bj * 128 + n * 16; *(f32x4*)(hout + o) = *(const f32x4*)(hin + o) + acc[ai][bj][m][n]; } }
    }
};
struct EpiResidH {
    static constexpr bool PERM = true, AFTER_DRAIN = true;
    bf16_t* hb; float* ssq; float mult;
    unsigned char* q8; float* qsc; float* xslab; unsigned* xcnt; unsigned target;
    __device__ __forceinline__ void fused(pg8::f32x4 (&acc)[2][2][4][2], const pg8::Unit& u, int wr, int wc, int fr, int fq, PG8_LAS unsigned char* lds, int wid, int lane) const {
        const int row0 = u.pm * 256 + wr * 64 + fr, col0 = u.pn * 256 + wc * 32 + 8 * fq;
        PG8_LAS float* P = (PG8_LAS float*)lds;
        PG8_LAS float* PM = (PG8_LAS float*)(lds + 4096);
        PG8_LAS float* INV = (PG8_LAS float*)(lds + 8192);
#pragma unroll
        for (int ai = 0; ai < 2; ++ai) {
            bf16x8 hv[4][2];
#pragma unroll
            for (int m = 0; m < 4; ++m)
#pragma unroll
                for (int bj = 0; bj < 2; ++bj) hv[m][bj] = *(const bf16x8*)(hb + (size_t)(row0 + ai * 128 + m * 16) * DM + col0 + bj * 128);
#pragma unroll
            for (int m = 0; m < 4; ++m) { const size_t off = (size_t)(row0 + ai * 128 + m * 16) * DM + col0; float ss = 0.f, am = 0.f;
#pragma unroll
                for (int bj = 0; bj < 2; ++bj) { f32x4 v0 = acc[ai][bj][m][0] * mult, v1 = acc[ai][bj][m][1] * mult;
#pragma unroll
                    for (int e = 0; e < 4; ++e) { v0[e] += (float)hv[m][bj][e]; v1[e] += (float)hv[m][bj][4 + e]; }
                    u32x4 w; w.x = pk2(v0.x, v0.y); w.y = pk2(v0.z, v0.w); w.z = pk2(v1.x, v1.y); w.w = pk2(v1.z, v1.w); *(u32x4*)(hb + off + bj * 128) = w;
                    acc[ai][bj][m][0] = v0; acc[ai][bj][m][1] = v1;
#pragma unroll
                    for (int e = 0; e < 4; ++e) am = fmaxf(am, fmaxf(fabsf(v0[e]), fabsf(v1[e])));
                    ss += ((v0.x * v0.x + v0.y * v0.y) + (v0.z * v0.z + v0.w * v0.w)) + ((v1.x * v1.x + v1.y * v1.y) + (v1.z * v1.z + v1.w * v1.w)); }
                ss += __builtin_bit_cast(float, __builtin_amdgcn_ds_swizzle(__builtin_bit_cast(int, ss), 0x401F)); ss += partner32(ss, fq >> 1);
                am = fmaxf(am, __builtin_bit_cast(float, __builtin_amdgcn_ds_swizzle(__builtin_bit_cast(int, am), 0x401F))); am = fmaxf(am, partner32(am, fq >> 1));
                if (fq == 0) { P[(ai * 128 + wr * 64 + m * 16 + fr) * 4 + wc] = ss; PM[(ai * 128 + wr * 64 + m * 16 + fr) * 4 + wc] = am; }
                asm volatile("" ::: "memory"); } }
        asm volatile("s_waitcnt lgkmcnt(0)" ::: "memory"); __builtin_amdgcn_s_barrier(); asm volatile("" ::: "memory");
        const int t = wid * 64 + lane;
        if (q8) {
            if (t < 256) { const PG8_LAS float* q = PM + t * 4; __hip_atomic_store(xslab + (size_t)(u.pm * 8 + u.pn) * 256 + t, fmaxf(fmaxf(q[0], q[1]), fmaxf(q[2], q[3])), __ATOMIC_RELAXED, __HIP_MEMORY_SCOPE_AGENT); }
            asm volatile("s_waitcnt vmcnt(0)" ::: "memory");
        }
        if (t < 256) { const PG8_LAS float* q = P + t * 4; ssq[(size_t)(u.pm * 256 + t) * 8 + u.pn] = (q[0] + q[1]) + (q[2] + q[3]); }
        if (q8) {
            __syncthreads();
            if (t == 0) { (void)__hip_atomic_fetch_add(xcnt + 64 * u.pm, 1u, __ATOMIC_RELAXED, __HIP_MEMORY_SCOPE_AGENT);
                unsigned spins = 0; while (__hip_atomic_load(xcnt + 64 * u.pm, __ATOMIC_RELAXED, __HIP_MEMORY_SCOPE_AGENT) < target && ++spins < (1u << 22)) __builtin_amdgcn_s_sleep(1); }
            __syncthreads();
            if (t < 256) { float pm8[8];
#pragma unroll
                for (int j = 0; j < 8; ++j) pm8[j] = __hip_atomic_load(xslab + (size_t)(u.pm * 8 + j) * 256 + t, __ATOMIC_RELAXED, __HIP_MEMORY_SCOPE_AGENT);
                const float mx = fmaxf(fmaxf(fmaxf(pm8[0], pm8[1]), fmaxf(pm8[2], pm8[3])), fmaxf(fmaxf(pm8[4], pm8[5]), fmaxf(pm8[6], pm8[7])));
                INV[t] = mx > 0.f ? 127.0f / mx : 0.f;
                if (u.pn == 0) qsc[u.pm * 256 + t] = mx * (1.0f / 127.0f); }
            asm volatile("s_waitcnt lgkmcnt(0)" ::: "memory"); __builtin_amdgcn_s_barrier(); asm volatile("" ::: "memory");
#pragma unroll
            for (int ai = 0; ai < 2; ++ai)
#pragma unroll
                for (int m = 0; m < 4; ++m) { const float inv = INV[ai * 128 + wr * 64 + m * 16 + fr]; const size_t off = (size_t)(row0 + ai * 128 + m * 16) * DM + col0;
#pragma unroll
                    for (int bj = 0; bj < 2; ++bj) { unsigned w[2];
#pragma unroll
                        for (int n = 0; n < 2; ++n) { const f32x4 v = acc[ai][bj][m][n]; unsigned uu = 0u;
#pragma unroll
                            for (int e = 0; e < 4; ++e) { int q = (int)__builtin_rintf(v[e] * inv); q = q > 127 ? 127 : (q < -127 ? -127 : q); uu |= ((unsigned)q & 0xFFu) << (8 * e); }
                            w[n] = uu; }
                        u32x2 o; o.x = w[0]; o.y = w[1]; *(u32x2*)(q8 + off + bj * 128) = o; } }
        }
    }
};

struct EpiSwiGLU {
    static constexpr bool PERM = true, AFTER_DRAIN = false;
    unsigned char* act; const LAS float* rtab; const LAS float* ctab;
    __device__ __forceinline__ void operator()(const pg8::f32x4 (&acc)[2][2][4][2], const pg8::Unit& u, int wr, int wc, int fr, int fq) const {
        const int row0 = u.pm * 256 + wr * 64 + fr, col0 = u.pn * 128 + wc * 32 + 8 * fq;
        const LAS f32x4* cs = (const LAS f32x4*)(ctab + u.ord * 256 + wc * 32 + 8 * fq);
        const f32x4 cg0 = cs[0], cg1 = cs[1], cu0 = cs[32], cu1 = cs[33];
#pragma unroll
        for (int ai = 0; ai < 2; ++ai)
#pragma unroll
            for (int m = 0; m < 4; ++m) {
                const float rs = rtab[u.ord * 256 + ai * 128 + wr * 64 + m * 16 + fr];
                f32x4 g0, g1, u0, u1;
                const pg8::i32x4 ig0 = __builtin_bit_cast(pg8::i32x4, acc[ai][0][m][0]), ig1 = __builtin_bit_cast(pg8::i32x4, acc[ai][0][m][1]);
                const pg8::i32x4 iu0 = __builtin_bit_cast(pg8::i32x4, acc[ai][1][m][0]), iu1 = __builtin_bit_cast(pg8::i32x4, acc[ai][1][m][1]);
#pragma unroll
                for (int j = 0; j < 4; ++j) {
                    g0[j] = (float)ig0[j] * (rs * cg0[j]); g1[j] = (float)ig1[j] * (rs * cg1[j]);
                    u0[j] = (float)iu0[j] * (rs * cu0[j]); u1[j] = (float)iu1[j] * (rs * cu1[j]); }
                f32x4 o0, o1;
#pragma unroll
                for (int j = 0; j < 4; ++j) { o0[j] = g0[j] * sigmoidf_(g0[j]) * u0[j]; o1[j] = g1[j] * sigmoidf_(g1[j]) * u1[j]; }
                int w0 = 0, w1 = 0;
                w0 = __builtin_amdgcn_cvt_pk_fp8_f32(o0[0] * A8_SCALE, o0[1] * A8_SCALE, w0, false); w0 = __builtin_amdgcn_cvt_pk_fp8_f32(o0[2] * A8_SCALE, o0[3] * A8_SCALE, w0, true);
                w1 = __builtin_amdgcn_cvt_pk_fp8_f32(o1[0] * A8_SCALE, o1[1] * A8_SCALE, w1, false); w1 = __builtin_amdgcn_cvt_pk_fp8_f32(o1[2] * A8_SCALE, o1[3] * A8_SCALE, w1, true);
                u32x2 w; w.x = (unsigned)w0; w.y = (unsigned)w1;
                *(u32x2*)(act + (size_t)(row0 + ai * 128 + m * 16) * DFF + col0) = w;
            }
    }
};

constexpr int CMPR_A_BYTES = 272 * 256 + 17 * 16, CMPR_HID = 70144;
__device__ __forceinline__ void phase_cmpr(const Params& p, const Ctx& c, int l) {
    const bf16_t* proj = (const bf16_t*)(p.ws + WS_PROJ); const float* rope = (const float*)(p.ws + WS_ROPE); const float* cbf = (const float*)(p.ws + WS_CBF);
    LAS bf16_t* hid = (LAS bf16_t*)(c.lds + CMPR_HID);
    const int lane = c.lane, w = c.wave, l15 = lane & 15, q4 = lane >> 4;
    const int u = c.bx >> 1, hh = c.bx & 1;
    const int kv = u >> 6, g = (u >> 5) & 1, rb = u & 31, n0 = 16 * rb;
    { bf16x8 sv[9];
      const bf16_t* src = proj + (size_t)((kv ? 10 : 8) + g) * S * HD;
#pragma unroll
      for (int i = 0; i < 9; ++i) { int ci = c.tid + NTHREADS * i; if (ci > 272 * 16 - 1) ci = 272 * 16 - 1; const int tk = ci >> 4, ch = ci & 15; int ta = 16 * n0 + tk; if (ta > S - 1) ta = S - 1;
          sv[i] = *(const bf16x8*)(src + (size_t)ta * HD + ch * 8); }
#pragma unroll
      for (int i = 0; i < 9; ++i) { const int ci = c.tid + NTHREADS * i; const int tk = ci >> 4, ch = ci & 15;
          if (ci < 272 * 16) *(LAS bf16x8*)(c.lds + tk * 256 + (tk >> 4) * 16 + ch * 16) = sv[i]; } }
    __syncthreads();
    const int ct = 8 * hh + w;
    const bf16_t* bf = w_ptr(p, l, W_C1) + (size_t)kv * 256 * 4096 + (size_t)ct * 128 * 512 + lane * 8;
    const LAS unsigned char* abase = c.lds + l15 * (4096 + 16) + q4 * 16;
    f32x4 acc = {0.f, 0.f, 0.f, 0.f};
    {
        bf16x8 B0[8], B1[8];
#define CMPR_LD(B_, ks_) do { _Pragma("unroll") for (int i = 0; i < 8; ++i) B_[i] = *(const bf16x8*)(bf + (size_t)((ks_) + i) * 512); } while (0)
#define CMPR_MM(B_, ks_) do { _Pragma("unroll") for (int i = 0; i < 8; ++i) { const int k_ = 32 * ((ks_) + i); \
            const bf16x8 a_ = *(const LAS bf16x8*)(abase + (k_ >> 7) * 256 + ((k_ >> 7) >= 16 ? 16 : 0) + (k_ & 127) * 2); \
            acc = __builtin_amdgcn_mfma_f32_16x16x32_f16(a_, B_[i], acc, 0, 0, 0); } } while (0)
        CMPR_LD(B0, 0);
        for (int ks = 0; ks < 128; ks += 16) {
            CMPR_LD(B1, ks + 8);
            CMPR_MM(B0, ks);
            if (ks + 16 < 128) CMPR_LD(B0, ks + 16);
            CMPR_MM(B1, ks + 8);
        }
#undef CMPR_LD
#undef CMPR_MM
    }
    { const int col = 16 * ct + l15; const float bs = cbf[(l * 2 + kv) * 256 + col];
#pragma unroll
      for (int j = 0; j < 4; ++j) hid[(q4 * 4 + j) * 136 + 16 * w + l15] = (bf16_t)f2bf(gelu_tanh(acc[j] + bs)); }
    __syncthreads();
    f32x4 o = {0.f, 0.f, 0.f, 0.f};
    const int ocol = (w < 2) ? ((l15 < 8) ? 8 * w + l15 : 16 + 8 * w + (l15 - 8)) : 16 * w + l15;
    const bf16_t* w2 = w_ptr(p, l, W_C2) + (size_t)kv * 128 * 256 + (size_t)ocol * 256 + 128 * hh + 8 * q4;
#pragma unroll
    for (int k0 = 0; k0 < 128; k0 += 32) {
        const bf16x8 a = *(const LAS bf16x8*)(hid + l15 * 136 + k0 + 8 * q4), b = *(const bf16x8*)(w2 + k0);
        o = __builtin_amdgcn_mfma_f32_16x16x32_f16(a, b, o, 0, 0, 0);
    }
    float* part = (float*)(p.ws + WS_CPART) + (size_t)u * 2048; unsigned* flag = (unsigned*)(p.ws + WS_CTL) + CW_CFLAG + 64 * u;
    if (hh == 1) {
#pragma unroll
        for (int j = 0; j < 4; ++j) __hip_atomic_store(part + (q4 * 4 + j) * 128 + 16 * w + l15, o[j], __ATOMIC_RELAXED, __HIP_MEMORY_SCOPE_AGENT);
        asm volatile("s_waitcnt vmcnt(0)" ::: "memory");
        __syncthreads();
        if (c.tid == 0) __hip_atomic_store(flag, (unsigned)(l + 1), __ATOMIC_RELAXED, __HIP_MEMORY_SCOPE_AGENT);
    } else {
        if (c.tid == 0) { unsigned spins = 0; while (__hip_atomic_load(flag, __ATOMIC_RELAXED, __HIP_MEMORY_SCOPE_AGENT) != (unsigned)(l + 1) && ++spins < (1u << 22)) __builtin_amdgcn_s_sleep(2); }
        __syncthreads();
        bf16_t* dst = (bf16_t*)(p.ws + (kv ? WS_VC : WS_KC)) + (size_t)g * 512 * HD;
        float pv[4], cs[4], sn[4];
#pragma unroll
        for (int j = 0; j < 4; ++j) { pv[j] = __hip_atomic_load(part + (q4 * 4 + j) * 128 + 16 * w + l15, __ATOMIC_RELAXED, __HIP_MEMORY_SCOPE_AGENT); cs[j] = 1.f; sn[j] = 0.f;
            if (kv == 0 && w < 2) { int ti = 16 * (n0 + q4 * 4 + j) + 31; if (ti > S - 1) ti = S - 1; const int fi = 8 * w + (l15 & 7); cs[j] = rope[ti * 32 + fi]; sn[j] = rope[ti * 32 + 16 + fi]; } }
#pragma unroll
        for (int j = 0; j < 4; ++j) {
            const int n = n0 + q4 * 4 + j; float v = o[j] + pv[j];
            if (kv == 0 && w < 2) { const float pr = DPP_F(0.f, v, 0x128, 0xf);     v = (l15 < 8) ? v * cs[j] - pr * sn[j] : v * cs[j] + pr * sn[j]; }
            if (n > 510) v = 0.f;
            dst[(size_t)n * HD + ocol] = (bf16_t)f2bf(v);
        }
    }
    __syncthreads();
}
typedef float f32x16 __attribute__((ext_vector_type(16)));
typedef _Float16 h4_t __attribute__((ext_vector_type(4)));
#define KSWZ(row, colB) ((row) * 256 + ((colB) ^ (((row) & 7) << 4)))
__device__ __forceinline__ int v_st(int k, int c) { const int kk = (k & ~0xC) | ((k & 4) << 1) | ((k & 8) >> 1); return ((kk >> 3) * 4 + (c >> 5)) * 512 + ((kk & 7) * 32 + (c & 31)) * 2; }
__device__ __forceinline__ int v_rd_base(int lane) { return ((lane & 3) << 3) | (((lane >> 2) & 3) << 6) | (((lane >> 4) & 1) << 5) | (((lane >> 5) & 1) << 8); }
constexpr int v_rd_off(int d0, int ks, int half) { return d0 * 512 + ks * 4096 + half * 2048; }
__device__ __forceinline__ int crow(int r, int hi) { return (r & 3) + 8 * (r >> 2) + 4 * hi; }
__device__ __forceinline__ void qkt(f32x16& p0, f32x16& p1, const LAS char* K_lds, int r32, int hi, const bf16x8* qr) {
#pragma unroll
    for (int r = 0; r < 16; ++r) { p0[r] = 0.f; p1[r] = 0.f; }
    int base = r32 * 256 + ((hi * 16) ^ ((r32 & 7) << 4));
    asm volatile("" : "+v"(base));
#pragma unroll
    for (int d0 = 0; d0 < 8; ++d0) { const LAS char* a = K_lds + (base ^ ((d0 & 3) << 5)) + (d0 >> 2) * 128;
        const bf16x8 b0 = *(const LAS bf16x8*)a, b1 = *(const LAS bf16x8*)(a + 32 * 256);
        p0 = __builtin_amdgcn_mfma_f32_32x32x16_f16(b0, qr[d0], p0, 0, 0, 0);
        p1 = __builtin_amdgcn_mfma_f32_32x32x16_f16(b1, qr[d0], p1, 0, 0, 0);
        if (d0 == 3) __builtin_amdgcn_sched_barrier(0); }
}
__device__ __forceinline__ void pack_p(const f32x16& p0, const f32x16& p1, bf16x8& pa0, bf16x8& pa1, bf16x8& pa2, bf16x8& pa3) {
#define PK4(P, B_, OUT) do { const unsigned a0 = pk2(P[B_ + 0], P[B_ + 1]), a1 = pk2(P[B_ + 2], P[B_ + 3]), b0 = pk2(P[B_ + 4], P[B_ + 5]), b1 = pk2(P[B_ + 6], P[B_ + 7]); \
        auto r0 = __builtin_amdgcn_permlane32_swap(a0, b0, false, false); auto r1 = __builtin_amdgcn_permlane32_swap(a1, b1, false, false); \
        u32x4 w = {r0[0], r1[0], r0[1], r1[1]}; OUT = __builtin_bit_cast(bf16x8, w); } while (0)
    PK4(p0, 0, pa0); PK4(p0, 8, pa1); PK4(p1, 0, pa2); PK4(p1, 8, pa3);
#undef PK4
}
__device__ __forceinline__ void pv_tile(f32x16* o, int vb0, bf16x8 pa0, bf16x8 pa1, bf16x8 pa2, bf16x8 pa3) {
#define TRRD(dst, off) asm volatile("ds_read_b64_tr_b16 %0, %1 offset:%2" : "=&v"(dst) : "v"(vb0), "i"(off) : "memory")
#define PV_D0(d0) do { h4_t l0, l1, l2, l3, h0, h1, h2, h3; constexpr int b_ = v_rd_off(d0, 0, 0); \
        TRRD(l0, b_); TRRD(h0, b_ + 2048); TRRD(l1, b_ + 4096); TRRD(h1, b_ + 6144); TRRD(l2, b_ + 8192); TRRD(h2, b_ + 10240); TRRD(l3, b_ + 12288); TRRD(h3, b_ + 14336); \
        asm volatile("s_waitcnt lgkmcnt(0)" ::: "memory"); __builtin_amdgcn_sched_barrier(0); \
        o[d0] = __builtin_amdgcn_mfma_f32_32x32x16_f16(pa0, (bf16x8){l0[0], l0[1], l0[2], l0[3], h0[0], h0[1], h0[2], h0[3]}, o[d0], 0, 0, 0); \
        o[d0] = __builtin_amdgcn_mfma_f32_32x32x16_f16(pa1, (bf16x8){l1[0], l1[1], l1[2], l1[3], h1[0], h1[1], h1[2], h1[3]}, o[d0], 0, 0, 0); \
        o[d0] = __builtin_amdgcn_mfma_f32_32x32x16_f16(pa2, (bf16x8){l2[0], l2[1], l2[2], l2[3], h2[0], h2[1], h2[2], h2[3]}, o[d0], 0, 0, 0); \
        o[d0] = __builtin_amdgcn_mfma_f32_32x32x16_f16(pa3, (bf16x8){l3[0], l3[1], l3[2], l3[3], h3[0], h3[1], h3[2], h3[3]}, o[d0], 0, 0, 0); } while (0)
    PV_D0(0); PV_D0(1); PV_D0(2); PV_D0(3);
#undef PV_D0
#undef TRRD
}

__device__ __forceinline__ void qkt_half(f32x16& ph, const LAS char* K_lds, int half, int r32, int hi, const bf16x8* qr) {
#pragma unroll
    for (int r = 0; r < 16; ++r) ph[r] = 0.f;
    int base = r32 * 256 + ((hi * 16) ^ ((r32 & 7) << 4)) + half * 8192;
    asm volatile("" : "+v"(base));
    __builtin_amdgcn_s_setprio(1);
#pragma unroll
    for (int d0 = 0; d0 < 8; ++d0) { const LAS char* a = K_lds + (base ^ ((d0 & 3) << 5)) + (d0 >> 2) * 128;
        const bf16x8 b0 = *(const LAS bf16x8*)a;
        ph = __builtin_amdgcn_mfma_f32_32x32x16_f16(b0, qr[d0], ph, 0, 0, 0); }
    __builtin_amdgcn_s_setprio(0);
}
__device__ __forceinline__ void pack_half(const f32x16& ph, bf16x8& pa0, bf16x8& pa1) {
#define PK4(P, B_, OUT) do { const unsigned a0 = pk2(P[B_ + 0], P[B_ + 1]), a1 = pk2(P[B_ + 2], P[B_ + 3]), b0 = pk2(P[B_ + 4], P[B_ + 5]), b1 = pk2(P[B_ + 6], P[B_ + 7]); \
        auto r0 = __builtin_amdgcn_permlane32_swap(a0, b0, false, false); auto r1 = __builtin_amdgcn_permlane32_swap(a1, b1, false, false); \
        u32x4 w = {r0[0], r1[0], r0[1], r1[1]}; OUT = __builtin_bit_cast(bf16x8, w); } while (0)
    PK4(ph, 0, pa0); PK4(ph, 8, pa1);
#undef PK4
}
__device__ __forceinline__ void pv_half(f32x16* o, int vbh, bf16x8 pa0, bf16x8 pa1) {
#define TRRD(dst, off) asm volatile("ds_read_b64_tr_b16 %0, %1 offset:%2" : "=&v"(dst) : "v"(vbh), "i"(off) : "memory")
    h4_t l0[4], h0[4], l1[4], h1[4];
#define PV_RD(d0) do { constexpr int b_ = v_rd_off(d0, 0, 0); TRRD(l0[d0], b_); TRRD(h0[d0], b_ + 2048); TRRD(l1[d0], b_ + 4096); TRRD(h1[d0], b_ + 6144); } while (0)
    PV_RD(0); PV_RD(1); PV_RD(2); PV_RD(3);
    asm volatile("s_waitcnt lgkmcnt(0)" ::: "memory"); __builtin_amdgcn_sched_barrier(0);
    __builtin_amdgcn_s_setprio(1);
#pragma unroll
    for (int d0 = 0; d0 < 4; ++d0) {
        o[d0] = __builtin_amdgcn_mfma_f32_32x32x16_f16(pa0, (bf16x8){l0[d0][0], l0[d0][1], l0[d0][2], l0[d0][3], h0[d0][0], h0[d0][1], h0[d0][2], h0[d0][3]}, o[d0], 0, 0, 0);
        o[d0] = __builtin_amdgcn_mfma_f32_32x32x16_f16(pa1, (bf16x8){l1[d0][0], l1[d0][1], l1[d0][2], l1[d0][3], h1[d0][0], h1[d0][1], h1[d0][2], h1[d0][3]}, o[d0], 0, 0, 0); }
    __builtin_amdgcn_s_setprio(0);
#undef PV_RD
#undef TRRD
}

__device__ __forceinline__ float wave_max_dpp(float v) {
    v = fmaxf(v, DPP_F(v, v, 0x111, 0xf)); v = fmaxf(v, DPP_F(v, v, 0x112, 0xf)); v = fmaxf(v, DPP_F(v, v, 0x114, 0xf)); v = fmaxf(v, DPP_F(v, v, 0x118, 0xf));
    v = fmaxf(v, DPP_F(v, v, 0x142, 0xa)); v = fmaxf(v, DPP_F(v, v, 0x143, 0xc));
    return __builtin_bit_cast(float, __builtin_amdgcn_readlane(__builtin_bit_cast(int, v), 63));
}
__device__ __forceinline__ float half_sum_dpp(float v, int hi) {
    v += DPP_F(0.f, v, 0x111, 0xf); v += DPP_F(0.f, v, 0x112, 0xf); v += DPP_F(0.f, v, 0x114, 0xf); v += DPP_F(0.f, v, 0x118, 0xf);
    v += DPP_F(0.f, v, 0x142, 0xa);
    const float lo = __builtin_bit_cast(float, __builtin_amdgcn_readlane(__builtin_bit_cast(int, v), 31)), hs = __builtin_bit_cast(float, __builtin_amdgcn_readlane(__builtin_bit_cast(int, v), 63));
    return hi ? hs : lo;
}

__device__ __forceinline__ float quad_swap1(float x) { return __int_as_float(__builtin_amdgcn_update_dpp(0, __float_as_int(x), 0xB1, 0xF, 0xF, true)); }
__device__ __forceinline__ void store_row4(bf16_t* orow_e  , float v0, float v1, float v2, float v3, int odd) {
    { const float y = quad_swap1(odd ? v0 : v1); *(unsigned*)(orow_e + (odd ? 32 : 0)) = odd ? pk2(y, v1) : pk2(v0, y); }
    { const float y = quad_swap1(odd ? v2 : v3); *(unsigned*)(orow_e + (odd ? 96 : 64)) = odd ? pk2(y, v3) : pk2(v2, y); }
}
__device__ __forceinline__ void store_head_rows(const f32x16* o, const float* ggrp_h, bf16_t* Obase  , int r32, int hi) {
    float gg[4];
#pragma unroll
    for (int d0 = 0; d0 < 4; ++d0) gg[d0] = ggrp_h[d0 * 32 + r32];
    const int odd = r32 & 1;
#pragma unroll
    for (int r = 0; r < 16; ++r) {
        const float ss = half_sum_dpp((o[0][r] * o[0][r] + o[1][r] * o[1][r]) + (o[2][r] * o[2][r] + o[3][r] * o[3][r]), hi);
        const float rs = __builtin_amdgcn_rsqf(ss * (1.0f / HD) + EPS);
        store_row4(Obase + (size_t)crow(r, hi) * DM + (r32 & ~1), o[0][r] * rs * gg[0], o[1][r] * rs * gg[1], o[2][r] * rs * gg[2], o[3][r] * rs * gg[3], odd);
    }
}

typedef unsigned long long u64x2 __attribute__((ext_vector_type(2)));

enum { M_CSTAT = 0, M_CIMP = 1, M_SLC = 2, M_CPV = 3, M_WSTAT = 4, M_WPV = 5, M_SB = 6 };
constexpr int ATT_WS = 0, ATT_FLAGS = 2048, NSA_SEL = 2112, NSA_WUNI = 3136, ATT_V0 = 4096, ATT_K0 = ATT_V0 + 3 * 16384, NSA_P = ATT_V0  ;
constexpr int ATT_END = ATT_K0 + 4 * 16384;
constexpr int TNONE = 128;
static_assert(ATT_END <= MISC_OFF, "LDS map");
__device__ __forceinline__ int next_bit(unsigned m0, unsigned m1, unsigned m2, unsigned m3, int from) {
    if (from < 32) { const unsigned w = m0 & (~0u << from); if (w) return __builtin_ctz(w); from = 32; }
    if (from < 64) { const unsigned w = m1 & (~0u << (from - 32)); if (w) return 32 + __builtin_ctz(w); from = 64; }
    if (from < 96) { const unsigned w = m2 & (~0u << (from - 64)); if (w) return 64 + __builtin_ctz(w); from = 96; }
    if (from < 128) { const unsigned w = m3 & (~0u << (from - 96)); if (w) return 96 + __builtin_ctz(w); }
    return 128;
}
__device__ __forceinline__ unsigned bit_of(unsigned m0, unsigned m1, unsigned m2, unsigned m3, int j) { const unsigned w = j < 32 ? m0 : j < 64 ? m1 : j < 96 ? m2 : m3; return (w >> (j & 31)) & 1u; }
__device__ __forceinline__ float quad_sum(float x) {
    x += __builtin_bit_cast(float, __builtin_amdgcn_update_dpp(0, __builtin_bit_cast(int, x), 0xB1, 0xf, 0xf, true));
    x += __builtin_bit_cast(float, __builtin_amdgcn_update_dpp(0, __builtin_bit_cast(int, x), 0x4E, 0xf, 0xf, true));
    return x;
}
struct PassArgs {
    const bf16_t* Kp; const bf16_t* Vp;
    unsigned tm0, tm1, tm2, tm3;
    unsigned wm0, wm1, wm2, wm3;
    unsigned sw0, sw1, sw2, sw3;
    int tok, nvr, b, nvmin;
    int jtop, tw0;
    float f;
};
template <int MODE>
__device__ __forceinline__ void attn_pass(const Ctx& c, const bf16x8 (&qr)[8], f32x16 (&o)[4], float& m, float& l, const PassArgs& a) {
    constexpr bool SB = (MODE == M_SB);
    constexpr bool HASV = (MODE == M_SLC || MODE == M_CPV || MODE == M_WPV || SB);
    constexpr bool CMP = (MODE == M_CSTAT || MODE == M_CIMP || MODE == M_CPV);
    constexpr bool WIN = (MODE == M_WSTAT || MODE == M_WPV);
    constexpr int HA = SB ? 1 : 0, HB = SB ? 0 : 1;
    constexpr float C2 = SCALE * 1.4426950408889634f;
    const int lane = c.lane, w = c.wave, r32 = lane & 31, hi = lane >> 5;
    LAS char* V_lds = (LAS char*)c.lds + ATT_V0; LAS char* K_lds = (LAS char*)c.lds + ATT_K0;
    LAS float* wsf = (LAS float*)(c.lds + ATT_WS) + w * 64;
    volatile LAS unsigned* flags = (volatile LAS unsigned*)(c.lds + ATT_FLAGS);
    unsigned kg0, kg1, vg0, vg1;
    { const int A0 = 16 * (64 * w + lane), A1 = A0 + 8192;
      { const int row = A0 >> 8, cB = (A0 & 255) ^ ((row & 7) << 4); kg0 = (unsigned)(row * HD * 2 + cB); }
      { const int row = A1 >> 8, cB = (A1 & 255) ^ ((row & 7) << 4); kg1 = (unsigned)(row * HD * 2 + cB); }
      { const int st = A0 >> 9, wi = A0 & 511, kk = (st >> 2) * 8 + (wi >> 6), cc = (st & 3) * 32 + ((wi & 63) >> 1), k = (kk & ~0xC) | ((kk & 4) << 1) | ((kk & 8) >> 1); vg0 = (unsigned)((k * HD + cc) * 2); }
      { const int st = A1 >> 9, wi = A1 & 511, kk = (st >> 2) * 8 + (wi >> 6), cc = (st & 3) * 32 + ((wi & 63) >> 1), k = (kk & ~0xC) | ((kk & 4) << 1) | ((kk & 8) >> 1); vg1 = (unsigned)((k * HD + cc) * 2); } }
    const int vb0 = (int)(unsigned)(size_t)V_lds + v_rd_base(lane);
    const float NEG = -__builtin_inff();
    bool done = false;
#define AP_NEXT(j_) (SB ? ((j_) > 0 ? (j_) - 1 : TNONE) : next_bit(a.tm0, a.tm1, a.tm2, a.tm3, (j_) + 1))
#define AP_ACT(j_) (SB ? (!done && 64 * (j_) <= a.tw0 + 30) : (bit_of(a.wm0, a.wm1, a.wm2, a.wm3, (j_)) != 0u))
#define AP_DMAK(j_, buf) do { const bf16_t* g_ = a.Kp + (size_t)(64 * (j_)) * HD; \
        __builtin_amdgcn_global_load_lds((const unsigned*)((const char*)g_ + kg0), (LAS unsigned*)(K_lds + (buf) * 16384 + w * 1024), 16, 0, 0); \
        __builtin_amdgcn_global_load_lds((const unsigned*)((const char*)g_ + kg1), (LAS unsigned*)(K_lds + (buf) * 16384 + 8192 + w * 1024), 16, 0, 0); } while (0)
#define AP_DMAV(j_, buf) do { if (HASV) { const bf16_t* g_ = a.Vp + (size_t)(64 * (j_)) * HD; \
        __builtin_amdgcn_global_load_lds((const unsigned*)((const char*)g_ + vg0), (LAS unsigned*)(V_lds + (buf) * 16384 + w * 1024), 16, 0, 0); \
        __builtin_amdgcn_global_load_lds((const unsigned*)((const char*)g_ + vg1), (LAS unsigned*)(V_lds + (buf) * 16384 + 8192 + w * 1024), 16, 0, 0); } } while (0)
#define AP_WAITN(full) do { if (full) { if (HASV) asm volatile("s_waitcnt vmcnt(4)" ::: "memory"); else asm volatile("s_waitcnt vmcnt(2)" ::: "memory"); } \
                            else asm volatile("s_waitcnt vmcnt(0)" ::: "memory"); } while (0)
    int j0 = SB ? a.jtop : next_bit(a.tm0, a.tm1, a.tm2, a.tm3, 0);
    if (j0 >= TNONE) return;
    int j1 = AP_NEXT(j0), j2 = j1 < TNONE ? AP_NEXT(j1) : TNONE, j3 = j2 < TNONE ? AP_NEXT(j2) : TNONE;
    int kc = 0, vc = 0;
    f32x16 pX, pY;
    bf16x8 kf[4];
    float carry = 0.f;
    __syncthreads();
    AP_DMAK(j0, 0); AP_DMAV(j0, 0);
    if (j1 < TNONE) AP_DMAK(j1, 1);
    bool full = j2 < TNONE;
    if (j2 < TNONE) AP_DMAK(j2, 2);
    if (j1 < TNONE) AP_DMAV(j1, 1);
    AP_WAITN(full); __syncthreads();
    if (AP_ACT(j0)) qkt_half(pX, K_lds, HA, r32, hi, qr);
#define AP_SB_EL(P, HF, r) do { const float y = P[r] * C2; \
                const float sp = fmaxf(y, 0.f) + __builtin_amdgcn_logf(1.0f + __builtin_amdgcn_exp2f(-fabsf(y))); \
                float Lr = -sp, br = y - sp; \
                if (needmask) { const bool ok = (dq - 32 * (HF) - (((r) & 3) + 8 * ((r) >> 2))) >= 0; Lr = ok ? Lr : 0.f; br = ok ? br : NEG; } \
                Lv[r] = Lr; P[r] = br; } while (0)
#define AP_KADDR(KT, QH, d_) ((KT) + (kb_ ^ (((d_) & 3) << 5)) + ((d_) >> 2) * 128)
#define AP_QMFMA(PN, c_, KT, QH) do { if ((c_) == 0) { f32x16 z_; _Pragma("unroll") for (int q_ = 0; q_ < 16; ++q_) z_[q_] = 0.f; PN = __builtin_amdgcn_mfma_f32_32x32x16_f16(kf[0], qr[0], z_, 0, 0, 0); } \
        else PN = __builtin_amdgcn_mfma_f32_32x32x16_f16(kf[(c_) & 3], qr[c_], PN, 0, 0, 0); \
        if ((c_) + 4 < 8) kf[(c_) & 3] = *(const LAS bf16x8*)AP_KADDR(KT, QH, (c_) + 4);        \
        __builtin_amdgcn_sched_barrier(0); } while (0)
#define AP_QPIN(KT, QH) int kb_ = r32 * 256 + ((hi * 16) ^ ((r32 & 7) << 4)) + (QH) * 8192; asm volatile("" : "+v"(kb_)); \
        _Pragma("unroll") for (int d_ = 0; d_ < 4; ++d_) kf[d_] = *(const LAS bf16x8*)AP_KADDR(KT, QH, d_); \
        __builtin_amdgcn_sched_barrier(0)
#define AP_PROCH(P, J, HF, VB, DOQ, PN, KT, QH) do { \
        if (SB) { \
            const int key0 = 64 * (J); const bool needmask = key0 + 63 >= a.tw0; const int dq = a.tok - 1 - key0 - 4 * hi; float run = carry; \
            float Lv[16]; \
            if (DOQ) { AP_QPIN(KT, QH); _Pragma("unroll") for (int c_ = 0; c_ < 8; ++c_) { AP_SB_EL(P, HF, 2 * c_); AP_SB_EL(P, HF, 2 * c_ + 1); AP_QMFMA(PN, c_, KT, QH); } } \
            else { _Pragma("unroll") for (int r = 0; r < 16; ++r) AP_SB_EL(P, HF, r); } \
            float g[4], pg[4]; \
            _Pragma("unroll") for (int i = 0; i < 4; ++i) { g[i] = (Lv[4 * i] + Lv[4 * i + 1]) + (Lv[4 * i + 2] + Lv[4 * i + 3]); pg[i] = partner32(g[i], hi); } \
            _Pragma("unroll") for (int i = 3; i >= 0; --i) { float aft = run + (hi ? 0.f : pg[i]); run += g[i] + pg[i]; \
                P[4 * i + 3] = __builtin_amdgcn_exp2f(P[4 * i + 3] + aft); aft += Lv[4 * i + 3]; \
                P[4 * i + 2] = __builtin_amdgcn_exp2f(P[4 * i + 2] + aft); aft += Lv[4 * i + 2]; \
                P[4 * i + 1] = __builtin_amdgcn_exp2f(P[4 * i + 1] + aft); aft += Lv[4 * i + 1]; \
                P[4 * i + 0] = __builtin_amdgcn_exp2f(P[4 * i + 0] + aft); } \
            carry = run; \
            bf16x8 pa0, pa1; pack_half(P, pa0, pa1); pv_half(o, vb0 + (VB) * 16384 + (HF) * 8192, pa0, pa1); \
            if ((HF) == HB) done = __all(carry <= -151.0f); \
        } else { \
            if (CMP) { if (64 * (J) + 32 * (HF) + 32 > a.nvmin) { const int dq = a.nvr - 1 - 64 * (J) - 32 * (HF) - 4 * hi;     \
                _Pragma("unroll") for (int r = 0; r < 16; ++r) { const int cr = (r & 3) + 8 * (r >> 2); if (dq - cr < 0) P[r] = NEG; } } } \
            if (WIN) { if ((J) == a.b || (J) == a.b - 8) { const int dq = a.tok - 64 * (J) - 32 * (HF) - 4 * hi; \
                _Pragma("unroll") for (int r = 0; r < 16; ++r) { const int cr = (r & 3) + 8 * (r >> 2); if ((unsigned)(dq - cr) >= 512u) P[r] = NEG; } } } \
            if (MODE == M_SLC) { if ((J) == a.b) { const int dq = a.tok - 64 * (J) - 32 * (HF) - 4 * hi; \
                _Pragma("unroll") for (int r = 0; r < 16; ++r) { const int cr = (r & 3) + 8 * (r >> 2); if (dq - cr < 0) P[r] = NEG; } } } \
            if (MODE == M_CSTAT || MODE == M_WSTAT || MODE == M_SLC) { \
                float pmax = P[0]; \
                _Pragma("unroll") for (int r = 1; r < 16; ++r) pmax = fmaxf(pmax, P[r]); \
                bool selr = true; \
                if (MODE == M_SLC) { selr = bit_of(a.sw0, a.sw1, a.sw2, a.sw3, (J)) != 0u; pmax = selr ? pmax : NEG; } \
                pmax = fmaxf(pmax, partner32(pmax, hi)); \
                  \
                const bool keep = (MODE == M_SLC) && __all((pmax - m) * C2 <= 8.0f); \
                const float mn = keep ? m : fmaxf(m, pmax); \
                const float alpha = keep ? 1.0f : __builtin_amdgcn_exp2f((m - mn) * C2); \
                m = mn; \
                const float mnL = selr ? -mn * C2 : NEG; \
                float ps = 0.f; \
                if (DOQ) { AP_QPIN(KT, QH); _Pragma("unroll") for (int c_ = 0; c_ < 8; ++c_) { \
                        P[2 * c_] = __builtin_amdgcn_exp2f(fmaf(P[2 * c_], C2, mnL)); P[2 * c_ + 1] = __builtin_amdgcn_exp2f(fmaf(P[2 * c_ + 1], C2, mnL)); ps += P[2 * c_] + P[2 * c_ + 1]; AP_QMFMA(PN, c_, KT, QH); } } \
                else { _Pragma("unroll") for (int r = 0; r < 16; ++r) { P[r] = __builtin_amdgcn_exp2f(fmaf(P[r], C2, mnL)); ps += P[r]; } } \
                ps += partner32(ps, hi); \
                l = l * alpha + ps; \
                if (MODE == M_SLC) { \
                    if (!keep && __any(alpha < 1.f)) { \
                        if (hi == 0) wsf[r32] = alpha; \
                        asm volatile("s_waitcnt lgkmcnt(0)" ::: "memory"); \
                        _Pragma("unroll") for (int r = 0; r < 16; ++r) { const float al = wsf[crow(r, hi)]; \
                            _Pragma("unroll") for (int d0 = 0; d0 < 4; ++d0) o[d0][r] *= al; } \
                    } \
                    bf16x8 pa0, pa1; pack_half(P, pa0, pa1); pv_half(o, vb0 + (VB) * 16384 + (HF) * 8192, pa0, pa1); \
                } \
            } else { \
                const float mL = -m * C2; \
                if (DOQ) { AP_QPIN(KT, QH); _Pragma("unroll") for (int c_ = 0; c_ < 8; ++c_) { \
                        P[2 * c_] = __builtin_amdgcn_exp2f(fmaf(P[2 * c_], C2, mL)) * a.f; P[2 * c_ + 1] = __builtin_amdgcn_exp2f(fmaf(P[2 * c_ + 1], C2, mL)) * a.f; AP_QMFMA(PN, c_, KT, QH); } } \
                else { _Pragma("unroll") for (int r = 0; r < 16; ++r) P[r] = __builtin_amdgcn_exp2f(fmaf(P[r], C2, mL)) * a.f; } \
                if (MODE == M_CIMP) { \
                      \
                    LAS float* PT = (LAS float*)(c.lds + NSA_P) + (8 * w + (r32 >> 2)) * 128; \
                    float s3v[4], av[4]; \
                    _Pragma("unroll") for (int i = 0; i < 4; ++i) { \
                        const float s0 = quad_sum(P[4 * i]), s1 = quad_sum(P[4 * i + 1]), s2 = quad_sum(P[4 * i + 2]); s3v[i] = quad_sum(P[4 * i + 3]); \
                        av[i] = 2.f * ((s0 + s1) + s2) + s3v[i]; } \
                    float ps3[4]; \
                    _Pragma("unroll") for (int i = 0; i < 4; ++i) ps3[i] = partner32(s3v[i], hi); \
                    _Pragma("unroll") for (int i = 0; i < 4; ++i) { \
                        const int Jb = 16 * (J) + 8 * (HF) + 2 * i + hi; \
                        const float prev = hi ? ps3[i] : (i == 0 ? carry : ps3[i > 0 ? i - 1 : 0]); \
                        if ((r32 & 3) == 0) PT[Jb] = av[i] + prev; } \
                    carry = ps3[3];      \
                } else { bf16x8 pa0, pa1; pack_half(P, pa0, pa1); pv_half(o, vb0 + (VB) * 16384 + (HF) * 8192, pa0, pa1); } \
            } \
        } } while (0)
    for (;;) {
        if (SB) { if (lane == 0) flags[w] = done ? 1u : 0u; }
        AP_WAITN(full); __syncthreads();
        if (SB) { unsigned all = 1u;
#pragma unroll
            for (int i = 0; i < NWAVES; ++i) all &= flags[i];
            if (all) break; }
        full = j3 < TNONE;
        if (j3 < TNONE) AP_DMAK(j3, (kc + 3) & 3);
        if (j2 < TNONE) AP_DMAV(j2, vc == 0 ? 2 : vc - 1);
        const bool act0 = AP_ACT(j0);
        const bool actq = (j1 < TNONE) && AP_ACT(j1);
        if (act0) AP_PROCH(pX, j0, HA, vc, true, pY, K_lds + kc * 16384, HB);
        if (actq) qkt_half(pX, K_lds + ((kc + 1) & 3) * 16384, HA, r32, hi, qr);
        if (act0) AP_PROCH(pY, j0, HB, vc, false, pX, K_lds, HA);
        if (j1 >= TNONE) break;
        j0 = j1; j1 = j2; j2 = j3; j3 = j3 < TNONE ? AP_NEXT(j3) : TNONE;
        kc = (kc + 1) & 3; vc = vc == 2 ? 0 : vc + 1;
    }
    asm volatile("s_waitcnt vmcnt(0)" ::: "memory");
#undef AP_PROCH
#undef AP_QMFMA
#undef AP_QPIN
#undef AP_KADDR
#undef AP_SB_EL
#undef AP_NEXT
#undef AP_ACT
#undef AP_DMAK
#undef AP_DMAV
#undef AP_WAITN
}

__device__ __forceinline__ void sb_unit(const Params& p, const Ctx& c, int l, int h, int qb) {
    const bf16_t* proj = (const bf16_t*)(p.ws + WS_PROJ);
    const bf16_t* Q = proj + (size_t)(20 + h) * S * HD;
    int lane_; asm volatile("v_mbcnt_lo_u32_b32 %0, -1, 0\n\tv_mbcnt_hi_u32_b32 %0, -1, %0" : "=v"(lane_));
    const int lane = lane_, w = c.wave, r32 = lane & 31, hi = lane >> 5;
    const int t0 = 256 * qb, tw0 = t0 + 32 * w, tq = tw0 + r32;
    bf16x8 qr[8];
#pragma unroll
    for (int d0 = 0; d0 < 8; ++d0) qr[d0] = *(const bf16x8*)(Q + (size_t)tq * HD + d0 * 16 + hi * 8);
    f32x16 o[4];
#pragma unroll
    for (int d0 = 0; d0 < 4; ++d0)
#pragma unroll
        for (int r = 0; r < 16; ++r) o[d0][r] = 0.f;
    PassArgs a{}; a.Kp = proj + (size_t)(28 + h) * S * HD; a.Vp = proj + (size_t)(36 + h) * S * HD; a.tok = tq; a.jtop = (t0 + 254) >> 6; a.tw0 = tw0;
    float m = 0.f, lsum = 0.f;
    attn_pass<M_SB>(c, qr, o, m, lsum, a);
    store_head_rows(o, p.in[10] + (size_t)l * DM + (8 + h) * HD, (bf16_t*)(p.ws + WS_O) + (size_t)tw0 * DM + (8 + h) * HD, r32, hi);
}

template <int role>
__device__ __forceinline__ void nsa_unit(const Params& p, const Ctx& c, int l, int g, int b) {
    const bf16_t* proj = (const bf16_t*)(p.ws + WS_PROJ);
    const bf16_t* kc = (const bf16_t*)(p.ws + WS_KC) + (size_t)g * 512 * HD; const bf16_t* vc = (const bf16_t*)(p.ws + WS_VC) + (size_t)g * 512 * HD;
    const float* gates = (const float*)(p.ws + WS_GATES);
    const int lane = c.lane, w = c.wave, r32 = lane & 31, hi = lane >> 5;
    const int t0 = 64 * b, tl = 8 * w + (r32 >> 2), tok = t0 + tl, H = 4 * g + (r32 & 3);
    bf16x8 qr[8];
#pragma unroll
    for (int d0 = 0; d0 < 8; ++d0) qr[d0] = *(const bf16x8*)(proj + (size_t)H * S * HD + (size_t)tok * HD + d0 * 16 + hi * 8);
    const float g0 = gates[(size_t)tok * 24 + H], g1 = gates[(size_t)tok * 24 + 8 + H], g2 = gates[(size_t)tok * 24 + 16 + H];
    f32x16 o[4];
    __syncthreads();
    { LAS f32x4* za = (LAS f32x4*)(c.lds + NSA_P);
      for (int i = c.tid; i < 32768 / 16; i += NTHREADS) za[i] = (f32x4){0.f, 0.f, 0.f, 0.f}; }
    PassArgs a{}; a.tok = tok; a.b = b;
    a.nvr = tok >= 31 ? (tok - 31) / 16 + 1 : 0; if (a.nvr > NCMP) a.nvr = NCMP;
    { const int tmin = t0 + 8 * w; a.nvmin = tmin >= 31 ? (tmin - 31) / 16 + 1 : 0; if (a.nvmin > NCMP) a.nvmin = NCMP; }
    int nvmax = (t0 + 63 - 31) / 16 + 1; if (nvmax > NCMP) nvmax = NCMP;
    const unsigned cm0 = (1u << ((nvmax + 63) >> 6)) - 1u;
    float mc = -1e30f, lc = 0.f;
    a.Kp = kc; a.Vp = vc; a.tm0 = cm0; a.wm0 = cm0;
    attn_pass<M_CSTAT>(c, qr, o, mc, lc, a);
    const float ilc = lc > 0.f ? 1.0f / lc : 0.f;
    a.f = ilc;
    attn_pass<M_CIMP>(c, qr, o, mc, lc, a);
    __syncthreads();
    { const LAS float* PTb = (const LAS float*)(c.lds + NSA_P);
      LAS unsigned* selw = (LAS unsigned*)(c.lds + NSA_SEL); LAS unsigned* wuni = (LAS unsigned*)(c.lds + NSA_WUNI);
      unsigned long long u0 = 0ull, u1 = 0ull;
      for (int tt = 0; tt < 8; ++tt) {
          const int tk = 8 * w + tt; const int j0 = lane, j1 = lane + 64;
          const float a0 = PTb[tk * 128 + j0], a1 = PTb[tk * 128 + j1];
          const bool f0 = (j0 == 0) || (j0 == b) || (j0 == b - 1), f1 = (j1 == b) || (j1 == b - 1);
          bool sel0 = f0 && j0 <= b, sel1 = f1 && j1 <= b;
          float c0 = (!f0 && j0 >= 1 && j0 <= b - 2) ? a0 : -1.f, c1 = (!f1 && j1 <= b - 2) ? a1 : -1.f;
          const int ncand = b - 2 > 0 ? b - 2 : 0, ksel = 16 - (b >= 2 ? 3 : b + 1);
          if (ncand <= ksel) { if (c0 >= 0.f) sel0 = true; if (c1 >= 0.f) sel1 = true; }
          else { for (int it = 0; it < ksel; ++it) {
                     const float mx = wave_max_dpp(fmaxf(c0, c1));
                     const unsigned long long b0 = __ballot(c0 == mx);
                     if (b0) { const int first = __ffsll((long long)b0) - 1; if (lane == first) { c0 = -1.f; sel0 = true; } }
                     else { const unsigned long long b1 = __ballot(c1 == mx); const int first = __ffsll((long long)b1) - 1; if (lane == first) { c1 = -1.f; sel1 = true; } } } }
          const unsigned long long m0 = __ballot(sel0), m1 = __ballot(sel1);
          u0 |= m0; u1 |= m1;
          if (lane == 0) { selw[tk * 4 + 0] = (unsigned)m0; selw[tk * 4 + 1] = (unsigned)(m0 >> 32); selw[tk * 4 + 2] = (unsigned)m1; selw[tk * 4 + 3] = (unsigned)(m1 >> 32); }
      }
      if (lane == 0) { wuni[w * 4 + 0] = (unsigned)u0; wuni[w * 4 + 1] = (unsigned)(u0 >> 32); wuni[w * 4 + 2] = (unsigned)u1; wuni[w * 4 + 3] = (unsigned)(u1 >> 32); }
      __syncthreads();
      unsigned gu0 = 0u, gu1 = 0u, gu2 = 0u, gu3 = 0u;
#pragma unroll
      for (int i = 0; i < NWAVES; ++i) { gu0 |= wuni[i * 4 + 0]; gu1 |= wuni[i * 4 + 1]; gu2 |= wuni[i * 4 + 2]; gu3 |= wuni[i * 4 + 3]; }
      a.tm0 = __builtin_amdgcn_readfirstlane(gu0); a.tm1 = __builtin_amdgcn_readfirstlane(gu1); a.tm2 = __builtin_amdgcn_readfirstlane(gu2); a.tm3 = __builtin_amdgcn_readfirstlane(gu3);
      a.wm0 = (unsigned)u0; a.wm1 = (unsigned)(u0 >> 32); a.wm2 = (unsigned)u1; a.wm3 = (unsigned)(u1 >> 32);
      a.sw0 = selw[tl * 4 + 0]; a.sw1 = selw[tl * 4 + 1]; a.sw2 = selw[tl * 4 + 2]; a.sw3 = selw[tl * 4 + 3];
      if (role != 0) {
          const int n = b - 63; const unsigned lo0 = n >= 32 ? ~0u : ((1u << n) - 1u), lo1 = n >= 64 ? ~0u : (n > 32 ? ((1u << (n - 32)) - 1u) : 0u);
          if (role == 2) { a.tm0 &= lo0; a.tm1 &= lo1; a.tm2 = 0u; a.tm3 = 0u; a.wm0 &= lo0; a.wm1 &= lo1; a.wm2 = 0u; a.wm3 = 0u; }
          else { a.tm0 &= ~lo0; a.tm1 &= ~lo1; a.wm0 &= ~lo0; a.wm1 &= ~lo1; } }
    }
#pragma unroll
    for (int d0 = 0; d0 < 4; ++d0)
#pragma unroll
        for (int r = 0; r < 16; ++r) o[d0][r] = 0.f;
    { float ms = -1e30f, ls = 0.f;
      a.Kp = proj + (size_t)(12 + g) * S * HD; a.Vp = proj + (size_t)(14 + g) * S * HD;
      attn_pass<M_SLC>(c, qr, o, ms, ls, a);
      LAS float* wsf = (LAS float*)(c.lds + ATT_WS) + w * 64;
      constexpr float C2 = SCALE * 1.4426950408889634f;
      if (role != 0) {
          int lane_; asm volatile("v_mbcnt_lo_u32_b32 %0, -1, 0\n\tv_mbcnt_hi_u32_b32 %0, -1, %0" : "=v"(lane_));
          const int lane = lane_, r32 = lane & 31, hi = lane >> 5;
          float* part = (float*)(p.ws + WS_PART + (size_t)(g * 64 + (b - 64)) * PART_SLOT); float* pml = part + 32768 + w * 64;
          unsigned* flag = (unsigned*)(p.ws + WS_CTL) + CW_NSAFLAG + 64 * (g * 64 + (b - 64));
          if (role == 2) {
#pragma unroll
              for (int r = 0; r < 16; ++r) { const f32x4 v_ = (f32x4){o[0][r], o[1][r], o[2][r], o[3][r]}; float* dp_ = part + (size_t)(w * 16 + r) * 256 + lane * 4;
                  asm volatile("global_store_dwordx4 %0, %1, off sc1\n\ts_nop 1" :: "v"(dp_), "v"(v_) : "memory"); }
              if (hi == 0) { __hip_atomic_store(pml + r32, ms, __ATOMIC_RELAXED, __HIP_MEMORY_SCOPE_AGENT); __hip_atomic_store(pml + 32 + r32, ls, __ATOMIC_RELAXED, __HIP_MEMORY_SCOPE_AGENT); }
              asm volatile("s_waitcnt vmcnt(0)" ::: "memory");
              __syncthreads();
              if (c.tid == 0) __hip_atomic_store(flag, (unsigned)(l + 1), __ATOMIC_RELAXED, __HIP_MEMORY_SCOPE_AGENT);
              return;
          }
          if (c.tid == 0) { unsigned spins = 0; while (__hip_atomic_load(flag, __ATOMIC_RELAXED, __HIP_MEMORY_SCOPE_AGENT) != (unsigned)(l + 1) && ++spins < (1u << 22)) __builtin_amdgcn_s_sleep(4); }
          __syncthreads();
          const float m1 = __hip_atomic_load(pml + r32, __ATOMIC_RELAXED, __HIP_MEMORY_SCOPE_AGENT), l1 = __hip_atomic_load(pml + 32 + r32, __ATOMIC_RELAXED, __HIP_MEMORY_SCOPE_AGENT);
          f32x4 qa[4];
#define NSA_LDROW(i_, r_) do { unsigned long long* qp_ = (unsigned long long*)(part + (size_t)(w * 16 + (r_)) * 256 + lane * 4); u64x2 t_; \
              t_.x = __hip_atomic_load(qp_, __ATOMIC_RELAXED, __HIP_MEMORY_SCOPE_AGENT); t_.y = __hip_atomic_load(qp_ + 1, __ATOMIC_RELAXED, __HIP_MEMORY_SCOPE_AGENT); qa[i_] = __builtin_bit_cast(f32x4, t_); } while (0)
#pragma unroll
          for (int i = 0; i < 4; ++i) NSA_LDROW(i, i);
          const float mm = fmaxf(m1, ms), f1 = __builtin_amdgcn_exp2f((m1 - mm) * C2), f2 = __builtin_amdgcn_exp2f((ms - mm) * C2);
          ls = l1 * f1 + ls * f2;
          if (hi == 0) { wsf[r32] = f1; wsf[32 + r32] = f2; }
          asm volatile("s_waitcnt lgkmcnt(0)" ::: "memory");
#pragma unroll
          for (int hb = 0; hb < 4; ++hb) {
#pragma unroll
              for (int i = 0; i < 4; ++i) { const int r = hb * 4 + i; const float a1 = wsf[crow(r, hi)], a2 = wsf[32 + crow(r, hi)];
#pragma unroll
                  for (int d0 = 0; d0 < 4; ++d0) o[d0][r] = qa[i][d0] * a1 + o[d0][r] * a2; }
              asm volatile("" : "+v"(o[0][4 * hb]), "+v"(o[1][4 * hb]), "+v"(o[2][4 * hb]), "+v"(o[3][4 * hb]), "+v"(o[0][4 * hb + 1]), "+v"(o[1][4 * hb + 1]), "+v"(o[2][4 * hb + 1]), "+v"(o[3][4 * hb + 1]),
                               "+v"(o[0][4 * hb + 2]), "+v"(o[1][4 * hb + 2]), "+v"(o[2][4 * hb + 2]), "+v"(o[3][4 * hb + 2]), "+v"(o[0][4 * hb + 3]), "+v"(o[1][4 * hb + 3]), "+v"(o[2][4 * hb + 3]), "+v"(o[3][4 * hb + 3]) :: "memory");
              if (hb < 3) {
#pragma unroll
                  for (int i = 0; i < 4; ++i) NSA_LDROW(i, 4 * (hb + 1) + i); }
          }
          asm volatile("s_waitcnt lgkmcnt(0)" ::: "memory");
      }
      if (hi == 0) wsf[r32] = g1 / ls;
      asm volatile("s_waitcnt lgkmcnt(0)" ::: "memory");
#pragma unroll
      for (int r = 0; r < 16; ++r) { const float al = wsf[crow(r, hi)];
#pragma unroll
          for (int d0 = 0; d0 < 4; ++d0) o[d0][r] *= al; } }
    a.Kp = kc; a.Vp = vc; a.tm0 = cm0; a.tm1 = a.tm2 = a.tm3 = 0u; a.wm0 = cm0; a.wm1 = a.wm2 = a.wm3 = 0u; a.f = g0 * ilc;
    attn_pass<M_CPV>(c, qr, o, mc, lc, a);
    { unsigned wt0 = 0u, wt1 = 0u, wt2 = 0u, wt3 = 0u;
      for (int j = (b - 8 > 0 ? b - 8 : 0); j <= b; ++j) { const unsigned bit = 1u << (j & 31); if (j < 32) wt0 |= bit; else if (j < 64) wt1 |= bit; else if (j < 96) wt2 |= bit; else wt3 |= bit; }
      float mw = -1e30f, lw = 0.f;
      a.Kp = proj + (size_t)(16 + g) * S * HD; a.Vp = proj + (size_t)(18 + g) * S * HD;
      a.tm0 = wt0; a.tm1 = wt1; a.tm2 = wt2; a.tm3 = wt3; a.wm0 = wt0; a.wm1 = wt1; a.wm2 = wt2; a.wm3 = wt3; a.f = 0.f;
      attn_pass<M_WSTAT>(c, qr, o, mw, lw, a);
      a.f = g2 / lw;
      attn_pass<M_WPV>(c, qr, o, mw, lw, a); }
    { const float* ggrp = p.in[10] + (size_t)l * DM; bf16_t* O = (bf16_t*)(p.ws + WS_O);
      int lane_; asm volatile("v_mbcnt_lo_u32_b32 %0, -1, 0\n\tv_mbcnt_hi_u32_b32 %0, -1, %0" : "=v"(lane_));
      const int r32 = lane_ & 31, hi = lane_ >> 5, odd = lane_ & 1;
      float gg[4][4];
#pragma unroll
      for (int hh = 0; hh < 4; ++hh)
#pragma unroll
          for (int d0 = 0; d0 < 4; ++d0) gg[hh][d0] = ggrp[(4 * g + hh) * HD + d0 * 32 + r32];
#pragma unroll
      for (int r = 0; r < 16; ++r) {
          const float ss = half_sum_dpp((o[0][r] * o[0][r] + o[1][r] * o[1][r]) + (o[2][r] * o[2][r] + o[3][r] * o[3][r]), hi);
          const float rs = __builtin_amdgcn_rsqf(ss * (1.0f / HD) + EPS);
          const int rr = crow(r, hi), Hh = 4 * g + (r & 3); const int tk = t0 + 8 * w + (rr >> 2);
          store_row4(O + (size_t)tk * DM + Hh * HD + (r32 & ~1), o[0][r] * rs * gg[r & 3][0], o[1][r] * rs * gg[r & 3][1], o[2][r] * rs * gg[r & 3][2], o[3][r] * rs * gg[r & 3][3], odd);
      } }
}
__device__ __forceinline__ void phase_nsa(const Params& p, const Ctx& c, int l) {
    const int u0 = c.bx, g = u0 & 1, rk = u0 >> 1;
    if (rk < 64) { nsa_unit<2>(p, c, l, g, 127 - rk); nsa_unit<0>(p, c, l, g, rk); }
    else nsa_unit<1>(p, c, l, g, rk);
    __syncthreads();
}
__device__ __forceinline__ void phase_cmpr_sb(const Params& p, const Ctx& c, int l) {
    phase_cmpr(p, c, l);
    sb_unit(p, c, l, c.bx & 7, 31 - (c.bx >> 3));
    __syncthreads();
}
__device__ __forceinline__ Ctx make_ctx(unsigned char* lds, int wave) {
    Ctx c; c.lds = (LAS unsigned char*)lds; int ln_; asm volatile("v_mbcnt_lo_u32_b32 %0, -1, 0\n\tv_mbcnt_hi_u32_b32 %0, -1, %0" : "=v"(ln_));
    int wv_ = wave; asm volatile("" : "+s"(wv_));
    c.lane = ln_; c.wave = wv_; c.tid = wv_ * 64 + ln_;
    int bx_ = blockIdx.x; asm volatile("" : "+s"(bx_)); c.bx = bx_;
    c.gw = bx_ * NWAVES + c.wave; c.ngw = gridDim.x * NWAVES; return c;
}
#define AS4 __attribute__((address_space(4)))
__device__ __forceinline__ Params load_params() {
    unsigned long long v = (unsigned long long)(const AS4 void*)__builtin_amdgcn_kernarg_segment_ptr();
    asm volatile("" : "+s"(v));
    const AS4 Params* q = (const AS4 Params*)v; Params r;
#pragma unroll
    for (int i = 0; i < 17; ++i) r.in[i] = q->in[i];
    r.out = q->out; r.ws = q->ws; return r;
}
constexpr int CW_BAR = 4096;
#ifndef MEGA
#define MEGA 1
#endif
__global__ void __launch_bounds__(NTHREADS, 2) k_mega(Params p_arg) {
    extern __shared__ __attribute__((aligned(16))) unsigned char lds_raw[];
#define PCTX const Ctx c = make_ctx(lds_raw, wave0); const Params p = load_params()
    const int wave0 = __builtin_amdgcn_readfirstlane((int)threadIdx.x >> 6);
    volatile LAS unsigned* misc = (volatile LAS unsigned*)((LAS unsigned char*)lds_raw + MISC_OFF);
    if (threadIdx.x < 8) misc[threadIdx.x] = 0u;
    __syncthreads();
    { const Params p = load_params(); (void)xcd_barrier_post((unsigned*)(p.ws + WS_CTL) + CW_BAR, misc, threadIdx.x == 0); }
#define GBAR() do { const Params p = load_params(); XcdBarrier b_; b_.bar = (unsigned*)(p.ws + WS_CTL) + CW_BAR; b_.x = xb_xcc_id(); b_.st = misc; { int ln__; asm volatile("v_mbcnt_lo_u32_b32 %0, -1, 0\n\tv_mbcnt_hi_u32_b32 %0, -1, %0" : "=v"(ln__)); b_.leader = (wave0 == 0) && (ln__ == 0); } xcd_barrier(b_); } while (0)
    { PCTX; phase_conv(p, c); }
    GBAR();
    for (int l = 0; l < NL; ++l) {
        if (l == 0) { { PCTX; quant_rows(c, (const bf16_t*)(p.ws + WS_XN), p.ws + WS_XN8, (float*)(p.ws + WS_ASC), S); cbias_reduce(p, c); }
          GBAR(); }
        { PCTX; pg8::Gemm g{(const bf16_t*)(p.ws + WS_XN8), (const bf16_t*)(p.ws + WS_WI8 + (size_t)l * 12 * MiB), S, DINP, DM / 2}; pg8::StaticOrder so; so.init(S, DINP, gridDim.x, c.bx);
          EpiProj E{(bf16_t*)(p.ws + WS_PROJ), (float*)(p.ws + WS_GATES), (const bf16_t*)(p.ws + WS_ROPEH), p.in[4] + 24 * l, (const LAS float*)(c.lds + RSTD_OFF), (const LAS float*)(c.lds + CSC_OFF)};
          pg8::gemm_phase<EpiProj, pg8::StaticOrder, true, true, PrepRstd, 2>(c.lds, g, so, E, c.tid, PrepRstd{c, so, (const float*)(p.ws + WS_SSQ), (const float*)(p.ws + WS_ASC), (const float*)(p.ws + WS_WISC) + l * DINP});
        }
        GBAR();
        { PCTX; phase_cmpr_sb(p, c, l); }
        GBAR();
        { PCTX; phase_nsa(p, c, l); }
        GBAR();
        { PCTX; pg8::Gemm g{(const bf16_t*)(p.ws + WS_O), w_ptr(p, l, W_OUT), S, DM, DM}; pg8::StaticOrder so; so.init(S, DM, gridDim.x, c.bx);
          EpiResidH E{(bf16_t*)(p.ws + WS_XN), (float*)(p.ws + WS_SSQ), 1.0f, p.ws + WS_XN8, (float*)(p.ws + WS_ASC), (float*)(p.ws + WS_XSLAB), (unsigned*)(p.ws + WS_CTL) + CW_XCNT, 8u * (unsigned)(2 * l + 1)};
          pg8::gemm_phase<EpiResidH, pg8::StaticOrder, false, true>(c.lds, g, so, E, c.tid); }
        GBAR();
        { PCTX; pg8::Gemm g{(const bf16_t*)(p.ws + WS_XN8), (const bf16_t*)(p.ws + WS_W8 + (size_t)l * 22 * MiB), S, 2 * DFF, DM / 2}; pg8::StaticOrder so; so.init(S, 2 * DFF, gridDim.x, c.bx);
          EpiSwiGLU E{p.ws + WS_ACT, (const LAS float*)(c.lds + RSTD_OFF), (const LAS float*)(c.lds + CSC_OFF)};
          pg8::gemm_phase<EpiSwiGLU, pg8::StaticOrder, true, true, PrepRstd, 2>(c.lds, g, so, E, c.tid, PrepRstd{c, so, (const float*)(p.ws + WS_SSQ), (const float*)(p.ws + WS_ASC), (const float*)(p.ws + WS_WSC) + l * 2 * DFF});
        }
        GBAR();
        { PCTX; pg8::Gemm g{(const bf16_t*)(p.ws + WS_ACT), w_ptr(p, l, W_DN), S, DM, DFF / 2}; pg8::StaticOrder so; so.init(S, DM, gridDim.x, c.bx);
          EpiResidH E{(bf16_t*)(p.ws + WS_XN), (float*)(p.ws + WS_SSQ), 1.0f / (A8_SCALE * W8_SCALE), l + 1 < NL ? p.ws + WS_XN8 : nullptr, (float*)(p.ws + WS_ASC), (float*)(p.ws + WS_XSLAB), (unsigned*)(p.ws + WS_CTL) + CW_XCNT, 8u * (unsigned)(2 * l + 2)};
          pg8::gemm_phase<EpiResidH, pg8::StaticOrder, false, true, pg8::NoPre, 1>(c.lds, g, so, E, c.tid); }
        GBAR();
    }
    { PCTX; phase_final_norm(c, (const bf16_t*)(p.ws + WS_XN), (const float*)(p.ws + WS_SSQ), p.in[16], (float*)p.out); }
}

extern "C" void kernel_launch(void* const* d_in, const int* in_sizes, int n_in, void* d_out, int out_size, void* d_ws, size_t ws_size, hipStream_t stream) {
    static int grid = 0;
    if (grid == 0) {
        if (n_in != 17 || out_size != S * DM || ws_size < WS_END) { fprintf(stderr, "kernel_launch: unexpected shapes (n_in %d, out %d, ws %zu)\n", n_in, out_size, ws_size); grid = -1; return; }
        int dev = 0, cus = 0; (void)hipGetDevice(&dev); (void)hipDeviceGetAttribute(&cus, hipDeviceAttributeMultiprocessorCount, dev); if (cus <= 0) cus = 256;
#if MEGA
        if (hipFuncSetAttribute((const void*)k_mega, hipFuncAttributeMaxDynamicSharedMemorySize, LDS_BYTES) != hipSuccess) { fprintf(stderr, "kernel_launch: hipFuncSetAttribute failed\n"); grid = -1; return; }
        int per_cu = 0;
        if (hipOccupancyMaxActiveBlocksPerMultiprocessor(&per_cu, (const void*)k_mega, NTHREADS, LDS_BYTES) != hipSuccess || per_cu < 1) { fprintf(stderr, "kernel_launch: occupancy query says %d\n", per_cu); per_cu = 1; }
        (void)hipGetLastError();
        if (cus < 256) fprintf(stderr, "kernel_launch: this kernel's static unit schedules need 256 resident workgroups; the device reports %d CUs\n", cus);
        grid = 256;
#endif
    }
    if (grid < 0) return;
    Params p{};
    for (int i = 0; i < 17; ++i) p.in[i] = (const float*)d_in[i];
    p.out = (float*)d_out; p.ws = (unsigned char*)d_ws;
    const dim3 G(grid), B(NTHREADS);
#if MEGA
    (void)hipMemsetAsync((unsigned char*)d_ws + WS_CTL, 0, CTL_ZERO_BYTES, stream);
    hipLaunchKernelGGL(k_mega, G, B, LDS_BYTES, stream, p);
#endif
}
```

```cpp
#include <hip/hip_runtime.h>
#include <cstdio>
#include <cstdint>
namespace pg8 {
#define PG8_LAS __attribute__((address_space(3)))
typedef unsigned short bf16_t;
typedef _Float16 bf16x8 __attribute__((ext_vector_type(8)));
typedef float f32x4 __attribute__((ext_vector_type(4)));
typedef unsigned u32x4 __attribute__((ext_vector_type(4)));
constexpr int BM = 256, BK = 64, HALF = 128, HTB = HALF * BK * 2  , STAGE_BYTES = 8 * HTB, NXCD = 8, WGM = 8;

__host__ __device__ __forceinline__ int lds_byte(int r, int c) { const int st = (r >> 4) * 2 + (c >> 5), rr = r & 15, cc = c & 31, ob = rr * 64 + cc * 2; return st * 1024 + (ob ^ (((ob >> 9) & 1) << 5)); }
__host__ __device__ __forceinline__ void stage_rc(int b, int& R, int& C) { const int st = b / 1024, sb = b % 1024, swz = sb ^ (((sb >> 9) & 1) << 5); R = (st >> 1) * 16 + swz / 64; C = (st & 1) * 32 + (swz % 64) / 2; }
__host__ __device__ __forceinline__ int perm32(int rho) { const int n = rho >> 4, i = rho & 15; return 8 * (i >> 2) + 4 * n + (i & 3); }

struct Unit { int pm, pn, ord; };
struct Gemm { const bf16_t* A; const bf16_t* Bt; int M, N, K; };

struct StaticOrder {
    int nM, nN, nwg, G, c;
    __host__ __device__ void init(int M, int N, int G_, int c_) { nM = M / BM; nN = N / BM; nwg = nM * nN; G = G_; c = c_; }
    __host__ __device__ bool next(int i, Unit& u) const {
        const long L = (long)i * G + c; if (L >= nwg) return false;
        int wgid = (int)L; { const int q = nwg / NXCD, r = nwg % NXCD, xcd = wgid % NXCD, off = wgid / NXCD; wgid = (xcd < r ? xcd * (q + 1) : r * (q + 1) + (xcd - r) * q) + off; }
        const int nig = WGM * nN, gid = wgid / nig, fm = gid * WGM, gsz = (nM - fm) < WGM ? (nM - fm) : WGM;
        u.pm = fm + ((wgid % nig) % gsz); u.pn = (wgid % nig) / gsz; u.ord = i; return true;
    }
    __device__ __forceinline__ void a_ready(const Unit&) const {}
    __device__ __forceinline__ void done(const Unit&) const {}
};
__device__ __forceinline__ unsigned cvt_pk_bf16(float lo, float hi) { unsigned r; asm volatile("v_cvt_pk_bf16_f32 %0, %1, %2" : "=v"(r) : "v"(lo), "v"(hi)); return r; }
typedef float f32x2 __attribute__((ext_vector_type(2)));
struct NoPre { __device__ __forceinline__ void operator()() const {} };
typedef int i32x8 __attribute__((ext_vector_type(8)));
typedef int i32x4 __attribute__((ext_vector_type(4)));
template <class Epi, class Sched, bool ALIGN_EPI = false, bool SP2 = false, class Pre = NoPre, int F8 = 0>
__device__ __forceinline__ void gemm_phase(PG8_LAS unsigned char* lds, const Gemm g, const Sched& S, const Epi& E, int tid_in, const Pre& pre = Pre()) {
    int tid_ = tid_in; asm volatile("" : "+v"(tid_));
    const int tid = tid_, wid = __builtin_amdgcn_readfirstlane(tid >> 6), lane = tid & 63, wr = wid >> 2, wc = wid & 3, fr = lane & 15, fq = lane >> 4;
    const int K = g.K, nt = K / BK;
    unsigned voffA[2], voffB[2];
#pragma unroll
    for (int i = 0; i < 2; ++i) { int R, C; stage_rc(tid * 16 + i * 8192, R, C); const int Rb = Epi::PERM ? ((R & ~31) + perm32(R & 31)) : R;
        voffA[i] = (unsigned)(R * K + C) * 2u; voffB[i] = (unsigned)(Rb * K + C) * 2u; }
    const size_t kstep = (size_t)(BK * 2);
    const size_t hstep = (size_t)HALF * K * 2;
    const size_t tstep = 2 * hstep;
    const unsigned ldsw = (unsigned)wid * 1024u;
    const int aoff = lds_byte(wr * 64 + fr, fq * 8), boff = lds_byte(wc * 32 + fr, fq * 8);
#define PG8_SA(b, h) (((b) * 2 + (h)) * HTB)
#define PG8_SB(b, h) ((4 + (b) * 2 + (h)) * HTB)
#define PG8_STAGE(bufoff, gbase, voff) do { _Pragma("unroll") for (int _i = 0; _i < 2; ++_i) \
        __builtin_amdgcn_global_load_lds((const unsigned*)((const char*)(gbase) + (voff)[_i]), (PG8_LAS unsigned*)(lds + (bufoff) + ldsw + _i * 8192), 16, 0, 0); } while (0)
#define PG8_LDA(dst, b, h) do { _Pragma("unroll") for (int m = 0; m < 4; ++m) _Pragma("unroll") for (int k = 0; k < 2; ++k) dst[m][k] = *(const PG8_LAS bf16x8*)(lds + PG8_SA(b, h) + aoff + m * 2048 + k * 1024); } while (0)
#define PG8_LDB(dst, b, h) do { _Pragma("unroll") for (int n = 0; n < 2; ++n) _Pragma("unroll") for (int k = 0; k < 2; ++k) dst[n][k] = *(const PG8_LAS bf16x8*)(lds + PG8_SB(b, h) + boff + n * 2048 + k * 1024); } while (0)
#define PG8_F8FRAG(X) __builtin_shufflevector(__builtin_bit_cast(i32x4, (X)[0]), __builtin_bit_cast(i32x4, (X)[1]), 0, 1, 2, 3, 4, 5, 6, 7)
#define PG8_MMA(ai, bj, At, Bt) do { __builtin_amdgcn_s_setprio(1); \
        if constexpr (F8 == 2) { _Pragma("unroll") for (int m = 0; m < 4; ++m) _Pragma("unroll") for (int n = 0; n < 2; ++n) _Pragma("unroll") for (int k = 0; k < 2; ++k) \
            acc[ai][bj][m][n] = __builtin_bit_cast(f32x4, __builtin_amdgcn_mfma_i32_16x16x64_i8(__builtin_bit_cast(i32x4, Bt[n][k]), __builtin_bit_cast(i32x4, At[m][k]), __builtin_bit_cast(i32x4, acc[ai][bj][m][n]), 0, 0, 0)); } \
        else if constexpr (F8 == 1) { _Pragma("unroll") for (int m = 0; m < 4; ++m) _Pragma("unroll") for (int n = 0; n < 2; ++n) \
            { const i32x8 a8_ = PG8_F8FRAG(Bt[n]), b8_ = PG8_F8FRAG(At[m]); asm volatile("v_mfma_f32_16x16x128_f8f6f4 %0, %1, %2, %0" : "+v"(acc[ai][bj][m][n]) : "v"(a8_), "v"(b8_)); } } \
        else { _Pragma("unroll") for (int m = 0; m < 4; ++m) _Pragma("unroll") for (int n = 0; n < 2; ++n) _Pragma("unroll") for (int k = 0; k < 2; ++k) \
            acc[ai][bj][m][n] = __builtin_amdgcn_mfma_f32_16x16x32_f16(Bt[n][k], At[m][k], acc[ai][bj][m][n], 0, 0, 0); } \
        __builtin_amdgcn_s_setprio(0); } while (0)
#define PG8_WAIT_V(n) asm volatile("s_waitcnt vmcnt(" #n ")" ::: "memory")
#define PG8_WAIT_L(n) asm volatile("s_waitcnt lgkmcnt(" #n ")" ::: "memory")
#define PG8_BAR __builtin_amdgcn_s_barrier()
#define PG8_SCHED __builtin_amdgcn_sched_barrier(0)
    Unit cur, nxt; int ui = 0;
    if (!S.next(0, cur)) return;
    f32x4 acc[2][2][4][2];
#pragma unroll
    for (int a = 0; a < 2; ++a)
#pragma unroll
        for (int b = 0; b < 2; ++b)
#pragma unroll
            for (int m = 0; m < 4; ++m)
#pragma unroll
                for (int n = 0; n < 2; ++n) acc[a][b][m][n] = (f32x4){0.f, 0.f, 0.f, 0.f};
    bf16x8 At[4][2], B0[2][2], B1[2][2];
    const char* cA = (const char*)g.A + (size_t)cur.pm * tstep; const char* cB = (const char*)g.Bt + (size_t)cur.pn * tstep;
    S.a_ready(cur);
    if constexpr (SP2) {
        PG8_STAGE(PG8_SB(0, 0), cB, voffB); PG8_STAGE(PG8_SB(0, 1), cB + hstep, voffB); PG8_STAGE(PG8_SA(0, 0), cA, voffA); PG8_STAGE(PG8_SA(0, 1), cA + hstep, voffA);
        pre();
        if (wr == 1) PG8_BAR;
        PG8_WAIT_V(2); PG8_BAR;
        PG8_STAGE(PG8_SB(1, 0), cB + kstep, voffB); PG8_STAGE(PG8_SA(1, 0), cA + kstep, voffA); PG8_STAGE(PG8_SB(1, 1), cB + hstep + kstep, voffB);
        PG8_WAIT_V(6); PG8_BAR;
    } else {
        PG8_STAGE(PG8_SB(0, 0), cB, voffB); PG8_STAGE(PG8_SA(0, 0), cA, voffA); PG8_STAGE(PG8_SB(0, 1), cB + hstep, voffB); PG8_STAGE(PG8_SA(0, 1), cA + hstep, voffA);
        if (wr == 1) PG8_BAR;
        PG8_WAIT_V(4); PG8_BAR;
        PG8_STAGE(PG8_SB(1, 0), cB + kstep, voffB); PG8_STAGE(PG8_SA(1, 0), cA + kstep, voffA); PG8_STAGE(PG8_SB(1, 1), cB + hstep + kstep, voffB);
        PG8_WAIT_V(6); PG8_BAR;
    }
    for (;;) {
        const bool has_next = S.next(ui + 1, nxt);
        const char* nA = has_next ? (const char*)g.A + (size_t)nxt.pm * tstep : cA; const char* nB = has_next ? (const char*)g.Bt + (size_t)nxt.pn * tstep : cB;
        for (int t = 0; t < nt; t += 2) {
            const bool last = (t == nt - 2);
            const char* a1 = cA + (size_t)(t + 1) * kstep;
            const char* a2 = last ? nA : cA + (size_t)(t + 2) * kstep; const char* b2 = last ? nB : cB + (size_t)(t + 2) * kstep;
            const char* a3 = a2 + kstep; const char* b3 = b2 + kstep;
            if (last && has_next) S.a_ready(nxt);
            if constexpr (SP2) {
            PG8_LDB(B0, 0, 0); PG8_LDB(B1, 0, 1); PG8_SCHED; PG8_LDA(At, 0, 0); PG8_STAGE(PG8_SA(1, 1), a1 + hstep, voffA);
            PG8_WAIT_V(8); PG8_WAIT_L(0); PG8_BAR; PG8_MMA(0, 0, At, B0); PG8_MMA(0, 1, At, B1); PG8_BAR; PG8_SCHED;
            PG8_LDA(At, 0, 1); PG8_STAGE(PG8_SB(0, 0), b2, voffB); PG8_STAGE(PG8_SB(0, 1), b2 + hstep, voffB); PG8_STAGE(PG8_SA(0, 0), a2, voffA);
            PG8_WAIT_V(8); PG8_WAIT_L(0); PG8_BAR; PG8_MMA(1, 0, At, B0); PG8_MMA(1, 1, At, B1); PG8_BAR; PG8_SCHED;
            PG8_LDB(B0, 1, 0); PG8_LDB(B1, 1, 1); PG8_SCHED; PG8_LDA(At, 1, 0); PG8_STAGE(PG8_SA(0, 1), a2 + hstep, voffA);
            PG8_WAIT_V(8); PG8_WAIT_L(0); PG8_BAR; PG8_MMA(0, 0, At, B0); PG8_MMA(0, 1, At, B1); PG8_BAR; PG8_SCHED;
            PG8_LDA(At, 1, 1); PG8_STAGE(PG8_SB(1, 0), b3, voffB); PG8_STAGE(PG8_SB(1, 1), b3 + hstep, voffB); PG8_STAGE(PG8_SA(1, 0), a3, voffA);
            PG8_WAIT_V(8); PG8_WAIT_L(0); PG8_BAR; PG8_MMA(1, 0, At, B0); PG8_MMA(1, 1, At, B1); PG8_BAR; PG8_SCHED;
            } else {
            PG8_LDB(B0, 0, 0); PG8_SCHED; PG8_LDA(At, 0, 0); PG8_STAGE(PG8_SA(1, 1), a1 + hstep, voffA);
            PG8_WAIT_L(8); PG8_BAR; PG8_WAIT_L(0); PG8_MMA(0, 0, At, B0); PG8_BAR; PG8_SCHED;
            PG8_LDB(B1, 0, 1); PG8_STAGE(PG8_SB(0, 0), b2, voffB);
            PG8_BAR; PG8_WAIT_L(0); PG8_MMA(0, 1, At, B1); PG8_BAR;
            PG8_LDA(At, 0, 1); PG8_STAGE(PG8_SA(0, 0), a2, voffA);
            PG8_BAR; PG8_WAIT_L(0); PG8_MMA(1, 0, At, B0); PG8_BAR; PG8_SCHED;
            PG8_STAGE(PG8_SB(0, 1), b2 + hstep, voffB);
            PG8_WAIT_V(6); PG8_BAR; PG8_MMA(1, 1, At, B1); PG8_BAR;
            PG8_LDB(B0, 1, 0); PG8_SCHED; PG8_LDA(At, 1, 0); PG8_STAGE(PG8_SA(0, 1), a2 + hstep, voffA);
            PG8_WAIT_L(8); PG8_BAR; PG8_WAIT_L(0); PG8_MMA(0, 0, At, B0); PG8_BAR; PG8_SCHED;
            PG8_LDB(B1, 1, 1); PG8_STAGE(PG8_SB(1, 0), b3, voffB);
            PG8_BAR; PG8_WAIT_L(0); PG8_MMA(0, 1, At, B1); PG8_BAR;
            PG8_LDA(At, 1, 1); PG8_STAGE(PG8_SA(1, 0), a3, voffA);
            PG8_BAR; PG8_WAIT_L(0); PG8_MMA(1, 0, At, B0); PG8_BAR; PG8_SCHED;
            PG8_STAGE(PG8_SB(1, 1), b3 + hstep, voffB);
            PG8_WAIT_V(6); PG8_BAR; PG8_MMA(1, 1, At, B1); PG8_BAR;
            }
        }
        if constexpr (F8) asm volatile("s_nop 15\n\ts_nop 15" ::: "memory");
        if constexpr (ALIGN_EPI) { if (wr == 0) PG8_BAR; }
        if constexpr (!Epi::AFTER_DRAIN) { E(acc, cur, wr, wc, fr, fq); S.done(cur); }
        if (!has_next) break;
#pragma unroll
        for (int a = 0; a < 2; ++a)
#pragma unroll
            for (int b = 0; b < 2; ++b)
#pragma unroll
                for (int m = 0; m < 4; ++m)
#pragma unroll
                    for (int n = 0; n < 2; ++n) acc[a][b][m][n] = (f32x4){0.f, 0.f, 0.f, 0.f};
        cur = nxt; cA = nA; cB = nB; ++ui;
        if constexpr (ALIGN_EPI) { if (wr == 1) PG8_BAR; }
    }
    PG8_WAIT_V(0);
    if constexpr (!ALIGN_EPI) { if (wr == 0) PG8_BAR; }
    PG8_BAR;
    if constexpr (Epi::AFTER_DRAIN) { E.fused(acc, cur, wr, wc, fr, fq, lds, wid, lane); S.done(cur); }
#undef PG8_SA
#undef PG8_SB
#undef PG8_STAGE
#undef PG8_LDA
#undef PG8_LDB
#undef PG8_MMA
#undef PG8_WAIT_V
#undef PG8_WAIT_L
#undef PG8_BAR
#undef PG8_SCHED
}
}
#define LAS __attribute__((address_space(3)))
#define XB_TMO      128
#define XB_XCNT(j)  (256  + 64 * (j))
#define XB_XSUB(j)  (1280 + 64 * (j))
#define XB_XGEN(j)  (2304 + 64 * (j))
#define XB_TOP      3328
#define XB_TOPGEN   3392
#define XCD_BAR_WORDS 3456
#define XB_SPIN_CAP (1u << 18)

__device__ __forceinline__ unsigned xb_ld(unsigned* p)              { return __hip_atomic_load(p, __ATOMIC_RELAXED, __HIP_MEMORY_SCOPE_AGENT); }
__device__ __forceinline__ unsigned xb_add(unsigned* p, unsigned v) { return __hip_atomic_fetch_add(p, v, __ATOMIC_RELAXED, __HIP_MEMORY_SCOPE_AGENT); }
__device__ __forceinline__ unsigned xb_xcc_id() { return (unsigned)__builtin_amdgcn_s_getreg((3 << 11) | 20) & 0xFu; }
#define XB_SPIN(cond, bar) do { unsigned _sp = 0; while (cond) { __builtin_amdgcn_s_sleep(1); \
    if ((++_sp & 255u) == 0u) { if (xb_ld(&(bar)[XB_TMO])) break; if (_sp > XB_SPIN_CAP) { atomicAdd(&(bar)[XB_TMO], 1u); break; } } } } while (0)

struct XcdBarrier {
    unsigned* bar; unsigned x;
    volatile LAS unsigned* st;
    bool leader;
};

__device__ __forceinline__ XcdBarrier xcd_barrier_post(unsigned* bar, volatile LAS unsigned* st, bool leader) {
    XcdBarrier b; b.bar = bar; b.x = xb_xcc_id(); b.st = st; b.leader = leader;
    if (leader) (void)xb_add(&bar[XB_XCNT(b.x)], 1u);
    return b;
}
__device__ __forceinline__ void xcd_barrier_complete(unsigned* bar, unsigned x, unsigned& nloc, unsigned& nx) {
    const unsigned G = gridDim.x * gridDim.y * gridDim.z;
    unsigned sum, cnt, mine, sp = 0u;
    for (;;) {
        sum = 0u; cnt = 0u; mine = 0u;
#pragma unroll
        for (unsigned j = 0; j < 16; ++j) { const unsigned c = xb_ld(&bar[XB_XCNT(j)]); sum += c; cnt += (c > 0u) ? 1u : 0u; mine = (j == x) ? c : mine; }
        if (sum == G) break;
        __builtin_amdgcn_s_sleep(1);
        if ((++sp & 255u) == 0u) { if (xb_ld(&bar[XB_TMO])) break; if (sp > XB_SPIN_CAP) { atomicAdd(&bar[XB_TMO], 1u); break; } }
    }
    nloc = mine > 0u ? mine : 1u; nx = cnt > 0u ? cnt : 1u;
}

__device__ __forceinline__ void xcd_barrier(const XcdBarrier& b) {
    asm volatile("s_waitcnt vmcnt(0)" ::: "memory");
    __syncthreads();
    if (b.leader) {
        unsigned* bar = b.bar;
        __builtin_amdgcn_s_waitcnt(0);
        unsigned nloc = b.st[0], nx = b.st[1];
        if (nloc == 0u) { xcd_barrier_complete(bar, b.x, nloc, nx); b.st[0] = nloc; b.st[1] = nx; }
        const unsigned old = xb_add(&bar[XB_XSUB(b.x)], 1u);
        const unsigned gen = old / nloc;
        if (old + 1u == (gen + 1u) * nloc) {
            __builtin_amdgcn_fence(__ATOMIC_RELEASE, "agent");
            asm volatile("s_waitcnt vmcnt(0)" ::: "memory");
            const unsigned og = xb_add(&bar[XB_TOP], 1u);
            const unsigned tg = og / nx;
            if (og + 1u == (tg + 1u) * nx) xb_add(&bar[XB_TOPGEN], 1u);
            else XB_SPIN(xb_ld(&bar[XB_TOPGEN]) == tg, bar);
            __builtin_amdgcn_fence(__ATOMIC_ACQUIRE, "agent");
            xb_add(&bar[XB_XGEN(b.x)], 1u);
            asm volatile("s_waitcnt vmcnt(0)" ::: "memory");
        } else {
            XB_SPIN(xb_ld(&bar[XB_XGEN(b.x)]) == gen, bar);
            __builtin_amdgcn_fence(__ATOMIC_ACQUIRE, "agent");
            asm volatile("s_waitcnt vmcnt(0)" ::: "memory");
        }
    }
    __syncthreads();
}

#ifndef LAS
#define LAS __attribute__((address_space(3)))
#endif
typedef unsigned short bf16_t;
typedef _Float16 bf16x8 __attribute__((ext_vector_type(8)));
typedef _Float16 bf16x4 __attribute__((ext_vector_type(4)));
typedef float f32x4 __attribute__((ext_vector_type(4)));
typedef float f32x2 __attribute__((ext_vector_type(2)));
typedef unsigned u32x4 __attribute__((ext_vector_type(4)));
typedef unsigned u32x2 __attribute__((ext_vector_type(2)));

constexpr int S = 8192, DM = 2048, NL = 4, HD = 128, DIN = 5656, DINP = 5888, DFF = 5632, NCMP = 511;
constexpr float EPS = 1e-6f;
constexpr float SCALE = 0.08838834764831845f;
constexpr int NWAVES = 8, NTHREADS = 512;
constexpr int LDS_BYTES = 147456;
constexpr int RING_BYTES = 131072, MISC_OFF = LDS_BYTES - 64;

constexpr size_t MiB = 1u << 20;
constexpr float W8_SCALE = 64.0f, A8_SCALE = 8.0f;
constexpr size_t WS_CTL = 0, CTL_ZERO_BYTES = 1 * MiB;
constexpr size_t WS_ROPE = 1 * MiB;
constexpr size_t WS_CBP = WS_ROPE + 1024 * 1024;
constexpr size_t WS_ROPEH = 5 * MiB + 512 * 1024;
constexpr size_t WS_CBF = 3 * MiB + 512 * 1024;
constexpr size_t WS_KC = 2 * MiB + 512 * 1024;
constexpr size_t WS_VC = WS_KC + 256 * 1024;
constexpr size_t WS_SEL = 3 * MiB;
constexpr size_t WS_GATES = 4 * MiB;
constexpr size_t WS_SSQ = 5 * MiB;
constexpr size_t WS_W = 8 * MiB;
constexpr size_t W_IN = 0, W_OUT = 23 * MiB, W_GU = 31 * MiB, W_DN = 75 * MiB, W_C1 = 97 * MiB, W_C2 = 101 * MiB, W_LAYER = 102 * MiB;
constexpr size_t WS_H = WS_W + NL * W_LAYER;
constexpr size_t WS_XN8 = WS_H;
constexpr size_t WS_XSLAB = WS_H + 32 * MiB;
constexpr size_t WS_XN = WS_H + 64 * MiB;
constexpr size_t WS_O = WS_XN + 32 * MiB;
constexpr size_t WS_OCMP = WS_O + 32 * MiB;
constexpr size_t WS_PROJ = WS_OCMP + 32 * MiB;
constexpr size_t WS_ACT = WS_PROJ;
constexpr size_t WS_PART = WS_PROJ + 88 * MiB;
constexpr size_t PART_SLOT = 131072 + 2048;
constexpr size_t WS_W8 = 688 * MiB;
constexpr size_t WS_WSC = WS_W8 + NL * 22 * MiB;
constexpr size_t WS_ASC = WS_WSC + 1 * MiB;
constexpr size_t WS_WI8 = WS_ASC + 1 * MiB;
constexpr size_t WS_WISC = WS_WI8 + NL * 12 * MiB;
constexpr size_t WS_END = WS_WISC + 1 * MiB;
static_assert(WS_PART + 128 * PART_SLOT <= WS_W8, "ws map");
constexpr size_t WS_CPART = 6 * MiB;
constexpr int CW_CFLAG = 32768;
constexpr int CW_XCNT = 49152;
constexpr int CW_NSAFLAG = 16384;
static_assert((size_t)DINP * DM * 2 == 23 * MiB && (size_t)2 * DFF * DM * 2 == 44 * MiB && (size_t)DM * DFF * 2 == 22 * MiB, "weight map");

struct Params { const float* in[17]; float* out; unsigned char* ws; };

struct Ctx {
    LAS unsigned char* lds;
    int tid, lane, wave, gw, ngw, bx;
};

__device__ __forceinline__ float bf2f(unsigned b) { return (float)__builtin_bit_cast(_Float16, (unsigned short)b); }
__device__ __forceinline__ unsigned f2bf(float f) { return (unsigned)__builtin_bit_cast(unsigned short, (_Float16)f); }
typedef _Float16 h2_t __attribute__((ext_vector_type(2)));
__device__ __forceinline__ unsigned pk2(float lo, float hi) { const h2_t v = {(_Float16)lo, (_Float16)hi}; return __builtin_bit_cast(unsigned, v); }
#define DPP_F(old_, src_, ctrl_, rmask_) __builtin_bit_cast(float, __builtin_amdgcn_update_dpp(__builtin_bit_cast(int, (old_)), __builtin_bit_cast(int, (src_)), (ctrl_), (rmask_), 0xf, false))
__device__ __forceinline__ float wave_sum(float v) {
    v += DPP_F(0.f, v, 0x111, 0xf); v += DPP_F(0.f, v, 0x112, 0xf); v += DPP_F(0.f, v, 0x114, 0xf); v += DPP_F(0.f, v, 0x118, 0xf);
    v += DPP_F(0.f, v, 0x142, 0xa); v += DPP_F(0.f, v, 0x143, 0xc);
    return __builtin_bit_cast(float, __builtin_amdgcn_readlane(__builtin_bit_cast(int, v), 63));
}
__device__ __forceinline__ float wave_max_u(float v) {
    v = fmaxf(v, DPP_F(0.f, v, 0x111, 0xf)); v = fmaxf(v, DPP_F(0.f, v, 0x112, 0xf)); v = fmaxf(v, DPP_F(0.f, v, 0x114, 0xf)); v = fmaxf(v, DPP_F(0.f, v, 0x118, 0xf));
    v = fmaxf(v, DPP_F(0.f, v, 0x142, 0xa)); v = fmaxf(v, DPP_F(0.f, v, 0x143, 0xc));
    return __builtin_bit_cast(float, __builtin_amdgcn_readlane(__builtin_bit_cast(int, v), 63));
}
__device__ __forceinline__ float rope_inv(int i) {
    switch (i) {
        case 0: return 1.0f;
        case 1: return 0.44036659598350525f;
        case 2: return 0.1939227432012558f;
        case 3: return 0.08539710193872452f;
        case 4: return 0.03760603070259094f;
        case 5: return 0.016560440883040428f;
        case 6: return 0.007292664609849453f;
        case 7: return 0.0032114461064338684f;
        case 8: return 0.0014142135623842478f;
        case 9: return 0.0006227724370546639f;
        case 10: return 0.00027424818836152554f;
        case 11: return 0.00012076973507646471f;
        case 12: return 5.3182957344688475e-05f;
        case 13: return 2.34199997066753e-05f;
        case 14: return 1.0313385246263351e-05f;
        default: return 4.541670477919979e-06f;
    }
}
__device__ __forceinline__ void sincos_d(float ang, float& c, float& s) {
    const double x = (double)ang;
    const double q = rint(x * 0.63661977236758134308);
    const double r = fma(-q, 1.57079632679489661923, x) - q * 6.123233995736766e-17;
    const double r2 = r * r;
    double cs = 1.0 / 479001600.0; cs = cs * r2 - 1.0 / 3628800.0; cs = cs * r2 + 1.0 / 40320.0; cs = cs * r2 - 1.0 / 720.0; cs = cs * r2 + 1.0 / 24.0; cs = cs * r2 - 0.5; cs = cs * r2 + 1.0;
    double sn = 1.0 / 6227020800.0; sn = sn * r2 - 1.0 / 39916800.0; sn = sn * r2 + 1.0 / 362880.0; sn = sn * r2 - 1.0 / 5040.0; sn = sn * r2 + 1.0 / 120.0; sn = sn * r2 - 1.0 / 6.0; sn = sn * r2 + 1.0; sn *= r;
    const int qi = ((int)(long long)q) & 3;
    double cc, ss;
    if (qi == 0) { cc = cs; ss = sn; } else if (qi == 1) { cc = -sn; ss = cs; } else if (qi == 2) { cc = -cs; ss = -sn; } else { cc = sn; ss = -cs; }
    c = (float)cc; s = (float)ss;
}
__device__ __forceinline__ float gelu_tanh(float x) {
    const float y = 0.7978845608028654f * (x + 0.044715f * x * x * x);
    const float e = __expf(2.0f * y);
    const float th = 1.0f - 2.0f / (e + 1.0f);
    return 0.5f * x * (1.0f + th);
}
__device__ __forceinline__ float partner32(float x, int hi) { auto rr = __builtin_amdgcn_permlane32_swap(__float_as_uint(x), __float_as_uint(x), false, false); return __uint_as_float(hi ? rr[0] : rr[1]); }
__device__ __forceinline__ float sigmoidf_(float x) { return __builtin_amdgcn_rcpf(1.0f + __builtin_amdgcn_exp2f(x * -1.4426950408889634f)); }

__device__ __forceinline__ bf16_t* w_ptr(const Params& p, int l, size_t off) { return (bf16_t*)(p.ws + WS_W + (size_t)l * W_LAYER + off); }

struct ConvItem { const float* W; const float* gain; bf16_t* WT; int N, k0, sc, nv, drow, dK, frag, f8; };
constexpr int I_IN = 32 * 184, I_OUT = 32 * 64, I_GU = 32 * 352, I_DN = 88 * 64, I_C1 = 1024, I_C2 = 32;
constexpr int I_LAYER = I_OUT + I_DN + I_C1 + I_C2;
__device__ __forceinline__ ConvItem conv_desc(const Params& p, int it) {
    const int l = it / I_LAYER; int r = it - l * I_LAYER; ConvItem d; d.frag = 0; d.f8 = 0;
    if (r < I_OUT) { const int kb = r / 64, nb = r % 64;
        d.W = p.in[11] + (size_t)l * DM * DM; d.N = DM; d.k0 = 64 * kb; d.sc = 32 * nb; d.nv = 32; d.WT = w_ptr(p, l, W_OUT); d.drow = 32 * nb; d.dK = DM; d.gain = nullptr; return d; }
    r -= I_OUT;
    if (r < I_DN) { const int kb = r / 64, nb = r % 64;
        d.W = p.in[15] + (size_t)l * DFF * DM; d.N = DM; d.k0 = 64 * kb; d.sc = 32 * nb; d.nv = 32; d.WT = w_ptr(p, l, W_DN); d.drow = 32 * nb; d.dK = DFF; d.gain = nullptr; d.f8 = 1; return d; }
    r -= I_DN;
    if (r < I_C1) { const int kv = r / 512, rr = r % 512, kb = rr / 8, nb = rr % 8;
        d.W = p.in[kv ? 8 : 6] + (size_t)l * 4096 * 256; d.N = 256; d.k0 = 64 * kb; d.sc = 32 * nb; d.nv = 32; d.WT = w_ptr(p, l, W_C1) + (size_t)kv * 256 * 4096; d.drow = 32 * nb; d.dK = 4096; d.gain = nullptr; d.frag = 1; return d; }
    r -= I_C1;
    { const int kv = r / 16, rr = r % 16, kb = rr / 4, nb = rr % 4;
        d.W = p.in[kv ? 9 : 7] + (size_t)l * 256 * 128; d.N = 128; d.k0 = 64 * kb; d.sc = 32 * nb; d.nv = 32; d.WT = w_ptr(p, l, W_C2) + (size_t)kv * 128 * 256; d.drow = 32 * nb; d.dK = 256; d.gain = nullptr; return d; }
}
#define CONV_LOAD(d, tv) do { const int c_ = lane & 31; const float* wp_ = (d).W + (size_t)((d).k0 + (lane >> 5)) * (d).N + (d).sc + (c_ < (d).nv ? c_ : 0); \
        _Pragma("unroll") for (int i = 0; i < 32; ++i) tv[i] = wp_[(size_t)(2 * i) * (d).N]; } while (0)
#define CONV_STORE(d, tv) do { const int c_ = lane & 31; const bool ok_ = c_ < (d).nv; _Pragma("unroll") for (int i = 0; i < 32; ++i) { const int kk = 2 * i + (lane >> 5); scr[kk * 33 + c_] = ok_ ? tv[i] : 0.f; } \
        asm volatile("s_waitcnt lgkmcnt(0)" ::: "memory"); \
        const int c8 = lane & 7; f32x4 ga = {1.f, 1.f, 1.f, 1.f}, gb = {1.f, 1.f, 1.f, 1.f}; \
        if ((d).gain) { ga = *(const f32x4*)((d).gain + (d).k0 + 8 * c8); gb = *(const f32x4*)((d).gain + (d).k0 + 8 * c8 + 4); } \
        _Pragma("unroll") for (int j = 0; j < 4; ++j) { const int n = (lane >> 3) + 8 * j; const LAS float* s = scr + (8 * c8) * 33 + n; \
            u32x4 o; o.x = pk2(s[0 * 33] * ga.x, s[1 * 33] * ga.y); o.y = pk2(s[2 * 33] * ga.z, s[3 * 33] * ga.w); o.z = pk2(s[4 * 33] * gb.x, s[5 * 33] * gb.y); o.w = pk2(s[6 * 33] * gb.z, s[7 * 33] * gb.w); \
            const int na_ = (d).drow + n, ka_ = (d).k0 + 8 * c8; \
            const size_t off_ = (d).frag ? (size_t)((((na_ >> 4) * 128 + (ka_ >> 5)) * 64 + (((ka_ >> 3) & 3) * 16 + (na_ & 15))) * 8) : (size_t)na_ * (d).dK + ka_; \
            if ((d).f8) { int w0_ = 0, w1_ = 0; \
                w0_ = __builtin_amdgcn_cvt_pk_fp8_f32(s[0 * 33] * ga.x * W8_SCALE, s[1 * 33] * ga.y * W8_SCALE, w0_, false); w0_ = __builtin_amdgcn_cvt_pk_fp8_f32(s[2 * 33] * ga.z * W8_SCALE, s[3 * 33] * ga.w * W8_SCALE, w0_, true); \
                w1_ = __builtin_amdgcn_cvt_pk_fp8_f32(s[4 * 33] * gb.x * W8_SCALE, s[5 * 33] * gb.y * W8_SCALE, w1_, false); w1_ = __builtin_amdgcn_cvt_pk_fp8_f32(s[6 * 33] * gb.z * W8_SCALE, s[7 * 33] * gb.w * W8_SCALE, w1_, true); \
                u32x2 o8_; o8_.x = (unsigned)w0_; o8_.y = (unsigned)w1_; *(u32x2*)((unsigned char*)(d).WT + off_) = o8_; } \
            else *(u32x4*)((d).WT + off_) = o; } \
        asm volatile("s_waitcnt lgkmcnt(0)" ::: "memory"); } while (0)

constexpr int STRIP_RS = 4100, N_STRIPS_L = 184 + 352;
static_assert(32 * STRIP_RS <= MISC_OFF, "LDS map");
struct StripDesc { const float* W; const float* gain; unsigned char* dst; float* dsc; int N, sc, nv, drow; };
__device__ __forceinline__ StripDesc strip_desc(const Params& p, int s) {
    const int l = s / N_STRIPS_L, r = s - l * N_STRIPS_L; StripDesc d;
    if (r < 184) { const int n0 = 32 * r; int sc, nv;
        if (n0 < 2560) { sc = n0; nv = 32; } else if (n0 < 5632) { sc = n0 + 24; nv = 32; } else if (n0 == 5632) { sc = 2560; nv = 24; } else { sc = 0; nv = 0; }
        d.W = p.in[3] + (size_t)l * DM * DIN; d.N = DIN; d.sc = sc; d.nv = nv; d.gain = p.in[2] + (size_t)l * DM;
        d.dst = p.ws + WS_WI8 + (size_t)l * 12 * MiB; d.dsc = (float*)(p.ws + WS_WISC) + l * DINP; d.drow = n0; }
    else { const int r0 = 32 * (r - 184), pn = r0 >> 8, w = r0 & 255;
        d.W = (w < 128 ? p.in[13] : p.in[14]) + (size_t)l * DM * DFF; d.N = DFF; d.sc = 128 * pn + (w & 127); d.nv = 32; d.gain = p.in[12] + (size_t)l * DM;
        d.dst = p.ws + WS_W8 + (size_t)l * 22 * MiB; d.dsc = (float*)(p.ws + WS_WSC) + l * 2 * DFF; d.drow = r0; }
    return d;
}
#define STRIP_LOAD(d, k0, tv) do { const int c_ = lane & 31; const float* wp_ = (d).W + (size_t)((k0) + (lane >> 5)) * (d).N + (d).sc + (c_ < (d).nv ? c_ : 0); \
        _Pragma("unroll") for (int i = 0; i < 32; ++i) tv[i] = wp_[(size_t)(2 * i) * (d).N]; } while (0)
#define STRIP_PUT(d, k0, tv) do { const int c_ = lane & 31, hi_ = lane >> 5; const bool ok_ = c_ < (d).nv; \
        _Pragma("unroll") for (int pp = 0; pp < 16; ++pp) { \
            auto sw_ = __builtin_amdgcn_permlane32_swap(__float_as_uint(tv[2 * pp]), __float_as_uint(tv[2 * pp + 1]), false, false); \
            const float v0_ = __uint_as_float(sw_[0]), v1_ = __uint_as_float(sw_[1]);         \
            const f32x4 g_ = *(const f32x4*)((d).gain + (k0) + 4 * pp); \
            const float g0_ = hi_ ? g_.z : g_.x, g1_ = hi_ ? g_.w : g_.y; \
            *(LAS unsigned*)(c.lds + c_ * STRIP_RS + ((k0) + 4 * pp + 2 * hi_) * 2) = ok_ ? pk2(v0_ * g0_, v1_ * g1_) : 0u; } } while (0)
__device__ __forceinline__ void conv_strips(const Params& p, const Ctx& c) {
    const int lane = c.lane, w = c.wave, total = NL * N_STRIPS_L, step = c.ngw / NWAVES;
    int s = c.bx; float ta[32], tb[32]; StripDesc d{}, d1{};
    if (s < total) { d = strip_desc(p, s); STRIP_LOAD(d, 256 * w, ta); }
    while (s < total) {
        STRIP_LOAD(d, 256 * w + 64, tb);  STRIP_PUT(d, 256 * w, ta);
        STRIP_LOAD(d, 256 * w + 128, ta); STRIP_PUT(d, 256 * w + 64, tb);
        STRIP_LOAD(d, 256 * w + 192, tb); STRIP_PUT(d, 256 * w + 128, ta);
        const int s1 = s + step;
        if (s1 < total) { d1 = strip_desc(p, s1); STRIP_LOAD(d1, 256 * w, ta); }
        STRIP_PUT(d, 256 * w + 192, tb);
        __syncthreads();
#pragma unroll 1
        for (int q = 0; q < 4; ++q) { const int n = w + 8 * q;
            bf16x8 v[4];
#pragma unroll
            for (int j = 0; j < 4; ++j) { const LAS unsigned* q_ = (const LAS unsigned*)(c.lds + n * STRIP_RS + (lane + 64 * j) * 16); u32x4 t_; t_.x = q_[0]; t_.y = q_[1]; t_.z = q_[2]; t_.w = q_[3]; v[j] = __builtin_bit_cast(bf16x8, t_); }
            float mx = 0.f;
#pragma unroll
            for (int j = 0; j < 4; ++j)
#pragma unroll
                for (int e = 0; e < 8; ++e) mx = fmaxf(mx, fabsf((float)v[j][e]));
            mx = wave_max_u(mx);
            const float inv = mx > 0.f ? 127.0f / mx : 0.f;
#pragma unroll
            for (int j = 0; j < 4; ++j) { unsigned ww[2];
#pragma unroll
                for (int h = 0; h < 2; ++h) { unsigned u = 0u;
#pragma unroll
                    for (int e = 0; e < 4; ++e) { const int qv = (int)__builtin_rintf((float)v[j][4 * h + e] * inv); u |= ((unsigned)qv & 0xFFu) << (8 * e); }
                    ww[h] = u; }
                u32x2 o; o.x = ww[0]; o.y = ww[1]; ((u32x2*)(d.dst + (size_t)(d.drow + n) * DM))[lane + 64 * j] = o; }
            if (lane == 0) d.dsc[d.drow + n] = mx * (1.0f / 127.0f); }
        __syncthreads();
        d = d1; s = s1;
    }
}
__device__ __forceinline__ void phase_conv(const Params& p, const Ctx& c) {
    LAS float* scr = (LAS float*)(c.lds + c.wave * 8704);
    const int lane = c.lane;
    { float* cbp = (float*)(p.ws + WS_CBP);
      for (int task = c.gw; task < NL * 2 * 4 * 64; task += c.ngw) { const int ic = task & 63, jg = (task >> 6) & 3, kv = (task >> 8) & 1, l = task >> 9;
          const float* w1 = p.in[kv ? 8 : 6] + (size_t)l * 4096 * 256 + (size_t)(64 * ic) * 256 + 64 * jg + c.lane; const float* cp = p.in[5] + (size_t)l * 4096 + 64 * ic;
          float s = 0.f;
#pragma unroll
          for (int b = 0; b < 4; ++b) { float wv[16];
#pragma unroll
              for (int i = 0; i < 16; ++i) wv[i] = w1[(size_t)(16 * b + i) * 256];
#pragma unroll
              for (int i = 0; i < 16; ++i) s += cp[16 * b + i] * wv[i]; }
          cbp[((l * 2 + kv) * 64 + ic) * 256 + 64 * jg + c.lane] = s; } }
    { const int total = NL * I_LAYER; int it = c.gw;
      float ta[32], tb[32]; ConvItem da, db;
      if (it < total) { da = conv_desc(p, it); CONV_LOAD(da, ta); }
      while (it < total) {
          const int i1 = it + c.ngw;
          if (i1 < total) { db = conv_desc(p, i1); CONV_LOAD(db, tb); }
          CONV_STORE(da, ta);
          if (i1 >= total) break;
          const int i2 = i1 + c.ngw;
          if (i2 < total) { da = conv_desc(p, i2); CONV_LOAD(da, ta); }
          CONV_STORE(db, tb);
          it = i2;
      } }
    __syncthreads();
    conv_strips(p, c);
    { bf16_t* hb = (bf16_t*)(p.ws + WS_XN); float* ssq = (float*)(p.ws + WS_SSQ);
      for (int m = c.gw; m < S; m += c.ngw) {
          const f32x4* xr = (const f32x4*)(p.in[0] + (size_t)m * DM) + c.lane; float ss = 0.f; f32x4 xv[8];
#pragma unroll
          for (int j = 0; j < 8; ++j) xv[j] = xr[64 * j];
          float mx = 0.f;
#pragma unroll
          for (int j = 0; j < 8; ++j) { const f32x4 v = xv[j]; ss += (v.x * v.x + v.y * v.y) + (v.z * v.z + v.w * v.w);
              u32x2 w; w.x = pk2(v.x, v.y); w.y = pk2(v.z, v.w); ((u32x2*)(hb + (size_t)m * DM))[c.lane + 64 * j] = w;
              const bf16x4 h4 = __builtin_bit_cast(bf16x4, w);
#pragma unroll
              for (int e = 0; e < 4; ++e) { xv[j][e] = (float)h4[e]; mx = fmaxf(mx, fabsf(xv[j][e])); } }
          ss = wave_sum(ss); mx = wave_max_u(mx);
          if (c.lane < 8) ssq[(size_t)m * 8 + c.lane] = c.lane == 0 ? ss : 0.f;
          const float inv = mx > 0.f ? 127.0f / mx : 0.f;
#pragma unroll
          for (int j = 0; j < 8; ++j) { unsigned u = 0u;
#pragma unroll
              for (int e = 0; e < 4; ++e) { const int qv = (int)__builtin_rintf(xv[j][e] * inv); u |= ((unsigned)qv & 0xFFu) << (8 * e); }
              ((unsigned*)(p.ws + WS_XN8 + (size_t)m * DM))[c.lane + 64 * j] = u; }
          if (c.lane == 0) ((float*)(p.ws + WS_ASC))[m] = mx * (1.0f / 127.0f); } }
    { const int* pos = (const int*)p.in[1]; float* tab = (float*)(p.ws + WS_ROPE); bf16_t* tabh = (bf16_t*)(p.ws + WS_ROPEH);
      for (int idx = c.gw * 64 + c.lane; idx < S * 16; idx += c.ngw * 64) { const int t = idx >> 4, i = idx & 15;
          const float ang = (float)pos[t] * rope_inv(i); float cs, sn; sincos_d(ang, cs, sn); tab[t * 32 + i] = cs; tab[t * 32 + 16 + i] = sn; tabh[t * 32 + i] = (bf16_t)f2bf(cs); tabh[t * 32 + 16 + i] = (bf16_t)f2bf(sn); } }
}

__device__ __forceinline__ void cbias_reduce(const Params& p, const Ctx& c) {
    const float* cbp = (const float*)(p.ws + WS_CBP); float* cbf = (float*)(p.ws + WS_CBF);
    for (int o = c.gw; o < NL * 2 * 256; o += c.ngw) { const int col = o & 255, lk = o >> 8;
        const float v = wave_sum(cbp[(size_t)(lk * 64 + c.lane) * 256 + col]); if (c.lane == 0) cbf[o] = v; }
}

__device__ __forceinline__ void phase_final_norm(const Ctx& c, const bf16_t* hb, const float* ssq, const float* gain, float* dst) {
    f32x4 g[4][2];
#pragma unroll
    for (int j = 0; j < 4; ++j) { g[j][0] = ((const f32x4*)gain)[2 * (c.lane + 64 * j)]; g[j][1] = ((const f32x4*)gain)[2 * (c.lane + 64 * j) + 1]; }
    for (int m = c.gw; m < S; m += c.ngw) {
        const f32x4* q = (const f32x4*)(ssq + (size_t)m * 8); const f32x4 a = q[0], b = q[1];
        bf16x8 v[4];
#pragma unroll
        for (int j = 0; j < 4; ++j) v[j] = ((const bf16x8*)(hb + (size_t)m * DM))[c.lane + 64 * j];
        const float rstd = __builtin_amdgcn_rsqf((((a.x + a.y) + (a.z + a.w)) + ((b.x + b.y) + (b.z + b.w))) * (1.0f / DM) + EPS);
#pragma unroll
        for (int j = 0; j < 4; ++j) { f32x4 o0, o1;
#pragma unroll
            for (int e = 0; e < 4; ++e) { o0[e] = (float)v[j][e] * rstd * g[j][0][e]; o1[e] = (float)v[j][4 + e] * rstd * g[j][1][e]; }
            f32x4* d = (f32x4*)(dst + (size_t)m * DM) + 2 * (c.lane + 64 * j); d[0] = o0; d[1] = o1; }
    }
}

__device__ __forceinline__ void quant_rows(const Ctx& c, const bf16_t* src, unsigned char* dst, float* scale, int R, float fixed = 0.f) {
    for (int r = c.gw; r < R; r += c.ngw) {
        bf16x8 v[4];
#pragma unroll
        for (int j = 0; j < 4; ++j) v[j] = ((const bf16x8*)(src + (size_t)r * DM))[c.lane + 64 * j];
        float mx = 0.f;
#pragma unroll
        for (int j = 0; j < 4; ++j)
#pragma unroll
            for (int e = 0; e < 8; ++e) mx = fmaxf(mx, fabsf((float)v[j][e]));
        mx = wave_max_u(mx);
        if (fixed > 0.f) mx = fixed;
        const float inv = mx > 0.f ? 127.0f / mx : 0.f;
#pragma unroll
        for (int j = 0; j < 4; ++j) { unsigned w[2];
#pragma unroll
            for (int h = 0; h < 2; ++h) { unsigned u = 0u;
#pragma unroll
                for (int e = 0; e < 4; ++e) { int q = (int)__builtin_rintf((float)v[j][4 * h + e] * inv); q = q > 127 ? 127 : (q < -127 ? -127 : q); u |= ((unsigned)q & 0xFFu) << (8 * e); }
                w[h] = u; }
            u32x2 o; o.x = w[0]; o.y = w[1]; ((u32x2*)(dst + (size_t)r * DM))[c.lane + 64 * j] = o; }
        if (c.lane == 0) scale[r] = mx * (1.0f / 127.0f);
    }
}

constexpr int RSTD_OFF = RING_BYTES, RSTD_MAX_UNITS = 8;
constexpr int CSC_OFF = RSTD_OFF + RSTD_MAX_UNITS * 1024, CSC_MAX_UNITS = 6;
static_assert(CSC_OFF + CSC_MAX_UNITS * 1024 <= MISC_OFF, "LDS map");
__device__ __forceinline__ void prep_rstd(const Ctx& c, const pg8::StaticOrder& so, const float* ssq, const float* asc = nullptr, const float* wsc = nullptr) {
    LAS float* tab = (LAS float*)(c.lds + RSTD_OFF); LAS float* ctab = (LAS float*)(c.lds + CSC_OFF);
    const int half = c.tid >> 8, t = c.tid & 255;
    for (int i = half; i < RSTD_MAX_UNITS; i += 2) { pg8::Unit u; if (!so.next(i, u)) break;
        const f32x4* q = (const f32x4*)(ssq + (size_t)(u.pm * 256 + t) * 8); const f32x4 a = q[0], b = q[1];
        float rs = __builtin_amdgcn_rsqf((((a.x + a.y) + (a.z + a.w)) + ((b.x + b.y) + (b.z + b.w))) * (1.0f / DM) + EPS);
        if (asc) { rs *= asc[u.pm * 256 + t]; if (i < CSC_MAX_UNITS) ctab[i * 256 + t] = wsc[u.pn * 256 + t]; }
        tab[i * 256 + t] = rs; }
}
struct PrepRstd { const Ctx& c; const pg8::StaticOrder& so; const float* ssq; const float* asc; const float* wsc; __device__ __forceinline__ void operator()() const { prep_rstd(c, so, ssq, asc, wsc); } };
struct EpiProj {
    static constexpr bool PERM = true, AFTER_DRAIN = false;
    bf16_t* proj; float* gates; const bf16_t* ropeh; const float* bg; const LAS float* rtab; const LAS float* ctab;
    __device__ __forceinline__ void operator()(pg8::f32x4 (&acc)[2][2][4][2], const pg8::Unit& u, int wr, int wc, int fr, int fq) const {
        const int row0 = u.pm * 256 + wr * 64 + fr;
        {
            const LAS f32x4* cs = (const LAS f32x4*)(ctab + u.ord * 256 + wc * 32 + 8 * fq);
#pragma unroll
            for (int bj = 0; bj < 2; ++bj) { const f32x4 c0 = cs[32 * bj], c1 = cs[32 * bj + 1];
#pragma unroll
                for (int ai = 0; ai < 2; ++ai)
#pragma unroll
                    for (int m = 0; m < 4; ++m) { const pg8::i32x4 i0 = __builtin_bit_cast(pg8::i32x4, acc[ai][bj][m][0]), i1 = __builtin_bit_cast(pg8::i32x4, acc[ai][bj][m][1]);
#pragma unroll
                        for (int j = 0; j < 4; ++j) { acc[ai][bj][m][0][j] = (float)i0[j] * c0[j]; acc[ai][bj][m][1][j] = (float)i1[j] * c1[j]; } } }
        }
        float rstd[2][4];
#pragma unroll
        for (int ai = 0; ai < 2; ++ai)
#pragma unroll
            for (int m = 0; m < 4; ++m) rstd[ai][m] = rtab[u.ord * 256 + ai * 128 + wr * 64 + m * 16 + fr];
        const bool rp = (u.pn < 4 || u.pn == 6 || u.pn == 8) && wc == 0;
        if (rp) {
#pragma unroll
            for (int ai = 0; ai < 2; ++ai) {
                bf16x8 rc[4], rsn[4];
#pragma unroll
                for (int m = 0; m < 4; ++m) { const bf16_t* cs = ropeh + (size_t)(row0 + ai * 128 + m * 16) * 32 + (fq & 1) * 8; rc[m] = *(const bf16x8*)cs; rsn[m] = *(const bf16x8*)(cs + 16); }
#pragma unroll
                for (int m = 0; m < 4; ++m) {
                    f32x4 c0, c1, s0, s1;
#pragma unroll
                    for (int j = 0; j < 4; ++j) { c0[j] = (float)rc[m][j]; c1[j] = (float)rc[m][4 + j]; s0[j] = (float)rsn[m][j]; s1[j] = (float)rsn[m][4 + j]; }
                    if (fq < 2) { s0 = -s0; s1 = -s1; }
#pragma unroll
                    for (int bj = 0; bj < 2; ++bj) {
                        const f32x4 v0 = acc[ai][bj][m][0] * rstd[ai][m], v1 = acc[ai][bj][m][1] * rstd[ai][m]; f32x4 q0, q1;
#pragma unroll
                        for (int j = 0; j < 4; ++j) { q0[j] = partner32(v0[j], fq >> 1); q1[j] = partner32(v1[j], fq >> 1); }
                        acc[ai][bj][m][0] = v0 * c0 + q0 * s0; acc[ai][bj][m][1] = v1 * c1 + q1 * s1;
                    }
                }
            }
        }
        if (u.pn < 22) {
#pragma unroll
            for (int bj = 0; bj < 2; ++bj) {
                bf16_t* base = proj + (size_t)(2 * u.pn + bj) * S * HD + wc * 32 + 8 * fq;
#pragma unroll
                for (int ai = 0; ai < 2; ++ai)
#pragma unroll
                    for (int m = 0; m < 4; ++m) {
                        const float rs = rp ? 1.0f : rstd[ai][m];
                        const f32x4 v0 = acc[ai][bj][m][0] * rs, v1 = acc[ai][bj][m][1] * rs;
                        u32x4 w; w.x = pk2(v0[0], v0[1]); w.y = pk2(v0[2], v0[3]); w.z = pk2(v1[0], v1[1]); w.w = pk2(v1[2], v1[3]);
                        *(u32x4*)(base + (size_t)(row0 + ai * 128 + m * 16) * HD) = w;
                    }
            }
        } else {
            if (wc == 0 && fq < 3) {
                const f32x4 b0 = *(const f32x4*)(bg + 8 * fq), b1 = *(const f32x4*)(bg + 8 * fq + 4);
#pragma unroll
                for (int ai = 0; ai < 2; ++ai)
#pragma unroll
                    for (int m = 0; m < 4; ++m) {
                        f32x4 g0 = acc[ai][0][m][0] * rstd[ai][m] + b0, g1 = acc[ai][0][m][1] * rstd[ai][m] + b1;
#pragma unroll
                        for (int j = 0; j < 4; ++j) { g0[j] = sigmoidf_(g0[j]); g1[j] = sigmoidf_(g1[j]); }
                        f32x4* d = (f32x4*)(gates + (size_t)(row0 + ai * 128 + m * 16) * 24 + 8 * fq); d[0] = g0; d[1] = g1;
                    }
            }
        }
    }
};
struct EpiResid {
    static constexpr bool PERM = false, AFTER_DRAIN = false;
    const float* hin; float* hout;
    __device__ __forceinline__ void operator()(const pg8::f32x4 (&acc)[2][2][4][2], const pg8::Unit& u, int wr, int wc, int fr, int fq) const {
        const int row0 = u.pm * 256 + wr * 64 + fr, col0 = u.pn * 256 + wc * 32 + 4 * fq;
#pragma unroll
        for (int ai = 0; ai < 2; ++ai)
#pragma unroll
            for (int m = 0; m < 4; ++m) { const size_t off = (size_t)(row0 + ai * 128 + m * 16) * DM + col0;
#pragma unroll
                for (int bj = 0; bj < 2; ++bj)
#pragma unroll
                    for (int n = 0; n < 2; ++n) { const size_t o = off + bj * 128 + n * 16; *(f32x4*)(hout + o) = *(const f32x4*)(hin + o) + acc[ai][bj][m][n]; } }
    }
};
struct EpiResidH {
    static constexpr bool PERM = true, AFTER_DRAIN = true;
    bf16_t* hb; float* ssq; float mult;
    unsigned char* q8; float* qsc; float* xslab; unsigned* xcnt; unsigned target;
    __device__ __forceinline__ void fused(pg8::f32x4 (&acc)[2][2][4][2], const pg8::Unit& u, int wr, int wc, int fr, int fq, PG8_LAS unsigned char* lds, int wid, int lane) const {
        const int row0 = u.pm * 256 + wr * 64 + fr, col0 = u.pn * 256 + wc * 32 + 8 * fq;
        PG8_LAS float* P = (PG8_LAS float*)lds;
        PG8_LAS float* PM = (PG8_LAS float*)(lds + 4096);
        PG8_LAS float* INV = (PG8_LAS float*)(lds + 8192);
#pragma unroll
        for (int ai = 0; ai < 2; ++ai) {
            bf16x8 hv[4][2];
#pragma unroll
            for (int m = 0; m < 4; ++m)
#pragma unroll
                for (int bj = 0; bj < 2; ++bj) hv[m][bj] = *(const bf16x8*)(hb + (size_t)(row0 + ai * 128 + m * 16) * DM + col0 + bj * 128);
#pragma unroll
            for (int m = 0; m < 4; ++m) { const size_t off = (size_t)(row0 + ai * 128 + m * 16) * DM + col0; float ss = 0.f, am = 0.f;
#pragma unroll
                for (int bj = 0; bj < 2; ++bj) { f32x4 v0 = acc[ai][bj][m][0] * mult, v1 = acc[ai][bj][m][1] * mult;
#pragma unroll
                    for (int e = 0; e < 4; ++e) { v0[e] += (float)hv[m][bj][e]; v1[e] += (float)hv[m][bj][4 + e]; }
                    u32x4 w; w.x = pk2(v0.x, v0.y); w.y = pk2(v0.z, v0.w); w.z = pk2(v1.x, v1.y); w.w = pk2(v1.z, v1.w); *(u32x4*)(hb + off + bj * 128) = w;
                    acc[ai][bj][m][0] = v0; acc[ai][bj][m][1] = v1;
#pragma unroll
                    for (int e = 0; e < 4; ++e) am = fmaxf(am, fmaxf(fabsf(v0[e]), fabsf(v1[e])));
                    ss += ((v0.x * v0.x + v0.y * v0.y) + (v0.z * v0.z + v0.w * v0.w)) + ((v1.x * v1.x + v1.y * v1.y) + (v1.z * v1.z + v1.w * v1.w)); }
                ss += __builtin_bit_cast(float, __builtin_amdgcn_ds_swizzle(__builtin_bit_cast(int, ss), 0x401F)); ss += partner32(ss, fq >> 1);
                am = fmaxf(am, __builtin_bit_cast(float, __builtin_amdgcn_ds_swizzle(__builtin_bit_cast(int, am), 0x401F))); am = fmaxf(am, partner32(am, fq >> 1));
                if (fq == 0) { P[(ai * 128 + wr * 64 + m * 16 + fr) * 4 + wc] = ss; PM[(ai * 128 + wr * 64 + m * 16 + fr) * 4 + wc] = am; }
                asm volatile("" ::: "memory"); } }
        asm volatile("s_waitcnt lgkmcnt(0)" ::: "memory"); __builtin_amdgcn_s_barrier(); asm volatile("" ::: "memory");
        const int t = wid * 64 + lane;
        if (q8) {
            if (t < 256) { const PG8_LAS float* q = PM + t * 4; __hip_atomic_store(xslab + (size_t)(u.pm * 8 + u.pn) * 256 + t, fmaxf(fmaxf(q[0], q[1]), fmaxf(q[2], q[3])), __ATOMIC_RELAXED, __HIP_MEMORY_SCOPE_AGENT); }
            asm volatile("s_waitcnt vmcnt(0)" ::: "memory");
        }
        if (t < 256) { const PG8_LAS float* q = P + t * 4; ssq[(size_t)(u.pm * 256 + t) * 8 + u.pn] = (q[0] + q[1]) + (q[2] + q[3]); }
        if (q8) {
            __syncthreads();
            if (t == 0) { (void)__hip_atomic_fetch_add(xcnt + 64 * u.pm, 1u, __ATOMIC_RELAXED, __HIP_MEMORY_SCOPE_AGENT);
                unsigned spins = 0; while (__hip_atomic_load(xcnt + 64 * u.pm, __ATOMIC_RELAXED, __HIP_MEMORY_SCOPE_AGENT) < target && ++spins < (1u << 22)) __builtin_amdgcn_s_sleep(1); }
            __syncthreads();
            if (t < 256) { float pm8[8];
#pragma unroll
                for (int j = 0; j < 8; ++j) pm8[j] = __hip_atomic_load(xslab + (size_t)(u.pm * 8 + j) * 256 + t, __ATOMIC_RELAXED, __HIP_MEMORY_SCOPE_AGENT);
                const float mx = fmaxf(fmaxf(fmaxf(pm8[0], pm8[1]), fmaxf(pm8[2], pm8[3])), fmaxf(fmaxf(pm8[4], pm8[5]), fmaxf(pm8[6], pm8[7])));
                INV[t] = mx > 0.f ? 127.0f / mx : 0.f;
                if (u.pn == 0) qsc[u.pm * 256 + t] = mx * (1.0f / 127.0f); }
            asm volatile("s_waitcnt lgkmcnt(0)" ::: "memory"); __builtin_amdgcn_s_barrier(); asm volatile("" ::: "memory");
#pragma unroll
            for (int ai = 0; ai < 2; ++ai)
#pragma unroll
                for (int m = 0; m < 4; ++m) { const float inv = INV[ai * 128 + wr * 64 + m * 16 + fr]; const size_t off = (size_t)(row0 + ai * 128 + m * 16) * DM + col0;
#pragma unroll
                    for (int bj = 0; bj < 2; ++bj) { unsigned w[2];
#pragma unroll
                        for (int n = 0; n < 2; ++n) { const f32x4 v = acc[ai][bj][m][n]; unsigned uu = 0u;
#pragma unroll
                            for (int e = 0; e < 4; ++e) { int q = (int)__builtin_rintf(v[e] * inv); q = q > 127 ? 127 : (q < -127 ? -127 : q); uu |= ((unsigned)q & 0xFFu) << (8 * e); }
                            w[n] = uu; }
                        u32x2 o; o.x = w[0]; o.y = w[1]; *(u32x2*)(q8 + off + bj * 128) = o; } }
        }
    }
};

struct EpiSwiGLU {
    static constexpr bool PERM = true, AFTER_DRAIN = false;
    unsigned char* act; const LAS float* rtab; const LAS float* ctab;
    __device__ __forceinline__ void operator()(const pg8::f32x4 (&acc)[2][2][4][2], const pg8::Unit& u, int wr, int wc, int fr, int fq) const {
        const int row0 = u.pm * 256 + wr * 64 + fr, col0 = u.pn * 128 + wc * 32 + 8 * fq;
        const LAS f32x4* cs = (const LAS f32x4*)(ctab + u.ord * 256 + wc * 32 + 8 * fq);
        const f32x4 cg0 = cs[0], cg1 = cs[1], cu0 = cs[32], cu1 = cs[33];
#pragma unroll
        for (int ai = 0; ai < 2; ++ai)
#pragma unroll
            for (int m = 0; m < 4; ++m) {
                const float rs = rtab[u.ord * 256 + ai * 128 + wr * 64 + m * 16 + fr];
                f32x4 g0, g1, u0, u1;
                const pg8::i32x4 ig0 = __builtin_bit_cast(pg8::i32x4, acc[ai][0][m][0]), ig1 = __builtin_bit_cast(pg8::i32x4, acc[ai][0][m][1]);
                const pg8::i32x4 iu0 = __builtin_bit_cast(pg8::i32x4, acc[ai][1][m][0]), iu1 = __builtin_bit_cast(pg8::i32x4, acc[ai][1][m][1]);
#pragma unroll
                for (int j = 0; j < 4; ++j) {
                    g0[j] = (float)ig0[j] * (rs * cg0[j]); g1[j] = (float)ig1[j] * (rs * cg1[j]);
                    u0[j] = (float)iu0[j] * (rs * cu0[j]); u1[j] = (float)iu1[j] * (rs * cu1[j]); }
                f32x4 o0, o1;
#pragma unroll
                for (int j = 0; j < 4; ++j) { o0[j] = g0[j] * sigmoidf_(g0[j]) * u0[j]; o1[j] = g1[j] * sigmoidf_(g1[j]) * u1[j]; }
                int w0 = 0, w1 = 0;
                w0 = __builtin_amdgcn_cvt_pk_fp8_f32(o0[0] * A8_SCALE, o0[1] * A8_SCALE, w0, false); w0 = __builtin_amdgcn_cvt_pk_fp8_f32(o0[2] * A8_SCALE, o0[3] * A8_SCALE, w0, true);
                w1 = __builtin_amdgcn_cvt_pk_fp8_f32(o1[0] * A8_SCALE, o1[1] * A8_SCALE, w1, false); w1 = __builtin_amdgcn_cvt_pk_fp8_f32(o1[2] * A8_SCALE, o1[3] * A8_SCALE, w1, true);
                u32x2 w; w.x = (unsigned)w0; w.y = (unsigned)w1;
                *(u32x2*)(act + (size_t)(row0 + ai * 128 + m * 16) * DFF + col0) = w;
            }
    }
};

constexpr int CMPR_A_BYTES = 272 * 256 + 17 * 16, CMPR_HID = 70144;
__device__ __forceinline__ void phase_cmpr(const Params& p, const Ctx& c, int l) {
    const bf16_t* proj = (const bf16_t*)(p.ws + WS_PROJ); const float* rope = (const float*)(p.ws + WS_ROPE); const float* cbf = (const float*)(p.ws + WS_CBF);
    LAS bf16_t* hid = (LAS bf16_t*)(c.lds + CMPR_HID);
    const int lane = c.lane, w = c.wave, l15 = lane & 15, q4 = lane >> 4;
    const int u = c.bx >> 1, hh = c.bx & 1;
    const int kv = u >> 6, g = (u >> 5) & 1, rb = u & 31, n0 = 16 * rb;
    { bf16x8 sv[9];
      const bf16_t* src = proj + (size_t)((kv ? 10 : 8) + g) * S * HD;
#pragma unroll
      for (int i = 0; i < 9; ++i) { int ci = c.tid + NTHREADS * i; if (ci > 272 * 16 - 1) ci = 272 * 16 - 1; const int tk = ci >> 4, ch = ci & 15; int ta = 16 * n0 + tk; if (ta > S - 1) ta = S - 1;
          sv[i] = *(const bf16x8*)(src + (size_t)ta * HD + ch * 8); }
#pragma unroll
      for (int i = 0; i < 9; ++i) { const int ci = c.tid + NTHREADS * i; const int tk = ci >> 4, ch = ci & 15;
          if (ci < 272 * 16) *(LAS bf16x8*)(c.lds + tk * 256 + (tk >> 4) * 16 + ch * 16) = sv[i]; } }
    __syncthreads();
    const int ct = 8 * hh + w;
    const bf16_t* bf = w_ptr(p, l, W_C1) + (size_t)kv * 256 * 4096 + (size_t)ct * 128 * 512 + lane * 8;
    const LAS unsigned char* abase = c.lds + l15 * (4096 + 16) + q4 * 16;
    f32x4 acc = {0.f, 0.f, 0.f, 0.f};
    {
        bf16x8 B0[8], B1[8];
#define CMPR_LD(B_, ks_) do { _Pragma("unroll") for (int i = 0; i < 8; ++i) B_[i] = *(const bf16x8*)(bf + (size_t)((ks_) + i) * 512); } while (0)
#define CMPR_MM(B_, ks_) do { _Pragma("unroll") for (int i = 0; i < 8; ++i) { const int k_ = 32 * ((ks_) + i); \
            const bf16x8 a_ = *(const LAS bf16x8*)(abase + (k_ >> 7) * 256 + ((k_ >> 7) >= 16 ? 16 : 0) + (k_ & 127) * 2); \
            acc = __builtin_amdgcn_mfma_f32_16x16x32_f16(a_, B_[i], acc, 0, 0, 0); } } while (0)
        CMPR_LD(B0, 0);
        for (int ks = 0; ks < 128; ks += 16) {
            CMPR_LD(B1, ks + 8);
            CMPR_MM(B0, ks);
            if (ks + 16 < 128) CMPR_LD(B0, ks + 16);
            CMPR_MM(B1, ks + 8);
        }
#undef CMPR_LD
#undef CMPR_MM
    }
    { const int col = 16 * ct + l15; const float bs = cbf[(l * 2 + kv) * 256 + col];
#pragma unroll
      for (int j = 0; j < 4; ++j) hid[(q4 * 4 + j) * 136 + 16 * w + l15] = (bf16_t)f2bf(gelu_tanh(acc[j] + bs)); }
    __syncthreads();
    f32x4 o = {0.f, 0.f, 0.f, 0.f};
    const int ocol = (w < 2) ? ((l15 < 8) ? 8 * w + l15 : 16 + 8 * w + (l15 - 8)) : 16 * w + l15;
    const bf16_t* w2 = w_ptr(p, l, W_C2) + (size_t)kv * 128 * 256 + (size_t)ocol * 256 + 128 * hh + 8 * q4;
#pragma unroll
    for (int k0 = 0; k0 < 128; k0 += 32) {
        const bf16x8 a = *(const LAS bf16x8*)(hid + l15 * 136 + k0 + 8 * q4), b = *(const bf16x8*)(w2 + k0);
        o = __builtin_amdgcn_mfma_f32_16x16x32_f16(a, b, o, 0, 0, 0);
    }
    float* part = (float*)(p.ws + WS_CPART) + (size_t)u * 2048; unsigned* flag = (unsigned*)(p.ws + WS_CTL) + CW_CFLAG + 64 * u;
    if (hh == 1) {
#pragma unroll
        for (int j = 0; j < 4; ++j) __hip_atomic_store(part + (q4 * 4 + j) * 128 + 16 * w + l15, o[j], __ATOMIC_RELAXED, __HIP_MEMORY_SCOPE_AGENT);
        asm volatile("s_waitcnt vmcnt(0)" ::: "memory");
        __syncthreads();
        if (c.tid == 0) __hip_atomic_store(flag, (unsigned)(l + 1), __ATOMIC_RELAXED, __HIP_MEMORY_SCOPE_AGENT);
    } else {
        if (c.tid == 0) { unsigned spins = 0; while (__hip_atomic_load(flag, __ATOMIC_RELAXED, __HIP_MEMORY_SCOPE_AGENT) != (unsigned)(l + 1) && ++spins < (1u << 22)) __builtin_amdgcn_s_sleep(2); }
        __syncthreads();
        bf16_t* dst = (bf16_t*)(p.ws + (kv ? WS_VC : WS_KC)) + (size_t)g * 512 * HD;
        float pv[4], cs[4], sn[4];
#pragma unroll
        for (int j = 0; j < 4; ++j) { pv[j] = __hip_atomic_load(part + (q4 * 4 + j) * 128 + 16 * w + l15, __ATOMIC_RELAXED, __HIP_MEMORY_SCOPE_AGENT); cs[j] = 1.f; sn[j] = 0.f;
            if (kv == 0 && w < 2) { int ti = 16 * (n0 + q4 * 4 + j) + 31; if (ti > S - 1) ti = S - 1; const int fi = 8 * w + (l15 & 7); cs[j] = rope[ti * 32 + fi]; sn[j] = rope[ti * 32 + 16 + fi]; } }
#pragma unroll
        for (int j = 0; j < 4; ++j) {
            const int n = n0 + q4 * 4 + j; float v = o[j] + pv[j];
            if (kv == 0 && w < 2) { const float pr = DPP_F(0.f, v, 0x128, 0xf);     v = (l15 < 8) ? v * cs[j] - pr * sn[j] : v * cs[j] + pr * sn[j]; }
            if (n > 510) v = 0.f;
            dst[(size_t)n * HD + ocol] = (bf16_t)f2bf(v);
        }
    }
    __syncthreads();
}
typedef float f32x16 __attribute__((ext_vector_type(16)));
typedef _Float16 h4_t __attribute__((ext_vector_type(4)));
#define KSWZ(row, colB) ((row) * 256 + ((colB) ^ (((row) & 7) << 4)))
__device__ __forceinline__ int v_st(int k, int c) { const int kk = (k & ~0xC) | ((k & 4) << 1) | ((k & 8) >> 1); return ((kk >> 3) * 4 + (c >> 5)) * 512 + ((kk & 7) * 32 + (c & 31)) * 2; }
__device__ __forceinline__ int v_rd_base(int lane) { return ((lane & 3) << 3) | (((lane >> 2) & 3) << 6) | (((lane >> 4) & 1) << 5) | (((lane >> 5) & 1) << 8); }
constexpr int v_rd_off(int d0, int ks, int half) { return d0 * 512 + ks * 4096 + half * 2048; }
__device__ __forceinline__ int crow(int r, int hi) { return (r & 3) + 8 * (r >> 2) + 4 * hi; }
__device__ __forceinline__ void qkt(f32x16& p0, f32x16& p1, const LAS char* K_lds, int r32, int hi, const bf16x8* qr) {
#pragma unroll
    for (int r = 0; r < 16; ++r) { p0[r] = 0.f; p1[r] = 0.f; }
    int base = r32 * 256 + ((hi * 16) ^ ((r32 & 7) << 4));
    asm volatile("" : "+v"(base));
#pragma unroll
    for (int d0 = 0; d0 < 8; ++d0) { const LAS char* a = K_lds + (base ^ ((d0 & 3) << 5)) + (d0 >> 2) * 128;
        const bf16x8 b0 = *(const LAS bf16x8*)a, b1 = *(const LAS bf16x8*)(a + 32 * 256);
        p0 = __builtin_amdgcn_mfma_f32_32x32x16_f16(b0, qr[d0], p0, 0, 0, 0);
        p1 = __builtin_amdgcn_mfma_f32_32x32x16_f16(b1, qr[d0], p1, 0, 0, 0);
        if (d0 == 3) __builtin_amdgcn_sched_barrier(0); }
}
__device__ __forceinline__ void pack_p(const f32x16& p0, const f32x16& p1, bf16x8& pa0, bf16x8& pa1, bf16x8& pa2, bf16x8& pa3) {
#define PK4(P, B_, OUT) do { const unsigned a0 = pk2(P[B_ + 0], P[B_ + 1]), a1 = pk2(P[B_ + 2], P[B_ + 3]), b0 = pk2(P[B_ + 4], P[B_ + 5]), b1 = pk2(P[B_ + 6], P[B_ + 7]); \
        auto r0 = __builtin_amdgcn_permlane32_swap(a0, b0, false, false); auto r1 = __builtin_amdgcn_permlane32_swap(a1, b1, false, false); \
        u32x4 w = {r0[0], r1[0], r0[1], r1[1]}; OUT = __builtin_bit_cast(bf16x8, w); } while (0)
    PK4(p0, 0, pa0); PK4(p0, 8, pa1); PK4(p1, 0, pa2); PK4(p1, 8, pa3);
#undef PK4
}
__device__ __forceinline__ void pv_tile(f32x16* o, int vb0, bf16x8 pa0, bf16x8 pa1, bf16x8 pa2, bf16x8 pa3) {
#define TRRD(dst, off) asm volatile("ds_read_b64_tr_b16 %0, %1 offset:%2" : "=&v"(dst) : "v"(vb0), "i"(off) : "memory")
#define PV_D0(d0) do { h4_t l0, l1, l2, l3, h0, h1, h2, h3; constexpr int b_ = v_rd_off(d0, 0, 0); \
        TRRD(l0, b_); TRRD(h0, b_ + 2048); TRRD(l1, b_ + 4096); TRRD(h1, b_ + 6144); TRRD(l2, b_ + 8192); TRRD(h2, b_ + 10240); TRRD(l3, b_ + 12288); TRRD(h3, b_ + 14336); \
        asm volatile("s_waitcnt lgkmcnt(0)" ::: "memory"); __builtin_amdgcn_sched_barrier(0); \
        o[d0] = __builtin_amdgcn_mfma_f32_32x32x16_f16(pa0, (bf16x8){l0[0], l0[1], l0[2], l0[3], h0[0], h0[1], h0[2], h0[3]}, o[d0], 0, 0, 0); \
        o[d0] = __builtin_amdgcn_mfma_f32_32x32x16_f16(pa1, (bf16x8){l1[0], l1[1], l1[2], l1[3], h1[0], h1[1], h1[2], h1[3]}, o[d0], 0, 0, 0); \
        o[d0] = __builtin_amdgcn_mfma_f32_32x32x16_f16(pa2, (bf16x8){l2[0], l2[1], l2[2], l2[3], h2[0], h2[1], h2[2], h2[3]}, o[d0], 0, 0, 0); \
        o[d0] = __builtin_amdgcn_mfma_f32_32x32x16_f16(pa3, (bf16x8){l3[0], l3[1], l3[2], l3[3], h3[0], h3[1], h3[2], h3[3]}, o[d0], 0, 0, 0); } while (0)
    PV_D0(0); PV_D0(1); PV_D0(2); PV_D0(3);
#undef PV_D0
#undef TRRD
}

__device__ __forceinline__ void qkt_half(f32x16& ph, const LAS char* K_lds, int half, int r32, int hi, const bf16x8* qr) {
#pragma unroll
    for (int r = 0; r < 16; ++r) ph[r] = 0.f;
    int base = r32 * 256 + ((hi * 16) ^ ((r32 & 7) << 4)) + half * 8192;
    asm volatile("" : "+v"(base));
    __builtin_amdgcn_s_setprio(1);
#pragma unroll
    for (int d0 = 0; d0 < 8; ++d0) { const LAS char* a = K_lds + (base ^ ((d0 & 3) << 5)) + (d0 >> 2) * 128;
        const bf16x8 b0 = *(const LAS bf16x8*)a;
        ph = __builtin_amdgcn_mfma_f32_32x32x16_f16(b0, qr[d0], ph, 0, 0, 0); }
    __builtin_amdgcn_s_setprio(0);
}
__device__ __forceinline__ void pack_half(const f32x16& ph, bf16x8& pa0, bf16x8& pa1) {
#define PK4(P, B_, OUT) do { const unsigned a0 = pk2(P[B_ + 0], P[B_ + 1]), a1 = pk2(P[B_ + 2], P[B_ + 3]), b0 = pk2(P[B_ + 4], P[B_ + 5]), b1 = pk2(P[B_ + 6], P[B_ + 7]); \
        auto r0 = __builtin_amdgcn_permlane32_swap(a0, b0, false, false); auto r1 = __builtin_amdgcn_permlane32_swap(a1, b1, false, false); \
        u32x4 w = {r0[0], r1[0], r0[1], r1[1]}; OUT = __builtin_bit_cast(bf16x8, w); } while (0)
    PK4(ph, 0, pa0); PK4(ph, 8, pa1);
#undef PK4
}
__device__ __forceinline__ void pv_half(f32x16* o, int vbh, bf16x8 pa0, bf16x8 pa1) {
#define TRRD(dst, off) asm volatile("ds_read_b64_tr_b16 %0, %1 offset:%2" : "=&v"(dst) : "v"(vbh), "i"(off) : "memory")
    h4_t l0[4], h0[4], l1[4], h1[4];
#define PV_RD(d0) do { constexpr int b_ = v_rd_off(d0, 0, 0); TRRD(l0[d0], b_); TRRD(h0[d0], b_ + 2048); TRRD(l1[d0], b_ + 4096); TRRD(h1[d0], b_ + 6144); } while (0)
    PV_RD(0); PV_RD(1); PV_RD(2); PV_RD(3);
    asm volatile("s_waitcnt lgkmcnt(0)" ::: "memory"); __builtin_amdgcn_sched_barrier(0);
    __builtin_amdgcn_s_setprio(1);
#pragma unroll
    for (int d0 = 0; d0 < 4; ++d0) {
        o[d0] = __builtin_amdgcn_mfma_f32_32x32x16_f16(pa0, (bf16x8){l0[d0][0], l0[d0][1], l0[d0][2], l0[d0][3], h0[d0][0], h0[d0][1], h0[d0][2], h0[d0][3]}, o[d0], 0, 0, 0);
        o[d0] = __builtin_amdgcn_mfma_f32_32x32x16_f16(pa1, (bf16x8){l1[d0][0], l1[d0][1], l1[d0][2], l1[d0][3], h1[d0][0], h1[d0][1], h1[d0][2], h1[d0][3]}, o[d0], 0, 0, 0); }
    __builtin_amdgcn_s_setprio(0);
#undef PV_RD
#undef TRRD
}

__device__ __forceinline__ float wave_max_dpp(float v) {
    v = fmaxf(v, DPP_F(v, v, 0x111, 0xf)); v = fmaxf(v, DPP_F(v, v, 0x112, 0xf)); v = fmaxf(v, DPP_F(v, v, 0x114, 0xf)); v = fmaxf(v, DPP_F(v, v, 0x118, 0xf));
    v = fmaxf(v, DPP_F(v, v, 0x142, 0xa)); v = fmaxf(v, DPP_F(v, v, 0x143, 0xc));
    return __builtin_bit_cast(float, __builtin_amdgcn_readlane(__builtin_bit_cast(int, v), 63));
}
__device__ __forceinline__ float half_sum_dpp(float v, int hi) {
    v += DPP_F(0.f, v, 0x111, 0xf); v += DPP_F(0.f, v, 0x112, 0xf); v += DPP_F(0.f, v, 0x114, 0xf); v += DPP_F(0.f, v, 0x118, 0xf);
    v += DPP_F(0.f, v, 0x142, 0xa);
    const float lo = __builtin_bit_cast(float, __builtin_amdgcn_readlane(__builtin_bit_cast(int, v), 31)), hs = __builtin_bit_cast(float, __builtin_amdgcn_readlane(__builtin_bit_cast(int, v), 63));
    return hi ? hs : lo;
}

__device__ __forceinline__ float quad_swap1(float x) { return __int_as_float(__builtin_amdgcn_update_dpp(0, __float_as_int(x), 0xB1, 0xF, 0xF, true)); }
__device__ __forceinline__ void store_row4(bf16_t* orow_e  , float v0, float v1, float v2, float v3, int odd) {
    { const float y = quad_swap1(odd ? v0 : v1); *(unsigned*)(orow_e + (odd ? 32 : 0)) = odd ? pk2(y, v1) : pk2(v0, y); }
    { const float y = quad_swap1(odd ? v2 : v3); *(unsigned*)(orow_e + (odd ? 96 : 64)) = odd ? pk2(y, v3) : pk2(v2, y); }
}
__device__ __forceinline__ void store_head_rows(const f32x16* o, const float* ggrp_h, bf16_t* Obase  , int r32, int hi) {
    float gg[4];
#pragma unroll
    for (int d0 = 0; d0 < 4; ++d0) gg[d0] = ggrp_h[d0 * 32 + r32];
    const int odd = r32 & 1;
#pragma unroll
    for (int r = 0; r < 16; ++r) {
        const float ss = half_sum_dpp((o[0][r] * o[0][r] + o[1][r] * o[1][r]) + (o[2][r] * o[2][r] + o[3][r] * o[3][r]), hi);
        const float rs = __builtin_amdgcn_rsqf(ss * (1.0f / HD) + EPS);
        store_row4(Obase + (size_t)crow(r, hi) * DM + (r32 & ~1), o[0][r] * rs * gg[0], o[1][r] * rs * gg[1], o[2][r] * rs * gg[2], o[3][r] * rs * gg[3], odd);
    }
}

typedef unsigned long long u64x2 __attribute__((ext_vector_type(2)));

enum { M_CSTAT = 0, M_CIMP = 1, M_SLC = 2, M_CPV = 3, M_WSTAT = 4, M_WPV = 5, M_SB = 6 };
constexpr int ATT_WS = 0, ATT_FLAGS = 2048, NSA_SEL = 2112, NSA_WUNI = 3136, ATT_V0 = 4096, ATT_K0 = ATT_V0 + 3 * 16384, NSA_P = ATT_V0  ;
constexpr int ATT_END = ATT_K0 + 4 * 16384;
constexpr int TNONE = 128;
static_assert(ATT_END <= MISC_OFF, "LDS map");
__device__ __forceinline__ int next_bit(unsigned m0, unsigned m1, unsigned m2, unsigned m3, int from) {
    if (from < 32) { const unsigned w = m0 & (~0u << from); if (w) return __builtin_ctz(w); from = 32; }
    if (from < 64) { const unsigned w = m1 & (~0u << (from - 32)); if (w) return 32 + __builtin_ctz(w); from = 64; }
    if (from < 96) { const unsigned w = m2 & (~0u << (from - 64)); if (w) return 64 + __builtin_ctz(w); from = 96; }
    if (from < 128) { const unsigned w = m3 & (~0u << (from - 96)); if (w) return 96 + __builtin_ctz(w); }
    return 128;
}
__device__ __forceinline__ unsigned bit_of(unsigned m0, unsigned m1, unsigned m2, unsigned m3, int j) { const unsigned w = j < 32 ? m0 : j < 64 ? m1 : j < 96 ? m2 : m3; return (w >> (j & 31)) & 1u; }
__device__ __forceinline__ float quad_sum(float x) {
    x += __builtin_bit_cast(float, __builtin_amdgcn_update_dpp(0, __builtin_bit_cast(int, x), 0xB1, 0xf, 0xf, true));
    x += __builtin_bit_cast(float, __builtin_amdgcn_update_dpp(0, __builtin_bit_cast(int, x), 0x4E, 0xf, 0xf, true));
    return x;
}
struct PassArgs {
    const bf16_t* Kp; const bf16_t* Vp;
    unsigned tm0, tm1, tm2, tm3;
    unsigned wm0, wm1, wm2, wm3;
    unsigned sw0, sw1, sw2, sw3;
    int tok, nvr, b, nvmin;
    int jtop, tw0;
    float f;
};
template <int MODE>
__device__ __forceinline__ void attn_pass(const Ctx& c, const bf16x8 (&qr)[8], f32x16 (&o)[4], float& m, float& l, const PassArgs& a) {
    constexpr bool SB = (MODE == M_SB);
    constexpr bool HASV = (MODE == M_SLC || MODE == M_CPV || MODE == M_WPV || SB);
    constexpr bool CMP = (MODE == M_CSTAT || MODE == M_CIMP || MODE == M_CPV);
    constexpr bool WIN = (MODE == M_WSTAT || MODE == M_WPV);
    constexpr int HA = SB ? 1 : 0, HB = SB ? 0 : 1;
    constexpr float C2 = SCALE * 1.4426950408889634f;
    const int lane = c.lane, w = c.wave, r32 = lane & 31, hi = lane >> 5;
    LAS char* V_lds = (LAS char*)c.lds + ATT_V0; LAS char* K_lds = (LAS char*)c.lds + ATT_K0;
    LAS float* wsf = (LAS float*)(c.lds + ATT_WS) + w * 64;
    volatile LAS unsigned* flags = (volatile LAS unsigned*)(c.lds + ATT_FLAGS);
    unsigned kg0, kg1, vg0, vg1;
    { const int A0 = 16 * (64 * w + lane), A1 = A0 + 8192;
      { const int row = A0 >> 8, cB = (A0 & 255) ^ ((row & 7) << 4); kg0 = (unsigned)(row * HD * 2 + cB); }
      { const int row = A1 >> 8, cB = (A1 & 255) ^ ((row & 7) << 4); kg1 = (unsigned)(row * HD * 2 + cB); }
      { const int st = A0 >> 9, wi = A0 & 511, kk = (st >> 2) * 8 + (wi >> 6), cc = (st & 3) * 32 + ((wi & 63) >> 1), k = (kk & ~0xC) | ((kk & 4) << 1) | ((kk & 8) >> 1); vg0 = (unsigned)((k * HD + cc) * 2); }
      { const int st = A1 >> 9, wi = A1 & 511, kk = (st >> 2) * 8 + (wi >> 6), cc = (st & 3) * 32 + ((wi & 63) >> 1), k = (kk & ~0xC) | ((kk & 4) << 1) | ((kk & 8) >> 1); vg1 = (unsigned)((k * HD + cc) * 2); } }
    const int vb0 = (int)(unsigned)(size_t)V_lds + v_rd_base(lane);
    const float NEG = -__builtin_inff();
    bool done = false;
#define AP_NEXT(j_) (SB ? ((j_) > 0 ? (j_) - 1 : TNONE) : next_bit(a.tm0, a.tm1, a.tm2, a.tm3, (j_) + 1))
#define AP_ACT(j_) (SB ? (!done && 64 * (j_) <= a.tw0 + 30) : (bit_of(a.wm0, a.wm1, a.wm2, a.wm3, (j_)) != 0u))
#define AP_DMAK(j_, buf) do { const bf16_t* g_ = a.Kp + (size_t)(64 * (j_)) * HD; \
        __builtin_amdgcn_global_load_lds((const unsigned*)((const char*)g_ + kg0), (LAS unsigned*)(K_lds + (buf) * 16384 + w * 1024), 16, 0, 0); \
        __builtin_amdgcn_global_load_lds((const unsigned*)((const char*)g_ + kg1), (LAS unsigned*)(K_lds + (buf) * 16384 + 8192 + w * 1024), 16, 0, 0); } while (0)
#define AP_DMAV(j_, buf) do { if (HASV) { const bf16_t* g_ = a.Vp + (size_t)(64 * (j_)) * HD; \
        __builtin_amdgcn_global_load_lds((const unsigned*)((const char*)g_ + vg0), (LAS unsigned*)(V_lds + (buf) * 16384 + w * 1024), 16, 0, 0); \
        __builtin_amdgcn_global_load_lds((const unsigned*)((const char*)g_ + vg1), (LAS unsigned*)(V_lds + (buf) * 16384 + 8192 + w * 1024), 16, 0, 0); } } while (0)
#define AP_WAITN(full) do { if (full) { if (HASV) asm volatile("s_waitcnt vmcnt(4)" ::: "memory"); else asm volatile("s_waitcnt vmcnt(2)" ::: "memory"); } \
                            else asm volatile("s_waitcnt vmcnt(0)" ::: "memory"); } while (0)
    int j0 = SB ? a.jtop : next_bit(a.tm0, a.tm1, a.tm2, a.tm3, 0);
    if (j0 >= TNONE) return;
    int j1 = AP_NEXT(j0), j2 = j1 < TNONE ? AP_NEXT(j1) : TNONE, j3 = j2 < TNONE ? AP_NEXT(j2) : TNONE;
    int kc = 0, vc = 0;
    f32x16 pX, pY;
    bf16x8 kf[4];
    float carry = 0.f;
    __syncthreads();
    AP_DMAK(j0, 0); AP_DMAV(j0, 0);
    if (j1 < TNONE) AP_DMAK(j1, 1);
    bool full = j2 < TNONE;
    if (j2 < TNONE) AP_DMAK(j2, 2);
    if (j1 < TNONE) AP_DMAV(j1, 1);
    AP_WAITN(full); __syncthreads();
    if (AP_ACT(j0)) qkt_half(pX, K_lds, HA, r32, hi, qr);
#define AP_SB_EL(P, HF, r) do { const float y = P[r] * C2; \
                const float sp = fmaxf(y, 0.f) + __builtin_amdgcn_logf(1.0f + __builtin_amdgcn_exp2f(-fabsf(y))); \
                float Lr = -sp, br = y - sp; \
                if (needmask) { const bool ok = (dq - 32 * (HF) - (((r) & 3) + 8 * ((r) >> 2))) >= 0; Lr = ok ? Lr : 0.f; br = ok ? br : NEG; } \
                Lv[r] = Lr; P[r] = br; } while (0)
#define AP_KADDR(KT, QH, d_) ((KT) + (kb_ ^ (((d_) & 3) << 5)) + ((d_) >> 2) * 128)
#define AP_QMFMA(PN, c_, KT, QH) do { if ((c_) == 0) { f32x16 z_; _Pragma("unroll") for (int q_ = 0; q_ < 16; ++q_) z_[q_] = 0.f; PN = __builtin_amdgcn_mfma_f32_32x32x16_f16(kf[0], qr[0], z_, 0, 0, 0); } \
        else PN = __builtin_amdgcn_mfma_f32_32x32x16_f16(kf[(c_) & 3], qr[c_], PN, 0, 0, 0); \
        if ((c_) + 4 < 8) kf[(c_) & 3] = *(const LAS bf16x8*)AP_KADDR(KT, QH, (c_) + 4);        \
        __builtin_amdgcn_sched_barrier(0); } while (0)
#define AP_QPIN(KT, QH) int kb_ = r32 * 256 + ((hi * 16) ^ ((r32 & 7) << 4)) + (QH) * 8192; asm volatile("" : "+v"(kb_)); \
        _Pragma("unroll") for (int d_ = 0; d_ < 4; ++d_) kf[d_] = *(const LAS bf16x8*)AP_KADDR(KT, QH, d_); \
        __builtin_amdgcn_sched_barrier(0)
#define AP_PROCH(P, J, HF, VB, DOQ, PN, KT, QH) do { \
        if (SB) { \
            const int key0 = 64 * (J); const bool needmask = key0 + 63 >= a.tw0; const int dq = a.tok - 1 - key0 - 4 * hi; float run = carry; \
            float Lv[16]; \
            if (DOQ) { AP_QPIN(KT, QH); _Pragma("unroll") for (int c_ = 0; c_ < 8; ++c_) { AP_SB_EL(P, HF, 2 * c_); AP_SB_EL(P, HF, 2 * c_ + 1); AP_QMFMA(PN, c_, KT, QH); } } \
            else { _Pragma("unroll") for (int r = 0; r < 16; ++r) AP_SB_EL(P, HF, r); } \
            float g[4], pg[4]; \
            _Pragma("unroll") for (int i = 0; i < 4; ++i) { g[i] = (Lv[4 * i] + Lv[4 * i + 1]) + (Lv[4 * i + 2] + Lv[4 * i + 3]); pg[i] = partner32(g[i], hi); } \
            _Pragma("unroll") for (int i = 3; i >= 0; --i) { float aft = run + (hi ? 0.f : pg[i]); run += g[i] + pg[i]; \
                P[4 * i + 3] = __builtin_amdgcn_exp2f(P[4 * i + 3] + aft); aft += Lv[4 * i + 3]; \
                P[4 * i + 2] = __builtin_amdgcn_exp2f(P[4 * i + 2] + aft); aft += Lv[4 * i + 2]; \
                P[4 * i + 1] = __builtin_amdgcn_exp2f(P[4 * i + 1] + aft); aft += Lv[4 * i + 1]; \
                P[4 * i + 0] = __builtin_amdgcn_exp2f(P[4 * i + 0] + aft); } \
            carry = run; \
            bf16x8 pa0, pa1; pack_half(P, pa0, pa1); pv_half(o, vb0 + (VB) * 16384 + (HF) * 8192, pa0, pa1); \
            if ((HF) == HB) done = __all(carry <= -151.0f); \
        } else { \
            if (CMP) { if (64 * (J) + 32 * (HF) + 32 > a.nvmin) { const int dq = a.nvr - 1 - 64 * (J) - 32 * (HF) - 4 * hi;     \
                _Pragma("unroll") for (int r = 0; r < 16; ++r) { const int cr = (r & 3) + 8 * (r >> 2); if (dq - cr < 0) P[r] = NEG; } } } \
            if (WIN) { if ((J) == a.b || (J) == a.b - 8) { const int dq = a.tok - 64 * (J) - 32 * (HF) - 4 * hi; \
                _Pragma("unroll") for (int r = 0; r < 16; ++r) { const int cr = (r & 3) + 8 * (r >> 2); if ((unsigned)(dq - cr) >= 512u) P[r] = NEG; } } } \
            if (MODE == M_SLC) { if ((J) == a.b) { const int dq = a.tok - 64 * (J) - 32 * (HF) - 4 * hi; \
                _Pragma("unroll") for (int r = 0; r < 16; ++r) { const int cr = (r & 3) + 8 * (r >> 2); if (dq - cr < 0) P[r] = NEG; } } } \
            if (MODE == M_CSTAT || MODE == M_WSTAT || MODE == M_SLC) { \
                float pmax = P[0]; \
                _Pragma("unroll") for (int r = 1; r < 16; ++r) pmax = fmaxf(pmax, P[r]); \
                bool selr = true; \
                if (MODE == M_SLC) { selr = bit_of(a.sw0, a.sw1, a.sw2, a.sw3, (J)) != 0u; pmax = selr ? pmax : NEG; } \
                pmax = fmaxf(pmax, partner32(pmax, hi)); \
                  \
                const bool keep = (MODE == M_SLC) && __all((pmax - m) * C2 <= 8.0f); \
                const float mn = keep ? m : fmaxf(m, pmax); \
                const float alpha = keep ? 1.0f : __builtin_amdgcn_exp2f((m - mn) * C2); \
                m = mn; \
                const float mnL = selr ? -mn * C2 : NEG; \
                float ps = 0.f; \
                if (DOQ) { AP_QPIN(KT, QH); _Pragma("unroll") for (int c_ = 0; c_ < 8; ++c_) { \
                        P[2 * c_] = __builtin_amdgcn_exp2f(fmaf(P[2 * c_], C2, mnL)); P[2 * c_ + 1] = __builtin_amdgcn_exp2f(fmaf(P[2 * c_ + 1], C2, mnL)); ps += P[2 * c_] + P[2 * c_ + 1]; AP_QMFMA(PN, c_, KT, QH); } } \
                else { _Pragma("unroll") for (int r = 0; r < 16; ++r) { P[r] = __builtin_amdgcn_exp2f(fmaf(P[r], C2, mnL)); ps += P[r]; } } \
                ps += partner32(ps, hi); \
                l = l * alpha + ps; \
                if (MODE == M_SLC) { \
                    if (!keep && __any(alpha < 1.f)) { \
                        if (hi == 0) wsf[r32] = alpha; \
                        asm volatile("s_waitcnt lgkmcnt(0)" ::: "memory"); \
                        _Pragma("unroll") for (int r = 0; r < 16; ++r) { const float al = wsf[crow(r, hi)]; \
                            _Pragma("unroll") for (int d0 = 0; d0 < 4; ++d0) o[d0][r] *= al; } \
                    } \
                    bf16x8 pa0, pa1; pack_half(P, pa0, pa1); pv_half(o, vb0 + (VB) * 16384 + (HF) * 8192, pa0, pa1); \
                } \
            } else { \
                const float mL = -m * C2; \
                if (DOQ) { AP_QPIN(KT, QH); _Pragma("unroll") for (int c_ = 0; c_ < 8; ++c_) { \
                        P[2 * c_] = __builtin_amdgcn_exp2f(fmaf(P[2 * c_], C2, mL)) * a.f; P[2 * c_ + 1] = __builtin_amdgcn_exp2f(fmaf(P[2 * c_ + 1], C2, mL)) * a.f; AP_QMFMA(PN, c_, KT, QH); } } \
                else { _Pragma("unroll") for (int r = 0; r < 16; ++r) P[r] = __builtin_amdgcn_exp2f(fmaf(P[r], C2, mL)) * a.f; } \
                if (MODE == M_CIMP) { \
                      \
                    LAS float* PT = (LAS float*)(c.lds + NSA_P) + (8 * w + (r32 >> 2)) * 128; \
                    float s3v[4], av[4]; \
                    _Pragma("unroll") for (int i = 0; i < 4; ++i) { \
                        const float s0 = quad_sum(P[4 * i]), s1 = quad_sum(P[4 * i + 1]), s2 = quad_sum(P[4 * i + 2]); s3v[i] = quad_sum(P[4 * i + 3]); \
                        av[i] = 2.f * ((s0 + s1) + s2) + s3v[i]; } \
                    float ps3[4]; \
                    _Pragma("unroll") for (int i = 0; i < 4; ++i) ps3[i] = partner32(s3v[i], hi); \
                    _Pragma("unroll") for (int i = 0; i < 4; ++i) { \
                        const int Jb = 16 * (J) + 8 * (HF) + 2 * i + hi; \
                        const float prev = hi ? ps3[i] : (i == 0 ? carry : ps3[i > 0 ? i - 1 : 0]); \
                        if ((r32 & 3) == 0) PT[Jb] = av[i] + prev; } \
                    carry = ps3[3];      \
                } else { bf16x8 pa0, pa1; pack_half(P, pa0, pa1); pv_half(o, vb0 + (VB) * 16384 + (HF) * 8192, pa0, pa1); } \
            } \
        } } while (0)
    for (;;) {
        if (SB) { if (lane == 0) flags[w] = done ? 1u : 0u; }
        AP_WAITN(full); __syncthreads();
        if (SB) { unsigned all = 1u;
#pragma unroll
            for (int i = 0; i < NWAVES; ++i) all &= flags[i];
            if (all) break; }
        full = j3 < TNONE;
        if (j3 < TNONE) AP_DMAK(j3, (kc + 3) & 3);
        if (j2 < TNONE) AP_DMAV(j2, vc == 0 ? 2 : vc - 1);
        const bool act0 = AP_ACT(j0);
        const bool actq = (j1 < TNONE) && AP_ACT(j1);
        if (act0) AP_PROCH(pX, j0, HA, vc, true, pY, K_lds + kc * 16384, HB);
        if (actq) qkt_half(pX, K_lds + ((kc + 1) & 3) * 16384, HA, r32, hi, qr);
        if (act0) AP_PROCH(pY, j0, HB, vc, false, pX, K_lds, HA);
        if (j1 >= TNONE) break;
        j0 = j1; j1 = j2; j2 = j3; j3 = j3 < TNONE ? AP_NEXT(j3) : TNONE;
        kc = (kc + 1) & 3; vc = vc == 2 ? 0 : vc + 1;
    }
    asm volatile("s_waitcnt vmcnt(0)" ::: "memory");
#undef AP_PROCH
#undef AP_QMFMA
#undef AP_QPIN
#undef AP_KADDR
#undef AP_SB_EL
#undef AP_NEXT
#undef AP_ACT
#undef AP_DMAK
#undef AP_DMAV
#undef AP_WAITN
}

__device__ __forceinline__ void sb_unit(const Params& p, const Ctx& c, int l, int h, int qb) {
    const bf16_t* proj = (const bf16_t*)(p.ws + WS_PROJ);
    const bf16_t* Q = proj + (size_t)(20 + h) * S * HD;
    int lane_; asm volatile("v_mbcnt_lo_u32_b32 %0, -1, 0\n\tv_mbcnt_hi_u32_b32 %0, -1, %0" : "=v"(lane_));
    const int lane = lane_, w = c.wave, r32 = lane & 31, hi = lane >> 5;
    const int t0 = 256 * qb, tw0 = t0 + 32 * w, tq = tw0 + r32;
    bf16x8 qr[8];
#pragma unroll
    for (int d0 = 0; d0 < 8; ++d0) qr[d0] = *(const bf16x8*)(Q + (size_t)tq * HD + d0 * 16 + hi * 8);
    f32x16 o[4];
#pragma unroll
    for (int d0 = 0; d0 < 4; ++d0)
#pragma unroll
        for (int r = 0; r < 16; ++r) o[d0][r] = 0.f;
    PassArgs a{}; a.Kp = proj + (size_t)(28 + h) * S * HD; a.Vp = proj + (size_t)(36 + h) * S * HD; a.tok = tq; a.jtop = (t0 + 254) >> 6; a.tw0 = tw0;
    float m = 0.f, lsum = 0.f;
    attn_pass<M_SB>(c, qr, o, m, lsum, a);
    store_head_rows(o, p.in[10] + (size_t)l * DM + (8 + h) * HD, (bf16_t*)(p.ws + WS_O) + (size_t)tw0 * DM + (8 + h) * HD, r32, hi);
}

template <int role>
__device__ __forceinline__ void nsa_unit(const Params& p, const Ctx& c, int l, int g, int b) {
    const bf16_t* proj = (const bf16_t*)(p.ws + WS_PROJ);
    const bf16_t* kc = (const bf16_t*)(p.ws + WS_KC) + (size_t)g * 512 * HD; const bf16_t* vc = (const bf16_t*)(p.ws + WS_VC) + (size_t)g * 512 * HD;
    const float* gates = (const float*)(p.ws + WS_GATES);
    const int lane = c.lane, w = c.wave, r32 = lane & 31, hi = lane >> 5;
    const int t0 = 64 * b, tl = 8 * w + (r32 >> 2), tok = t0 + tl, H = 4 * g + (r32 & 3);
    bf16x8 qr[8];
#pragma unroll
    for (int d0 = 0; d0 < 8; ++d0) qr[d0] = *(const bf16x8*)(proj + (size_t)H * S * HD + (size_t)tok * HD + d0 * 16 + hi * 8);
    const float g0 = gates[(size_t)tok * 24 + H], g1 = gates[(size_t)tok * 24 + 8 + H], g2 = gates[(size_t)tok * 24 + 16 + H];
    f32x16 o[4];
    __syncthreads();
    { LAS f32x4* za = (LAS f32x4*)(c.lds + NSA_P);
      for (int i = c.tid; i < 32768 / 16; i += NTHREADS) za[i] = (f32x4){0.f, 0.f, 0.f, 0.f}; }
    PassArgs a{}; a.tok = tok; a.b = b;
    a.nvr = tok >= 31 ? (tok - 31) / 16 + 1 : 0; if (a.nvr > NCMP) a.nvr = NCMP;
    { const int tmin = t0 + 8 * w; a.nvmin = tmin >= 31 ? (tmin - 31) / 16 + 1 : 0; if (a.nvmin > NCMP) a.nvmin = NCMP; }
    int nvmax = (t0 + 63 - 31) / 16 + 1; if (nvmax > NCMP) nvmax = NCMP;
    const unsigned cm0 = (1u << ((nvmax + 63) >> 6)) - 1u;
    float mc = -1e30f, lc = 0.f;
    a.Kp = kc; a.Vp = vc; a.tm0 = cm0; a.wm0 = cm0;
    attn_pass<M_CSTAT>(c, qr, o, mc, lc, a);
    const float ilc = lc > 0.f ? 1.0f / lc : 0.f;
    a.f = ilc;
    attn_pass<M_CIMP>(c, qr, o, mc, lc, a);
    __syncthreads();
    { const LAS float* PTb = (const LAS float*)(c.lds + NSA_P);
      LAS unsigned* selw = (LAS unsigned*)(c.lds + NSA_SEL); LAS unsigned* wuni = (LAS unsigned*)(c.lds + NSA_WUNI);
      unsigned long long u0 = 0ull, u1 = 0ull;
      for (int tt = 0; tt < 8; ++tt) {
          const int tk = 8 * w + tt; const int j0 = lane, j1 = lane + 64;
          const float a0 = PTb[tk * 128 + j0], a1 = PTb[tk * 128 + j1];
          const bool f0 = (j0 == 0) || (j0 == b) || (j0 == b - 1), f1 = (j1 == b) || (j1 == b - 1);
          bool sel0 = f0 && j0 <= b, sel1 = f1 && j1 <= b;
          float c0 = (!f0 && j0 >= 1 && j0 <= b - 2) ? a0 : -1.f, c1 = (!f1 && j1 <= b - 2) ? a1 : -1.f;
          const int ncand = b - 2 > 0 ? b - 2 : 0, ksel = 16 - (b >= 2 ? 3 : b + 1);
          if (ncand <= ksel) { if (c0 >= 0.f) sel0 = true; if (c1 >= 0.f) sel1 = true; }
          else { for (int it = 0; it < ksel; ++it) {
                     const float mx = wave_max_dpp(fmaxf(c0, c1));
                     const unsigned long long b0 = __ballot(c0 == mx);
                     if (b0) { const int first = __ffsll((long long)b0) - 1; if (lane == first) { c0 = -1.f; sel0 = true; } }
                     else { const unsigned long long b1 = __ballot(c1 == mx); const int first = __ffsll((long long)b1) - 1; if (lane == first) { c1 = -1.f; sel1 = true; } } } }
          const unsigned long long m0 = __ballot(sel0), m1 = __ballot(sel1);
          u0 |= m0; u1 |= m1;
          if (lane == 0) { selw[tk * 4 + 0] = (unsigned)m0; selw[tk * 4 + 1] = (unsigned)(m0 >> 32); selw[tk * 4 + 2] = (unsigned)m1; selw[tk * 4 + 3] = (unsigned)(m1 >> 32); }
      }
      if (lane == 0) { wuni[w * 4 + 0] = (unsigned)u0; wuni[w * 4 + 1] = (unsigned)(u0 >> 32); wuni[w * 4 + 2] = (unsigned)u1; wuni[w * 4 + 3] = (unsigned)(u1 >> 32); }
      __syncthreads();
      unsigned gu0 = 0u, gu1 = 0u, gu2 = 0u, gu3 = 0u;
#pragma unroll
      for (int i = 0; i < NWAVES; ++i) { gu0 |= wuni[i * 4 + 0]; gu1 |= wuni[i * 4 + 1]; gu2 |= wuni[i * 4 + 2]; gu3 |= wuni[i * 4 + 3]; }
      a.tm0 = __builtin_amdgcn_readfirstlane(gu0); a.tm1 = __builtin_amdgcn_readfirstlane(gu1); a.tm2 = __builtin_amdgcn_readfirstlane(gu2); a.tm3 = __builtin_amdgcn_readfirstlane(gu3);
      a.wm0 = (unsigned)u0; a.wm1 = (unsigned)(u0 >> 32); a.wm2 = (unsigned)u1; a.wm3 = (unsigned)(u1 >> 32);
      a.sw0 = selw[tl * 4 + 0]; a.sw1 = selw[tl * 4 + 1]; a.sw2 = selw[tl * 4 + 2]; a.sw3 = selw[tl * 4 + 3];
      if (role != 0) {
          const int n = b - 63; const unsigned lo0 = n >= 32 ? ~0u : ((1u << n) - 1u), lo1 = n >= 64 ? ~0u : (n > 32 ? ((1u << (n - 32)) - 1u) : 0u);
          if (role == 2) { a.tm0 &= lo0; a.tm1 &= lo1; a.tm2 = 0u; a.tm3 = 0u; a.wm0 &= lo0; a.wm1 &= lo1; a.wm2 = 0u; a.wm3 = 0u; }
          else { a.tm0 &= ~lo0; a.tm1 &= ~lo1; a.wm0 &= ~lo0; a.wm1 &= ~lo1; } }
    }
#pragma unroll
    for (int d0 = 0; d0 < 4; ++d0)
#pragma unroll
        for (int r = 0; r < 16; ++r) o[d0][r] = 0.f;
    { float ms = -1e30f, ls = 0.f;
      a.Kp = proj + (size_t)(12 + g) * S * HD; a.Vp = proj + (size_t)(14 + g) * S * HD;
      attn_pass<M_SLC>(c, qr, o, ms, ls, a);
      LAS float* wsf = (LAS float*)(c.lds + ATT_WS) + w * 64;
      constexpr float C2 = SCALE * 1.4426950408889634f;
      if (role != 0) {
          int lane_; asm volatile("v_mbcnt_lo_u32_b32 %0, -1, 0\n\tv_mbcnt_hi_u32_b32 %0, -1, %0" : "=v"(lane_));
          const int lane = lane_, r32 = lane & 31, hi = lane >> 5;
          float* part = (float*)(p.ws + WS_PART + (size_t)(g * 64 + (b - 64)) * PART_SLOT); float* pml = part + 32768 + w * 64;
          unsigned* flag = (unsigned*)(p.ws + WS_CTL) + CW_NSAFLAG + 64 * (g * 64 + (b - 64));
          if (role == 2) {
#pragma unroll
              for (int r = 0; r < 16; ++r) { const f32x4 v_ = (f32x4){o[0][r], o[1][r], o[2][r], o[3][r]}; float* dp_ = part + (size_t)(w * 16 + r) * 256 + lane * 4;
                  asm volatile("global_store_dwordx4 %0, %1, off sc1\n\ts_nop 1" :: "v"(dp_), "v"(v_) : "memory"); }
              if (hi == 0) { __hip_atomic_store(pml + r32, ms, __ATOMIC_RELAXED, __HIP_MEMORY_SCOPE_AGENT); __hip_atomic_store(pml + 32 + r32, ls, __ATOMIC_RELAXED, __HIP_MEMORY_SCOPE_AGENT); }
              asm volatile("s_waitcnt vmcnt(0)" ::: "memory");
              __syncthreads();
              if (c.tid == 0) __hip_atomic_store(flag, (unsigned)(l + 1), __ATOMIC_RELAXED, __HIP_MEMORY_SCOPE_AGENT);
              return;
          }
          if (c.tid == 0) { unsigned spins = 0; while (__hip_atomic_load(flag, __ATOMIC_RELAXED, __HIP_MEMORY_SCOPE_AGENT) != (unsigned)(l + 1) && ++spins < (1u << 22)) __builtin_amdgcn_s_sleep(4); }
          __syncthreads();
          const float m1 = __hip_atomic_load(pml + r32, __ATOMIC_RELAXED, __HIP_MEMORY_SCOPE_AGENT), l1 = __hip_atomic_load(pml + 32 + r32, __ATOMIC_RELAXED, __HIP_MEMORY_SCOPE_AGENT);
          f32x4 qa[4];
#define NSA_LDROW(i_, r_) do { unsigned long long* qp_ = (unsigned long long*)(part + (size_t)(w * 16 + (r_)) * 256 + lane * 4); u64x2 t_; \
              t_.x = __hip_atomic_load(qp_, __ATOMIC_RELAXED, __HIP_MEMORY_SCOPE_AGENT); t_.y = __hip_atomic_load(qp_ + 1, __ATOMIC_RELAXED, __HIP_MEMORY_SCOPE_AGENT); qa[i_] = __builtin_bit_cast(f32x4, t_); } while (0)
#pragma unroll
          for (int i = 0; i < 4; ++i) NSA_LDROW(i, i);
          const float mm = fmaxf(m1, ms), f1 = __builtin_amdgcn_exp2f((m1 - mm) * C2), f2 = __builtin_amdgcn_exp2f((ms - mm) * C2);
          ls = l1 * f1 + ls * f2;
          if (hi == 0) { wsf[r32] = f1; wsf[32 + r32] = f2; }
          asm volatile("s_waitcnt lgkmcnt(0)" ::: "memory");
#pragma unroll
          for (int hb = 0; hb < 4; ++hb) {
#pragma unroll
              for (int i = 0; i < 4; ++i) { const int r = hb * 4 + i; const float a1 = wsf[crow(r, hi)], a2 = wsf[32 + crow(r, hi)];
#pragma unroll
                  for (int d0 = 0; d0 < 4; ++d0) o[d0][r] = qa[i][d0] * a1 + o[d0][r] * a2; }
              asm volatile("" : "+v"(o[0][4 * hb]), "+v"(o[1][4 * hb]), "+v"(o[2][4 * hb]), "+v"(o[3][4 * hb]), "+v"(o[0][4 * hb + 1]), "+v"(o[1][4 * hb + 1]), "+v"(o[2][4 * hb + 1]), "+v"(o[3][4 * hb + 1]),
                               "+v"(o[0][4 * hb + 2]), "+v"(o[1][4 * hb + 2]), "+v"(o[2][4 * hb + 2]), "+v"(o[3][4 * hb + 2]), "+v"(o[0][4 * hb + 3]), "+v"(o[1][4 * hb + 3]), "+v"(o[2][4 * hb + 3]), "+v"(o[3][4 * hb + 3]) :: "memory");
              if (hb < 3) {
#pragma unroll
                  for (int i = 0; i < 4; ++i) NSA_LDROW(i, 4 * (hb + 1) + i); }
          }
          asm volatile("s_waitcnt lgkmcnt(0)" ::: "memory");
      }
      if (hi == 0) wsf[r32] = g1 / ls;
      asm volatile("s_waitcnt lgkmcnt(0)" ::: "memory");
#pragma unroll
      for (int r = 0; r < 16; ++r) { const float al = wsf[crow(r, hi)];
#pragma unroll
          for (int d0 = 0; d0 < 4; ++d0) o[d0][r] *= al; } }
    a.Kp = kc; a.Vp = vc; a.tm0 = cm0; a.tm1 = a.tm2 = a.tm3 = 0u; a.wm0 = cm0; a.wm1 = a.wm2 = a.wm3 = 0u; a.f = g0 * ilc;
    attn_pass<M_CPV>(c, qr, o, mc, lc, a);
    { unsigned wt0 = 0u, wt1 = 0u, wt2 = 0u, wt3 = 0u;
      for (int j = (b - 8 > 0 ? b - 8 : 0); j <= b; ++j) { const unsigned bit = 1u << (j & 31); if (j < 32) wt0 |= bit; else if (j < 64) wt1 |= bit; else if (j < 96) wt2 |= bit; else wt3 |= bit; }
      float mw = -1e30f, lw = 0.f;
      a.Kp = proj + (size_t)(16 + g) * S * HD; a.Vp = proj + (size_t)(18 + g) * S * HD;
      a.tm0 = wt0; a.tm1 = wt1; a.tm2 = wt2; a.tm3 = wt3; a.wm0 = wt0; a.wm1 = wt1; a.wm2 = wt2; a.wm3 = wt3; a.f = 0.f;
      attn_pass<M_WSTAT>(c, qr, o, mw, lw, a);
      a.f = g2 / lw;
      attn_pass<M_WPV>(c, qr, o, mw, lw, a); }
    { const float* ggrp = p.in[10] + (size_t)l * DM; bf16_t* O = (bf16_t*)(p.ws + WS_O);
      int lane_; asm volatile("v_mbcnt_lo_u32_b32 %0, -1, 0\n\tv_mbcnt_hi_u32_b32 %0, -1, %0" : "=v"(lane_));
      const int r32 = lane_ & 31, hi = lane_ >> 5, odd = lane_ & 1;
      float gg[4][4];
#pragma unroll
      for (int hh = 0; hh < 4; ++hh)
#pragma unroll
          for (int d0 = 0; d0 < 4; ++d0) gg[hh][d0] = ggrp[(4 * g + hh) * HD + d0 * 32 + r32];
#pragma unroll
      for (int r = 0; r < 16; ++r) {
          const float ss = half_sum_dpp((o[0][r] * o[0][r] + o[1][r] * o[1][r]) + (o[2][r] * o[2][r] + o[3][r] * o[3][r]), hi);
          const float rs = __builtin_amdgcn_rsqf(ss * (1.0f / HD) + EPS);
          const int rr = crow(r, hi), Hh = 4 * g + (r & 3); const int tk = t0 + 8 * w + (rr >> 2);
          store_row4(O + (size_t)tk * DM + Hh * HD + (r32 & ~1), o[0][r] * rs * gg[r & 3][0], o[1][r] * rs * gg[r & 3][1], o[2][r] * rs * gg[r & 3][2], o[3][r] * rs * gg[r & 3][3], odd);
      } }
}
__device__ __forceinline__ void phase_nsa(const Params& p, const Ctx& c, int l) {
    const int u0 = c.bx, g = u0 & 1, rk = u0 >> 1;
    if (rk < 64) { nsa_unit<2>(p, c, l, g, 127 - rk); nsa_unit<0>(p, c, l, g, rk); }
    else nsa_unit<1>(p, c, l, g, rk);
    __syncthreads();
}
__device__ __forceinline__ void phase_cmpr_sb(const Params& p, const Ctx& c, int l) {
    phase_cmpr(p, c, l);
    sb_unit(p, c, l, c.bx & 7, 31 - (c.bx >> 3));
    __syncthreads();
}
__device__ __forceinline__ Ctx make_ctx(unsigned char* lds, int wave) {
    Ctx c; c.lds = (LAS unsigned char*)lds; int ln_; asm volatile("v_mbcnt_lo_u32_b32 %0, -1, 0\n\tv_mbcnt_hi_u32_b32 %0, -1, %0" : "=v"(ln_));
    int wv_ = wave; asm volatile("" : "+s"(wv_));
    c.lane = ln_; c.wave = wv_; c.tid = wv_ * 64 + ln_;
    int bx_ = blockIdx.x; asm volatile("" : "+s"(bx_)); c.bx = bx_;
    c.gw = bx_ * NWAVES + c.wave; c.ngw = gridDim.x * NWAVES; return c;
}
#define AS4 __attribute__((address_space(4)))
__device__ __forceinline__ Params load_params() {
    unsigned long long v = (unsigned long long)(const AS4 void*)__builtin_amdgcn_kernarg_segment_ptr();
    asm volatile("" : "+s"(v));
    const AS4 Params* q = (const AS4 Params*)v; Params r;
#pragma unroll
    for (int i = 0; i < 17; ++i) r.in[i] = q->in[i];
    r.out = q->out; r.ws = q->ws; return r;
}
constexpr int CW_BAR = 4096;
#ifndef MEGA
#define MEGA 1
#endif
__global__ void __launch_bounds__(NTHREADS, 2) k_mega(Params p_arg) {
    extern __shared__ __attribute__((aligned(16))) unsigned char lds_raw[];
#define PCTX const Ctx c = make_ctx(lds_raw, wave0); const Params p = load_params()
    const int wave0 = __builtin_amdgcn_readfirstlane((int)threadIdx.x >> 6);
    volatile LAS unsigned* misc = (volatile LAS unsigned*)((LAS unsigned char*)lds_raw + MISC_OFF);
    if (threadIdx.x < 8) misc[threadIdx.x] = 0u;
    __syncthreads();
    { const Params p = load_params(); (void)xcd_barrier_post((unsigned*)(p.ws + WS_CTL) + CW_BAR, misc, threadIdx.x == 0); }
#define GBAR() do { const Params p = load_params(); XcdBarrier b_; b_.bar = (unsigned*)(p.ws + WS_CTL) + CW_BAR; b_.x = xb_xcc_id(); b_.st = misc; { int ln__; asm volatile("v_mbcnt_lo_u32_b32 %0, -1, 0\n\tv_mbcnt_hi_u32_b32 %0, -1, %0" : "=v"(ln__)); b_.leader = (wave0 == 0) && (ln__ == 0); } xcd_barrier(b_); } while (0)
    { PCTX; phase_conv(p, c); }
    GBAR();
    for (int l = 0; l < NL; ++l) {
        { PCTX; if (l == 0) cbias_reduce(p, c);
          pg8::Gemm g{(const bf16_t*)(p.ws + WS_XN8), (const bf16_t*)(p.ws + WS_WI8 + (size_t)l * 12 * MiB), S, DINP, DM / 2}; pg8::StaticOrder so; so.init(S, DINP, gridDim.x, c.bx);
          EpiProj E{(bf16_t*)(p.ws + WS_PROJ), (float*)(p.ws + WS_GATES), (const bf16_t*)(p.ws + WS_ROPEH), p.in[4] + 24 * l, (const LAS float*)(c.lds + RSTD_OFF), (const LAS float*)(c.lds + CSC_OFF)};
          pg8::gemm_phase<EpiProj, pg8::StaticOrder, true, true, PrepRstd, 2>(c.lds, g, so, E, c.tid, PrepRstd{c, so, (const float*)(p.ws + WS_SSQ), (const float*)(p.ws + WS_ASC), (const float*)(p.ws + WS_WISC) + l * DINP});
        }
        GBAR();
        { PCTX; phase_cmpr_sb(p, c, l); }
        GBAR();
        { PCTX; phase_nsa(p, c, l); }
        GBAR();
        { PCTX; pg8::Gemm g{(const bf16_t*)(p.ws + WS_O), w_ptr(p, l, W_OUT), S, DM, DM}; pg8::StaticOrder so; so.init(S, DM, gridDim.x, c.bx);
          EpiResidH E{(bf16_t*)(p.ws + WS_XN), (float*)(p.ws + WS_SSQ), 1.0f, p.ws + WS_XN8, (float*)(p.ws + WS_ASC), (float*)(p.ws + WS_XSLAB), (unsigned*)(p.ws + WS_CTL) + CW_XCNT, 8u * (unsigned)(2 * l + 1)};
          pg8::gemm_phase<EpiResidH, pg8::StaticOrder, false, true>(c.lds, g, so, E, c.tid); }
        GBAR();
        { PCTX; pg8::Gemm g{(const bf16_t*)(p.ws + WS_XN8), (const bf16_t*)(p.ws + WS_W8 + (size_t)l * 22 * MiB), S, 2 * DFF, DM / 2}; pg8::StaticOrder so; so.init(S, 2 * DFF, gridDim.x, c.bx);
          EpiSwiGLU E{p.ws + WS_ACT, (const LAS float*)(c.lds + RSTD_OFF), (const LAS float*)(c.lds + CSC_OFF)};
          pg8::gemm_phase<EpiSwiGLU, pg8::StaticOrder, true, true, PrepRstd, 2>(c.lds, g, so, E, c.tid, PrepRstd{c, so, (const float*)(p.ws + WS_SSQ), (const float*)(p.ws + WS_ASC), (const float*)(p.ws + WS_WSC) + l * 2 * DFF});
        }
        GBAR();
        { PCTX; pg8::Gemm g{(const bf16_t*)(p.ws + WS_ACT), w_ptr(p, l, W_DN), S, DM, DFF / 2}; pg8::StaticOrder so; so.init(S, DM, gridDim.x, c.bx);
          EpiResidH E{(bf16_t*)(p.ws + WS_XN), (float*)(p.ws + WS_SSQ), 1.0f / (A8_SCALE * W8_SCALE), l + 1 < NL ? p.ws + WS_XN8 : nullptr, (float*)(p.ws + WS_ASC), (float*)(p.ws + WS_XSLAB), (unsigned*)(p.ws + WS_CTL) + CW_XCNT, 8u * (unsigned)(2 * l + 2)};
          pg8::gemm_phase<EpiResidH, pg8::StaticOrder, false, true, pg8::NoPre, 1>(c.lds, g, so, E, c.tid); }
        GBAR();
    }
    { PCTX; phase_final_norm(c, (const bf16_t*)(p.ws + WS_XN), (const float*)(p.ws + WS_SSQ), p.in[16], (float*)p.out); }
}

extern "C" void kernel_launch(void* const* d_in, const int* in_sizes, int n_in, void* d_out, int out_size, void* d_ws, size_t ws_size, hipStream_t stream) {
    static int grid = 0;
    if (grid == 0) {
        if (n_in != 17 || out_size != S * DM || ws_size < WS_END) { fprintf(stderr, "kernel_launch: unexpected shapes (n_in %d, out %d, ws %zu)\n", n_in, out_size, ws_size); grid = -1; return; }
        int dev = 0, cus = 0; (void)hipGetDevice(&dev); (void)hipDeviceGetAttribute(&cus, hipDeviceAttributeMultiprocessorCount, dev); if (cus <= 0) cus = 256;
#if MEGA
        if (hipFuncSetAttribute((const void*)k_mega, hipFuncAttributeMaxDynamicSharedMemorySize, LDS_BYTES) != hipSuccess) { fprintf(stderr, "kernel_launch: hipFuncSetAttribute failed\n"); grid = -1; return; }
        int per_cu = 0;
        if (hipOccupancyMaxActiveBlocksPerMultiprocessor(&per_cu, (const void*)k_mega, NTHREADS, LDS_BYTES) != hipSuccess || per_cu < 1) { fprintf(stderr, "kernel_launch: occupancy query says %d\n", per_cu); per_cu = 1; }
        (void)hipGetLastError();
        if (cus < 256) fprintf(stderr, "kernel_launch: this kernel's static unit schedules need 256 resident workgroups; the device reports %d CUs\n", cus);
        grid = 256;
#endif
    }
    if (grid < 0) return;
    Params p{};
    for (int i = 0; i < 17; ++i) p.in[i] = (const float*)d_in[i];
    p.out = (float*)d_out; p.ws = (unsigned char*)d_ws;
    const dim3 G(grid), B(NTHREADS);
#if MEGA
    (void)hipMemsetAsync((unsigned char*)d_ws + WS_CTL, 0, CTL_ZERO_BYTES, stream);
    hipLaunchKernelGGL(k_mega, G, B, LDS_BYTES, stream, p);
#endif
}
```

```cpp
#include <hip/hip_runtime.h>
#include <cstdio>
#include <cstdint>
namespace pg8 {
#define PG8_LAS __attribute__((address_space(3)))
typedef unsigned short bf16_t;
typedef _Float16 bf16x8 __attribute__((ext_vector_type(8)));
typedef float f32x4 __attribute__((ext_vector_type(4)));
typedef unsigned u32x4 __attribute__((ext_vector_type(4)));
constexpr int BM = 256, BK = 64, HALF = 128, HTB = HALF * BK * 2  , STAGE_BYTES = 8 * HTB, NXCD = 8, WGM = 8;

__host__ __device__ __forceinline__ int lds_byte(int r, int c) { const int st = (r >> 4) * 2 + (c >> 5), rr = r & 15, cc = c & 31, ob = rr * 64 + cc * 2; return st * 1024 + (ob ^ (((ob >> 9) & 1) << 5)); }
__host__ __device__ __forceinline__ void stage_rc(int b, int& R, int& C) { const int st = b / 1024, sb = b % 1024, swz = sb ^ (((sb >> 9) & 1) << 5); R = (st >> 1) * 16 + swz / 64; C = (st & 1) * 32 + (swz % 64) / 2; }
__host__ __device__ __forceinline__ int perm32(int rho) { const int n = rho >> 4, i = rho & 15; return 8 * (i >> 2) + 4 * n + (i & 3); }

struct Unit { int pm, pn, ord; };
struct Gemm { const bf16_t* A; const bf16_t* Bt; int M, N, K; };

struct StaticOrder {
    int nM, nN, nwg, G, c;
    __host__ __device__ void init(int M, int N, int G_, int c_) { nM = M / BM; nN = N / BM; nwg = nM * nN; G = G_; c = c_; }
    __host__ __device__ bool next(int i, Unit& u) const {
        const long L = (long)i * G + c; if (L >= nwg) return false;
        int wgid = (int)L; { const int q = nwg / NXCD, r = nwg % NXCD, xcd = wgid % NXCD, off = wgid / NXCD; wgid = (xcd < r ? xcd * (q + 1) : r * (q + 1) + (xcd - r) * q) + off; }
        const int nig = WGM * nN, gid = wgid / nig, fm = gid * WGM, gsz = (nM - fm) < WGM ? (nM - fm) : WGM;
        u.pm = fm + ((wgid % nig) % gsz); u.pn = (wgid % nig) / gsz; u.ord = i; return true;
    }
    __device__ __forceinline__ void a_ready(const Unit&) const {}
    __device__ __forceinline__ void done(const Unit&) const {}
};
__device__ __forceinline__ unsigned cvt_pk_bf16(float lo, float hi) { unsigned r; asm volatile("v_cvt_pk_bf16_f32 %0, %1, %2" : "=v"(r) : "v"(lo), "v"(hi)); return r; }
typedef float f32x2 __attribute__((ext_vector_type(2)));
struct NoPre { __device__ __forceinline__ void operator()() const {} };
typedef int i32x8 __attribute__((ext_vector_type(8)));
typedef int i32x4 __attribute__((ext_vector_type(4)));
template <class Epi, class Sched, bool ALIGN_EPI = false, bool SP2 = false, class Pre = NoPre, int F8 = 0>
__device__ __forceinline__ void gemm_phase(PG8_LAS unsigned char* lds, const Gemm g, const Sched& S, const Epi& E, int tid_in, const Pre& pre = Pre()) {
    int tid_ = tid_in; asm volatile("" : "+v"(tid_));
    const int tid = tid_, wid = __builtin_amdgcn_readfirstlane(tid >> 6), lane = tid & 63, wr = wid >> 2, wc = wid & 3, fr = lane & 15, fq = lane >> 4;
    const int K = g.K, nt = K / BK;
    unsigned voffA[2], voffB[2];
#pragma unroll
    for (int i = 0; i < 2; ++i) { int R, C; stage_rc(tid * 16 + i * 8192, R, C); const int Rb = Epi::PERM ? ((R & ~31) + perm32(R & 31)) : R;
        voffA[i] = (unsigned)(R * K + C) * 2u; voffB[i] = (unsigned)(Rb * K + C) * 2u; }
    const size_t kstep = (size_t)(BK * 2);
    const size_t hstep = (size_t)HALF * K * 2;
    const size_t tstep = 2 * hstep;
    const unsigned ldsw = (unsigned)wid * 1024u;
    const int aoff = lds_byte(wr * 64 + fr, fq * 8), boff = lds_byte(wc * 32 + fr, fq * 8);
#define PG8_SA(b, h) (((b) * 2 + (h)) * HTB)
#define PG8_SB(b, h) ((4 + (b) * 2 + (h)) * HTB)
#define PG8_STAGE(bufoff, gbase, voff) do { _Pragma("unroll") for (int _i = 0; _i < 2; ++_i) \
        __builtin_amdgcn_global_load_lds((const unsigned*)((const char*)(gbase) + (voff)[_i]), (PG8_LAS unsigned*)(lds + (bufoff) + ldsw + _i * 8192), 16, 0, 0); } while (0)
#define PG8_LDA(dst, b, h) do { _Pragma("unroll") for (int m = 0; m < 4; ++m) _Pragma("unroll") for (int k = 0; k < 2; ++k) dst[m][k] = *(const PG8_LAS bf16x8*)(lds + PG8_SA(b, h) + aoff + m * 2048 + k * 1024); } while (0)
#define PG8_LDB(dst, b, h) do { _Pragma("unroll") for (int n = 0; n < 2; ++n) _Pragma("unroll") for (int k = 0; k < 2; ++k) dst[n][k] = *(const PG8_LAS bf16x8*)(lds + PG8_SB(b, h) + boff + n * 2048 + k * 1024); } while (0)
#define PG8_F8FRAG(X) __builtin_shufflevector(__builtin_bit_cast(i32x4, (X)[0]), __builtin_bit_cast(i32x4, (X)[1]), 0, 1, 2, 3, 4, 5, 6, 7)
#define PG8_MMA(ai, bj, At, Bt) do { __builtin_amdgcn_s_setprio(1); \
        if constexpr (F8 == 2) { _Pragma("unroll") for (int m = 0; m < 4; ++m) _Pragma("unroll") for (int n = 0; n < 2; ++n) _Pragma("unroll") for (int k = 0; k < 2; ++k) \
            acc[ai][bj][m][n] = __builtin_bit_cast(f32x4, __builtin_amdgcn_mfma_i32_16x16x64_i8(__builtin_bit_cast(i32x4, Bt[n][k]), __builtin_bit_cast(i32x4, At[m][k]), __builtin_bit_cast(i32x4, acc[ai][bj][m][n]), 0, 0, 0)); } \
        else if constexpr (F8 == 1) { _Pragma("unroll") for (int m = 0; m < 4; ++m) _Pragma("unroll") for (int n = 0; n < 2; ++n) \
            { const i32x8 a8_ = PG8_F8FRAG(Bt[n]), b8_ = PG8_F8FRAG(At[m]); asm volatile("v_mfma_f32_16x16x128_f8f6f4 %0, %1, %2, %0" : "+v"(acc[ai][bj][m][n]) : "v"(a8_), "v"(b8_)); } } \
        else { _Pragma("unroll") for (int m = 0; m < 4; ++m) _Pragma("unroll") for (int n = 0; n < 2; ++n) _Pragma("unroll") for (int k = 0; k < 2; ++k) \
            acc[ai][bj][m][n] = __builtin_amdgcn_mfma_f32_16x16x32_f16(Bt[n][k], At[m][k], acc[ai][bj][m][n], 0, 0, 0); } \
        __builtin_amdgcn_s_setprio(0); } while (0)
#define PG8_WAIT_V(n) asm volatile("s_waitcnt vmcnt(" #n ")" ::: "memory")
#define PG8_WAIT_L(n) asm volatile("s_waitcnt lgkmcnt(" #n ")" ::: "memory")
#define PG8_BAR __builtin_amdgcn_s_barrier()
#define PG8_SCHED __builtin_amdgcn_sched_barrier(0)
    Unit cur, nxt; int ui = 0;
    if (!S.next(0, cur)) return;
    f32x4 acc[2][2][4][2];
#pragma unroll
    for (int a = 0; a < 2; ++a)
#pragma unroll
        for (int b = 0; b < 2; ++b)
#pragma unroll
            for (int m = 0; m < 4; ++m)
#pragma unroll
                for (int n = 0; n < 2; ++n) acc[a][b][m][n] = (f32x4){0.f, 0.f, 0.f, 0.f};
    bf16x8 At[4][2], B0[2][2], B1[2][2];
    const char* cA = (const char*)g.A + (size_t)cur.pm * tstep; const char* cB = (const char*)g.Bt + (size_t)cur.pn * tstep;
    S.a_ready(cur);
    if constexpr (SP2) {
        PG8_STAGE(PG8_SB(0, 0), cB, voffB); PG8_STAGE(PG8_SB(0, 1), cB + hstep, voffB); PG8_STAGE(PG8_SA(0, 0), cA, voffA); PG8_STAGE(PG8_SA(0, 1), cA + hstep, voffA);
        pre();
        if (wr == 1) PG8_BAR;
        PG8_WAIT_V(2); PG8_BAR;
        PG8_STAGE(PG8_SB(1, 0), cB + kstep, voffB); PG8_STAGE(PG8_SA(1, 0), cA + kstep, voffA); PG8_STAGE(PG8_SB(1, 1), cB + hstep + kstep, voffB);
        PG8_WAIT_V(6); PG8_BAR;
    } else {
        PG8_STAGE(PG8_SB(0, 0), cB, voffB); PG8_STAGE(PG8_SA(0, 0), cA, voffA); PG8_STAGE(PG8_SB(0, 1), cB + hstep, voffB); PG8_STAGE(PG8_SA(0, 1), cA + hstep, voffA);
        if (wr == 1) PG8_BAR;
        PG8_WAIT_V(4); PG8_BAR;
        PG8_STAGE(PG8_SB(1, 0), cB + kstep, voffB); PG8_STAGE(PG8_SA(1, 0), cA + kstep, voffA); PG8_STAGE(PG8_SB(1, 1), cB + hstep + kstep, voffB);
        PG8_WAIT_V(6); PG8_BAR;
    }
    for (;;) {
        const bool has_next = S.next(ui + 1, nxt);
        const char* nA = has_next ? (const char*)g.A + (size_t)nxt.pm * tstep : cA; const char* nB = has_next ? (const char*)g.Bt + (size_t)nxt.pn * tstep : cB;
        for (int t = 0; t < nt; t += 2) {
            const bool last = (t == nt - 2);
            const char* a1 = cA + (size_t)(t + 1) * kstep;
            const char* a2 = last ? nA : cA + (size_t)(t + 2) * kstep; const char* b2 = last ? nB : cB + (size_t)(t + 2) * kstep;
            const char* a3 = a2 + kstep; const char* b3 = b2 + kstep;
            if (last && has_next) S.a_ready(nxt);
            if constexpr (SP2) {
            PG8_LDB(B0, 0, 0); PG8_LDB(B1, 0, 1); PG8_SCHED; PG8_LDA(At, 0, 0); PG8_STAGE(PG8_SA(1, 1), a1 + hstep, voffA);
            PG8_WAIT_V(8); PG8_WAIT_L(0); PG8_BAR; PG8_MMA(0, 0, At, B0); PG8_MMA(0, 1, At, B1); PG8_BAR; PG8_SCHED;
            PG8_LDA(At, 0, 1); PG8_STAGE(PG8_SB(0, 0), b2, voffB); PG8_STAGE(PG8_SB(0, 1), b2 + hstep, voffB); PG8_STAGE(PG8_SA(0, 0), a2, voffA);
            PG8_WAIT_V(8); PG8_WAIT_L(0); PG8_BAR; PG8_MMA(1, 0, At, B0); PG8_MMA(1, 1, At, B1); PG8_BAR; PG8_SCHED;
            PG8_LDB(B0, 1, 0); PG8_LDB(B1, 1, 1); PG8_SCHED; PG8_LDA(At, 1, 0); PG8_STAGE(PG8_SA(0, 1), a2 + hstep, voffA);
            PG8_WAIT_V(8); PG8_WAIT_L(0); PG8_BAR; PG8_MMA(0, 0, At, B0); PG8_MMA(0, 1, At, B1); PG8_BAR; PG8_SCHED;
            PG8_LDA(At, 1, 1); PG8_STAGE(PG8_SB(1, 0), b3, voffB); PG8_STAGE(PG8_SB(1, 1), b3 + hstep, voffB); PG8_STAGE(PG8_SA(1, 0), a3, voffA);
            PG8_WAIT_V(8); PG8_WAIT_L(0); PG8_BAR; PG8_MMA(1, 0, At, B0); PG8_MMA(1, 1, At, B1); PG8_BAR; PG8_SCHED;
            } else {
            PG8_LDB(B0, 0, 0); PG8_SCHED; PG8_LDA(At, 0, 0); PG8_STAGE(PG8_SA(1, 1), a1 + hstep, voffA);
            PG8_WAIT_L(8); PG8_BAR; PG8_WAIT_L(0); PG8_MMA(0, 0, At, B0); PG8_BAR; PG8_SCHED;
            PG8_LDB(B1, 0, 1); PG8_STAGE(PG8_SB(0, 0), b2, voffB);
            PG8_BAR; PG8_WAIT_L(0); PG8_MMA(0, 1, At, B1); PG8_BAR;
            PG8_LDA(At, 0, 1); PG8_STAGE(PG8_SA(0, 0), a2, voffA);
            PG8_BAR; PG8_WAIT_L(0); PG8_MMA(1, 0, At, B0); PG8_BAR; PG8_SCHED;
            PG8_STAGE(PG8_SB(0, 1), b2 + hstep, voffB);
            PG8_WAIT_V(6); PG8_BAR; PG8_MMA(1, 1, At, B1); PG8_BAR;
            PG8_LDB(B0, 1, 0); PG8_SCHED; PG8_LDA(At, 1, 0); PG8_STAGE(PG8_SA(0, 1), a2 + hstep, voffA);
            PG8_WAIT_L(8); PG8_BAR; PG8_WAIT_L(0); PG8_MMA(0, 0, At, B0); PG8_BAR; PG8_SCHED;
            PG8_LDB(B1, 1, 1); PG8_STAGE(PG8_SB(1, 0), b3, voffB);
            PG8_BAR; PG8_WAIT_L(0); PG8_MMA(0, 1, At, B1); PG8_BAR;
            PG8_LDA(At, 1, 1); PG8_STAGE(PG8_SA(1, 0), a3, voffA);
            PG8_BAR; PG8_WAIT_L(0); PG8_MMA(1, 0, At, B0); PG8_BAR; PG8_SCHED;
            PG8_STAGE(PG8_SB(1, 1), b3 + hstep, voffB);
            PG8_WAIT_V(6); PG8_BAR; PG8_MMA(1, 1, At, B1); PG8_BAR;
            }
        }
        if constexpr (F8) asm volatile("s_nop 15\n\ts_nop 15" ::: "memory");
        if constexpr (ALIGN_EPI) { if (wr == 0) PG8_BAR; }
        if constexpr (!Epi::AFTER_DRAIN) { E(acc, cur, wr, wc, fr, fq); S.done(cur); }
        if (!has_next) break;
#pragma unroll
        for (int a = 0; a < 2; ++a)
#pragma unroll
            for (int b = 0; b < 2; ++b)
#pragma unroll
                for (int m = 0; m < 4; ++m)
#pragma unroll
                    for (int n = 0; n < 2; ++n) acc[a][b][m][n] = (f32x4){0.f, 0.f, 0.f, 0.f};
        cur = nxt; cA = nA; cB = nB; ++ui;
        if constexpr (ALIGN_EPI) { if (wr == 1) PG8_BAR; }
    }
    PG8_WAIT_V(0);
    if constexpr (!ALIGN_EPI) { if (wr == 0) PG8_BAR; }
    PG8_BAR;
    if constexpr (Epi::AFTER_DRAIN) { E.fused(acc, cur, wr, wc, fr, fq, lds, wid, lane); S.done(cur); }
#undef PG8_SA
#undef PG8_SB
#undef PG8_STAGE
#undef PG8_LDA
#undef PG8_LDB
#undef PG8_MMA
#undef PG8_WAIT_V
#undef PG8_WAIT_L
#undef PG8_BAR
#undef PG8_SCHED
}
}
#define LAS __attribute__((address_space(3)))
#define XB_TMO      128
#define XB_XCNT(j)  (256  + 64 * (j))
#define XB_XSUB(j)  (1280 + 64 * (j))
#define XB_XGEN(j)  (2304 + 64 * (j))
#define XB_TOP      3328
#define XB_TOPGEN   3392
#define XCD_BAR_WORDS 3456
#define XB_SPIN_CAP (1u << 18)

__device__ __forceinline__ unsigned xb_ld(unsigned* p)              { return __hip_atomic_load(p, __ATOMIC_RELAXED, __HIP_MEMORY_SCOPE_AGENT); }
__device__ __forceinline__ unsigned xb_add(unsigned* p, unsigned v) { return __hip_atomic_fetch_add(p, v, __ATOMIC_RELAXED, __HIP_MEMORY_SCOPE_AGENT); }
__device__ __forceinline__ unsigned xb_xcc_id() { return (unsigned)__builtin_amdgcn_s_getreg((3 << 11) | 20) & 0xFu; }
#define XB_SPIN(cond, bar) do { unsigned _sp = 0; while (cond) { __builtin_amdgcn_s_sleep(1); \
    if ((++_sp & 255u) == 0u) { if (xb_ld(&(bar)[XB_TMO])) break; if (_sp > XB_SPIN_CAP) { atomicAdd(&(bar)[XB_TMO], 1u); break; } } } } while (0)

struct XcdBarrier {
    unsigned* bar; unsigned x;
    volatile LAS unsigned* st;
    bool leader;
};

__device__ __forceinline__ XcdBarrier xcd_barrier_post(unsigned* bar, volatile LAS unsigned* st, bool leader) {
    XcdBarrier b; b.bar = bar; b.x = xb_xcc_id(); b.st = st; b.leader = leader;
    if (leader) (void)xb_add(&bar[XB_XCNT(b.x)], 1u);
    return b;
}
__device__ __forceinline__ void xcd_barrier_complete(unsigned* bar, unsigned x, unsigned& nloc, unsigned& nx) {
    const unsigned G = gridDim.x * gridDim.y * gridDim.z;
    unsigned sum, cnt, mine, sp = 0u;
    for (;;) {
        sum = 0u; cnt = 0u; mine = 0u;
#pragma unroll
        for (unsigned j = 0; j < 16; ++j) { const unsigned c = xb_ld(&bar[XB_XCNT(j)]); sum += c; cnt += (c > 0u) ? 1u : 0u; mine = (j == x) ? c : mine; }
        if (sum == G) break;
        __builtin_amdgcn_s_sleep(1);
        if ((++sp & 255u) == 0u) { if (xb_ld(&bar[XB_TMO])) break; if (sp > XB_SPIN_CAP) { atomicAdd(&bar[XB_TMO], 1u); break; } }
    }
    nloc = mine > 0u ? mine : 1u; nx = cnt > 0u ? cnt : 1u;
}

__device__ __forceinline__ void xcd_barrier(const XcdBarrier& b) {
    asm volatile("s_waitcnt vmcnt(0)" ::: "memory");
    __syncthreads();
    if (b.leader) {
        unsigned* bar = b.bar;
        __builtin_amdgcn_s_waitcnt(0);
        unsigned nloc = b.st[0], nx = b.st[1];
        if (nloc == 0u) { xcd_barrier_complete(bar, b.x, nloc, nx); b.st[0] = nloc; b.st[1] = nx; }
        const unsigned old = xb_add(&bar[XB_XSUB(b.x)], 1u);
        const unsigned gen = old / nloc;
        if (old + 1u == (gen + 1u) * nloc) {
            __builtin_amdgcn_fence(__ATOMIC_RELEASE, "agent");
            asm volatile("s_waitcnt vmcnt(0)" ::: "memory");
            const unsigned og = xb_add(&bar[XB_TOP], 1u);
            const unsigned tg = og / nx;
            if (og + 1u == (tg + 1u) * nx) xb_add(&bar[XB_TOPGEN], 1u);
            else XB_SPIN(xb_ld(&bar[XB_TOPGEN]) == tg, bar);
            __builtin_amdgcn_fence(__ATOMIC_ACQUIRE, "agent");
            xb_add(&bar[XB_XGEN(b.x)], 1u);
            asm volatile("s_waitcnt vmcnt(0)" ::: "memory");
        } else {
            XB_SPIN(xb_ld(&bar[XB_XGEN(b.x)]) == gen, bar);
            __builtin_amdgcn_fence(__ATOMIC_ACQUIRE, "agent");
            asm volatile("s_waitcnt vmcnt(0)" ::: "memory");
        }
    }
    __syncthreads();
}

#ifndef LAS
#define LAS __attribute__((address_space(3)))
#endif
typedef unsigned short bf16_t;
typedef _Float16 bf16x8 __attribute__((ext_vector_type(8)));
typedef _Float16 bf16x4 __attribute__((ext_vector_type(4)));
typedef float f32x4 __attribute__((ext_vector_type(4)));
typedef float f32x2 __attribute__((ext_vector_type(2)));
typedef unsigned u32x4 __attribute__((ext_vector_type(4)));
typedef unsigned u32x2 __attribute__((ext_vector_type(2)));

constexpr int S = 8192, DM = 2048, NL = 4, HD = 128, DIN = 5656, DINP = 5888, DFF = 5632, NCMP = 511;
constexpr float EPS = 1e-6f;
constexpr float SCALE = 0.08838834764831845f;
constexpr int NWAVES = 8, NTHREADS = 512;
constexpr int LDS_BYTES = 147456;
constexpr int RING_BYTES = 131072, MISC_OFF = LDS_BYTES - 64;

constexpr size_t MiB = 1u << 20;
constexpr float W8_SCALE = 64.0f, A8_SCALE = 8.0f;
constexpr size_t WS_CTL = 0, CTL_ZERO_BYTES = 1 * MiB;
constexpr size_t WS_ROPE = 1 * MiB;
constexpr size_t WS_CBP = WS_ROPE + 1024 * 1024;
constexpr size_t WS_ROPEH = 5 * MiB + 512 * 1024;
constexpr size_t WS_CBF = 3 * MiB + 512 * 1024;
constexpr size_t WS_KC = 2 * MiB + 512 * 1024;
constexpr size_t WS_VC = WS_KC + 256 * 1024;
constexpr size_t WS_SEL = 3 * MiB;
constexpr size_t WS_GATES = 4 * MiB;
constexpr size_t WS_SSQ = 5 * MiB;
constexpr size_t WS_W = 8 * MiB;
constexpr size_t W_IN = 0, W_OUT = 23 * MiB, W_GU = 31 * MiB, W_DN = 75 * MiB, W_C1 = 97 * MiB, W_C2 = 101 * MiB, W_LAYER = 102 * MiB;
constexpr size_t WS_H = WS_W + NL * W_LAYER;
constexpr size_t WS_XN8 = WS_H;
constexpr size_t WS_XSLAB = WS_H + 32 * MiB;
constexpr size_t WS_XN = WS_H + 64 * MiB;
constexpr size_t WS_O = WS_XN + 32 * MiB;
constexpr size_t WS_OCMP = WS_O + 32 * MiB;
constexpr size_t WS_PROJ = WS_OCMP + 32 * MiB;
constexpr size_t WS_ACT = WS_PROJ;
constexpr size_t WS_PART = WS_PROJ + 88 * MiB;
constexpr size_t PART_SLOT = 131072 + 2048;
constexpr size_t WS_W8 = 688 * MiB;
constexpr size_t WS_WSC = WS_W8 + NL * 22 * MiB;
constexpr size_t WS_ASC = WS_WSC + 1 * MiB;
constexpr size_t WS_WI8 = WS_ASC + 1 * MiB;
constexpr size_t WS_WISC = WS_WI8 + NL * 12 * MiB;
constexpr size_t WS_END = WS_WISC + 1 * MiB;
static_assert(WS_PART + 128 * PART_SLOT <= WS_W8, "ws map");
constexpr size_t WS_CPART = 6 * MiB;
constexpr int CW_CFLAG = 32768;
constexpr int CW_XCNT = 49152;
constexpr int CW_NSAFLAG = 16384;
static_assert((size_t)DINP * DM * 2 == 23 * MiB && (size_t)2 * DFF * DM * 2 == 44 * MiB && (size_t)DM * DFF * 2 == 22 * MiB, "weight map");

struct Params { const float* in[17]; float* out; unsigned char* ws; };

struct Ctx {
    LAS unsigned char* lds;
    int tid, lane, wave, gw, ngw, bx;
};

__device__ __forceinline__ float bf2f(unsigned b) { return (float)__builtin_bit_cast(_Float16, (unsigned short)b); }
__device__ __forceinline__ unsigned f2bf(float f) { return (unsigned)__builtin_bit_cast(unsigned short, (_Float16)f); }
typedef _Float16 h2_t __attribute__((ext_vector_type(2)));
__device__ __forceinline__ unsigned pk2(float lo, float hi) { const h2_t v = {(_Float16)lo, (_Float16)hi}; return __builtin_bit_cast(unsigned, v); }
#define DPP_F(old_, src_, ctrl_, rmask_) __builtin_bit_cast(float, __builtin_amdgcn_update_dpp(__builtin_bit_cast(int, (old_)), __builtin_bit_cast(int, (src_)), (ctrl_), (rmask_), 0xf, false))
__device__ __forceinline__ float wave_sum(float v) {
    v += DPP_F(0.f, v, 0x111, 0xf); v += DPP_F(0.f, v, 0x112, 0xf); v += DPP_F(0.f, v, 0x114, 0xf); v += DPP_F(0.f, v, 0x118, 0xf);
    v += DPP_F(0.f, v, 0x142, 0xa); v += DPP_F(0.f, v, 0x143, 0xc);
    return __builtin_bit_cast(float, __builtin_amdgcn_readlane(__builtin_bit_cast(int, v), 63));
}
__device__ __forceinline__ float wave_max_u(float v) {
    v = fmaxf(v, DPP_F(0.f, v, 0x111, 0xf)); v = fmaxf(v, DPP_F(0.f, v, 0x112, 0xf)); v = fmaxf(v, DPP_F(0.f, v, 0x114, 0xf)); v = fmaxf(v, DPP_F(0.f, v, 0x118, 0xf));
    v = fmaxf(v, DPP_F(0.f, v, 0x142, 0xa)); v = fmaxf(v, DPP_F(0.f, v, 0x143, 0xc));
    return __builtin_bit_cast(float, __builtin_amdgcn_readlane(__builtin_bit_cast(int, v), 63));
}
__device__ __forceinline__ float rope_inv(int i) {
    switch (i) {
        case 0: return 1.0f;
        case 1: return 0.44036659598350525f;
        case 2: return 0.1939227432012558f;
        case 3: return 0.08539710193872452f;
        case 4: return 0.03760603070259094f;
        case 5: return 0.016560440883040428f;
        case 6: return 0.007292664609849453f;
        case 7: return 0.0032114461064338684f;
        case 8: return 0.0014142135623842478f;
        case 9: return 0.0006227724370546639f;
        case 10: return 0.00027424818836152554f;
        case 11: return 0.00012076973507646471f;
        case 12: return 5.3182957344688475e-05f;
        case 13: return 2.34199997066753e-05f;
        case 14: return 1.0313385246263351e-05f;
        default: return 4.541670477919979e-06f;
    }
}
__device__ __forceinline__ void sincos_d(float ang, float& c, float& s) {
    const double x = (double)ang;
    const double q = rint(x * 0.63661977236758134308);
    const double r = fma(-q, 1.57079632679489661923, x) - q * 6.123233995736766e-17;
    const double r2 = r * r;
    double cs = 1.0 / 479001600.0; cs = cs * r2 - 1.0 / 3628800.0; cs = cs * r2 + 1.0 / 40320.0; cs = cs * r2 - 1.0 / 720.0; cs = cs * r2 + 1.0 / 24.0; cs = cs * r2 - 0.5; cs = cs * r2 + 1.0;
    double sn = 1.0 / 6227020800.0; sn = sn * r2 - 1.0 / 39916800.0; sn = sn * r2 + 1.0 / 362880.0; sn = sn * r2 - 1.0 / 5040.0; sn = sn * r2 + 1.0 / 120.0; sn = sn * r2 - 1.0 / 6.0; sn = sn * r2 + 1.0; sn *= r;
    const int qi = ((int)(long long)q) & 3;
    double cc, ss;
    if (qi == 0) { cc = cs; ss = sn; } else if (qi == 1) { cc = -sn; ss = cs; } else if (qi == 2) { cc = -cs; ss = -sn; } else { cc = sn; ss = -cs; }
    c = (float)cc; s = (float)ss;
}
__device__ __forceinline__ float gelu_tanh(float x) {
    const float y = 0.7978845608028654f * (x + 0.044715f * x * x * x);
    const float e = __expf(2.0f * y);
    const float th = 1.0f - 2.0f / (e + 1.0f);
    return 0.5f * x * (1.0f + th);
}
__device__ __forceinline__ float partner32(float x, int hi) { auto rr = __builtin_amdgcn_permlane32_swap(__float_as_uint(x), __float_as_uint(x), false, false); return __uint_as_float(hi ? rr[0] : rr[1]); }
__device__ __forceinline__ float sigmoidf_(float x) { return __builtin_amdgcn_rcpf(1.0f + __builtin_amdgcn_exp2f(x * -1.4426950408889634f)); }

__device__ __forceinline__ bf16_t* w_ptr(const Params& p, int l, size_t off) { return (bf16_t*)(p.ws + WS_W + (size_t)l * W_LAYER + off); }

struct ConvItem { const float* W; const float* gain; bf16_t* WT; int N, k0, sc, nv, drow, dK, frag, f8; };
constexpr int I_IN = 32 * 184, I_OUT = 32 * 64, I_GU = 32 * 352, I_DN = 88 * 64, I_C1 = 1024, I_C2 = 32;
constexpr int I_LAYER = I_OUT + I_DN + I_C1 + I_C2;
__device__ __forceinline__ ConvItem conv_desc(const Params& p, int it) {
    const int l = it / I_LAYER; int r = it - l * I_LAYER; ConvItem d; d.frag = 0; d.f8 = 0;
    if (r < I_OUT) { const int kb = r / 64, nb = r % 64;
        d.W = p.in[11] + (size_t)l * DM * DM; d.N = DM; d.k0 = 64 * kb; d.sc = 32 * nb; d.nv = 32; d.WT = w_ptr(p, l, W_OUT); d.drow = 32 * nb; d.dK = DM; d.gain = nullptr; return d; }
    r -= I_OUT;
    if (r < I_DN) { const int kb = r / 64, nb = r % 64;
        d.W = p.in[15] + (size_t)l * DFF * DM; d.N = DM; d.k0 = 64 * kb; d.sc = 32 * nb; d.nv = 32; d.WT = w_ptr(p, l, W_DN); d.drow = 32 * nb; d.dK = DFF; d.gain = nullptr; d.f8 = 1; return d; }
    r -= I_DN;
    if (r < I_C1) { const int kv = r / 512, rr = r % 512, kb = rr / 8, nb = rr % 8;
        d.W = p.in[kv ? 8 : 6] + (size_t)l * 4096 * 256; d.N = 256; d.k0 = 64 * kb; d.sc = 32 * nb; d.nv = 32; d.WT = w_ptr(p, l, W_C1) + (size_t)kv * 256 * 4096; d.drow = 32 * nb; d.dK = 4096; d.gain = nullptr; d.frag = 1; return d; }
    r -= I_C1;
    { const int kv = r / 16, rr = r % 16, kb = rr / 4, nb = rr % 4;
        d.W = p.in[kv ? 9 : 7] + (size_t)l * 256 * 128; d.N = 128; d.k0 = 64 * kb; d.sc = 32 * nb; d.nv = 32; d.WT = w_ptr(p, l, W_C2) + (size_t)kv * 128 * 256; d.drow = 32 * nb; d.dK = 256; d.gain = nullptr; return d; }
}
#define CONV_LOAD(d, tv) do { const int c_ = lane & 31; const float* wp_ = (d).W + (size_t)((d).k0 + (lane >> 5)) * (d).N + (d).sc + (c_ < (d).nv ? c_ : 0); \
        _Pragma("unroll") for (int i = 0; i < 32; ++i) tv[i] = wp_[(size_t)(2 * i) * (d).N]; } while (0)
#define CONV_STORE(d, tv) do { const int c_ = lane & 31; const bool ok_ = c_ < (d).nv; _Pragma("unroll") for (int i = 0; i < 32; ++i) { const int kk = 2 * i + (lane >> 5); scr[kk * 33 + c_] = ok_ ? tv[i] : 0.f; } \
        asm volatile("s_waitcnt lgkmcnt(0)" ::: "memory"); \
        const int c8 = lane & 7; f32x4 ga = {1.f, 1.f, 1.f, 1.f}, gb = {1.f, 1.f, 1.f, 1.f}; \
        if ((d).gain) { ga = *(const f32x4*)((d).gain + (d).k0 + 8 * c8); gb = *(const f32x4*)((d).gain + (d).k0 + 8 * c8 + 4); } \
        _Pragma("unroll") for (int j = 0; j < 4; ++j) { const int n = (lane >> 3) + 8 * j; const LAS float* s = scr + (8 * c8) * 33 + n; \
            u32x4 o; o.x = pk2(s[0 * 33] * ga.x, s[1 * 33] * ga.y); o.y = pk2(s[2 * 33] * ga.z, s[3 * 33] * ga.w); o.z = pk2(s[4 * 33] * gb.x, s[5 * 33] * gb.y); o.w = pk2(s[6 * 33] * gb.z, s[7 * 33] * gb.w); \
            const int na_ = (d).drow + n, ka_ = (d).k0 + 8 * c8; \
            const size_t off_ = (d).frag ? (size_t)((((na_ >> 4) * 128 + (ka_ >> 5)) * 64 + (((ka_ >> 3) & 3) * 16 + (na_ & 15))) * 8) : (size_t)na_ * (d).dK + ka_; \
            if ((d).f8) { int w0_ = 0, w1_ = 0; \
                w0_ = __builtin_amdgcn_cvt_pk_fp8_f32(s[0 * 33] * ga.x * W8_SCALE, s[1 * 33] * ga.y * W8_SCALE, w0_, false); w0_ = __builtin_amdgcn_cvt_pk_fp8_f32(s[2 * 33] * ga.z * W8_SCALE, s[3 * 33] * ga.w * W8_SCALE, w0_, true); \
                w1_ = __builtin_amdgcn_cvt_pk_fp8_f32(s[4 * 33] * gb.x * W8_SCALE, s[5 * 33] * gb.y * W8_SCALE, w1_, false); w1_ = __builtin_amdgcn_cvt_pk_fp8_f32(s[6 * 33] * gb.z * W8_SCALE, s[7 * 33] * gb.w * W8_SCALE, w1_, true); \
                u32x2 o8_; o8_.x = (unsigned)w0_; o8_.y = (unsigned)w1_; *(u32x2*)((unsigned char*)(d).WT + off_) = o8_; } \
            else *(u32x4*)((d).WT + off_) = o; } \
        asm volatile("s_waitcnt lgkmcnt(0)" ::: "memory"); } while (0)

constexpr int STRIP_RS = 4100, N_STRIPS_L = 184 + 352;
static_assert(32 * STRIP_RS <= MISC_OFF, "LDS map");
struct StripDesc { const float* W; const float* gain; unsigned char* dst; float* dsc; int N, sc, nv, drow; };
__device__ __forceinline__ StripDesc strip_desc(const Params& p, int s) {
    const int l = s / N_STRIPS_L, r = s - l * N_STRIPS_L; StripDesc d;
    if (r < 184) { const int n0 = 32 * r; int sc, nv;
        if (n0 < 2560) { sc = n0; nv = 32; } else if (n0 < 5632) { sc = n0 + 24; nv = 32; } else if (n0 == 5632) { sc = 2560; nv = 24; } else { sc = 0; nv = 0; }
        d.W = p.in[3] + (size_t)l * DM * DIN; d.N = DIN; d.sc = sc; d.nv = nv; d.gain = p.in[2] + (size_t)l * DM;
        d.dst = p.ws + WS_WI8 + (size_t)l * 12 * MiB; d.dsc = (float*)(p.ws + WS_WISC) + l * DINP; d.drow = n0; }
    else { const int r0 = 32 * (r - 184), pn = r0 >> 8, w = r0 & 255;
        d.W = (w < 128 ? p.in[13] : p.in[14]) + (size_t)l * DM * DFF; d.N = DFF; d.sc = 128 * pn + (w & 127); d.nv = 32; d.gain = p.in[12] + (size_t)l * DM;
        d.dst = p.ws + WS_W8 + (size_t)l * 22 * MiB; d.dsc = (float*)(p.ws + WS_WSC) + l * 2 * DFF; d.drow = r0; }
    return d;
}
#define STRIP_LOAD(d, k0, tv) do { const int c_ = lane & 31; const float* wp_ = (d).W + (size_t)((k0) + (lane >> 5)) * (d).N + (d).sc + (c_ < (d).nv ? c_ : 0); \
        _Pragma("unroll") for (int i = 0; i < 32; ++i) tv[i] = wp_[(size_t)(2 * i) * (d).N]; } while (0)
#define STRIP_PUT(d, k0, tv) do { const int c_ = lane & 31, hi_ = lane >> 5; const bool ok_ = c_ < (d).nv; \
        _Pragma("unroll") for (int pp = 0; pp < 16; ++pp) { \
            auto sw_ = __builtin_amdgcn_permlane32_swap(__float_as_uint(tv[2 * pp]), __float_as_uint(tv[2 * pp + 1]), false, false); \
            const float v0_ = __uint_as_float(sw_[0]), v1_ = __uint_as_float(sw_[1]);         \
            const f32x4 g_ = *(const f32x4*)((d).gain + (k0) + 4 * pp); \
            const float g0_ = hi_ ? g_.z : g_.x, g1_ = hi_ ? g_.w : g_.y; \
            *(LAS unsigned*)(c.lds + c_ * STRIP_RS + ((k0) + 4 * pp + 2 * hi_) * 2) = ok_ ? pk2(v0_ * g0_, v1_ * g1_) : 0u; } } while (0)
__device__ __forceinline__ void conv_strips(const Params& p, const Ctx& c) {
    const int lane = c.lane, w = c.wave, total = NL * N_STRIPS_L, step = c.ngw / NWAVES;
    int s = c.bx; float ta[32], tb[32]; StripDesc d{}, d1{};
    if (s < total) { d = strip_desc(p, s); STRIP_LOAD(d, 256 * w, ta); }
    while (s < total) {
        STRIP_LOAD(d, 256 * w + 64, tb);  STRIP_PUT(d, 256 * w, ta);
        STRIP_LOAD(d, 256 * w + 128, ta); STRIP_PUT(d, 256 * w + 64, tb);
        STRIP_LOAD(d, 256 * w + 192, tb); STRIP_PUT(d, 256 * w + 128, ta);
        const int s1 = s + step;
        if (s1 < total) { d1 = strip_desc(p, s1); STRIP_LOAD(d1, 256 * w, ta); }
        STRIP_PUT(d, 256 * w + 192, tb);
        __syncthreads();
#pragma unroll 1
        for (int q = 0; q < 4; ++q) { const int n = w + 8 * q;
            bf16x8 v[4];
#pragma unroll
            for (int j = 0; j < 4; ++j) { const LAS unsigned* q_ = (const LAS unsigned*)(c.lds + n * STRIP_RS + (lane + 64 * j) * 16); u32x4 t_; t_.x = q_[0]; t_.y = q_[1]; t_.z = q_[2]; t_.w = q_[3]; v[j] = __builtin_bit_cast(bf16x8, t_); }
            float mx = 0.f;
#pragma unroll
            for (int j = 0; j < 4; ++j)
#pragma unroll
                for (int e = 0; e < 8; ++e) mx = fmaxf(mx, fabsf((float)v[j][e]));
            mx = wave_max_u(mx);
            const float inv = mx > 0.f ? 127.0f / mx : 0.f;
#pragma unroll
            for (int j = 0; j < 4; ++j) { unsigned ww[2];
#pragma unroll
                for (int h = 0; h < 2; ++h) { unsigned u = 0u;
#pragma unroll
                    for (int e = 0; e < 4; ++e) { const int qv = (int)__builtin_rintf((float)v[j][4 * h + e] * inv); u |= ((unsigned)qv & 0xFFu) << (8 * e); }
                    ww[h] = u; }
                u32x2 o; o.x = ww[0]; o.y = ww[1]; ((u32x2*)(d.dst + (size_t)(d.drow + n) * DM))[lane + 64 * j] = o; }
            if (lane == 0) d.dsc[d.drow + n] = mx * (1.0f / 127.0f); }
        __syncthreads();
        d = d1; s = s1;
    }
}
__device__ __forceinline__ void phase_conv(const Params& p, const Ctx& c) {
    LAS float* scr = (LAS float*)(c.lds + c.wave * 8704);
    const int lane = c.lane;
    { float* cbp = (float*)(p.ws + WS_CBP);
      for (int task = c.gw; task < NL * 2 * 4 * 64; task += c.ngw) { const int ic = task & 63, jg = (task >> 6) & 3, kv = (task >> 8) & 1, l = task >> 9;
          const float* w1 = p.in[kv ? 8 : 6] + (size_t)l * 4096 * 256 + (size_t)(64 * ic) * 256 + 64 * jg + c.lane; const float* cp = p.in[5] + (size_t)l * 4096 + 64 * ic;
          float s = 0.f;
#pragma unroll
          for (int b = 0; b < 4; ++b) { float wv[16];
#pragma unroll
              for (int i = 0; i < 16; ++i) wv[i] = w1[(size_t)(16 * b + i) * 256];
#pragma unroll
              for (int i = 0; i < 16; ++i) s += cp[16 * b + i] * wv[i]; }
          cbp[((l * 2 + kv) * 64 + ic) * 256 + 64 * jg + c.lane] = s; } }
    { const int total = NL * I_LAYER; int it = c.gw;
      float ta[32], tb[32]; ConvItem da, db;
      if (it < total) { da = conv_desc(p, it); CONV_LOAD(da, ta); }
      while (it < total) {
          const int i1 = it + c.ngw;
          if (i1 < total) { db = conv_desc(p, i1); CONV_LOAD(db, tb); }
          CONV_STORE(da, ta);
          if (i1 >= total) break;
          const int i2 = i1 + c.ngw;
          if (i2 < total) { da = conv_desc(p, i2); CONV_LOAD(da, ta); }
          CONV_STORE(db, tb);
          it = i2;
      } }
    __syncthreads();
    conv_strips(p, c);
    { bf16_t* hb = (bf16_t*)(p.ws + WS_XN); float* ssq = (float*)(p.ws + WS_SSQ);
      for (int m = c.gw; m < S; m += c.ngw) {
          const f32x4* xr = (const f32x4*)(p.in[0] + (size_t)m * DM) + c.lane; float ss = 0.f; f32x4 xv[8];
#pragma unroll
          for (int j = 0; j < 8; ++j) xv[j] = xr[64 * j];
          float mx = 0.f;
#pragma unroll
          for (int j = 0; j < 8; ++j) { const f32x4 v = xv[j]; ss += (v.x * v.x + v.y * v.y) + (v.z * v.z + v.w * v.w);
              u32x2 w; w.x = pk2(v.x, v.y); w.y = pk2(v.z, v.w); ((u32x2*)(hb + (size_t)m * DM))[c.lane + 64 * j] = w;
              const bf16x4 h4 = __builtin_bit_cast(bf16x4, w);
#pragma unroll
              for (int e = 0; e < 4; ++e) { xv[j][e] = (float)h4[e]; mx = fmaxf(mx, fabsf(xv[j][e])); } }
          ss = wave_sum(ss); mx = wave_max_u(mx);
          if (c.lane < 8) ssq[(size_t)m * 8 + c.lane] = c.lane == 0 ? ss : 0.f;
          const float inv = mx > 0.f ? 127.0f / mx : 0.f;
#pragma unroll
          for (int j = 0; j < 8; ++j) { unsigned u = 0u;
#pragma unroll
              for (int e = 0; e < 4; ++e) { const int qv = (int)__builtin_rintf(xv[j][e] * inv); u |= ((unsigned)qv & 0xFFu) << (8 * e); }
              ((unsigned*)(p.ws + WS_XN8 + (size_t)m * DM))[c.lane + 64 * j] = u; }
          if (c.lane == 0) ((float*)(p.ws + WS_ASC))[m] = mx * (1.0f / 127.0f); } }
    { const int* pos = (const int*)p.in[1]; float* tab = (float*)(p.ws + WS_ROPE); bf16_t* tabh = (bf16_t*)(p.ws + WS_ROPEH);
      for (int idx = c.gw * 64 + c.lane; idx < S * 16; idx += c.ngw * 64) { const int t = idx >> 4, i = idx & 15;
          const float ang = (float)pos[t] * rope_inv(i); float cs, sn; sincos_d(ang, cs, sn); tab[t * 32 + i] = cs; tab[t * 32 + 16 + i] = sn; tabh[t * 32 + i] = (bf16_t)f2bf(cs); tabh[t * 32 + 16 + i] = (bf16_t)f2bf(sn); } }
}

__device__ __forceinline__ void cbias_reduce(const Params& p, const Ctx& c) {
    const float* cbp = (const float*)(p.ws + WS_CBP); float* cbf = (float*)(p.ws + WS_CBF);
    for (int o = c.gw; o < NL * 2 * 256; o += c.ngw) { const int col = o & 255, lk = o >> 8;
        const float v = wave_sum(cbp[(size_t)(lk * 64 + c.lane) * 256 + col]); if (c.lane == 0) cbf[o] = v; }
}

__device__ __forceinline__ void phase_final_norm(const Ctx& c, const bf16_t* hb, const float* ssq, const float* gain, float* dst) {
    f32x4 g[4][2];
#pragma unroll
    for (int j = 0; j < 4; ++j) { g[j][0] = ((const f32x4*)gain)[2 * (c.lane + 64 * j)]; g[j][1] = ((const f32x4*)gain)[2 * (c.lane + 64 * j) + 1]; }
    for (int m = c.gw; m < S; m += c.ngw) {
        const f32x4* q = (const f32x4*)(ssq + (size_t)m * 8); const f32x4 a = q[0], b = q[1];
        bf16x8 v[4];
#pragma unroll
        for (int j = 0; j < 4; ++j) v[j] = ((const bf16x8*)(hb + (size_t)m * DM))[c.lane + 64 * j];
        const float rstd = __builtin_amdgcn_rsqf((((a.x + a.y) + (a.z + a.w)) + ((b.x + b.y) + (b.z + b.w))) * (1.0f / DM) + EPS);
#pragma unroll
        for (int j = 0; j < 4; ++j) { f32x4 o0, o1;
#pragma unroll
            for (int e = 0; e < 4; ++e) { o0[e] = (float)v[j][e] * rstd * g[j][0][e]; o1[e] = (float)v[j][4 + e] * rstd * g[j][1][e]; }
            f32x4* d = (f32x4*)(dst + (size_t)m * DM) + 2 * (c.lane + 64 * j); d[0] = o0; d[1] = o1; }
    }
}

__device__ __forceinline__ void quant_rows(const Ctx& c, const bf16_t* src, unsigned char* dst, float* scale, int R, float fixed = 0.f) {
    for (int r = c.gw; r < R; r += c.ngw) {
        bf16x8 v[4];
#pragma unroll
        for (int j = 0; j < 4; ++j) v[j] = ((const bf16x8*)(src + (size_t)r * DM))[c.lane + 64 * j];
        float mx = 0.f;
#pragma unroll
        for (int j = 0; j < 4; ++j)
#pragma unroll
            for (int e = 0; e < 8; ++e) mx = fmaxf(mx, fabsf((float)v[j][e]));
        mx = wave_max_u(mx);
        if (fixed > 0.f) mx = fixed;
        const float inv = mx > 0.f ? 127.0f / mx : 0.f;
#pragma unroll
        for (int j = 0; j < 4; ++j) { unsigned w[2];
#pragma unroll
            for (int h = 0; h < 2; ++h) { unsigned u = 0u;
#pragma unroll
                for (int e = 0; e < 4; ++e) { int q = (int)__builtin_rintf((float)v[j][4 * h + e] * inv); q = q > 127 ? 127 : (q < -127 ? -127 : q); u |= ((unsigned)q & 0xFFu) << (8 * e); }
                w[h] = u; }
            u32x2 o; o.x = w[0]; o.y = w[1]; ((u32x2*)(dst + (size_t)r * DM))[c.lane + 64 * j] = o; }
        if (c.lane == 0) scale[r] = mx * (1.0f / 127.0f);
    }
}

constexpr int RSTD_OFF = RING_BYTES, RSTD_MAX_UNITS = 8;
constexpr int CSC_OFF = RSTD_OFF + RSTD_MAX_UNITS * 1024, CSC_MAX_UNITS = 6;
static_assert(CSC_OFF + CSC_MAX_UNITS * 1024 <= MISC_OFF, "LDS map");
__device__ __forceinline__ void prep_rstd(const Ctx& c, const pg8::StaticOrder& so, const float* ssq, const float* asc = nullptr, const float* wsc = nullptr) {
    LAS float* tab = (LAS float*)(c.lds + RSTD_OFF); LAS float* ctab = (LAS float*)(c.lds + CSC_OFF);
    const int half = c.tid >> 8, t = c.tid & 255;
    for (int i = half; i < RSTD_MAX_UNITS; i += 2) { pg8::Unit u; if (!so.next(i, u)) break;
        const f32x4* q = (const f32x4*)(ssq + (size_t)(u.pm * 256 + t) * 8); const f32x4 a = q[0], b = q[1];
        float rs = __builtin_amdgcn_rsqf((((a.x + a.y) + (a.z + a.w)) + ((b.x + b.y) + (b.z + b.w))) * (1.0f / DM) + EPS);
        if (asc) { rs *= asc[u.pm * 256 + t]; if (i < CSC_MAX_UNITS) ctab[i * 256 + t] = wsc[u.pn * 256 + t]; }
        tab[i * 256 + t] = rs; }
}
struct PrepRstd { const Ctx& c; const pg8::StaticOrder& so; const float* ssq; const float* asc; const float* wsc; __device__ __forceinline__ void operator()() const { prep_rstd(c, so, ssq, asc, wsc); } };
struct EpiProj {
    static constexpr bool PERM = true, AFTER_DRAIN = false;
    bf16_t* proj; float* gates; const bf16_t* ropeh; const float* bg; const LAS float* rtab; const LAS float* ctab;
    __device__ __forceinline__ void operator()(pg8::f32x4 (&acc)[2][2][4][2], const pg8::Unit& u, int wr, int wc, int fr, int fq) const {
        const int row0 = u.pm * 256 + wr * 64 + fr;
        {
            const LAS f32x4* cs = (const LAS f32x4*)(ctab + u.ord * 256 + wc * 32 + 8 * fq);
#pragma unroll
            for (int bj = 0; bj < 2; ++bj) { const f32x4 c0 = cs[32 * bj], c1 = cs[32 * bj + 1];
#pragma unroll
                for (int ai = 0; ai < 2; ++ai)
#pragma unroll
                    for (int m = 0; m < 4; ++m) { const pg8::i32x4 i0 = __builtin_bit_cast(pg8::i32x4, acc[ai][bj][m][0]), i1 = __builtin_bit_cast(pg8::i32x4, acc[ai][bj][m][1]);
#pragma unroll
                        for (int j = 0; j < 4; ++j) { acc[ai][bj][m][0][j] = (float)i0[j] * c0[j]; acc[ai][bj][m][1][j] = (float)i1[j] * c1[j]; } } }
        }
        float rstd[2][4];
#pragma unroll
        for (int ai = 0; ai < 2; ++ai)
#pragma unroll
            for (int m = 0; m < 4; ++m) rstd[ai][m] = rtab[u.ord * 256 + ai * 128 + wr * 64 + m * 16 + fr];
        const bool rp = (u.pn < 4 || u.pn == 6 || u.pn == 8) && wc == 0;
        if (rp) {
#pragma unroll
            for (int ai = 0; ai < 2; ++ai) {
                bf16x8 rc[4], rsn[4];
#pragma unroll
                for (int m = 0; m < 4; ++m) { const bf16_t* cs = ropeh + (size_t)(row0 + ai * 128 + m * 16) * 32 + (fq & 1) * 8; rc[m] = *(const bf16x8*)cs; rsn[m] = *(const bf16x8*)(cs + 16); }
#pragma unroll
                for (int m = 0; m < 4; ++m) {
                    f32x4 c0, c1, s0, s1;
#pragma unroll
                    for (int j = 0; j < 4; ++j) { c0[j] = (float)rc[m][j]; c1[j] = (float)rc[m][4 + j]; s0[j] = (float)rsn[m][j]; s1[j] = (float)rsn[m][4 + j]; }
                    if (fq < 2) { s0 = -s0; s1 = -s1; }
#pragma unroll
                    for (int bj = 0; bj < 2; ++bj) {
                        const f32x4 v0 = acc[ai][bj][m][0] * rstd[ai][m], v1 = acc[ai][bj][m][1] * rstd[ai][m]; f32x4 q0, q1;
#pragma unroll
                        for (int j = 0; j < 4; ++j) { q0[j] = partner32(v0[j], fq >> 1); q1[j] = partner32(v1[j], fq >> 1); }
                        acc[ai][bj][m][0] = v0 * c0 + q0 * s0; acc[ai][bj][m][1] = v1 * c1 + q1 * s1;
                    }
                }
            }
        }
        if (u.pn < 22) {
#pragma unroll
            for (int bj = 0; bj < 2; ++bj) {
                bf16_t* base = proj + (size_t)(2 * u.pn + bj) * S * HD + wc * 32 + 8 * fq;
#pragma unroll
                for (int ai = 0; ai < 2; ++ai)
#pragma unroll
                    for (int m = 0; m < 4; ++m) {
                        const float rs = rp ? 1.0f : rstd[ai][m];
                        const f32x4 v0 = acc[ai][bj][m][0] * rs, v1 = acc[ai][bj][m][1] * rs;
                        u32x4 w; w.x = pk2(v0[0], v0[1]); w.y = pk2(v0[2], v0[3]); w.z = pk2(v1[0], v1[1]); w.w = pk2(v1[2], v1[3]);
                        *(u32x4*)(base + (size_t)(row0 + ai * 128 + m * 16) * HD) = w;
                    }
            }
        } else {
            if (wc == 0 && fq < 3) {
                const f32x4 b0 = *(const f32x4*)(bg + 8 * fq), b1 = *(const f32x4*)(bg + 8 * fq + 4);
#pragma unroll
                for (int ai = 0; ai < 2; ++ai)
#pragma unroll
                    for (int m = 0; m < 4; ++m) {
                        f32x4 g0 = acc[ai][0][m][0] * rstd[ai][m] + b0, g1 = acc[ai][0][m][1] * rstd[ai][m] + b1;
#pragma unroll
                        for (int j = 0; j < 4; ++j) { g0[j] = sigmoidf_(g0[j]); g1[j] = sigmoidf_(g1[j]); }
                        f32x4* d = (f32x4*)(gates + (size_t)(row0 + ai * 128 + m * 16) * 24 + 8 * fq); d[0] = g0; d[1] = g1;
                    }
            }
        }
    }
};
struct EpiResid {
    static constexpr bool PERM = false, AFTER_DRAIN = false;
    const float* hin; float* hout;
    __device__ __forceinline__ void operator()(const pg8::f32x4 (&acc)[2][2][4][2], const pg8::Unit& u, int wr, int wc, int fr, int fq) const {
        const int row0 = u.pm * 256 + wr * 64 + fr, col0 = u.pn * 256 + wc * 32 + 4 * fq;
#pragma unroll
        for (int ai = 0; ai < 2; ++ai)
#pragma unroll
            for (int m = 0; m < 4; ++m) { const size_t off = (size_t)(row0 + ai * 128 + m * 16) * DM + col0;
#pragma unroll
                for (int bj = 0; bj < 2; ++bj)
#pragma unroll
                    for (int n = 0; n < 2; ++n) { const size_t o = off + bj * 128 + n * 16; *(f32x4*)(hout + o) = *(const f32x4*)(hin + o) + acc[ai][bj][m][n]; } }
    }
};
struct EpiFinal {
    static constexpr bool PERM = true, AFTER_DRAIN = true;
    const bf16_t* hb; float mult; float* out; const float* gain; float* xslab; unsigned* xcnt; unsigned target;
    __device__ __forceinline__ void fused(pg8::f32x4 (&acc)[2][2][4][2], const pg8::Unit& u, int wr, int wc, int fr, int fq, PG8_LAS unsigned char* lds, int wid, int lane) const {
        const int row0 = u.pm * 256 + wr * 64 + fr, col0 = u.pn * 256 + wc * 32 + 8 * fq;
        PG8_LAS float* P = (PG8_LAS float*)lds;
        PG8_LAS float* INV = (PG8_LAS float*)(lds + 8192);
#pragma unroll
        for (int ai = 0; ai < 2; ++ai) {
            bf16x8 hv[4][2];
#pragma unroll
            for (int m = 0; m < 4; ++m)
#pragma unroll
                for (int bj = 0; bj < 2; ++bj) hv[m][bj] = *(const bf16x8*)(hb + (size_t)(row0 + ai * 128 + m * 16) * DM + col0 + bj * 128);
#pragma unroll
            for (int m = 0; m < 4; ++m) { float ss = 0.f;
#pragma unroll
                for (int bj = 0; bj < 2; ++bj) { f32x4 v0 = acc[ai][bj][m][0] * mult, v1 = acc[ai][bj][m][1] * mult;
#pragma unroll
                    for (int e = 0; e < 4; ++e) { v0[e] += (float)hv[m][bj][e]; v1[e] += (float)hv[m][bj][4 + e]; }
                    acc[ai][bj][m][0] = v0; acc[ai][bj][m][1] = v1;
                    ss += ((v0.x * v0.x + v0.y * v0.y) + (v0.z * v0.z + v0.w * v0.w)) + ((v1.x * v1.x + v1.y * v1.y) + (v1.z * v1.z + v1.w * v1.w)); }
                ss += __builtin_bit_cast(float, __builtin_amdgcn_ds_swizzle(__builtin_bit_cast(int, ss), 0x401F)); ss += partner32(ss, fq >> 1);
                if (fq == 0) P[(ai * 128 + wr * 64 + m * 16 + fr) * 4 + wc] = ss;
                asm volatile("" ::: "memory"); } }
        asm volatile("s_waitcnt lgkmcnt(0)" ::: "memory"); __builtin_amdgcn_s_barrier(); asm volatile("" ::: "memory");
        const int t = wid * 64 + lane;
        if (t < 256) { const PG8_LAS float* q = P + t * 4; __hip_atomic_store(xslab + (size_t)(u.pm * 8 + u.pn) * 256 + t, (q[0] + q[1]) + (q[2] + q[3]), __ATOMIC_RELAXED, __HIP_MEMORY_SCOPE_AGENT); }
        asm volatile("s_waitcnt vmcnt(0)" ::: "memory");
        __syncthreads();
        if (t == 0) { (void)__hip_atomic_fetch_add(xcnt + 64 * u.pm, 1u, __ATOMIC_RELAXED, __HIP_MEMORY_SCOPE_AGENT);
            unsigned spins = 0; while (__hip_atomic_load(xcnt + 64 * u.pm, __ATOMIC_RELAXED, __HIP_MEMORY_SCOPE_AGENT) < target && ++spins < (1u << 22)) __builtin_amdgcn_s_sleep(1); }
        __syncthreads();
        if (t < 256) { float p8[8];
#pragma unroll
            for (int j = 0; j < 8; ++j) p8[j] = __hip_atomic_load(xslab + (size_t)(u.pm * 8 + j) * 256 + t, __ATOMIC_RELAXED, __HIP_MEMORY_SCOPE_AGENT);
            INV[t] = __builtin_amdgcn_rsqf((((p8[0] + p8[1]) + (p8[2] + p8[3])) + ((p8[4] + p8[5]) + (p8[6] + p8[7]))) * (1.0f / DM) + EPS); }
        asm volatile("s_waitcnt lgkmcnt(0)" ::: "memory"); __builtin_amdgcn_s_barrier(); asm volatile("" ::: "memory");
        f32x4 gn[2][2];
#pragma unroll
        for (int bj = 0; bj < 2; ++bj) { gn[bj][0] = *(const f32x4*)(gain + col0 + bj * 128); gn[bj][1] = *(const f32x4*)(gain + col0 + bj * 128 + 4); }
#pragma unroll
        for (int ai = 0; ai < 2; ++ai)
#pragma unroll
            for (int m = 0; m < 4; ++m) { const float rs = INV[ai * 128 + wr * 64 + m * 16 + fr]; float* orow = out + (size_t)(row0 + ai * 128 + m * 16) * DM + col0;
#pragma unroll
                for (int bj = 0; bj < 2; ++bj) { *(f32x4*)(orow + bj * 128) = acc[ai][bj][m][0] * rs * gn[bj][0]; *(f32x4*)(orow + bj * 128 + 4) = acc[ai][bj][m][1] * rs * gn[bj][1]; } }
    }
};
struct EpiResidH {
    static constexpr bool PERM = true, AFTER_DRAIN = true;
    bf16_t* hb; float* ssq; float mult;
    unsigned char* q8; float* qsc; float* xslab; unsigned* xcnt; unsigned target;
    __device__ __forceinline__ void fused(pg8::f32x4 (&acc)[2][2][4][2], const pg8::Unit& u, int wr, int wc, int fr, int fq, PG8_LAS unsigned char* lds, int wid, int lane) const {
        const int row0 = u.pm * 256 + wr * 64 + fr, col0 = u.pn * 256 + wc * 32 + 8 * fq;
        PG8_LAS float* P = (PG8_LAS float*)lds;
        PG8_LAS float* PM = (PG8_LAS float*)(lds + 4096);
        PG8_LAS float* INV = (PG8_LAS float*)(lds + 8192);
#pragma unroll
        for (int ai = 0; ai < 2; ++ai) {
            bf16x8 hv[4][2];
#pragma unroll
            for (int m = 0; m < 4; ++m)
#pragma unroll
                for (int bj = 0; bj < 2; ++bj) hv[m][bj] = *(const bf16x8*)(hb + (size_t)(row0 + ai * 128 + m * 16) * DM + col0 + bj * 128);
#pragma unroll
            for (int m = 0; m < 4; ++m) { const size_t off = (size_t)(row0 + ai * 128 + m * 16) * DM + col0; float ss = 0.f, am = 0.f;
#pragma unroll
                for (int bj = 0; bj < 2; ++bj) { f32x4 v0 = acc[ai][bj][m][0] * mult, v1 = acc[ai][bj][m][1] * mult;
#pragma unroll
                    for (int e = 0; e < 4; ++e) { v0[e] += (float)hv[m][bj][e]; v1[e] += (float)hv[m][bj][4 + e]; }
                    u32x4 w; w.x = pk2(v0.x, v0.y); w.y = pk2(v0.z, v0.w); w.z = pk2(v1.x, v1.y); w.w = pk2(v1.z, v1.w); *(u32x4*)(hb + off + bj * 128) = w;
                    acc[ai][bj][m][0] = v0; acc[ai][bj][m][1] = v1;
#pragma unroll
                    for (int e = 0; e < 4; ++e) am = fmaxf(am, fmaxf(fabsf(v0[e]), fabsf(v1[e])));
                    ss += ((v0.x * v0.x + v0.y * v0.y) + (v0.z * v0.z + v0.w * v0.w)) + ((v1.x * v1.x + v1.y * v1.y) + (v1.z * v1.z + v1.w * v1.w)); }
                ss += __builtin_bit_cast(float, __builtin_amdgcn_ds_swizzle(__builtin_bit_cast(int, ss), 0x401F)); ss += partner32(ss, fq >> 1);
                am = fmaxf(am, __builtin_bit_cast(float, __builtin_amdgcn_ds_swizzle(__builtin_bit_cast(int, am), 0x401F))); am = fmaxf(am, partner32(am, fq >> 1));
                if (fq == 0) { P[(ai * 128 + wr * 64 + m * 16 + fr) * 4 + wc] = ss; PM[(ai * 128 + wr * 64 + m * 16 + fr) * 4 + wc] = am; }
                asm volatile("" ::: "memory"); } }
        asm volatile("s_waitcnt lgkmcnt(0)" ::: "memory"); __builtin_amdgcn_s_barrier(); asm volatile("" ::: "memory");
        const int t = wid * 64 + lane;
        if (q8) {
            if (t < 256) { const PG8_LAS float* q = PM + t * 4; __hip_atomic_store(xslab + (size_t)(u.pm * 8 + u.pn) * 256 + t, fmaxf(fmaxf(q[0], q[1]), fmaxf(q[2], q[3])), __ATOMIC_RELAXED, __HIP_MEMORY_SCOPE_AGENT); }
            asm volatile("s_waitcnt vmcnt(0)" ::: "memory");
        }
        if (t < 256) { const PG8_LAS float* q = P + t * 4; ssq[(size_t)(u.pm * 256 + t) * 8 + u.pn] = (q[0] + q[1]) + (q[2] + q[3]); }
        if (q8) {
            __syncthreads();
            if (t == 0) { (void)__hip_atomic_fetch_add(xcnt + 64 * u.pm, 1u, __ATOMIC_RELAXED, __HIP_MEMORY_SCOPE_AGENT);
                unsigned spins = 0; while (__hip_atomic_load(xcnt + 64 * u.pm, __ATOMIC_RELAXED, __HIP_MEMORY_SCOPE_AGENT) < target && ++spins < (1u << 22)) __builtin_amdgcn_s_sleep(1); }
            __syncthreads();
            if (t < 256) { float pm8[8];
#pragma unroll
                for (int j = 0; j < 8; ++j) pm8[j] = __hip_atomic_load(xslab + (size_t)(u.pm * 8 + j) * 256 + t, __ATOMIC_RELAXED, __HIP_MEMORY_SCOPE_AGENT);
                const float mx = fmaxf(fmaxf(fmaxf(pm8[0], pm8[1]), fmaxf(pm8[2], pm8[3])), fmaxf(fmaxf(pm8[4], pm8[5]), fmaxf(pm8[6], pm8[7])));
                INV[t] = mx > 0.f ? 127.0f / mx : 0.f;
                if (u.pn == 0) qsc[u.pm * 256 + t] = mx * (1.0f / 127.0f); }
            asm volatile("s_waitcnt lgkmcnt(0)" ::: "memory"); __builtin_amdgcn_s_barrier(); asm volatile("" ::: "memory");
#pragma unroll
            for (int ai = 0; ai < 2; ++ai)
#pragma unroll
                for (int m = 0; m < 4; ++m) { const float inv = INV[ai * 128 + wr * 64 + m * 16 + fr]; const size_t off = (size_t)(row0 + ai * 128 + m * 16) * DM + col0;
#pragma unroll
                    for (int bj = 0; bj < 2; ++bj) { unsigned w[2];
#pragma unroll
                        for (int n = 0; n < 2; ++n) { const f32x4 v = acc[ai][bj][m][n]; unsigned uu = 0u;
#pragma unroll
                            for (int e = 0; e < 4; ++e) { int q = (int)__builtin_rintf(v[e] * inv); q = q > 127 ? 127 : (q < -127 ? -127 : q); uu |= ((unsigned)q & 0xFFu) << (8 * e); }
                            w[n] = uu; }
                        u32x2 o; o.x = w[0]; o.y = w[1]; *(u32x2*)(q8 + off + bj * 128) = o; } }
        }
    }
};

struct EpiSwiGLU {
    static constexpr bool PERM = true, AFTER_DRAIN = false;
    unsigned char* act; const LAS float* rtab; const LAS float* ctab;
    __device__ __forceinline__ void operator()(const pg8::f32x4 (&acc)[2][2][4][2], const pg8::Unit& u, int wr, int wc, int fr, int fq) const {
        const int row0 = u.pm * 256 + wr * 64 + fr, col0 = u.pn * 128 + wc * 32 + 8 * fq;
        const LAS f32x4* cs = (const LAS f32x4*)(ctab + u.ord * 256 + wc * 32 + 8 * fq);
        const f32x4 cg0 = cs[0], cg1 = cs[1], cu0 = cs[32], cu1 = cs[33];
#pragma unroll
        for (int ai = 0; ai < 2; ++ai)
#pragma unroll
            for (int m = 0; m < 4; ++m) {
                const float rs = rtab[u.ord * 256 + ai * 128 + wr * 64 + m * 16 + fr];
                f32x4 g0, g1, u0, u1;
                const pg8::i32x4 ig0 = __builtin_bit_cast(pg8::i32x4, acc[ai][0][m][0]), ig1 = __builtin_bit_cast(pg8::i32x4, acc[ai][0][m][1]);
                const pg8::i32x4 iu0 = __builtin_bit_cast(pg8::i32x4, acc[ai][1][m][0]), iu1 = __builtin_bit_cast(pg8::i32x4, acc[ai][1][m][1]);
#pragma unroll
                for (int j = 0; j < 4; ++j) {
                    g0[j] = (float)ig0[j] * (rs * cg0[j]); g1[j] = (float)ig1[j] * (rs * cg1[j]);
                    u0[j] = (float)iu0[j] * (rs * cu0[j]); u1[j] = (float)iu1[j] * (rs * cu1[j]); }
                f32x4 o0, o1;
#pragma unroll
                for (int j = 0; j < 4; ++j) { o0[j] = g0[j] * sigmoidf_(g0[j]) * u0[j]; o1[j] = g1[j] * sigmoidf_(g1[j]) * u1[j]; }
                int w0 = 0, w1 = 0;
                w0 = __builtin_amdgcn_cvt_pk_fp8_f32(o0[0] * A8_SCALE, o0[1] * A8_SCALE, w0, false); w0 = __builtin_amdgcn_cvt_pk_fp8_f32(o0[2] * A8_SCALE, o0[3] * A8_SCALE, w0, true);
                w1 = __builtin_amdgcn_cvt_pk_fp8_f32(o1[0] * A8_SCALE, o1[1] * A8_SCALE, w1, false); w1 = __builtin_amdgcn_cvt_pk_fp8_f32(o1[2] * A8_SCALE, o1[3] * A8_SCALE, w1, true);
                u32x2 w; w.x = (unsigned)w0; w.y = (unsigned)w1;
                *(u32x2*)(act + (size_t)(row0 + ai * 128 + m * 16) * DFF + col0) = w;
            }
    }
};

constexpr int CMPR_A_BYTES = 272 * 256 + 17 * 16, CMPR_HID = 70144;
__device__ __forceinline__ void phase_cmpr(const Params& p, const Ctx& c, int l) {
    const bf16_t* proj = (const bf16_t*)(p.ws + WS_PROJ); const float* rope = (const float*)(p.ws + WS_ROPE); const float* cbf = (const float*)(p.ws + WS_CBF);
    LAS bf16_t* hid = (LAS bf16_t*)(c.lds + CMPR_HID);
    const int lane = c.lane, w = c.wave, l15 = lane & 15, q4 = lane >> 4;
    const int u = c.bx >> 1, hh = c.bx & 1;
    const int kv = u >> 6, g = (u >> 5) & 1, rb = u & 31, n0 = 16 * rb;
    { bf16x8 sv[9];
      const bf16_t* src = proj + (size_t)((kv ? 10 : 8) + g) * S * HD;
#pragma unroll
      for (int i = 0; i < 9; ++i) { int ci = c.tid + NTHREADS * i; if (ci > 272 * 16 - 1) ci = 272 * 16 - 1; const int tk = ci >> 4, ch = ci & 15; int ta = 16 * n0 + tk; if (ta > S - 1) ta = S - 1;
          sv[i] = *(const bf16x8*)(src + (size_t)ta * HD + ch * 8); }
#pragma unroll
      for (int i = 0; i < 9; ++i) { const int ci = c.tid + NTHREADS * i; const int tk = ci >> 4, ch = ci & 15;
          if (ci < 272 * 16) *(LAS bf16x8*)(c.lds + tk * 256 + (tk >> 4) * 16 + ch * 16) = sv[i]; } }
    __syncthreads();
    const int ct = 8 * hh + w;
    const bf16_t* bf = w_ptr(p, l, W_C1) + (size_t)kv * 256 * 4096 + (size_t)ct * 128 * 512 + lane * 8;
    const LAS unsigned char* abase = c.lds + l15 * (4096 + 16) + q4 * 16;
    f32x4 acc = {0.f, 0.f, 0.f, 0.f};
    {
        bf16x8 B0[8], B1[8];
#define CMPR_LD(B_, ks_) do { _Pragma("unroll") for (int i = 0; i < 8; ++i) B_[i] = *(const bf16x8*)(bf + (size_t)((ks_) + i) * 512); } while (0)
#define CMPR_MM(B_, ks_) do { _Pragma("unroll") for (int i = 0; i < 8; ++i) { const int k_ = 32 * ((ks_) + i); \
            const bf16x8 a_ = *(const LAS bf16x8*)(abase + (k_ >> 7) * 256 + ((k_ >> 7) >= 16 ? 16 : 0) + (k_ & 127) * 2); \
            acc = __builtin_amdgcn_mfma_f32_16x16x32_f16(a_, B_[i], acc, 0, 0, 0); } } while (0)
        CMPR_LD(B0, 0);
        for (int ks = 0; ks < 128; ks += 16) {
            CMPR_LD(B1, ks + 8);
            CMPR_MM(B0, ks);
            if (ks + 16 < 128) CMPR_LD(B0, ks + 16);
            CMPR_MM(B1, ks + 8);
        }
#undef CMPR_LD
#undef CMPR_MM
    }
    { const int col = 16 * ct + l15; const float bs = cbf[(l * 2 + kv) * 256 + col];
#pragma unroll
      for (int j = 0; j < 4; ++j) hid[(q4 * 4 + j) * 136 + 16 * w + l15] = (bf16_t)f2bf(gelu_tanh(acc[j] + bs)); }
    __syncthreads();
    f32x4 o = {0.f, 0.f, 0.f, 0.f};
    const int ocol = (w < 2) ? ((l15 < 8) ? 8 * w + l15 : 16 + 8 * w + (l15 - 8)) : 16 * w + l15;
    const bf16_t* w2 = w_ptr(p, l, W_C2) + (size_t)kv * 128 * 256 + (size_t)ocol * 256 + 128 * hh + 8 * q4;
#pragma unroll
    for (int k0 = 0; k0 < 128; k0 += 32) {
        const bf16x8 a = *(const LAS bf16x8*)(hid + l15 * 136 + k0 + 8 * q4), b = *(const bf16x8*)(w2 + k0);
        o = __builtin_amdgcn_mfma_f32_16x16x32_f16(a, b, o, 0, 0, 0);
    }
    float* part = (float*)(p.ws + WS_CPART) + (size_t)u * 2048; unsigned* flag = (unsigned*)(p.ws + WS_CTL) + CW_CFLAG + 64 * u;
    if (hh == 1) {
#pragma unroll
        for (int j = 0; j < 4; ++j) __hip_atomic_store(part + (q4 * 4 + j) * 128 + 16 * w + l15, o[j], __ATOMIC_RELAXED, __HIP_MEMORY_SCOPE_AGENT);
        asm volatile("s_waitcnt vmcnt(0)" ::: "memory");
        __syncthreads();
        if (c.tid == 0) __hip_atomic_store(flag, (unsigned)(l + 1), __ATOMIC_RELAXED, __HIP_MEMORY_SCOPE_AGENT);
    } else {
        if (c.tid == 0) { unsigned spins = 0; while (__hip_atomic_load(flag, __ATOMIC_RELAXED, __HIP_MEMORY_SCOPE_AGENT) != (unsigned)(l + 1) && ++spins < (1u << 22)) __builtin_amdgcn_s_sleep(2); }
        __syncthreads();
        bf16_t* dst = (bf16_t*)(p.ws + (kv ? WS_VC : WS_KC)) + (size_t)g * 512 * HD;
        float pv[4], cs[4], sn[4];
#pragma unroll
        for (int j = 0; j < 4; ++j) { pv[j] = __hip_atomic_load(part + (q4 * 4 + j) * 128 + 16 * w + l15, __ATOMIC_RELAXED, __HIP_MEMORY_SCOPE_AGENT); cs[j] = 1.f; sn[j] = 0.f;
            if (kv == 0 && w < 2) { int ti = 16 * (n0 + q4 * 4 + j) + 31; if (ti > S - 1) ti = S - 1; const int fi = 8 * w + (l15 & 7); cs[j] = rope[ti * 32 + fi]; sn[j] = rope[ti * 32 + 16 + fi]; } }
#pragma unroll
        for (int j = 0; j < 4; ++j) {
            const int n = n0 + q4 * 4 + j; float v = o[j] + pv[j];
            if (kv == 0 && w < 2) { const float pr = DPP_F(0.f, v, 0x128, 0xf);     v = (l15 < 8) ? v * cs[j] - pr * sn[j] : v * cs[j] + pr * sn[j]; }
            if (n > 510) v = 0.f;
            dst[(size_t)n * HD + ocol] = (bf16_t)f2bf(v);
        }
    }
    __syncthreads();
}
typedef float f32x16 __attribute__((ext_vector_type(16)));
typedef _Float16 h4_t __attribute__((ext_vector_type(4)));
#define KSWZ(row, colB) ((row) * 256 + ((colB) ^ (((row) & 7) << 4)))
__device__ __forceinline__ int v_st(int k, int c) { const int kk = (k & ~0xC) | ((k & 4) << 1) | ((k & 8) >> 1); return ((kk >> 3) * 4 + (c >> 5)) * 512 + ((kk & 7) * 32 + (c & 31)) * 2; }
__device__ __forceinline__ int v_rd_base(int lane) { return ((lane & 3) << 3) | (((lane >> 2) & 3) << 6) | (((lane >> 4) & 1) << 5) | (((lane >> 5) & 1) << 8); }
constexpr int v_rd_off(int d0, int ks, int half) { return d0 * 512 + ks * 4096 + half * 2048; }
__device__ __forceinline__ int crow(int r, int hi) { return (r & 3) + 8 * (r >> 2) + 4 * hi; }
__device__ __forceinline__ void qkt(f32x16& p0, f32x16& p1, const LAS char* K_lds, int r32, int hi, const bf16x8* qr) {
#pragma unroll
    for (int r = 0; r < 16; ++r) { p0[r] = 0.f; p1[r] = 0.f; }
    int base = r32 * 256 + ((hi * 16) ^ ((r32 & 7) << 4));
    asm volatile("" : "+v"(base));
#pragma unroll
    for (int d0 = 0; d0 < 8; ++d0) { const LAS char* a = K_lds + (base ^ ((d0 & 3) << 5)) + (d0 >> 2) * 128;
        const bf16x8 b0 = *(const LAS bf16x8*)a, b1 = *(const LAS bf16x8*)(a + 32 * 256);
        p0 = __builtin_amdgcn_mfma_f32_32x32x16_f16(b0, qr[d0], p0, 0, 0, 0);
        p1 = __builtin_amdgcn_mfma_f32_32x32x16_f16(b1, qr[d0], p1, 0, 0, 0);
        if (d0 == 3) __builtin_amdgcn_sched_barrier(0); }
}
__device__ __forceinline__ void pack_p(const f32x16& p0, const f32x16& p1, bf16x8& pa0, bf16x8& pa1, bf16x8& pa2, bf16x8& pa3) {
#define PK4(P, B_, OUT) do { const unsigned a0 = pk2(P[B_ + 0], P[B_ + 1]), a1 = pk2(P[B_ + 2], P[B_ + 3]), b0 = pk2(P[B_ + 4], P[B_ + 5]), b1 = pk2(P[B_ + 6], P[B_ + 7]); \
        auto r0 = __builtin_amdgcn_permlane32_swap(a0, b0, false, false); auto r1 = __builtin_amdgcn_permlane32_swap(a1, b1, false, false); \
        u32x4 w = {r0[0], r1[0], r0[1], r1[1]}; OUT = __builtin_bit_cast(bf16x8, w); } while (0)
    PK4(p0, 0, pa0); PK4(p0, 8, pa1); PK4(p1, 0, pa2); PK4(p1, 8, pa3);
#undef PK4
}
__device__ __forceinline__ void pv_tile(f32x16* o, int vb0, bf16x8 pa0, bf16x8 pa1, bf16x8 pa2, bf16x8 pa3) {
#define TRRD(dst, off) asm volatile("ds_read_b64_tr_b16 %0, %1 offset:%2" : "=&v"(dst) : "v"(vb0), "i"(off) : "memory")
#define PV_D0(d0) do { h4_t l0, l1, l2, l3, h0, h1, h2, h3; constexpr int b_ = v_rd_off(d0, 0, 0); \
        TRRD(l0, b_); TRRD(h0, b_ + 2048); TRRD(l1, b_ + 4096); TRRD(h1, b_ + 6144); TRRD(l2, b_ + 8192); TRRD(h2, b_ + 10240); TRRD(l3, b_ + 12288); TRRD(h3, b_ + 14336); \
        asm volatile("s_waitcnt lgkmcnt(0)" ::: "memory"); __builtin_amdgcn_sched_barrier(0); \
        o[d0] = __builtin_amdgcn_mfma_f32_32x32x16_f16(pa0, (bf16x8){l0[0], l0[1], l0[2], l0[3], h0[0], h0[1], h0[2], h0[3]}, o[d0], 0, 0, 0); \
        o[d0] = __builtin_amdgcn_mfma_f32_32x32x16_f16(pa1, (bf16x8){l1[0], l1[1], l1[2], l1[3], h1[0], h1[1], h1[2], h1[3]}, o[d0], 0, 0, 0); \
        o[d0] = __builtin_amdgcn_mfma_f32_32x32x16_f16(pa2, (bf16x8){l2[0], l2[1], l2[2], l2[3], h2[0], h2[1], h2[2], h2[3]}, o[d0], 0, 0, 0); \
        o[d0] = __builtin_amdgcn_mfma_f32_32x32x16_f16(pa3, (bf16x8){l3[0], l3[1], l3[2], l3[3], h3[0], h3[1], h3[2], h3[3]}, o[d0], 0, 0, 0); } while (0)
    PV_D0(0); PV_D0(1); PV_D0(2); PV_D0(3);
#undef PV_D0
#undef TRRD
}

__device__ __forceinline__ void qkt_half(f32x16& ph, const LAS char* K_lds, int half, int r32, int hi, const bf16x8* qr) {
#pragma unroll
    for (int r = 0; r < 16; ++r) ph[r] = 0.f;
    int base = r32 * 256 + ((hi * 16) ^ ((r32 & 7) << 4)) + half * 8192;
    asm volatile("" : "+v"(base));
    __builtin_amdgcn_s_setprio(1);
#pragma unroll
    for (int d0 = 0; d0 < 8; ++d0) { const LAS char* a = K_lds + (base ^ ((d0 & 3) << 5)) + (d0 >> 2) * 128;
        const bf16x8 b0 = *(const LAS bf16x8*)a;
        ph = __builtin_amdgcn_mfma_f32_32x32x16_f16(b0, qr[d0], ph, 0, 0, 0); }
    __builtin_amdgcn_s_setprio(0);
}
__device__ __forceinline__ void pack_half(const f32x16& ph, bf16x8& pa0, bf16x8& pa1) {
#define PK4(P, B_, OUT) do { const unsigned a0 = pk2(P[B_ + 0], P[B_ + 1]), a1 = pk2(P[B_ + 2], P[B_ + 3]), b0 = pk2(P[B_ + 4], P[B_ + 5]), b1 = pk2(P[B_ + 6], P[B_ + 7]); \
        auto r0 = __builtin_amdgcn_permlane32_swap(a0, b0, false, false); auto r1 = __builtin_amdgcn_permlane32_swap(a1, b1, false, false); \
        u32x4 w = {r0[0], r1[0], r0[1], r1[1]}; OUT = __builtin_bit_cast(bf16x8, w); } while (0)
    PK4(ph, 0, pa0); PK4(ph, 8, pa1);
#undef PK4
}
__device__ __forceinline__ void pv_half(f32x16* o, int vbh, bf16x8 pa0, bf16x8 pa1) {
#define TRRD(dst, off) asm volatile("ds_read_b64_tr_b16 %0, %1 offset:%2" : "=&v"(dst) : "v"(vbh), "i"(off) : "memory")
    h4_t l0[4], h0[4], l1[4], h1[4];
#define PV_RD(d0) do { constexpr int b_ = v_rd_off(d0, 0, 0); TRRD(l0[d0], b_); TRRD(h0[d0], b_ + 2048); TRRD(l1[d0], b_ + 4096); TRRD(h1[d0], b_ + 6144); } while (0)
    PV_RD(0); PV_RD(1); PV_RD(2); PV_RD(3);
    asm volatile("s_waitcnt lgkmcnt(0)" ::: "memory"); __builtin_amdgcn_sched_barrier(0);
    __builtin_amdgcn_s_setprio(1);
#pragma unroll
    for (int d0 = 0; d0 < 4; ++d0) {
        o[d0] = __builtin_amdgcn_mfma_f32_32x32x16_f16(pa0, (bf16x8){l0[d0][0], l0[d0][1], l0[d0][2], l0[d0][3], h0[d0][0], h0[d0][1], h0[d0][2], h0[d0][3]}, o[d0], 0, 0, 0);
        o[d0] = __builtin_amdgcn_mfma_f32_32x32x16_f16(pa1, (bf16x8){l1[d0][0], l1[d0][1], l1[d0][2], l1[d0][3], h1[d0][0], h1[d0][1], h1[d0][2], h1[d0][3]}, o[d0], 0, 0, 0); }
    __builtin_amdgcn_s_setprio(0);
#undef PV_RD
#undef TRRD
}

__device__ __forceinline__ float wave_max_dpp(float v) {
    v = fmaxf(v, DPP_F(v, v, 0x111, 0xf)); v = fmaxf(v, DPP_F(v, v, 0x112, 0xf)); v = fmaxf(v, DPP_F(v, v, 0x114, 0xf)); v = fmaxf(v, DPP_F(v, v, 0x118, 0xf));
    v = fmaxf(v, DPP_F(v, v, 0x142, 0xa)); v = fmaxf(v, DPP_F(v, v, 0x143, 0xc));
    return __builtin_bit_cast(float, __builtin_amdgcn_readlane(__builtin_bit_cast(int, v), 63));
}
__device__ __forceinline__ float half_sum_dpp(float v, int hi) {
    v += DPP_F(0.f, v, 0x111, 0xf); v += DPP_F(0.f, v, 0x112, 0xf); v += DPP_F(0.f, v, 0x114, 0xf); v += DPP_F(0.f, v, 0x118, 0xf);
    v += DPP_F(0.f, v, 0x142, 0xa);
    const float lo = __builtin_bit_cast(float, __builtin_amdgcn_readlane(__builtin_bit_cast(int, v), 31)), hs = __builtin_bit_cast(float, __builtin_amdgcn_readlane(__builtin_bit_cast(int, v), 63));
    return hi ? hs : lo;
}

__device__ __forceinline__ float quad_swap1(float x) { return __int_as_float(__builtin_amdgcn_update_dpp(0, __float_as_int(x), 0xB1, 0xF, 0xF, true)); }
__device__ __forceinline__ void store_row4(bf16_t* orow_e  , float v0, float v1, float v2, float v3, int odd) {
    { const float y = quad_swap1(odd ? v0 : v1); *(unsigned*)(orow_e + (odd ? 32 : 0)) = odd ? pk2(y, v1) : pk2(v0, y); }
    { const float y = quad_swap1(odd ? v2 : v3); *(unsigned*)(orow_e + (odd ? 96 : 64)) = odd ? pk2(y, v3) : pk2(v2, y); }
}
__device__ __forceinline__ void store_head_rows(const f32x16* o, const float* ggrp_h, bf16_t* Obase  , int r32, int hi) {
    float gg[4];
#pragma unroll
    for (int d0 = 0; d0 < 4; ++d0) gg[d0] = ggrp_h[d0 * 32 + r32];
    const int odd = r32 & 1;
#pragma unroll
    for (int r = 0; r < 16; ++r) {
        const float ss = half_sum_dpp((o[0][r] * o[0][r] + o[1][r] * o[1][r]) + (o[2][r] * o[2][r] + o[3][r] * o[3][r]), hi);
        const float rs = __builtin_amdgcn_rsqf(ss * (1.0f / HD) + EPS);
        store_row4(Obase + (size_t)crow(r, hi) * DM + (r32 & ~1), o[0][r] * rs * gg[0], o[1][r] * rs * gg[1], o[2][r] * rs * gg[2], o[3][r] * rs * gg[3], odd);
    }
}

typedef unsigned long long u64x2 __attribute__((ext_vector_type(2)));

enum { M_CSTAT = 0, M_CIMP = 1, M_SLC = 2, M_CPV = 3, M_WSTAT = 4, M_WPV = 5, M_SB = 6 };
constexpr int ATT_WS = 0, ATT_FLAGS = 2048, NSA_SEL = 2112, NSA_WUNI = 3136, ATT_V0 = 4096, ATT_K0 = ATT_V0 + 3 * 16384, NSA_P = ATT_V0  ;
constexpr int ATT_END = ATT_K0 + 4 * 16384;
constexpr int TNONE = 128;
static_assert(ATT_END <= MISC_OFF, "LDS map");
__device__ __forceinline__ int next_bit(unsigned m0, unsigned m1, unsigned m2, unsigned m3, int from) {
    if (from < 32) { const unsigned w = m0 & (~0u << from); if (w) return __builtin_ctz(w); from = 32; }
    if (from < 64) { const unsigned w = m1 & (~0u << (from - 32)); if (w) return 32 + __builtin_ctz(w); from = 64; }
    if (from < 96) { const unsigned w = m2 & (~0u << (from - 64)); if (w) return 64 + __builtin_ctz(w); from = 96; }
    if (from < 128) { const unsigned w = m3 & (~0u << (from - 96)); if (w) return 96 + __builtin_ctz(w); }
    return 128;
}
__device__ __forceinline__ unsigned bit_of(unsigned m0, unsigned m1, unsigned m2, unsigned m3, int j) { const unsigned w = j < 32 ? m0 : j < 64 ? m1 : j < 96 ? m2 : m3; return (w >> (j & 31)) & 1u; }
__device__ __forceinline__ float quad_sum(float x) {
    x += __builtin_bit_cast(float, __builtin_amdgcn_update_dpp(0, __builtin_bit_cast(int, x), 0xB1, 0xf, 0xf, true));
    x += __builtin_bit_cast(float, __builtin_amdgcn_update_dpp(0, __builtin_bit_cast(int, x), 0x4E, 0xf, 0xf, true));
    return x;
}
struct PassArgs {
    const bf16_t* Kp; const bf16_t* Vp;
    unsigned tm0, tm1, tm2, tm3;
    unsigned wm0, wm1, wm2, wm3;
    unsigned sw0, sw1, sw2, sw3;
    int tok, nvr, b, nvmin;
    int jtop, tw0;
    float f;
};
template <int MODE>
__device__ __forceinline__ void attn_pass(const Ctx& c, const bf16x8 (&qr)[8], f32x16 (&o)[4], float& m, float& l, const PassArgs& a) {
    constexpr bool SB = (MODE == M_SB);
    constexpr bool HASV = (MODE == M_SLC || MODE == M_CPV || MODE == M_WPV || SB);
    constexpr bool CMP = (MODE == M_CSTAT || MODE == M_CIMP || MODE == M_CPV);
    constexpr bool WIN = (MODE == M_WSTAT || MODE == M_WPV);
    constexpr int HA = SB ? 1 : 0, HB = SB ? 0 : 1;
    constexpr float C2 = SCALE * 1.4426950408889634f;
    const int lane = c.lane, w = c.wave, r32 = lane & 31, hi = lane >> 5;
    LAS char* V_lds = (LAS char*)c.lds + ATT_V0; LAS char* K_lds = (LAS char*)c.lds + ATT_K0;
    LAS float* wsf = (LAS float*)(c.lds + ATT_WS) + w * 64;
    volatile LAS unsigned* flags = (volatile LAS unsigned*)(c.lds + ATT_FLAGS);
    unsigned kg0, kg1, vg0, vg1;
    { const int A0 = 16 * (64 * w + lane), A1 = A0 + 8192;
      { const int row = A0 >> 8, cB = (A0 & 255) ^ ((row & 7) << 4); kg0 = (unsigned)(row * HD * 2 + cB); }
      { const int row = A1 >> 8, cB = (A1 & 255) ^ ((row & 7) << 4); kg1 = (unsigned)(row * HD * 2 + cB); }
      { const int st = A0 >> 9, wi = A0 & 511, kk = (st >> 2) * 8 + (wi >> 6), cc = (st & 3) * 32 + ((wi & 63) >> 1), k = (kk & ~0xC) | ((kk & 4) << 1) | ((kk & 8) >> 1); vg0 = (unsigned)((k * HD + cc) * 2); }
      { const int st = A1 >> 9, wi = A1 & 511, kk = (st >> 2) * 8 + (wi >> 6), cc = (st & 3) * 32 + ((wi & 63) >> 1), k = (kk & ~0xC) | ((kk & 4) << 1) | ((kk & 8) >> 1); vg1 = (unsigned)((k * HD + cc) * 2); } }
    const int vb0 = (int)(unsigned)(size_t)V_lds + v_rd_base(lane);
    const float NEG = -__builtin_inff();
    bool done = false;
#define AP_NEXT(j_) (SB ? ((j_) > 0 ? (j_) - 1 : TNONE) : next_bit(a.tm0, a.tm1, a.tm2, a.tm3, (j_) + 1))
#define AP_ACT(j_) (SB ? (!done && 64 * (j_) <= a.tw0 + 30) : (bit_of(a.wm0, a.wm1, a.wm2, a.wm3, (j_)) != 0u))
#define AP_DMAK(j_, buf) do { const bf16_t* g_ = a.Kp + (size_t)(64 * (j_)) * HD; \
        __builtin_amdgcn_global_load_lds((const unsigned*)((const char*)g_ + kg0), (LAS unsigned*)(K_lds + (buf) * 16384 + w * 1024), 16, 0, 0); \
        __builtin_amdgcn_global_load_lds((const unsigned*)((const char*)g_ + kg1), (LAS unsigned*)(K_lds + (buf) * 16384 + 8192 + w * 1024), 16, 0, 0); } while (0)
#define AP_DMAV(j_, buf) do { if (HASV) { const bf16_t* g_ = a.Vp + (size_t)(64 * (j_)) * HD; \
        __builtin_amdgcn_global_load_lds((const unsigned*)((const char*)g_ + vg0), (LAS unsigned*)(V_lds + (buf) * 16384 + w * 1024), 16, 0, 0); \
        __builtin_amdgcn_global_load_lds((const unsigned*)((const char*)g_ + vg1), (LAS unsigned*)(V_lds + (buf) * 16384 + 8192 + w * 1024), 16, 0, 0); } } while (0)
#define AP_WAITN(full) do { if (full) { if (HASV) asm volatile("s_waitcnt vmcnt(4)" ::: "memory"); else asm volatile("s_waitcnt vmcnt(2)" ::: "memory"); } \
                            else asm volatile("s_waitcnt vmcnt(0)" ::: "memory"); } while (0)
    int j0 = SB ? a.jtop : next_bit(a.tm0, a.tm1, a.tm2, a.tm3, 0);
    if (j0 >= TNONE) return;
    int j1 = AP_NEXT(j0), j2 = j1 < TNONE ? AP_NEXT(j1) : TNONE, j3 = j2 < TNONE ? AP_NEXT(j2) : TNONE;
    int kc = 0, vc = 0;
    f32x16 pX, pY;
    bf16x8 kf[4];
    float carry = 0.f;
    __syncthreads();
    AP_DMAK(j0, 0); AP_DMAV(j0, 0);
    if (j1 < TNONE) AP_DMAK(j1, 1);
    bool full = j2 < TNONE;
    if (j2 < TNONE) AP_DMAK(j2, 2);
    if (j1 < TNONE) AP_DMAV(j1, 1);
    AP_WAITN(full); __syncthreads();
    if (AP_ACT(j0)) qkt_half(pX, K_lds, HA, r32, hi, qr);
#define AP_SB_EL(P, HF, r) do { const float y = P[r] * C2; \
                const float sp = fmaxf(y, 0.f) + __builtin_amdgcn_logf(1.0f + __builtin_amdgcn_exp2f(-fabsf(y))); \
                float Lr = -sp, br = y - sp; \
                if (needmask) { const bool ok = (dq - 32 * (HF) - (((r) & 3) + 8 * ((r) >> 2))) >= 0; Lr = ok ? Lr : 0.f; br = ok ? br : NEG; } \
                Lv[r] = Lr; P[r] = br; } while (0)
#define AP_KADDR(KT, QH, d_) ((KT) + (kb_ ^ (((d_) & 3) << 5)) + ((d_) >> 2) * 128)
#define AP_QMFMA(PN, c_, KT, QH) do { if ((c_) == 0) { f32x16 z_; _Pragma("unroll") for (int q_ = 0; q_ < 16; ++q_) z_[q_] = 0.f; PN = __builtin_amdgcn_mfma_f32_32x32x16_f16(kf[0], qr[0], z_, 0, 0, 0); } \
        else PN = __builtin_amdgcn_mfma_f32_32x32x16_f16(kf[(c_) & 3], qr[c_], PN, 0, 0, 0); \
        if ((c_) + 4 < 8) kf[(c_) & 3] = *(const LAS bf16x8*)AP_KADDR(KT, QH, (c_) + 4);        \
        __builtin_amdgcn_sched_barrier(0); } while (0)
#define AP_QPIN(KT, QH) int kb_ = r32 * 256 + ((hi * 16) ^ ((r32 & 7) << 4)) + (QH) * 8192; asm volatile("" : "+v"(kb_)); \
        _Pragma("unroll") for (int d_ = 0; d_ < 4; ++d_) kf[d_] = *(const LAS bf16x8*)AP_KADDR(KT, QH, d_); \
        __builtin_amdgcn_sched_barrier(0)
#define AP_PROCH(P, J, HF, VB, DOQ, PN, KT, QH) do { \
        if (SB) { \
            const int key0 = 64 * (J); const bool needmask = key0 + 63 >= a.tw0; const int dq = a.tok - 1 - key0 - 4 * hi; float run = carry; \
            float Lv[16]; \
            if (DOQ) { AP_QPIN(KT, QH); _Pragma("unroll") for (int c_ = 0; c_ < 8; ++c_) { AP_SB_EL(P, HF, 2 * c_); AP_SB_EL(P, HF, 2 * c_ + 1); AP_QMFMA(PN, c_, KT, QH); } } \
            else { _Pragma("unroll") for (int r = 0; r < 16; ++r) AP_SB_EL(P, HF, r); } \
            float g[4], pg[4]; \
            _Pragma("unroll") for (int i = 0; i < 4; ++i) { g[i] = (Lv[4 * i] + Lv[4 * i + 1]) + (Lv[4 * i + 2] + Lv[4 * i + 3]); pg[i] = partner32(g[i], hi); } \
            _Pragma("unroll") for (int i = 3; i >= 0; --i) { float aft = run + (hi ? 0.f : pg[i]); run += g[i] + pg[i]; \
                P[4 * i + 3] = __builtin_amdgcn_exp2f(P[4 * i + 3] + aft); aft += Lv[4 * i + 3]; \
                P[4 * i + 2] = __builtin_amdgcn_exp2f(P[4 * i + 2] + aft); aft += Lv[4 * i + 2]; \
                P[4 * i + 1] = __builtin_amdgcn_exp2f(P[4 * i + 1] + aft); aft += Lv[4 * i + 1]; \
                P[4 * i + 0] = __builtin_amdgcn_exp2f(P[4 * i + 0] + aft); } \
            carry = run; \
            bf16x8 pa0, pa1; pack_half(P, pa0, pa1); pv_half(o, vb0 + (VB) * 16384 + (HF) * 8192, pa0, pa1); \
            if ((HF) == HB) done = __all(carry <= -151.0f); \
        } else { \
            if (CMP) { if (64 * (J) + 32 * (HF) + 32 > a.nvmin) { const int dq = a.nvr - 1 - 64 * (J) - 32 * (HF) - 4 * hi;     \
                _Pragma("unroll") for (int r = 0; r < 16; ++r) { const int cr = (r & 3) + 8 * (r >> 2); if (dq - cr < 0) P[r] = NEG; } } } \
            if (WIN) { if ((J) == a.b || (J) == a.b - 8) { const int dq = a.tok - 64 * (J) - 32 * (HF) - 4 * hi; \
                _Pragma("unroll") for (int r = 0; r < 16; ++r) { const int cr = (r & 3) + 8 * (r >> 2); if ((unsigned)(dq - cr) >= 512u) P[r] = NEG; } } } \
            if (MODE == M_SLC) { if ((J) == a.b) { const int dq = a.tok - 64 * (J) - 32 * (HF) - 4 * hi; \
                _Pragma("unroll") for (int r = 0; r < 16; ++r) { const int cr = (r & 3) + 8 * (r >> 2); if (dq - cr < 0) P[r] = NEG; } } } \
            if (MODE == M_CSTAT || MODE == M_WSTAT || MODE == M_SLC) { \
                float pmax = P[0]; \
                _Pragma("unroll") for (int r = 1; r < 16; ++r) pmax = fmaxf(pmax, P[r]); \
                bool selr = true; \
                if (MODE == M_SLC) { selr = bit_of(a.sw0, a.sw1, a.sw2, a.sw3, (J)) != 0u; pmax = selr ? pmax : NEG; } \
                pmax = fmaxf(pmax, partner32(pmax, hi)); \
                  \
                const bool keep = (MODE == M_SLC) && __all((pmax - m) * C2 <= 8.0f); \
                const float mn = keep ? m : fmaxf(m, pmax); \
                const float alpha = keep ? 1.0f : __builtin_amdgcn_exp2f((m - mn) * C2); \
                m = mn; \
                const float mnL = selr ? -mn * C2 : NEG; \
                float ps = 0.f; \
                if (DOQ) { AP_QPIN(KT, QH); _Pragma("unroll") for (int c_ = 0; c_ < 8; ++c_) { \
                        P[2 * c_] = __builtin_amdgcn_exp2f(fmaf(P[2 * c_], C2, mnL)); P[2 * c_ + 1] = __builtin_amdgcn_exp2f(fmaf(P[2 * c_ + 1], C2, mnL)); ps += P[2 * c_] + P[2 * c_ + 1]; AP_QMFMA(PN, c_, KT, QH); } } \
                else { _Pragma("unroll") for (int r = 0; r < 16; ++r) { P[r] = __builtin_amdgcn_exp2f(fmaf(P[r], C2, mnL)); ps += P[r]; } } \
                ps += partner32(ps, hi); \
                l = l * alpha + ps; \
                if (MODE == M_SLC) { \
                    if (!keep && __any(alpha < 1.f)) { \
                        if (hi == 0) wsf[r32] = alpha; \
                        asm volatile("s_waitcnt lgkmcnt(0)" ::: "memory"); \
                        _Pragma("unroll") for (int r = 0; r < 16; ++r) { const float al = wsf[crow(r, hi)]; \
                            _Pragma("unroll") for (int d0 = 0; d0 < 4; ++d0) o[d0][r] *= al; } \
                    } \
                    bf16x8 pa0, pa1; pack_half(P, pa0, pa1); pv_half(o, vb0 + (VB) * 16384 + (HF) * 8192, pa0, pa1); \
                } \
            } else { \
                const float mL = -m * C2; \
                if (DOQ) { AP_QPIN(KT, QH); _Pragma("unroll") for (int c_ = 0; c_ < 8; ++c_) { \
                        P[2 * c_] = __builtin_amdgcn_exp2f(fmaf(P[2 * c_], C2, mL)) * a.f; P[2 * c_ + 1] = __builtin_amdgcn_exp2f(fmaf(P[2 * c_ + 1], C2, mL)) * a.f; AP_QMFMA(PN, c_, KT, QH); } } \
                else { _Pragma("unroll") for (int r = 0; r < 16; ++r) P[r] = __builtin_amdgcn_exp2f(fmaf(P[r], C2, mL)) * a.f; } \
                if (MODE == M_CIMP) { \
                      \
                    LAS float* PT = (LAS float*)(c.lds + NSA_P) + (8 * w + (r32 >> 2)) * 128; \
                    float s3v[4], av[4]; \
                    _Pragma("unroll") for (int i = 0; i < 4; ++i) { \
                        const float s0 = quad_sum(P[4 * i]), s1 = quad_sum(P[4 * i + 1]), s2 = quad_sum(P[4 * i + 2]); s3v[i] = quad_sum(P[4 * i + 3]); \
                        av[i] = 2.f * ((s0 + s1) + s2) + s3v[i]; } \
                    float ps3[4]; \
                    _Pragma("unroll") for (int i = 0; i < 4; ++i) ps3[i] = partner32(s3v[i], hi); \
                    _Pragma("unroll") for (int i = 0; i < 4; ++i) { \
                        const int Jb = 16 * (J) + 8 * (HF) + 2 * i + hi; \
                        const float prev = hi ? ps3[i] : (i == 0 ? carry : ps3[i > 0 ? i - 1 : 0]); \
                        if ((r32 & 3) == 0) PT[Jb] = av[i] + prev; } \
                    carry = ps3[3];      \
                } else { bf16x8 pa0, pa1; pack_half(P, pa0, pa1); pv_half(o, vb0 + (VB) * 16384 + (HF) * 8192, pa0, pa1); } \
            } \
        } } while (0)
    for (;;) {
        if (SB) { if (lane == 0) flags[w] = done ? 1u : 0u; }
        AP_WAITN(full); __syncthreads();
        if (SB) { unsigned all = 1u;
#pragma unroll
            for (int i = 0; i < NWAVES; ++i) all &= flags[i];
            if (all) break; }
        full = j3 < TNONE;
        if (j3 < TNONE) AP_DMAK(j3, (kc + 3) & 3);
        if (j2 < TNONE) AP_DMAV(j2, vc == 0 ? 2 : vc - 1);
        const bool act0 = AP_ACT(j0);
        const bool actq = (j1 < TNONE) && AP_ACT(j1);
        if (act0) AP_PROCH(pX, j0, HA, vc, true, pY, K_lds + kc * 16384, HB);
        if (actq) qkt_half(pX, K_lds + ((kc + 1) & 3) * 16384, HA, r32, hi, qr);
        if (act0) AP_PROCH(pY, j0, HB, vc, false, pX, K_lds, HA);
        if (j1 >= TNONE) break;
        j0 = j1; j1 = j2; j2 = j3; j3 = j3 < TNONE ? AP_NEXT(j3) : TNONE;
        kc = (kc + 1) & 3; vc = vc == 2 ? 0 : vc + 1;
    }
    asm volatile("s_waitcnt vmcnt(0)" ::: "memory");
#undef AP_PROCH
#undef AP_QMFMA
#undef AP_QPIN
#undef AP_KADDR
#undef AP_SB_EL
#undef AP_NEXT
#undef AP_ACT
#undef AP_DMAK
#undef AP_DMAV
#undef AP_WAITN
}

__device__ __forceinline__ void sb_unit(const Params& p, const Ctx& c, int l, int h, int qb) {
    const bf16_t* proj = (const bf16_t*)(p.ws + WS_PROJ);
    const bf16_t* Q = proj + (size_t)(20 + h) * S * HD;
    int lane_; asm volatile("v_mbcnt_lo_u32_b32 %0, -1, 0\n\tv_mbcnt_hi_u32_b32 %0, -1, %0" : "=v"(lane_));
    const int lane = lane_, w = c.wave, r32 = lane & 31, hi = lane >> 5;
    const int t0 = 256 * qb, tw0 = t0 + 32 * w, tq = tw0 + r32;
    bf16x8 qr[8];
#pragma unroll
    for (int d0 = 0; d0 < 8; ++d0) qr[d0] = *(const bf16x8*)(Q + (size_t)tq * HD + d0 * 16 + hi * 8);
    f32x16 o[4];
#pragma unroll
    for (int d0 = 0; d0 < 4; ++d0)
#pragma unroll
        for (int r = 0; r < 16; ++r) o[d0][r] = 0.f;
    PassArgs a{}; a.Kp = proj + (size_t)(28 + h) * S * HD; a.Vp = proj + (size_t)(36 + h) * S * HD; a.tok = tq; a.jtop = (t0 + 254) >> 6; a.tw0 = tw0;
    float m = 0.f, lsum = 0.f;
    attn_pass<M_SB>(c, qr, o, m, lsum, a);
    store_head_rows(o, p.in[10] + (size_t)l * DM + (8 + h) * HD, (bf16_t*)(p.ws + WS_O) + (size_t)tw0 * DM + (8 + h) * HD, r32, hi);
}

template <int role>
__device__ __forceinline__ void nsa_unit(const Params& p, const Ctx& c, int l, int g, int b) {
    const bf16_t* proj = (const bf16_t*)(p.ws + WS_PROJ);
    const bf16_t* kc = (const bf16_t*)(p.ws + WS_KC) + (size_t)g * 512 * HD; const bf16_t* vc = (const bf16_t*)(p.ws + WS_VC) + (size_t)g * 512 * HD;
    const float* gates = (const float*)(p.ws + WS_GATES);
    const int lane = c.lane, w = c.wave, r32 = lane & 31, hi = lane >> 5;
    const int t0 = 64 * b, tl = 8 * w + (r32 >> 2), tok = t0 + tl, H = 4 * g + (r32 & 3);
    bf16x8 qr[8];
#pragma unroll
    for (int d0 = 0; d0 < 8; ++d0) qr[d0] = *(const bf16x8*)(proj + (size_t)H * S * HD + (size_t)tok * HD + d0 * 16 + hi * 8);
    const float g0 = gates[(size_t)tok * 24 + H], g1 = gates[(size_t)tok * 24 + 8 + H], g2 = gates[(size_t)tok * 24 + 16 + H];
    f32x16 o[4];
    __syncthreads();
    { LAS f32x4* za = (LAS f32x4*)(c.lds + NSA_P);
      for (int i = c.tid; i < 32768 / 16; i += NTHREADS) za[i] = (f32x4){0.f, 0.f, 0.f, 0.f}; }
    PassArgs a{}; a.tok = tok; a.b = b;
    a.nvr = tok >= 31 ? (tok - 31) / 16 + 1 : 0; if (a.nvr > NCMP) a.nvr = NCMP;
    { const int tmin = t0 + 8 * w; a.nvmin = tmin >= 31 ? (tmin - 31) / 16 + 1 : 0; if (a.nvmin > NCMP) a.nvmin = NCMP; }
    int nvmax = (t0 + 63 - 31) / 16 + 1; if (nvmax > NCMP) nvmax = NCMP;
    const unsigned cm0 = (1u << ((nvmax + 63) >> 6)) - 1u;
    float mc = -1e30f, lc = 0.f;
    a.Kp = kc; a.Vp = vc; a.tm0 = cm0; a.wm0 = cm0;
    attn_pass<M_CSTAT>(c, qr, o, mc, lc, a);
    const float ilc = lc > 0.f ? 1.0f / lc : 0.f;
    a.f = ilc;
    attn_pass<M_CIMP>(c, qr, o, mc, lc, a);
    __syncthreads();
    { const LAS float* PTb = (const LAS float*)(c.lds + NSA_P);
      LAS unsigned* selw = (LAS unsigned*)(c.lds + NSA_SEL); LAS unsigned* wuni = (LAS unsigned*)(c.lds + NSA_WUNI);
      unsigned long long u0 = 0ull, u1 = 0ull;
      for (int tt = 0; tt < 8; ++tt) {
          const int tk = 8 * w + tt; const int j0 = lane, j1 = lane + 64;
          const float a0 = PTb[tk * 128 + j0], a1 = PTb[tk * 128 + j1];
          const bool f0 = (j0 == 0) || (j0 == b) || (j0 == b - 1), f1 = (j1 == b) || (j1 == b - 1);
          bool sel0 = f0 && j0 <= b, sel1 = f1 && j1 <= b;
          float c0 = (!f0 && j0 >= 1 && j0 <= b - 2) ? a0 : -1.f, c1 = (!f1 && j1 <= b - 2) ? a1 : -1.f;
          const int ncand = b - 2 > 0 ? b - 2 : 0, ksel = 16 - (b >= 2 ? 3 : b + 1);
          if (ncand <= ksel) { if (c0 >= 0.f) sel0 = true; if (c1 >= 0.f) sel1 = true; }
          else { for (int it = 0; it < ksel; ++it) {
                     const float mx = wave_max_dpp(fmaxf(c0, c1));
                     const unsigned long long b0 = __ballot(c0 == mx);
                     if (b0) { const int first = __ffsll((long long)b0) - 1; if (lane == first) { c0 = -1.f; sel0 = true; } }
                     else { const unsigned long long b1 = __ballot(c1 == mx); const int first = __ffsll((long long)b1) - 1; if (lane == first) { c1 = -1.f; sel1 = true; } } } }
          const unsigned long long m0 = __ballot(sel0), m1 = __ballot(sel1);
          u0 |= m0; u1 |= m1;
          if (lane == 0) { selw[tk * 4 + 0] = (unsigned)m0; selw[tk * 4 + 1] = (unsigned)(m0 >> 32); selw[tk * 4 + 2] = (unsigned)m1; selw[tk * 4 + 3] = (unsigned)(m1 >> 32); }
      }
      if (lane == 0) { wuni[w * 4 + 0] = (unsigned)u0; wuni[w * 4 + 1] = (unsigned)(u0 >> 32); wuni[w * 4 + 2] = (unsigned)u1; wuni[w * 4 + 3] = (unsigned)(u1 >> 32); }
      __syncthreads();
      unsigned gu0 = 0u, gu1 = 0u, gu2 = 0u, gu3 = 0u;
#pragma unroll
      for (int i = 0; i < NWAVES; ++i) { gu0 |= wuni[i * 4 + 0]; gu1 |= wuni[i * 4 + 1]; gu2 |= wuni[i * 4 + 2]; gu3 |= wuni[i * 4 + 3]; }
      a.tm0 = __builtin_amdgcn_readfirstlane(gu0); a.tm1 = __builtin_amdgcn_readfirstlane(gu1); a.tm2 = __builtin_amdgcn_readfirstlane(gu2); a.tm3 = __builtin_amdgcn_readfirstlane(gu3);
      a.wm0 = (unsigned)u0; a.wm1 = (unsigned)(u0 >> 32); a.wm2 = (unsigned)u1; a.wm3 = (unsigned)(u1 >> 32);
      a.sw0 = selw[tl * 4 + 0]; a.sw1 = selw[tl * 4 + 1]; a.sw2 = selw[tl * 4 + 2]; a.sw3 = selw[tl * 4 + 3];
      if (role != 0) {
          const int n = b - 63; const unsigned lo0 = n >= 32 ? ~0u : ((1u << n) - 1u), lo1 = n >= 64 ? ~0u : (n > 32 ? ((1u << (n - 32)) - 1u) : 0u);
          if (role == 2) { a.tm0 &= lo0; a.tm1 &= lo1; a.tm2 = 0u; a.tm3 = 0u; a.wm0 &= lo0; a.wm1 &= lo1; a.wm2 = 0u; a.wm3 = 0u; }
          else { a.tm0 &= ~lo0; a.tm1 &= ~lo1; a.wm0 &= ~lo0; a.wm1 &= ~lo1; } }
    }
#pragma unroll
    for (int d0 = 0; d0 < 4; ++d0)
#pragma unroll
        for (int r = 0; r < 16; ++r) o[d0][r] = 0.f;
    { float ms = -1e30f, ls = 0.f;
      a.Kp = proj + (size_t)(12 + g) * S * HD; a.Vp = proj + (size_t)(14 + g) * S * HD;
      attn_pass<M_SLC>(c, qr, o, ms, ls, a);
      LAS float* wsf = (LAS float*)(c.lds + ATT_WS) + w * 64;
      constexpr float C2 = SCALE * 1.4426950408889634f;
      if (role != 0) {
          int lane_; asm volatile("v_mbcnt_lo_u32_b32 %0, -1, 0\n\tv_mbcnt_hi_u32_b32 %0, -1, %0" : "=v"(lane_));
          const int lane = lane_, r32 = lane & 31, hi = lane >> 5;
          float* part = (float*)(p.ws + WS_PART + (size_t)(g * 64 + (b - 64)) * PART_SLOT); float* pml = part + 32768 + w * 64;
          unsigned* flag = (unsigned*)(p.ws + WS_CTL) + CW_NSAFLAG + 64 * (g * 64 + (b - 64));
          if (role == 2) {
#pragma unroll
              for (int r = 0; r < 16; ++r) { const f32x4 v_ = (f32x4){o[0][r], o[1][r], o[2][r], o[3][r]}; float* dp_ = part + (size_t)(w * 16 + r) * 256 + lane * 4;
                  asm volatile("global_store_dwordx4 %0, %1, off sc1\n\ts_nop 1" :: "v"(dp_), "v"(v_) : "memory"); }
              if (hi == 0) { __hip_atomic_store(pml + r32, ms, __ATOMIC_RELAXED, __HIP_MEMORY_SCOPE_AGENT); __hip_atomic_store(pml + 32 + r32, ls, __ATOMIC_RELAXED, __HIP_MEMORY_SCOPE_AGENT); }
              asm volatile("s_waitcnt vmcnt(0)" ::: "memory");
              __syncthreads();
              if (c.tid == 0) __hip_atomic_store(flag, (unsigned)(l + 1), __ATOMIC_RELAXED, __HIP_MEMORY_SCOPE_AGENT);
              return;
          }
          if (c.tid == 0) { unsigned spins = 0; while (__hip_atomic_load(flag, __ATOMIC_RELAXED, __HIP_MEMORY_SCOPE_AGENT) != (unsigned)(l + 1) && ++spins < (1u << 22)) __builtin_amdgcn_s_sleep(4); }
          __syncthreads();
          const float m1 = __hip_atomic_load(pml + r32, __ATOMIC_RELAXED, __HIP_MEMORY_SCOPE_AGENT), l1 = __hip_atomic_load(pml + 32 + r32, __ATOMIC_RELAXED, __HIP_MEMORY_SCOPE_AGENT);
          f32x4 qa[4];
#define NSA_LDROW(i_, r_) do { unsigned long long* qp_ = (unsigned long long*)(part + (size_t)(w * 16 + (r_)) * 256 + lane * 4); u64x2 t_; \
              t_.x = __hip_atomic_load(qp_, __ATOMIC_RELAXED, __HIP_MEMORY_SCOPE_AGENT); t_.y = __hip_atomic_load(qp_ + 1, __ATOMIC_RELAXED, __HIP_MEMORY_SCOPE_AGENT); qa[i_] = __builtin_bit_cast(f32x4, t_); } while (0)
#pragma unroll
          for (int i = 0; i < 4; ++i) NSA_LDROW(i, i);
          const float mm = fmaxf(m1, ms), f1 = __builtin_amdgcn_exp2f((m1 - mm) * C2), f2 = __builtin_amdgcn_exp2f((ms - mm) * C2);
          ls = l1 * f1 + ls * f2;
          if (hi == 0) { wsf[r32] = f1; wsf[32 + r32] = f2; }
          asm volatile("s_waitcnt lgkmcnt(0)" ::: "memory");
#pragma unroll
          for (int hb = 0; hb < 4; ++hb) {
#pragma unroll
              for (int i = 0; i < 4; ++i) { const int r = hb * 4 + i; const float a1 = wsf[crow(r, hi)], a2 = wsf[32 + crow(r, hi)];
#pragma unroll
                  for (int d0 = 0; d0 < 4; ++d0) o[d0][r] = qa[i][d0] * a1 + o[d0][r] * a2; }
              asm volatile("" : "+v"(o[0][4 * hb]), "+v"(o[1][4 * hb]), "+v"(o[2][4 * hb]), "+v"(o[3][4 * hb]), "+v"(o[0][4 * hb + 1]), "+v"(o[1][4 * hb + 1]), "+v"(o[2][4 * hb + 1]), "+v"(o[3][4 * hb + 1]),
                               "+v"(o[0][4 * hb + 2]), "+v"(o[1][4 * hb + 2]), "+v"(o[2][4 * hb + 2]), "+v"(o[3][4 * hb + 2]), "+v"(o[0][4 * hb + 3]), "+v"(o[1][4 * hb + 3]), "+v"(o[2][4 * hb + 3]), "+v"(o[3][4 * hb + 3]) :: "memory");
              if (hb < 3) {
#pragma unroll
                  for (int i = 0; i < 4; ++i) NSA_LDROW(i, 4 * (hb + 1) + i); }
          }
          asm volatile("s_waitcnt lgkmcnt(0)" ::: "memory");
      }
      if (hi == 0) wsf[r32] = g1 / ls;
      asm volatile("s_waitcnt lgkmcnt(0)" ::: "memory");
#pragma unroll
      for (int r = 0; r < 16; ++r) { const float al = wsf[crow(r, hi)];
#pragma unroll
          for (int d0 = 0; d0 < 4; ++d0) o[d0][r] *= al; } }
    a.Kp = kc; a.Vp = vc; a.tm0 = cm0; a.tm1 = a.tm2 = a.tm3 = 0u; a.wm0 = cm0; a.wm1 = a.wm2 = a.wm3 = 0u; a.f = g0 * ilc;
    attn_pass<M_CPV>(c, qr, o, mc, lc, a);
    { unsigned wt0 = 0u, wt1 = 0u, wt2 = 0u, wt3 = 0u;
      for (int j = (b - 8 > 0 ? b - 8 : 0); j <= b; ++j) { const unsigned bit = 1u << (j & 31); if (j < 32) wt0 |= bit; else if (j < 64) wt1 |= bit; else if (j < 96) wt2 |= bit; else wt3 |= bit; }
      float mw = -1e30f, lw = 0.f;
      a.Kp = proj + (size_t)(16 + g) * S * HD; a.Vp = proj + (size_t)(18 + g) * S * HD;
      a.tm0 = wt0; a.tm1 = wt1; a.tm2 = wt2; a.tm3 = wt3; a.wm0 = wt0; a.wm1 = wt1; a.wm2 = wt2; a.wm3 = wt3; a.f = 0.f;
      attn_pass<M_WSTAT>(c, qr, o, mw, lw, a);
      a.f = g2 / lw;
      attn_pass<M_WPV>(c, qr, o, mw, lw, a); }
    { const float* ggrp = p.in[10] + (size_t)l * DM; bf16_t* O = (bf16_t*)(p.ws + WS_O);
      int lane_; asm volatile("v_mbcnt_lo_u32_b32 %0, -1, 0\n\tv_mbcnt_hi_u32_b32 %0, -1, %0" : "=v"(lane_));
      const int r32 = lane_ & 31, hi = lane_ >> 5, odd = lane_ & 1;
      float gg[4][4];
#pragma unroll
      for (int hh = 0; hh < 4; ++hh)
#pragma unroll
          for (int d0 = 0; d0 < 4; ++d0) gg[hh][d0] = ggrp[(4 * g + hh) * HD + d0 * 32 + r32];
#pragma unroll
      for (int r = 0; r < 16; ++r) {
          const float ss = half_sum_dpp((o[0][r] * o[0][r] + o[1][r] * o[1][r]) + (o[2][r] * o[2][r] + o[3][r] * o[3][r]), hi);
          const float rs = __builtin_amdgcn_rsqf(ss * (1.0f / HD) + EPS);
          const int rr = crow(r, hi), Hh = 4 * g + (r & 3); const int tk = t0 + 8 * w + (rr >> 2);
          store_row4(O + (size_t)tk * DM + Hh * HD + (r32 & ~1), o[0][r] * rs * gg[r & 3][0], o[1][r] * rs * gg[r & 3][1], o[2][r] * rs * gg[r & 3][2], o[3][r] * rs * gg[r & 3][3], odd);
      } }
}
__device__ __forceinline__ void phase_nsa(const Params& p, const Ctx& c, int l) {
    const int u0 = c.bx, g = u0 & 1, rk = u0 >> 1;
    if (rk < 64) { nsa_unit<2>(p, c, l, g, 127 - rk); nsa_unit<0>(p, c, l, g, rk); }
    else nsa_unit<1>(p, c, l, g, rk);
    __syncthreads();
}
__device__ __forceinline__ void phase_cmpr_sb(const Params& p, const Ctx& c, int l) {
    phase_cmpr(p, c, l);
    sb_unit(p, c, l, c.bx & 7, 31 - (c.bx >> 3));
    __syncthreads();
}
__device__ __forceinline__ Ctx make_ctx(unsigned char* lds, int wave) {
    Ctx c; c.lds = (LAS unsigned char*)lds; int ln_; asm volatile("v_mbcnt_lo_u32_b32 %0, -1, 0\n\tv_mbcnt_hi_u32_b32 %0, -1, %0" : "=v"(ln_));
    int wv_ = wave; asm volatile("" : "+s"(wv_));
    c.lane = ln_; c.wave = wv_; c.tid = wv_ * 64 + ln_;
    int bx_ = blockIdx.x; asm volatile("" : "+s"(bx_)); c.bx = bx_;
    c.gw = bx_ * NWAVES + c.wave; c.ngw = gridDim.x * NWAVES; return c;
}
#define AS4 __attribute__((address_space(4)))
__device__ __forceinline__ Params load_params() {
    unsigned long long v = (unsigned long long)(const AS4 void*)__builtin_amdgcn_kernarg_segment_ptr();
    asm volatile("" : "+s"(v));
    const AS4 Params* q = (const AS4 Params*)v; Params r;
#pragma unroll
    for (int i = 0; i < 17; ++i) r.in[i] = q->in[i];
    r.out = q->out; r.ws = q->ws; return r;
}
constexpr int CW_BAR = 4096;
#ifndef MEGA
#define MEGA 1
#endif
__global__ void __launch_bounds__(NTHREADS, 2) k_mega(Params p_arg) {
    extern __shared__ __attribute__((aligned(16))) unsigned char lds_raw[];
#define PCTX const Ctx c = make_ctx(lds_raw, wave0); const Params p = load_params()
    const int wave0 = __builtin_amdgcn_readfirstlane((int)threadIdx.x >> 6);
    volatile LAS unsigned* misc = (volatile LAS unsigned*)((LAS unsigned char*)lds_raw + MISC_OFF);
    if (threadIdx.x < 8) misc[threadIdx.x] = 0u;
    __syncthreads();
    { const Params p = load_params(); (void)xcd_barrier_post((unsigned*)(p.ws + WS_CTL) + CW_BAR, misc, threadIdx.x == 0); }
#define GBAR() do { const Params p = load_params(); XcdBarrier b_; b_.bar = (unsigned*)(p.ws + WS_CTL) + CW_BAR; b_.x = xb_xcc_id(); b_.st = misc; { int ln__; asm volatile("v_mbcnt_lo_u32_b32 %0, -1, 0\n\tv_mbcnt_hi_u32_b32 %0, -1, %0" : "=v"(ln__)); b_.leader = (wave0 == 0) && (ln__ == 0); } xcd_barrier(b_); } while (0)
    { PCTX; phase_conv(p, c); }
    GBAR();
    for (int l = 0; l < NL; ++l) {
        { PCTX; if (l == 0) cbias_reduce(p, c);
          pg8::Gemm g{(const bf16_t*)(p.ws + WS_XN8), (const bf16_t*)(p.ws + WS_WI8 + (size_t)l * 12 * MiB), S, DINP, DM / 2}; pg8::StaticOrder so; so.init(S, DINP, gridDim.x, c.bx);
          EpiProj E{(bf16_t*)(p.ws + WS_PROJ), (float*)(p.ws + WS_GATES), (const bf16_t*)(p.ws + WS_ROPEH), p.in[4] + 24 * l, (const LAS float*)(c.lds + RSTD_OFF), (const LAS float*)(c.lds + CSC_OFF)};
          pg8::gemm_phase<EpiProj, pg8::StaticOrder, true, true, PrepRstd, 2>(c.lds, g, so, E, c.tid, PrepRstd{c, so, (const float*)(p.ws + WS_SSQ), (const float*)(p.ws + WS_ASC), (const float*)(p.ws + WS_WISC) + l * DINP});
        }
        GBAR();
        { PCTX; phase_cmpr_sb(p, c, l); }
        GBAR();
        { PCTX; phase_nsa(p, c, l); }
        GBAR();
        { PCTX; pg8::Gemm g{(const bf16_t*)(p.ws + WS_O), w_ptr(p, l, W_OUT), S, DM, DM}; pg8::StaticOrder so; so.init(S, DM, gridDim.x, c.bx);
          EpiResidH E{(bf16_t*)(p.ws + WS_XN), (float*)(p.ws + WS_SSQ), 1.0f, p.ws + WS_XN8, (float*)(p.ws + WS_ASC), (float*)(p.ws + WS_XSLAB), (unsigned*)(p.ws + WS_CTL) + CW_XCNT, 8u * (unsigned)(2 * l + 1)};
          pg8::gemm_phase<EpiResidH, pg8::StaticOrder, false, true>(c.lds, g, so, E, c.tid); }
        GBAR();
        { PCTX; pg8::Gemm g{(const bf16_t*)(p.ws + WS_XN8), (const bf16_t*)(p.ws + WS_W8 + (size_t)l * 22 * MiB), S, 2 * DFF, DM / 2}; pg8::StaticOrder so; so.init(S, 2 * DFF, gridDim.x, c.bx);
          EpiSwiGLU E{p.ws + WS_ACT, (const LAS float*)(c.lds + RSTD_OFF), (const LAS float*)(c.lds + CSC_OFF)};
          pg8::gemm_phase<EpiSwiGLU, pg8::StaticOrder, true, true, PrepRstd, 2>(c.lds, g, so, E, c.tid, PrepRstd{c, so, (const float*)(p.ws + WS_SSQ), (const float*)(p.ws + WS_ASC), (const float*)(p.ws + WS_WSC) + l * 2 * DFF});
        }
        GBAR();
        if (l + 1 < NL) {
          { PCTX; pg8::Gemm g{(const bf16_t*)(p.ws + WS_ACT), w_ptr(p, l, W_DN), S, DM, DFF / 2}; pg8::StaticOrder so; so.init(S, DM, gridDim.x, c.bx);
            EpiResidH E{(bf16_t*)(p.ws + WS_XN), (float*)(p.ws + WS_SSQ), 1.0f / (A8_SCALE * W8_SCALE), p.ws + WS_XN8, (float*)(p.ws + WS_ASC), (float*)(p.ws + WS_XSLAB), (unsigned*)(p.ws + WS_CTL) + CW_XCNT, 8u * (unsigned)(2 * l + 2)};
            pg8::gemm_phase<EpiResidH, pg8::StaticOrder, false, true, pg8::NoPre, 1>(c.lds, g, so, E, c.tid); }
          GBAR();
        } else {
          PCTX; pg8::Gemm g{(const bf16_t*)(p.ws + WS_ACT), w_ptr(p, l, W_DN), S, DM, DFF / 2}; pg8::StaticOrder so; so.init(S, DM, gridDim.x, c.bx);
          EpiFinal E{(const bf16_t*)(p.ws + WS_XN), 1.0f / (A8_SCALE * W8_SCALE), (float*)p.out, p.in[16], (float*)(p.ws + WS_XSLAB), (unsigned*)(p.ws + WS_CTL) + CW_XCNT, 8u * (unsigned)(2 * l + 2)};
          pg8::gemm_phase<EpiFinal, pg8::StaticOrder, false, true, pg8::NoPre, 1>(c.lds, g, so, E, c.tid);
        }
    }
}

extern "C" void kernel_launch(void* const* d_in, const int* in_sizes, int n_in, void* d_out, int out_size, void* d_ws, size_t ws_size, hipStream_t stream) {
    static int grid = 0;
    if (grid == 0) {
        if (n_in != 17 || out_size != S * DM || ws_size < WS_END) { fprintf(stderr, "kernel_launch: unexpected shapes (n_in %d, out %d, ws %zu)\n", n_in, out_size, ws_size); grid = -1; return; }
        int dev = 0, cus = 0; (void)hipGetDevice(&dev); (void)hipDeviceGetAttribute(&cus, hipDeviceAttributeMultiprocessorCount, dev); if (cus <= 0) cus = 256;
#if MEGA
        if (hipFuncSetAttribute((const void*)k_mega, hipFuncAttributeMaxDynamicSharedMemorySize, LDS_BYTES) != hipSuccess) { fprintf(stderr, "kernel_launch: hipFuncSetAttribute failed\n"); grid = -1; return; }
        int per_cu = 0;
        if (hipOccupancyMaxActiveBlocksPerMultiprocessor(&per_cu, (const void*)k_mega, NTHREADS, LDS_BYTES) != hipSuccess || per_cu < 1) { fprintf(stderr, "kernel_launch: occupancy query says %d\n", per_cu); per_cu = 1; }
        (void)hipGetLastError();
        if (cus < 256) fprintf(stderr, "kernel_launch: this kernel's static unit schedules need 256 resident workgroups; the device reports %d CUs\n", cus);
        grid = 256;
#endif
    }
    if (grid < 0) return;
    Params p{};
    for (int i = 0; i < 17; ++i) p.in[i] = (const float*)d_in[i];
    p.out = (float*)d_out; p.ws = (unsigned char*)d_ws;
    const dim3 G(grid), B(NTHREADS);
#if MEGA
    (void)hipMemsetAsync((unsigned char*)d_ws + WS_CTL, 0, CTL_ZERO_BYTES, stream);
    hipLaunchKernelGGL(k_mega, G, B, LDS_BYTES, stream, p);
#endif
}
```

```cpp
#include <hip/hip_runtime.h>
#include <cstdio>
#include <cstdint>
namespace pg8 {
#define PG8_LAS __attribute__((address_space(3)))
typedef unsigned short bf16_t;
typedef _Float16 bf16x8 __attribute__((ext_vector_type(8)));
typedef float f32x4 __attribute__((ext_vector_type(4)));
typedef unsigned u32x4 __attribute__((ext_vector_type(4)));
constexpr int BM = 256, BK = 64, HALF = 128, HTB = HALF * BK * 2  , STAGE_BYTES = 8 * HTB, NXCD = 8, WGM = 8;

__host__ __device__ __forceinline__ int lds_byte(int r, int c) { const int st = (r >> 4) * 2 + (c >> 5), rr = r & 15, cc = c & 31, ob = rr * 64 + cc * 2; return st * 1024 + (ob ^ (((ob >> 9) & 1) << 5)); }
__host__ __device__ __forceinline__ void stage_rc(int b, int& R, int& C) { const int st = b / 1024, sb = b % 1024, swz = sb ^ (((sb >> 9) & 1) << 5); R = (st >> 1) * 16 + swz / 64; C = (st & 1) * 32 + (swz % 64) / 2; }
__host__ __device__ __forceinline__ int perm32(int rho) { const int n = rho >> 4, i = rho & 15; return 8 * (i >> 2) + 4 * n + (i & 3); }

struct Unit { int pm, pn, ord; };
struct Gemm { const bf16_t* A; const bf16_t* Bt; int M, N, K; };

struct StaticOrder {
    int nM, nN, nwg, G, c;
    __host__ __device__ void init(int M, int N, int G_, int c_) { nM = M / BM; nN = N / BM; nwg = nM * nN; G = G_; c = c_; }
    __host__ __device__ bool next(int i, Unit& u) const {
        const long L = (long)i * G + c; if (L >= nwg) return false;
        int wgid = (int)L; { const int q = nwg / NXCD, r = nwg % NXCD, xcd = wgid % NXCD, off = wgid / NXCD; wgid = (xcd < r ? xcd * (q + 1) : r * (q + 1) + (xcd - r) * q) + off; }
        const int nig = WGM * nN, gid = wgid / nig, fm = gid * WGM, gsz = (nM - fm) < WGM ? (nM - fm) : WGM;
        u.pm = fm + ((wgid % nig) % gsz); u.pn = (wgid % nig) / gsz; u.ord = i; return true;
    }
    __device__ __forceinline__ void a_ready(const Unit&) const {}
    __device__ __forceinline__ void done(const Unit&) const {}
};
__device__ __forceinline__ unsigned cvt_pk_bf16(float lo, float hi) { unsigned r; asm volatile("v_cvt_pk_bf16_f32 %0, %1, %2" : "=v"(r) : "v"(lo), "v"(hi)); return r; }
typedef float f32x2 __attribute__((ext_vector_type(2)));
struct NoPre { __device__ __forceinline__ void operator()() const {} };
typedef int i32x8 __attribute__((ext_vector_type(8)));
typedef int i32x4 __attribute__((ext_vector_type(4)));
template <class Epi, class Sched, bool ALIGN_EPI = false, bool SP2 = false, class Pre = NoPre, int F8 = 0>
__device__ __forceinline__ void gemm_phase(PG8_LAS unsigned char* lds, const Gemm g, const Sched& S, const Epi& E, int tid_in, const Pre& pre = Pre()) {
    int tid_ = tid_in; asm volatile("" : "+v"(tid_));
    const int tid = tid_, wid = __builtin_amdgcn_readfirstlane(tid >> 6), lane = tid & 63, wr = wid >> 2, wc = wid & 3, fr = lane & 15, fq = lane >> 4;
    const int K = g.K, nt = K / BK;
    unsigned voffA[2], voffB[2];
#pragma unroll
    for (int i = 0; i < 2; ++i) { int R, C; stage_rc(tid * 16 + i * 8192, R, C); const int Rb = Epi::PERM ? ((R & ~31) + perm32(R & 31)) : R;
        voffA[i] = (unsigned)(R * K + C) * 2u; voffB[i] = (unsigned)(Rb * K + C) * 2u; }
    const size_t kstep = (size_t)(BK * 2);
    const size_t hstep = (size_t)HALF * K * 2;
    const size_t tstep = 2 * hstep;
    const unsigned ldsw = (unsigned)wid * 1024u;
    const int aoff = lds_byte(wr * 64 + fr, fq * 8), boff = lds_byte(wc * 32 + fr, fq * 8);
#define PG8_SA(b, h) (((b) * 2 + (h)) * HTB)
#define PG8_SB(b, h) ((4 + (b) * 2 + (h)) * HTB)
#define PG8_STAGE(bufoff, gbase, voff) do { _Pragma("unroll") for (int _i = 0; _i < 2; ++_i) \
        __builtin_amdgcn_global_load_lds((const unsigned*)((const char*)(gbase) + (voff)[_i]), (PG8_LAS unsigned*)(lds + (bufoff) + ldsw + _i * 8192), 16, 0, 0); } while (0)
#define PG8_LDA(dst, b, h) do { _Pragma("unroll") for (int m = 0; m < 4; ++m) _Pragma("unroll") for (int k = 0; k < 2; ++k) dst[m][k] = *(const PG8_LAS bf16x8*)(lds + PG8_SA(b, h) + aoff + m * 2048 + k * 1024); } while (0)
#define PG8_LDB(dst, b, h) do { _Pragma("unroll") for (int n = 0; n < 2; ++n) _Pragma("unroll") for (int k = 0; k < 2; ++k) dst[n][k] = *(const PG8_LAS bf16x8*)(lds + PG8_SB(b, h) + boff + n * 2048 + k * 1024); } while (0)
#define PG8_F8FRAG(X) __builtin_shufflevector(__builtin_bit_cast(i32x4, (X)[0]), __builtin_bit_cast(i32x4, (X)[1]), 0, 1, 2, 3, 4, 5, 6, 7)
#define PG8_MMA(ai, bj, At, Bt) do { __builtin_amdgcn_s_setprio(1); \
        if constexpr (F8 == 2) { _Pragma("unroll") for (int m = 0; m < 4; ++m) _Pragma("unroll") for (int n = 0; n < 2; ++n) _Pragma("unroll") for (int k = 0; k < 2; ++k) \
            acc[ai][bj][m][n] = __builtin_bit_cast(f32x4, __builtin_amdgcn_mfma_i32_16x16x64_i8(__builtin_bit_cast(i32x4, Bt[n][k]), __builtin_bit_cast(i32x4, At[m][k]), __builtin_bit_cast(i32x4, acc[ai][bj][m][n]), 0, 0, 0)); } \
        else if constexpr (F8 == 1) { _Pragma("unroll") for (int m = 0; m < 4; ++m) _Pragma("unroll") for (int n = 0; n < 2; ++n) \
            { const i32x8 a8_ = PG8_F8FRAG(Bt[n]), b8_ = PG8_F8FRAG(At[m]); asm volatile("v_mfma_f32_16x16x128_f8f6f4 %0, %1, %2, %0" : "+v"(acc[ai][bj][m][n]) : "v"(a8_), "v"(b8_)); } } \
        else { _Pragma("unroll") for (int m = 0; m < 4; ++m) _Pragma("unroll") for (int n = 0; n < 2; ++n) _Pragma("unroll") for (int k = 0; k < 2; ++k) \
            acc[ai][bj][m][n] = __builtin_amdgcn_mfma_f32_16x16x32_f16(Bt[n][k], At[m][k], acc[ai][bj][m][n], 0, 0, 0); } \
        __builtin_amdgcn_s_setprio(0); } while (0)
#define PG8_WAIT_V(n) asm volatile("s_waitcnt vmcnt(" #n ")" ::: "memory")
#define PG8_WAIT_L(n) asm volatile("s_waitcnt lgkmcnt(" #n ")" ::: "memory")
#define PG8_BAR __builtin_amdgcn_s_barrier()
#define PG8_SCHED __builtin_amdgcn_sched_barrier(0)
    Unit cur, nxt; int ui = 0;
    if (!S.next(0, cur)) return;
    f32x4 acc[2][2][4][2];
#pragma unroll
    for (int a = 0; a < 2; ++a)
#pragma unroll
        for (int b = 0; b < 2; ++b)
#pragma unroll
            for (int m = 0; m < 4; ++m)
#pragma unroll
                for (int n = 0; n < 2; ++n) acc[a][b][m][n] = (f32x4){0.f, 0.f, 0.f, 0.f};
    bf16x8 At[4][2], B0[2][2], B1[2][2];
    const char* cA = (const char*)g.A + (size_t)cur.pm * tstep; const char* cB = (const char*)g.Bt + (size_t)cur.pn * tstep;
    S.a_ready(cur);
    if constexpr (SP2) {
        PG8_STAGE(PG8_SB(0, 0), cB, voffB); PG8_STAGE(PG8_SB(0, 1), cB + hstep, voffB); PG8_STAGE(PG8_SA(0, 0), cA, voffA); PG8_STAGE(PG8_SA(0, 1), cA + hstep, voffA);
        pre();
        if (wr == 1) PG8_BAR;
        PG8_WAIT_V(2); PG8_BAR;
        PG8_STAGE(PG8_SB(1, 0), cB + kstep, voffB); PG8_STAGE(PG8_SA(1, 0), cA + kstep, voffA); PG8_STAGE(PG8_SB(1, 1), cB + hstep + kstep, voffB);
        PG8_WAIT_V(6); PG8_BAR;
    } else {
        PG8_STAGE(PG8_SB(0, 0), cB, voffB); PG8_STAGE(PG8_SA(0, 0), cA, voffA); PG8_STAGE(PG8_SB(0, 1), cB + hstep, voffB); PG8_STAGE(PG8_SA(0, 1), cA + hstep, voffA);
        if (wr == 1) PG8_BAR;
        PG8_WAIT_V(4); PG8_BAR;
        PG8_STAGE(PG8_SB(1, 0), cB + kstep, voffB); PG8_STAGE(PG8_SA(1, 0), cA + kstep, voffA); PG8_STAGE(PG8_SB(1, 1), cB + hstep + kstep, voffB);
        PG8_WAIT_V(6); PG8_BAR;
    }
    for (;;) {
        const bool has_next = S.next(ui + 1, nxt);
        const char* nA = has_next ? (const char*)g.A + (size_t)nxt.pm * tstep : cA; const char* nB = has_next ? (const char*)g.Bt + (size_t)nxt.pn * tstep : cB;
        for (int t = 0; t < nt; t += 2) {
            const bool last = (t == nt - 2);
            const char* a1 = cA + (size_t)(t + 1) * kstep;
            const char* a2 = last ? nA : cA + (size_t)(t + 2) * kstep; const char* b2 = last ? nB : cB + (size_t)(t + 2) * kstep;
            const char* a3 = a2 + kstep; const char* b3 = b2 + kstep;
            if (last && has_next) S.a_ready(nxt);
            if constexpr (SP2) {
            PG8_LDB(B0, 0, 0); PG8_LDB(B1, 0, 1); PG8_SCHED; PG8_LDA(At, 0, 0); PG8_STAGE(PG8_SA(1, 1), a1 + hstep, voffA);
            PG8_WAIT_V(8); PG8_WAIT_L(0); PG8_BAR; PG8_MMA(0, 0, At, B0); PG8_MMA(0, 1, At, B1); PG8_BAR; PG8_SCHED;
            PG8_LDA(At, 0, 1); PG8_STAGE(PG8_SB(0, 0), b2, voffB); PG8_STAGE(PG8_SB(0, 1), b2 + hstep, voffB); PG8_STAGE(PG8_SA(0, 0), a2, voffA);
            PG8_WAIT_V(8); PG8_WAIT_L(0); PG8_BAR; PG8_MMA(1, 0, At, B0); PG8_MMA(1, 1, At, B1); PG8_BAR; PG8_SCHED;
            PG8_LDB(B0, 1, 0); PG8_LDB(B1, 1, 1); PG8_SCHED; PG8_LDA(At, 1, 0); PG8_STAGE(PG8_SA(0, 1), a2 + hstep, voffA);
            PG8_WAIT_V(8); PG8_WAIT_L(0); PG8_BAR; PG8_MMA(0, 0, At, B0); PG8_MMA(0, 1, At, B1); PG8_BAR; PG8_SCHED;
            PG8_LDA(At, 1, 1); PG8_STAGE(PG8_SB(1, 0), b3, voffB); PG8_STAGE(PG8_SB(1, 1), b3 + hstep, voffB); PG8_STAGE(PG8_SA(1, 0), a3, voffA);
            PG8_WAIT_V(8); PG8_WAIT_L(0); PG8_BAR; PG8_MMA(1, 0, At, B0); PG8_MMA(1, 1, At, B1); PG8_BAR; PG8_SCHED;
            } else {
            PG8_LDB(B0, 0, 0); PG8_SCHED; PG8_LDA(At, 0, 0); PG8_STAGE(PG8_SA(1, 1), a1 + hstep, voffA);
            PG8_WAIT_L(8); PG8_BAR; PG8_WAIT_L(0); PG8_MMA(0, 0, At, B0); PG8_BAR; PG8_SCHED;
            PG8_LDB(B1, 0, 1); PG8_STAGE(PG8_SB(0, 0), b2, voffB);
            PG8_BAR; PG8_WAIT_L(0); PG8_MMA(0, 1, At, B1); PG8_BAR;
            PG8_LDA(At, 0, 1); PG8_STAGE(PG8_SA(0, 0), a2, voffA);
            PG8_BAR; PG8_WAIT_L(0); PG8_MMA(1, 0, At, B0); PG8_BAR; PG8_SCHED;
            PG8_STAGE(PG8_SB(0, 1), b2 + hstep, voffB);
            PG8_WAIT_V(6); PG8_BAR; PG8_MMA(1, 1, At, B1); PG8_BAR;
            PG8_LDB(B0, 1, 0); PG8_SCHED; PG8_LDA(At, 1, 0); PG8_STAGE(PG8_SA(0, 1), a2 + hstep, voffA);
            PG8_WAIT_L(8); PG8_BAR; PG8_WAIT_L(0); PG8_MMA(0, 0, At, B0); PG8_BAR; PG8_SCHED;
            PG8_LDB(B1, 1, 1); PG8_STAGE(PG8_SB(1, 0), b3, voffB);
            PG8_BAR; PG8_WAIT_L(0); PG8_MMA(0, 1, At, B1); PG8_BAR;
            PG8_LDA(At, 1, 1); PG8_STAGE(PG8_SA(1, 0), a3, voffA);
            PG8_BAR; PG8_WAIT_L(0); PG8_MMA(1, 0, At, B0); PG8_BAR; PG8_SCHED;
            PG8_STAGE(PG8_SB(1, 1), b3 + hstep, voffB);
            PG8_WAIT_V(6); PG8_BAR; PG8_MMA(1, 1, At, B1); PG8_BAR;
            }
        }
        if constexpr (F8) asm volatile("s_nop 15\n\ts_nop 15" ::: "memory");
        if constexpr (ALIGN_EPI) { if (wr == 0) PG8_BAR; }
        if constexpr (!Epi::AFTER_DRAIN) { E(acc, cur, wr, wc, fr, fq); S.done(cur); }
        if (!has_next) break;
#pragma unroll
        for (int a = 0; a < 2; ++a)
#pragma unroll
            for (int b = 0; b < 2; ++b)
#pragma unroll
                for (int m = 0; m < 4; ++m)
#pragma unroll
                    for (int n = 0; n < 2; ++n) acc[a][b][m][n] = (f32x4){0.f, 0.f, 0.f, 0.f};
        cur = nxt; cA = nA; cB = nB; ++ui;
        if constexpr (ALIGN_EPI) { if (wr == 1) PG8_BAR; }
    }
    PG8_WAIT_V(0);
    if constexpr (!ALIGN_EPI) { if (wr == 0) PG8_BAR; }
    PG8_BAR;
    if constexpr (Epi::AFTER_DRAIN) { E.fused(acc, cur, wr, wc, fr, fq, lds, wid, lane); S.done(cur); }
#undef PG8_SA
#undef PG8_SB
#undef PG8_STAGE
#undef PG8_LDA
#undef PG8_LDB
#undef PG8_MMA
#undef PG8_WAIT_V
#undef PG8_WAIT_L
#undef PG8_BAR
#undef PG8_SCHED
}
}
#define LAS __attribute__((address_space(3)))
#define XB_TMO      128
#define XB_XCNT(j)  (256  + 64 * (j))
#define XB_XSUB(j)  (1280 + 64 * (j))
#define XB_XGEN(j)  (2304 + 64 * (j))
#define XB_TOP      3328
#define XB_TOPGEN   3392
#define XCD_BAR_WORDS 3456
#define XB_SPIN_CAP (1u << 18)

__device__ __forceinline__ unsigned xb_ld(unsigned* p)              { return __hip_atomic_load(p, __ATOMIC_RELAXED, __HIP_MEMORY_SCOPE_AGENT); }
__device__ __forceinline__ unsigned xb_add(unsigned* p, unsigned v) { return __hip_atomic_fetch_add(p, v, __ATOMIC_RELAXED, __HIP_MEMORY_SCOPE_AGENT); }
__device__ __forceinline__ unsigned xb_xcc_id() { return (unsigned)__builtin_amdgcn_s_getreg((3 << 11) | 20) & 0xFu; }
#define XB_SPIN(cond, bar) do { unsigned _sp = 0; while (cond) { __builtin_amdgcn_s_sleep(1); \
    if ((++_sp & 255u) == 0u) { if (xb_ld(&(bar)[XB_TMO])) break; if (_sp > XB_SPIN_CAP) { atomicAdd(&(bar)[XB_TMO], 1u); break; } } } } while (0)

struct XcdBarrier {
    unsigned* bar; unsigned x;
    volatile LAS unsigned* st;
    bool leader;
};

__device__ __forceinline__ XcdBarrier xcd_barrier_post(unsigned* bar, volatile LAS unsigned* st, bool leader) {
    XcdBarrier b; b.bar = bar; b.x = xb_xcc_id(); b.st = st; b.leader = leader;
    if (leader) (void)xb_add(&bar[XB_XCNT(b.x)], 1u);
    return b;
}
__device__ __forceinline__ void xcd_barrier_complete(unsigned* bar, unsigned x, unsigned& nloc, unsigned& nx) {
    const unsigned G = gridDim.x * gridDim.y * gridDim.z;
    unsigned sum, cnt, mine, sp = 0u;
    for (;;) {
        sum = 0u; cnt = 0u; mine = 0u;
#pragma unroll
        for (unsigned j = 0; j < 16; ++j) { const unsigned c = xb_ld(&bar[XB_XCNT(j)]); sum += c; cnt += (c > 0u) ? 1u : 0u; mine = (j == x) ? c : mine; }
        if (sum == G) break;
        __builtin_amdgcn_s_sleep(1);
        if ((++sp & 255u) == 0u) { if (xb_ld(&bar[XB_TMO])) break; if (sp > XB_SPIN_CAP) { atomicAdd(&bar[XB_TMO], 1u); break; } }
    }
    nloc = mine > 0u ? mine : 1u; nx = cnt > 0u ? cnt : 1u;
}

__device__ __forceinline__ void xcd_barrier(const XcdBarrier& b) {
    asm volatile("s_waitcnt vmcnt(0)" ::: "memory");
    __syncthreads();
    if (b.leader) {
        unsigned* bar = b.bar;
        __builtin_amdgcn_s_waitcnt(0);
        unsigned nloc = b.st[0], nx = b.st[1];
        if (nloc == 0u) { xcd_barrier_complete(bar, b.x, nloc, nx); b.st[0] = nloc; b.st[1] = nx; }
        const unsigned old = xb_add(&bar[XB_XSUB(b.x)], 1u);
        const unsigned gen = old / nloc;
        if (old + 1u == (gen + 1u) * nloc) {
            __builtin_amdgcn_fence(__ATOMIC_RELEASE, "agent");
            asm volatile("s_waitcnt vmcnt(0)" ::: "memory");
            const unsigned og = xb_add(&bar[XB_TOP], 1u);
            const unsigned tg = og / nx;
            if (og + 1u == (tg + 1u) * nx) xb_add(&bar[XB_TOPGEN], 1u);
            else XB_SPIN(xb_ld(&bar[XB_TOPGEN]) == tg, bar);
            __builtin_amdgcn_fence(__ATOMIC_ACQUIRE, "agent");
            xb_add(&bar[XB_XGEN(b.x)], 1u);
            asm volatile("s_waitcnt vmcnt(0)" ::: "memory");
        } else {
            XB_SPIN(xb_ld(&bar[XB_XGEN(b.x)]) == gen, bar);
            __builtin_amdgcn_fence(__ATOMIC_ACQUIRE, "agent");
            asm volatile("s_waitcnt vmcnt(0)" ::: "memory");
        }
    }
    __syncthreads();
}

#ifndef LAS
#define LAS __attribute__((address_space(3)))
#endif
typedef unsigned short bf16_t;
typedef _Float16 bf16x8 __attribute__((ext_vector_type(8)));
typedef _Float16 bf16x4 __attribute__((ext_vector_type(4)));
typedef float f32x4 __attribute__((ext_vector_type(4)));
typedef float f32x2 __attribute__((ext_vector_type(2)));
typedef unsigned u32x4 __attribute__((ext_vector_type(4)));
typedef unsigned u32x2 __attribute__((ext_vector_type(2)));

constexpr int S = 8192, DM = 2048, NL = 4, HD = 128, DIN = 5656, DINP = 5888, DFF = 5632, NCMP = 511;
constexpr float EPS = 1e-6f;
constexpr float SCALE = 0.08838834764831845f;
constexpr int NWAVES = 8, NTHREADS = 512;
constexpr int LDS_BYTES = 147456;
constexpr int RING_BYTES = 131072, MISC_OFF = LDS_BYTES - 64;

constexpr size_t MiB = 1u << 20;
constexpr float W8_SCALE = 64.0f, A8_SCALE = 8.0f;
constexpr size_t WS_CTL = 0, CTL_ZERO_BYTES = 1 * MiB;
constexpr size_t WS_ROPE = 1 * MiB;
constexpr size_t WS_CBP = WS_ROPE + 1024 * 1024;
constexpr size_t WS_ROPEH = 5 * MiB + 512 * 1024;
constexpr size_t WS_CBF = 3 * MiB + 512 * 1024;
constexpr size_t WS_KC = 2 * MiB + 512 * 1024;
constexpr size_t WS_VC = WS_KC + 256 * 1024;
constexpr size_t WS_SEL = 3 * MiB;
constexpr size_t WS_GATES = 4 * MiB;
constexpr size_t WS_SSQ = 5 * MiB;
constexpr size_t WS_W = 8 * MiB;
constexpr size_t W_IN = 0, W_OUT = 23 * MiB, W_GU = 31 * MiB, W_DN = 75 * MiB, W_C1 = 97 * MiB, W_C2 = 101 * MiB, W_LAYER = 102 * MiB;
constexpr size_t WS_H = WS_W + NL * W_LAYER;
constexpr size_t WS_XN8 = WS_H;
constexpr size_t WS_XSLAB = WS_H + 32 * MiB;
constexpr size_t WS_XN = WS_H + 64 * MiB;
constexpr size_t WS_O = WS_XN + 32 * MiB;
constexpr size_t WS_OCMP = WS_O + 32 * MiB;
constexpr size_t WS_PROJ = WS_OCMP + 32 * MiB;
constexpr size_t WS_ACT = WS_PROJ;
constexpr size_t WS_PART = WS_PROJ + 88 * MiB;
constexpr size_t PART_SLOT = 131072 + 2048;
constexpr size_t WS_W8 = 688 * MiB;
constexpr size_t WS_WSC = WS_W8 + NL * 22 * MiB;
constexpr size_t WS_ASC = WS_WSC + 1 * MiB;
constexpr size_t WS_WI8 = WS_ASC + 1 * MiB;
constexpr size_t WS_WISC = WS_WI8 + NL * 12 * MiB;
constexpr size_t WS_END = WS_WISC + 1 * MiB;
static_assert(WS_PART + 128 * PART_SLOT <= WS_W8, "ws map");
constexpr size_t WS_CPART = 6 * MiB;
constexpr int CW_CFLAG = 32768;
constexpr int CW_XCNT = 49152;
constexpr int CW_NSAFLAG = 16384;
static_assert((size_t)DINP * DM * 2 == 23 * MiB && (size_t)2 * DFF * DM * 2 == 44 * MiB && (size_t)DM * DFF * 2 == 22 * MiB, "weight map");

struct Params { const float* in[17]; float* out; unsigned char* ws; };

struct Ctx {
    LAS unsigned char* lds;
    int tid, lane, wave, gw, ngw, bx;
};

__device__ __forceinline__ float bf2f(unsigned b) { return (float)__builtin_bit_cast(_Float16, (unsigned short)b); }
__device__ __forceinline__ unsigned f2bf(float f) { return (unsigned)__builtin_bit_cast(unsigned short, (_Float16)f); }
typedef _Float16 h2_t __attribute__((ext_vector_type(2)));
__device__ __forceinline__ unsigned pk2(float lo, float hi) { const h2_t v = {(_Float16)lo, (_Float16)hi}; return __builtin_bit_cast(unsigned, v); }
#define DPP_F(old_, src_, ctrl_, rmask_) __builtin_bit_cast(float, __builtin_amdgcn_update_dpp(__builtin_bit_cast(int, (old_)), __builtin_bit_cast(int, (src_)), (ctrl_), (rmask_), 0xf, false))
__device__ __forceinline__ float wave_sum(float v) {
    v += DPP_F(0.f, v, 0x111, 0xf); v += DPP_F(0.f, v, 0x112, 0xf); v += DPP_F(0.f, v, 0x114, 0xf); v += DPP_F(0.f, v, 0x118, 0xf);
    v += DPP_F(0.f, v, 0x142, 0xa); v += DPP_F(0.f, v, 0x143, 0xc);
    return __builtin_bit_cast(float, __builtin_amdgcn_readlane(__builtin_bit_cast(int, v), 63));
}
__device__ __forceinline__ float wave_max_u(float v) {
    v = fmaxf(v, DPP_F(0.f, v, 0x111, 0xf)); v = fmaxf(v, DPP_F(0.f, v, 0x112, 0xf)); v = fmaxf(v, DPP_F(0.f, v, 0x114, 0xf)); v = fmaxf(v, DPP_F(0.f, v, 0x118, 0xf));
    v = fmaxf(v, DPP_F(0.f, v, 0x142, 0xa)); v = fmaxf(v, DPP_F(0.f, v, 0x143, 0xc));
    return __builtin_bit_cast(float, __builtin_amdgcn_readlane(__builtin_bit_cast(int, v), 63));
}
__device__ __forceinline__ float rope_inv(int i) {
    switch (i) {
        case 0: return 1.0f;
        case 1: return 0.44036659598350525f;
        case 2: return 0.1939227432012558f;
        case 3: return 0.08539710193872452f;
        case 4: return 0.03760603070259094f;
        case 5: return 0.016560440883040428f;
        case 6: return 0.007292664609849453f;
        case 7: return 0.0032114461064338684f;
        case 8: return 0.0014142135623842478f;
        case 9: return 0.0006227724370546639f;
        case 10: return 0.00027424818836152554f;
        case 11: return 0.00012076973507646471f;
        case 12: return 5.3182957344688475e-05f;
        case 13: return 2.34199997066753e-05f;
        case 14: return 1.0313385246263351e-05f;
        default: return 4.541670477919979e-06f;
    }
}
__device__ __forceinline__ void sincos_d(float ang, float& c, float& s) {
    const double x = (double)ang;
    const double q = rint(x * 0.63661977236758134308);
    const double r = fma(-q, 1.57079632679489661923, x) - q * 6.123233995736766e-17;
    const double r2 = r * r;
    double cs = 1.0 / 479001600.0; cs = cs * r2 - 1.0 / 3628800.0; cs = cs * r2 + 1.0 / 40320.0; cs = cs * r2 - 1.0 / 720.0; cs = cs * r2 + 1.0 / 24.0; cs = cs * r2 - 0.5; cs = cs * r2 + 1.0;
    double sn = 1.0 / 6227020800.0; sn = sn * r2 - 1.0 / 39916800.0; sn = sn * r2 + 1.0 / 362880.0; sn = sn * r2 - 1.0 / 5040.0; sn = sn * r2 + 1.0 / 120.0; sn = sn * r2 - 1.0 / 6.0; sn = sn * r2 + 1.0; sn *= r;
    const int qi = ((int)(long long)q) & 3;
    double cc, ss;
    if (qi == 0) { cc = cs; ss = sn; } else if (qi == 1) { cc = -sn; ss = cs; } else if (qi == 2) { cc = -cs; ss = -sn; } else { cc = sn; ss = -cs; }
    c = (float)cc; s = (float)ss;
}
__device__ __forceinline__ float gelu_tanh(float x) {
    const float y = 0.7978845608028654f * (x + 0.044715f * x * x * x);
    const float e = __expf(2.0f * y);
    const float th = 1.0f - 2.0f / (e + 1.0f);
    return 0.5f * x * (1.0f + th);
}
__device__ __forceinline__ float partner32(float x, int hi) { auto rr = __builtin_amdgcn_permlane32_swap(__float_as_uint(x), __float_as_uint(x), false, false); return __uint_as_float(hi ? rr[0] : rr[1]); }
__device__ __forceinline__ float sigmoidf_(float x) { return __builtin_amdgcn_rcpf(1.0f + __builtin_amdgcn_exp2f(x * -1.4426950408889634f)); }

__device__ __forceinline__ bf16_t* w_ptr(const Params& p, int l, size_t off) { return (bf16_t*)(p.ws + WS_W + (size_t)l * W_LAYER + off); }

struct ConvItem { const float* W; const float* gain; bf16_t* WT; int N, k0, sc, nv, drow, dK, frag, f8; };
constexpr int I_IN = 32 * 184, I_OUT = 32 * 64, I_GU = 32 * 352, I_DN = 88 * 64, I_C1 = 1024, I_C2 = 32;
constexpr int I_LAYER = I_OUT + I_DN + I_C1 + I_C2;
__device__ __forceinline__ ConvItem conv_desc(const Params& p, int it) {
    const int l = it / I_LAYER; int r = it - l * I_LAYER; ConvItem d; d.frag = 0; d.f8 = 0;
    if (r < I_OUT) { const int kb = r / 64, nb = r % 64;
        d.W = p.in[11] + (size_t)l * DM * DM; d.N = DM; d.k0 = 64 * kb; d.sc = 32 * nb; d.nv = 32; d.WT = w_ptr(p, l, W_OUT); d.drow = 32 * nb; d.dK = DM; d.gain = nullptr; return d; }
    r -= I_OUT;
    if (r < I_DN) { const int kb = r / 64, nb = r % 64;
        d.W = p.in[15] + (size_t)l * DFF * DM; d.N = DM; d.k0 = 64 * kb; d.sc = 32 * nb; d.nv = 32; d.WT = w_ptr(p, l, W_DN); d.drow = 32 * nb; d.dK = DFF; d.gain = nullptr; d.f8 = 1; return d; }
    r -= I_DN;
    if (r < I_C1) { const int kv = r / 512, rr = r % 512, kb = rr / 8, nb = rr % 8;
        d.W = p.in[kv ? 8 : 6] + (size_t)l * 4096 * 256; d.N = 256; d.k0 = 64 * kb; d.sc = 32 * nb; d.nv = 32; d.WT = w_ptr(p, l, W_C1) + (size_t)kv * 256 * 4096; d.drow = 32 * nb; d.dK = 4096; d.gain = nullptr; d.frag = 1; return d; }
    r -= I_C1;
    { const int kv = r / 16, rr = r % 16, kb = rr / 4, nb = rr % 4;
        d.W = p.in[kv ? 9 : 7] + (size_t)l * 256 * 128; d.N = 128; d.k0 = 64 * kb; d.sc = 32 * nb; d.nv = 32; d.WT = w_ptr(p, l, W_C2) + (size_t)kv * 128 * 256; d.drow = 32 * nb; d.dK = 256; d.gain = nullptr; return d; }
}
#define CONV_LOAD(d, tv) do { const int c_ = lane & 31; const float* wp_ = (d).W + (size_t)((d).k0 + (lane >> 5)) * (d).N + (d).sc + (c_ < (d).nv ? c_ : 0); \
        _Pragma("unroll") for (int i = 0; i < 32; ++i) tv[i] = wp_[(size_t)(2 * i) * (d).N]; } while (0)
#define CONV_STORE(d, tv) do { const int c_ = lane & 31; const bool ok_ = c_ < (d).nv; _Pragma("unroll") for (int i = 0; i < 32; ++i) { const int kk = 2 * i + (lane >> 5); scr[kk * 33 + c_] = ok_ ? tv[i] : 0.f; } \
        asm volatile("s_waitcnt lgkmcnt(0)" ::: "memory"); \
        const int c8 = lane & 7; f32x4 ga = {1.f, 1.f, 1.f, 1.f}, gb = {1.f, 1.f, 1.f, 1.f}; \
        if ((d).gain) { ga = *(const f32x4*)((d).gain + (d).k0 + 8 * c8); gb = *(const f32x4*)((d).gain + (d).k0 + 8 * c8 + 4); } \
        _Pragma("unroll") for (int j = 0; j < 4; ++j) { const int n = (lane >> 3) + 8 * j; const LAS float* s = scr + (8 * c8) * 33 + n; \
            u32x4 o; o.x = pk2(s[0 * 33] * ga.x, s[1 * 33] * ga.y); o.y = pk2(s[2 * 33] * ga.z, s[3 * 33] * ga.w); o.z = pk2(s[4 * 33] * gb.x, s[5 * 33] * gb.y); o.w = pk2(s[6 * 33] * gb.z, s[7 * 33] * gb.w); \
            const int na_ = (d).drow + n, ka_ = (d).k0 + 8 * c8; \
            const size_t off_ = (d).frag ? (size_t)((((na_ >> 4) * 128 + (ka_ >> 5)) * 64 + (((ka_ >> 3) & 3) * 16 + (na_ & 15))) * 8) : (size_t)na_ * (d).dK + ka_; \
            if ((d).f8) { int w0_ = 0, w1_ = 0; \
                w0_ = __builtin_amdgcn_cvt_pk_fp8_f32(s[0 * 33] * ga.x * W8_SCALE, s[1 * 33] * ga.y * W8_SCALE, w0_, false); w0_ = __builtin_amdgcn_cvt_pk_fp8_f32(s[2 * 33] * ga.z * W8_SCALE, s[3 * 33] * ga.w * W8_SCALE, w0_, true); \
                w1_ = __builtin_amdgcn_cvt_pk_fp8_f32(s[4 * 33] * gb.x * W8_SCALE, s[5 * 33] * gb.y * W8_SCALE, w1_, false); w1_ = __builtin_amdgcn_cvt_pk_fp8_f32(s[6 * 33] * gb.z * W8_SCALE, s[7 * 33] * gb.w * W8_SCALE, w1_, true); \
                u32x2 o8_; o8_.x = (unsigned)w0_; o8_.y = (unsigned)w1_; *(u32x2*)((unsigned char*)(d).WT + off_) = o8_; } \
            else *(u32x4*)((d).WT + off_) = o; } \
        asm volatile("s_waitcnt lgkmcnt(0)" ::: "memory"); } while (0)

constexpr int STRIP_RS = 4100, N_STRIPS_L = 184 + 352;
static_assert(32 * STRIP_RS <= MISC_OFF, "LDS map");
struct StripDesc { const float* W; const float* gain; unsigned char* dst; float* dsc; int N, sc, nv, drow; };
__device__ __forceinline__ StripDesc strip_desc(const Params& p, int s) {
    const int l = s / N_STRIPS_L, r = s - l * N_STRIPS_L; StripDesc d;
    if (r < 184) { const int n0 = 32 * r; int sc, nv;
        if (n0 < 2560) { sc = n0; nv = 32; } else if (n0 < 5632) { sc = n0 + 24; nv = 32; } else if (n0 == 5632) { sc = 2560; nv = 24; } else { sc = 0; nv = 0; }
        d.W = p.in[3] + (size_t)l * DM * DIN; d.N = DIN; d.sc = sc; d.nv = nv; d.gain = p.in[2] + (size_t)l * DM;
        d.dst = p.ws + WS_WI8 + (size_t)l * 12 * MiB; d.dsc = (float*)(p.ws + WS_WISC) + l * DINP; d.drow = n0; }
    else { const int r0 = 32 * (r - 184), pn = r0 >> 8, w = r0 & 255;
        d.W = (w < 128 ? p.in[13] : p.in[14]) + (size_t)l * DM * DFF; d.N = DFF; d.sc = 128 * pn + (w & 127); d.nv = 32; d.gain = p.in[12] + (size_t)l * DM;
        d.dst = p.ws + WS_W8 + (size_t)l * 22 * MiB; d.dsc = (float*)(p.ws + WS_WSC) + l * 2 * DFF; d.drow = r0; }
    return d;
}
#define STRIP_LOAD(d, k0, tv) do { const int c_ = lane & 31; const float* wp_ = (d).W + (size_t)((k0) + (lane >> 5)) * (d).N + (d).sc + (c_ < (d).nv ? c_ : 0); \
        _Pragma("unroll") for (int i = 0; i < 32; ++i) tv[i] = wp_[(size_t)(2 * i) * (d).N]; } while (0)
#define STRIP_PUT(d, k0, tv) do { const int c_ = lane & 31, hi_ = lane >> 5; const bool ok_ = c_ < (d).nv; \
        _Pragma("unroll") for (int pp = 0; pp < 16; ++pp) { \
            auto sw_ = __builtin_amdgcn_permlane32_swap(__float_as_uint(tv[2 * pp]), __float_as_uint(tv[2 * pp + 1]), false, false); \
            const float v0_ = __uint_as_float(sw_[0]), v1_ = __uint_as_float(sw_[1]);         \
            const f32x4 g_ = *(const f32x4*)((d).gain + (k0) + 4 * pp); \
            const float g0_ = hi_ ? g_.z : g_.x, g1_ = hi_ ? g_.w : g_.y; \
            *(LAS unsigned*)(c.lds + c_ * STRIP_RS + ((k0) + 4 * pp + 2 * hi_) * 2) = ok_ ? pk2(v0_ * g0_, v1_ * g1_) : 0u; } } while (0)
__device__ __forceinline__ void conv_strips(const Params& p, const Ctx& c) {
    const int lane = c.lane, w = c.wave, total = NL * N_STRIPS_L, step = c.ngw / NWAVES;
    int s = c.bx; float ta[32], tb[32]; StripDesc d{}, d1{};
    if (s < total) { d = strip_desc(p, s); STRIP_LOAD(d, 256 * w, ta); }
    while (s < total) {
        STRIP_LOAD(d, 256 * w + 64, tb);  STRIP_PUT(d, 256 * w, ta);
        STRIP_LOAD(d, 256 * w + 128, ta); STRIP_PUT(d, 256 * w + 64, tb);
        STRIP_LOAD(d, 256 * w + 192, tb); STRIP_PUT(d, 256 * w + 128, ta);
        const int s1 = s + step;
        if (s1 < total) { d1 = strip_desc(p, s1); STRIP_LOAD(d1, 256 * w, ta); }
        STRIP_PUT(d, 256 * w + 192, tb);
        __syncthreads();
#pragma unroll 1
        for (int q = 0; q < 4; ++q) { const int n = w + 8 * q;
            bf16x8 v[4];
#pragma unroll
            for (int j = 0; j < 4; ++j) { const LAS unsigned* q_ = (const LAS unsigned*)(c.lds + n * STRIP_RS + (lane + 64 * j) * 16); u32x4 t_; t_.x = q_[0]; t_.y = q_[1]; t_.z = q_[2]; t_.w = q_[3]; v[j] = __builtin_bit_cast(bf16x8, t_); }
            float mx = 0.f;
#pragma unroll
            for (int j = 0; j < 4; ++j)
#pragma unroll
                for (int e = 0; e < 8; ++e) mx = fmaxf(mx, fabsf((float)v[j][e]));
            mx = wave_max_u(mx);
            const float inv = mx > 0.f ? 127.0f / mx : 0.f;
#pragma unroll
            for (int j = 0; j < 4; ++j) { unsigned ww[2];
#pragma unroll
                for (int h = 0; h < 2; ++h) { unsigned u = 0u;
#pragma unroll
                    for (int e = 0; e < 4; ++e) { const int qv = (int)__builtin_rintf((float)v[j][4 * h + e] * inv); u |= ((unsigned)qv & 0xFFu) << (8 * e); }
                    ww[h] = u; }
                u32x2 o; o.x = ww[0]; o.y = ww[1]; ((u32x2*)(d.dst + (size_t)(d.drow + n) * DM))[lane + 64 * j] = o; }
            if (lane == 0) d.dsc[d.drow + n] = mx * (1.0f / 127.0f); }
        __syncthreads();
        d = d1; s = s1;
    }
}
__device__ __forceinline__ void conv_items(const Params& p, const Ctx& c, int it0, int total, int step, int nA = 0x7fffffff, int baseB = 0) {
    LAS float* scr = (LAS float*)(c.lds + c.wave * 8704);
    const int lane = c.lane;
    int it = it0;
    float ta[32], tb[32]; ConvItem da, db;
#define CONV_IDX(v_) ((v_) < nA ? (v_) : (v_) - nA + baseB)
    if (it < total) { da = conv_desc(p, CONV_IDX(it)); CONV_LOAD(da, ta); }
    while (it < total) {
        const int i1 = it + step;
        if (i1 < total) { db = conv_desc(p, CONV_IDX(i1)); CONV_LOAD(db, tb); }
        CONV_STORE(da, ta);
        if (i1 >= total) break;
        const int i2 = i1 + step;
        if (i2 < total) { da = conv_desc(p, CONV_IDX(i2)); CONV_LOAD(da, ta); }
        CONV_STORE(db, tb);
        it = i2;
    }
#undef CONV_IDX
}
__device__ __forceinline__ void phase_conv(const Params& p, const Ctx& c) {
    LAS float* scr = (LAS float*)(c.lds + c.wave * 8704);
    const int lane = c.lane;
    { float* cbp = (float*)(p.ws + WS_CBP);
      for (int task = c.gw; task < NL * 2 * 4 * 64; task += c.ngw) { const int ic = task & 63, jg = (task >> 6) & 3, kv = (task >> 8) & 1, l = task >> 9;
          const float* w1 = p.in[kv ? 8 : 6] + (size_t)l * 4096 * 256 + (size_t)(64 * ic) * 256 + 64 * jg + c.lane; const float* cp = p.in[5] + (size_t)l * 4096 + 64 * ic;
          float s = 0.f;
#pragma unroll
          for (int b = 0; b < 4; ++b) { float wv[16];
#pragma unroll
              for (int i = 0; i < 16; ++i) wv[i] = w1[(size_t)(16 * b + i) * 256];
#pragma unroll
              for (int i = 0; i < 16; ++i) s += cp[16 * b + i] * wv[i]; }
          cbp[((l * 2 + kv) * 64 + ic) * 256 + 64 * jg + c.lane] = s; } }
    conv_items(p, c, I_OUT + I_DN + c.gw, I_LAYER, c.ngw);
    __syncthreads();
    conv_strips(p, c);
    { bf16_t* hb = (bf16_t*)(p.ws + WS_XN); float* ssq = (float*)(p.ws + WS_SSQ);
      for (int m = c.gw; m < S; m += c.ngw) {
          const f32x4* xr = (const f32x4*)(p.in[0] + (size_t)m * DM) + c.lane; float ss = 0.f; f32x4 xv[8];
#pragma unroll
          for (int j = 0; j < 8; ++j) xv[j] = xr[64 * j];
          float mx = 0.f;
#pragma unroll
          for (int j = 0; j < 8; ++j) { const f32x4 v = xv[j]; ss += (v.x * v.x + v.y * v.y) + (v.z * v.z + v.w * v.w);
              u32x2 w; w.x = pk2(v.x, v.y); w.y = pk2(v.z, v.w); ((u32x2*)(hb + (size_t)m * DM))[c.lane + 64 * j] = w;
              const bf16x4 h4 = __builtin_bit_cast(bf16x4, w);
#pragma unroll
              for (int e = 0; e < 4; ++e) { xv[j][e] = (float)h4[e]; mx = fmaxf(mx, fabsf(xv[j][e])); } }
          ss = wave_sum(ss); mx = wave_max_u(mx);
          if (c.lane < 8) ssq[(size_t)m * 8 + c.lane] = c.lane == 0 ? ss : 0.f;
          const float inv = mx > 0.f ? 127.0f / mx : 0.f;
#pragma unroll
          for (int j = 0; j < 8; ++j) { unsigned u = 0u;
#pragma unroll
              for (int e = 0; e < 4; ++e) { const int qv = (int)__builtin_rintf(xv[j][e] * inv); u |= ((unsigned)qv & 0xFFu) << (8 * e); }
              ((unsigned*)(p.ws + WS_XN8 + (size_t)m * DM))[c.lane + 64 * j] = u; }
          if (c.lane == 0) ((float*)(p.ws + WS_ASC))[m] = mx * (1.0f / 127.0f); } }
    { const int* pos = (const int*)p.in[1]; float* tab = (float*)(p.ws + WS_ROPE); bf16_t* tabh = (bf16_t*)(p.ws + WS_ROPEH);
      for (int idx = c.gw * 64 + c.lane; idx < S * 16; idx += c.ngw * 64) { const int t = idx >> 4, i = idx & 15;
          const float ang = (float)pos[t] * rope_inv(i); float cs, sn; sincos_d(ang, cs, sn); tab[t * 32 + i] = cs; tab[t * 32 + 16 + i] = sn; tabh[t * 32 + i] = (bf16_t)f2bf(cs); tabh[t * 32 + 16 + i] = (bf16_t)f2bf(sn); } }
}

__device__ __forceinline__ void cbias_reduce(const Params& p, const Ctx& c) {
    const float* cbp = (const float*)(p.ws + WS_CBP); float* cbf = (float*)(p.ws + WS_CBF);
    for (int o = c.gw; o < NL * 2 * 256; o += c.ngw) { const int col = o & 255, lk = o >> 8;
        const float v = wave_sum(cbp[(size_t)(lk * 64 + c.lane) * 256 + col]); if (c.lane == 0) cbf[o] = v; }
}

__device__ __forceinline__ void phase_final_norm(const Ctx& c, const bf16_t* hb, const float* ssq, const float* gain, float* dst) {
    f32x4 g[4][2];
#pragma unroll
    for (int j = 0; j < 4; ++j) { g[j][0] = ((const f32x4*)gain)[2 * (c.lane + 64 * j)]; g[j][1] = ((const f32x4*)gain)[2 * (c.lane + 64 * j) + 1]; }
    for (int m = c.gw; m < S; m += c.ngw) {
        const f32x4* q = (const f32x4*)(ssq + (size_t)m * 8); const f32x4 a = q[0], b = q[1];
        bf16x8 v[4];
#pragma unroll
        for (int j = 0; j < 4; ++j) v[j] = ((const bf16x8*)(hb + (size_t)m * DM))[c.lane + 64 * j];
        const float rstd = __builtin_amdgcn_rsqf((((a.x + a.y) + (a.z + a.w)) + ((b.x + b.y) + (b.z + b.w))) * (1.0f / DM) + EPS);
#pragma unroll
        for (int j = 0; j < 4; ++j) { f32x4 o0, o1;
#pragma unroll
            for (int e = 0; e < 4; ++e) { o0[e] = (float)v[j][e] * rstd * g[j][0][e]; o1[e] = (float)v[j][4 + e] * rstd * g[j][1][e]; }
            f32x4* d = (f32x4*)(dst + (size_t)m * DM) + 2 * (c.lane + 64 * j); d[0] = o0; d[1] = o1; }
    }
}

__device__ __forceinline__ void quant_rows(const Ctx& c, const bf16_t* src, unsigned char* dst, float* scale, int R, float fixed = 0.f) {
    for (int r = c.gw; r < R; r += c.ngw) {
        bf16x8 v[4];
#pragma unroll
        for (int j = 0; j < 4; ++j) v[j] = ((const bf16x8*)(src + (size_t)r * DM))[c.lane + 64 * j];
        float mx = 0.f;
#pragma unroll
        for (int j = 0; j < 4; ++j)
#pragma unroll
            for (int e = 0; e < 8; ++e) mx = fmaxf(mx, fabsf((float)v[j][e]));
        mx = wave_max_u(mx);
        if (fixed > 0.f) mx = fixed;
        const float inv = mx > 0.f ? 127.0f / mx : 0.f;
#pragma unroll
        for (int j = 0; j < 4; ++j) { unsigned w[2];
#pragma unroll
            for (int h = 0; h < 2; ++h) { unsigned u = 0u;
#pragma unroll
                for (int e = 0; e < 4; ++e) { int q = (int)__builtin_rintf((float)v[j][4 * h + e] * inv); q = q > 127 ? 127 : (q < -127 ? -127 : q); u |= ((unsigned)q & 0xFFu) << (8 * e); }
                w[h] = u; }
            u32x2 o; o.x = w[0]; o.y = w[1]; ((u32x2*)(dst + (size_t)r * DM))[c.lane + 64 * j] = o; }
        if (c.lane == 0) scale[r] = mx * (1.0f / 127.0f);
    }
}

constexpr int RSTD_OFF = RING_BYTES, RSTD_MAX_UNITS = 8;
constexpr int CSC_OFF = RSTD_OFF + RSTD_MAX_UNITS * 1024, CSC_MAX_UNITS = 6;
static_assert(CSC_OFF + CSC_MAX_UNITS * 1024 <= MISC_OFF, "LDS map");
__device__ __forceinline__ void prep_rstd(const Ctx& c, const pg8::StaticOrder& so, const float* ssq, const float* asc = nullptr, const float* wsc = nullptr) {
    LAS float* tab = (LAS float*)(c.lds + RSTD_OFF); LAS float* ctab = (LAS float*)(c.lds + CSC_OFF);
    const int half = c.tid >> 8, t = c.tid & 255;
    for (int i = half; i < RSTD_MAX_UNITS; i += 2) { pg8::Unit u; if (!so.next(i, u)) break;
        const f32x4* q = (const f32x4*)(ssq + (size_t)(u.pm * 256 + t) * 8); const f32x4 a = q[0], b = q[1];
        float rs = __builtin_amdgcn_rsqf((((a.x + a.y) + (a.z + a.w)) + ((b.x + b.y) + (b.z + b.w))) * (1.0f / DM) + EPS);
        if (asc) { rs *= asc[u.pm * 256 + t]; if (i < CSC_MAX_UNITS) ctab[i * 256 + t] = wsc[u.pn * 256 + t]; }
        tab[i * 256 + t] = rs; }
}
struct PrepRstd { const Ctx& c; const pg8::StaticOrder& so; const float* ssq; const float* asc; const float* wsc; __device__ __forceinline__ void operator()() const { prep_rstd(c, so, ssq, asc, wsc); } };
struct EpiProj {
    static constexpr bool PERM = true, AFTER_DRAIN = false;
    bf16_t* proj; float* gates; const bf16_t* ropeh; const float* bg; const LAS float* rtab; const LAS float* ctab;
    __device__ __forceinline__ void operator()(pg8::f32x4 (&acc)[2][2][4][2], const pg8::Unit& u, int wr, int wc, int fr, int fq) const {
        const int row0 = u.pm * 256 + wr * 64 + fr;
        {
            const LAS f32x4* cs = (const LAS f32x4*)(ctab + u.ord * 256 + wc * 32 + 8 * fq);
#pragma unroll
            for (int bj = 0; bj < 2; ++bj) { const f32x4 c0 = cs[32 * bj], c1 = cs[32 * bj + 1];
#pragma unroll
                for (int ai = 0; ai < 2; ++ai)
#pragma unroll
                    for (int m = 0; m < 4; ++m) { const pg8::i32x4 i0 = __builtin_bit_cast(pg8::i32x4, acc[ai][bj][m][0]), i1 = __builtin_bit_cast(pg8::i32x4, acc[ai][bj][m][1]);
#pragma unroll
                        for (int j = 0; j < 4; ++j) { acc[ai][bj][m][0][j] = (float)i0[j] * c0[j]; acc[ai][bj][m][1][j] = (float)i1[j] * c1[j]; } } }
        }
        float rstd[2][4];
#pragma unroll
        for (int ai = 0; ai < 2; ++ai)
#pragma unroll
            for (int m = 0; m < 4; ++m) rstd[ai][m] = rtab[u.ord * 256 + ai * 128 + wr * 64 + m * 16 + fr];
        const bool rp = (u.pn < 4 || u.pn == 6 || u.pn == 8) && wc == 0;
        if (rp) {
#pragma unroll
            for (int ai = 0; ai < 2; ++ai) {
                bf16x8 rc[4], rsn[4];
#pragma unroll
                for (int m = 0; m < 4; ++m) { const bf16_t* cs = ropeh + (size_t)(row0 + ai * 128 + m * 16) * 32 + (fq & 1) * 8; rc[m] = *(const bf16x8*)cs; rsn[m] = *(const bf16x8*)(cs + 16); }
#pragma unroll
                for (int m = 0; m < 4; ++m) {
                    f32x4 c0, c1, s0, s1;
#pragma unroll
                    for (int j = 0; j < 4; ++j) { c0[j] = (float)rc[m][j]; c1[j] = (float)rc[m][4 + j]; s0[j] = (float)rsn[m][j]; s1[j] = (float)rsn[m][4 + j]; }
                    if (fq < 2) { s0 = -s0; s1 = -s1; }
#pragma unroll
                    for (int bj = 0; bj < 2; ++bj) {
                        const f32x4 v0 = acc[ai][bj][m][0] * rstd[ai][m], v1 = acc[ai][bj][m][1] * rstd[ai][m]; f32x4 q0, q1;
#pragma unroll
                        for (int j = 0; j < 4; ++j) { q0[j] = partner32(v0[j], fq >> 1); q1[j] = partner32(v1[j], fq >> 1); }
                        acc[ai][bj][m][0] = v0 * c0 + q0 * s0; acc[ai][bj][m][1] = v1 * c1 + q1 * s1;
                    }
                }
            }
        }
        if (u.pn < 22) {
#pragma unroll
            for (int bj = 0; bj < 2; ++bj) {
                bf16_t* base = proj + (size_t)(2 * u.pn + bj) * S * HD + wc * 32 + 8 * fq;
#pragma unroll
                for (int ai = 0; ai < 2; ++ai)
#pragma unroll
                    for (int m = 0; m < 4; ++m) {
                        const float rs = rp ? 1.0f : rstd[ai][m];
                        const f32x4 v0 = acc[ai][bj][m][0] * rs, v1 = acc[ai][bj][m][1] * rs;
                        u32x4 w; w.x = pk2(v0[0], v0[1]); w.y = pk2(v0[2], v0[3]); w.z = pk2(v1[0], v1[1]); w.w = pk2(v1[2], v1[3]);
                        *(u32x4*)(base + (size_t)(row0 + ai * 128 + m * 16) * HD) = w;
                    }
            }
        } else {
            if (wc == 0 && fq < 3) {
                const f32x4 b0 = *(const f32x4*)(bg + 8 * fq), b1 = *(const f32x4*)(bg + 8 * fq + 4);
#pragma unroll
                for (int ai = 0; ai < 2; ++ai)
#pragma unroll
                    for (int m = 0; m < 4; ++m) {
                        f32x4 g0 = acc[ai][0][m][0] * rstd[ai][m] + b0, g1 = acc[ai][0][m][1] * rstd[ai][m] + b1;
#pragma unroll
                        for (int j = 0; j < 4; ++j) { g0[j] = sigmoidf_(g0[j]); g1[j] = sigmoidf_(g1[j]); }
                        f32x4* d = (f32x4*)(gates + (size_t)(row0 + ai * 128 + m * 16) * 24 + 8 * fq); d[0] = g0; d[1] = g1;
                    }
            }
        }
    }
};
struct EpiResid {
    static constexpr bool PERM = false, AFTER_DRAIN = false;
    const float* hin; float* hout;
    __device__ __forceinline__ void operator()(const pg8::f32x4 (&acc)[2][2][4][2], const pg8::Unit& u, int wr, int wc, int fr, int fq) const {
        const int row0 = u.pm * 256 + wr * 64 + fr, col0 = u.pn * 256 + wc * 32 + 4 * fq;
#pragma unroll
        for (int ai = 0; ai < 2; ++ai)
#pragma unroll
            for (int m = 0; m < 4; ++m) { const size_t off = (size_t)(row0 + ai * 128 + m * 16) * DM + col0;
#pragma unroll
                for (int bj = 0; bj < 2; ++bj)
#pragma unroll
                    for (int n = 0; n < 2; ++n) { const size_t o = off + bj * 128 + n * 16; *(f32x4*)(hout + o) = *(const f32x4*)(hin + o) + acc[ai][bj][m][n]; } }
    }
};
struct EpiFinal {
    static constexpr bool PERM = true, AFTER_DRAIN = true;
    const bf16_t* hb; float mult; float* out; const float* gain; float* xslab; unsigned* xcnt; unsigned target;
    __device__ __forceinline__ void fused(pg8::f32x4 (&acc)[2][2][4][2], const pg8::Unit& u, int wr, int wc, int fr, int fq, PG8_LAS unsigned char* lds, int wid, int lane) const {
        const int row0 = u.pm * 256 + wr * 64 + fr, col0 = u.pn * 256 + wc * 32 + 8 * fq;
        PG8_LAS float* P = (PG8_LAS float*)lds;
        PG8_LAS float* INV = (PG8_LAS float*)(lds + 8192);
#pragma unroll
        for (int ai = 0; ai < 2; ++ai) {
            bf16x8 hv[4][2];
#pragma unroll
            for (int m = 0; m < 4; ++m)
#pragma unroll
                for (int bj = 0; bj < 2; ++bj) hv[m][bj] = *(const bf16x8*)(hb + (size_t)(row0 + ai * 128 + m * 16) * DM + col0 + bj * 128);
#pragma unroll
            for (int m = 0; m < 4; ++m) { float ss = 0.f;
#pragma unroll
                for (int bj = 0; bj < 2; ++bj) { f32x4 v0 = acc[ai][bj][m][0] * mult, v1 = acc[ai][bj][m][1] * mult;
#pragma unroll
                    for (int e = 0; e < 4; ++e) { v0[e] += (float)hv[m][bj][e]; v1[e] += (float)hv[m][bj][4 + e]; }
                    acc[ai][bj][m][0] = v0; acc[ai][bj][m][1] = v1;
                    ss += ((v0.x * v0.x + v0.y * v0.y) + (v0.z * v0.z + v0.w * v0.w)) + ((v1.x * v1.x + v1.y * v1.y) + (v1.z * v1.z + v1.w * v1.w)); }
                ss += __builtin_bit_cast(float, __builtin_amdgcn_ds_swizzle(__builtin_bit_cast(int, ss), 0x401F)); ss += partner32(ss, fq >> 1);
                if (fq == 0) P[(ai * 128 + wr * 64 + m * 16 + fr) * 4 + wc] = ss;
                asm volatile("" ::: "memory"); } }
        asm volatile("s_waitcnt lgkmcnt(0)" ::: "memory"); __builtin_amdgcn_s_barrier(); asm volatile("" ::: "memory");
        const int t = wid * 64 + lane;
        if (t < 256) { const PG8_LAS float* q = P + t * 4; __hip_atomic_store(xslab + (size_t)(u.pm * 8 + u.pn) * 256 + t, (q[0] + q[1]) + (q[2] + q[3]), __ATOMIC_RELAXED, __HIP_MEMORY_SCOPE_AGENT); }
        asm volatile("s_waitcnt vmcnt(0)" ::: "memory");
        __syncthreads();
        if (t == 0) { (void)__hip_atomic_fetch_add(xcnt + 64 * u.pm, 1u, __ATOMIC_RELAXED, __HIP_MEMORY_SCOPE_AGENT);
            unsigned spins = 0; while (__hip_atomic_load(xcnt + 64 * u.pm, __ATOMIC_RELAXED, __HIP_MEMORY_SCOPE_AGENT) < target && ++spins < (1u << 22)) __builtin_amdgcn_s_sleep(1); }
        __syncthreads();
        if (t < 256) { float p8[8];
#pragma unroll
            for (int j = 0; j < 8; ++j) p8[j] = __hip_atomic_load(xslab + (size_t)(u.pm * 8 + j) * 256 + t, __ATOMIC_RELAXED, __HIP_MEMORY_SCOPE_AGENT);
            INV[t] = __builtin_amdgcn_rsqf((((p8[0] + p8[1]) + (p8[2] + p8[3])) + ((p8[4] + p8[5]) + (p8[6] + p8[7]))) * (1.0f / DM) + EPS); }
        asm volatile("s_waitcnt lgkmcnt(0)" ::: "memory"); __builtin_amdgcn_s_barrier(); asm volatile("" ::: "memory");
        f32x4 gn[2][2];
#pragma unroll
        for (int bj = 0; bj < 2; ++bj) { gn[bj][0] = *(const f32x4*)(gain + col0 + bj * 128); gn[bj][1] = *(const f32x4*)(gain + col0 + bj * 128 + 4); }
#pragma unroll
        for (int ai = 0; ai < 2; ++ai)
#pragma unroll
            for (int m = 0; m < 4; ++m) { const float rs = INV[ai * 128 + wr * 64 + m * 16 + fr]; float* orow = out + (size_t)(row0 + ai * 128 + m * 16) * DM + col0;
#pragma unroll
                for (int bj = 0; bj < 2; ++bj) { *(f32x4*)(orow + bj * 128) = acc[ai][bj][m][0] * rs * gn[bj][0]; *(f32x4*)(orow + bj * 128 + 4) = acc[ai][bj][m][1] * rs * gn[bj][1]; } }
    }
};
struct EpiResidH {
    static constexpr bool PERM = true, AFTER_DRAIN = true;
    bf16_t* hb; float* ssq; float mult;
    unsigned char* q8; float* qsc; float* xslab; unsigned* xcnt; unsigned target;
    __device__ __forceinline__ void fused(pg8::f32x4 (&acc)[2][2][4][2], const pg8::Unit& u, int wr, int wc, int fr, int fq, PG8_LAS unsigned char* lds, int wid, int lane) const {
        const int row0 = u.pm * 256 + wr * 64 + fr, col0 = u.pn * 256 + wc * 32 + 8 * fq;
        PG8_LAS float* P = (PG8_LAS float*)lds;
        PG8_LAS float* PM = (PG8_LAS float*)(lds + 4096);
        PG8_LAS float* INV = (PG8_LAS float*)(lds + 8192);
#pragma unroll
        for (int ai = 0; ai < 2; ++ai) {
            bf16x8 hv[4][2];
#pragma unroll
            for (int m = 0; m < 4; ++m)
#pragma unroll
                for (int bj = 0; bj < 2; ++bj) hv[m][bj] = *(const bf16x8*)(hb + (size_t)(row0 + ai * 128 + m * 16) * DM + col0 + bj * 128);
#pragma unroll
            for (int m = 0; m < 4; ++m) { const size_t off = (size_t)(row0 + ai * 128 + m * 16) * DM + col0; float ss = 0.f, am = 0.f;
#pragma unroll
                for (int bj = 0; bj < 2; ++bj) { f32x4 v0 = acc[ai][bj][m][0] * mult, v1 = acc[ai][bj][m][1] * mult;
#pragma unroll
                    for (int e = 0; e < 4; ++e) { v0[e] += (float)hv[m][bj][e]; v1[e] += (float)hv[m][bj][4 + e]; }
                    u32x4 w; w.x = pk2(v0.x, v0.y); w.y = pk2(v0.z, v0.w); w.z = pk2(v1.x, v1.y); w.w = pk2(v1.z, v1.w); *(u32x4*)(hb + off + bj * 128) = w;
                    acc[ai][bj][m][0] = v0; acc[ai][bj][m][1] = v1;
#pragma unroll
                    for (int e = 0; e < 4; ++e) am = fmaxf(am, fmaxf(fabsf(v0[e]), fabsf(v1[e])));
                    ss += ((v0.x * v0.x + v0.y * v0.y) + (v0.z * v0.z + v0.w * v0.w)) + ((v1.x * v1.x + v1.y * v1.y) + (v1.z * v1.z + v1.w * v1.w)); }
                ss += __builtin_bit_cast(float, __builtin_amdgcn_ds_swizzle(__builtin_bit_cast(int, ss), 0x401F)); ss += partner32(ss, fq >> 1);
                am = fmaxf(am, __builtin_bit_cast(float, __builtin_amdgcn_ds_swizzle(__builtin_bit_cast(int, am), 0x401F))); am = fmaxf(am, partner32(am, fq >> 1));
                if (fq == 0) { P[(ai * 128 + wr * 64 + m * 16 + fr) * 4 + wc] = ss; PM[(ai * 128 + wr * 64 + m * 16 + fr) * 4 + wc] = am; }
                asm volatile("" ::: "memory"); } }
        asm volatile("s_waitcnt lgkmcnt(0)" ::: "memory"); __builtin_amdgcn_s_barrier(); asm volatile("" ::: "memory");
        const int t = wid * 64 + lane;
        if (q8) {
            if (t < 256) { const PG8_LAS float* q = PM + t * 4; __hip_atomic_store(xslab + (size_t)(u.pm * 8 + u.pn) * 256 + t, fmaxf(fmaxf(q[0], q[1]), fmaxf(q[2], q[3])), __ATOMIC_RELAXED, __HIP_MEMORY_SCOPE_AGENT); }
            asm volatile("s_waitcnt vmcnt(0)" ::: "memory");
        }
        if (t < 256) { const PG8_LAS float* q = P + t * 4; ssq[(size_t)(u.pm * 256 + t) * 8 + u.pn] = (q[0] + q[1]) + (q[2] + q[3]); }
        if (q8) {
            __syncthreads();
            if (t == 0) { (void)__hip_atomic_fetch_add(xcnt + 64 * u.pm, 1u, __ATOMIC_RELAXED, __HIP_MEMORY_SCOPE_AGENT);
                unsigned spins = 0; while (__hip_atomic_load(xcnt + 64 * u.pm, __ATOMIC_RELAXED, __HIP_MEMORY_SCOPE_AGENT) < target && ++spins < (1u << 22)) __builtin_amdgcn_s_sleep(1); }
            __syncthreads();
            if (t < 256) { float pm8[8];
#pragma unroll
                for (int j = 0; j < 8; ++j) pm8[j] = __hip_atomic_load(xslab + (size_t)(u.pm * 8 + j) * 256 + t, __ATOMIC_RELAXED, __HIP_MEMORY_SCOPE_AGENT);
                const float mx = fmaxf(fmaxf(fmaxf(pm8[0], pm8[1]), fmaxf(pm8[2], pm8[3])), fmaxf(fmaxf(pm8[4], pm8[5]), fmaxf(pm8[6], pm8[7])));
                INV[t] = mx > 0.f ? 127.0f / mx : 0.f;
                if (u.pn == 0) qsc[u.pm * 256 + t] = mx * (1.0f / 127.0f); }
            asm volatile("s_waitcnt lgkmcnt(0)" ::: "memory"); __builtin_amdgcn_s_barrier(); asm volatile("" ::: "memory");
#pragma unroll
            for (int ai = 0; ai < 2; ++ai)
#pragma unroll
                for (int m = 0; m < 4; ++m) { const float inv = INV[ai * 128 + wr * 64 + m * 16 + fr]; const size_t off = (size_t)(row0 + ai * 128 + m * 16) * DM + col0;
#pragma unroll
                    for (int bj = 0; bj < 2; ++bj) { unsigned w[2];
#pragma unroll
                        for (int n = 0; n < 2; ++n) { const f32x4 v = acc[ai][bj][m][n]; unsigned uu = 0u;
#pragma unroll
                            for (int e = 0; e < 4; ++e) { int q = (int)__builtin_rintf(v[e] * inv); q = q > 127 ? 127 : (q < -127 ? -127 : q); uu |= ((unsigned)q & 0xFFu) << (8 * e); }
                            w[n] = uu; }
                        u32x2 o; o.x = w[0]; o.y = w[1]; *(u32x2*)(q8 + off + bj * 128) = o; } }
        }
    }
};

struct EpiSwiGLU {
    static constexpr bool PERM = true, AFTER_DRAIN = false;
    unsigned char* act; const LAS float* rtab; const LAS float* ctab;
    __device__ __forceinline__ void operator()(const pg8::f32x4 (&acc)[2][2][4][2], const pg8::Unit& u, int wr, int wc, int fr, int fq) const {
        const int row0 = u.pm * 256 + wr * 64 + fr, col0 = u.pn * 128 + wc * 32 + 8 * fq;
        const LAS f32x4* cs = (const LAS f32x4*)(ctab + u.ord * 256 + wc * 32 + 8 * fq);
        const f32x4 cg0 = cs[0], cg1 = cs[1], cu0 = cs[32], cu1 = cs[33];
#pragma unroll
        for (int ai = 0; ai < 2; ++ai)
#pragma unroll
            for (int m = 0; m < 4; ++m) {
                const float rs = rtab[u.ord * 256 + ai * 128 + wr * 64 + m * 16 + fr];
                f32x4 g0, g1, u0, u1;
                const pg8::i32x4 ig0 = __builtin_bit_cast(pg8::i32x4, acc[ai][0][m][0]), ig1 = __builtin_bit_cast(pg8::i32x4, acc[ai][0][m][1]);
                const pg8::i32x4 iu0 = __builtin_bit_cast(pg8::i32x4, acc[ai][1][m][0]), iu1 = __builtin_bit_cast(pg8::i32x4, acc[ai][1][m][1]);
#pragma unroll
                for (int j = 0; j < 4; ++j) {
                    g0[j] = (float)ig0[j] * (rs * cg0[j]); g1[j] = (float)ig1[j] * (rs * cg1[j]);
                    u0[j] = (float)iu0[j] * (rs * cu0[j]); u1[j] = (float)iu1[j] * (rs * cu1[j]); }
                f32x4 o0, o1;
#pragma unroll
                for (int j = 0; j < 4; ++j) { o0[j] = g0[j] * sigmoidf_(g0[j]) * u0[j]; o1[j] = g1[j] * sigmoidf_(g1[j]) * u1[j]; }
                int w0 = 0, w1 = 0;
                w0 = __builtin_amdgcn_cvt_pk_fp8_f32(o0[0] * A8_SCALE, o0[1] * A8_SCALE, w0, false); w0 = __builtin_amdgcn_cvt_pk_fp8_f32(o0[2] * A8_SCALE, o0[3] * A8_SCALE, w0, true);
                w1 = __builtin_amdgcn_cvt_pk_fp8_f32(o1[0] * A8_SCALE, o1[1] * A8_SCALE, w1, false); w1 = __builtin_amdgcn_cvt_pk_fp8_f32(o1[2] * A8_SCALE, o1[3] * A8_SCALE, w1, true);
                u32x2 w; w.x = (unsigned)w0; w.y = (unsigned)w1;
                *(u32x2*)(act + (size_t)(row0 + ai * 128 + m * 16) * DFF + col0) = w;
            }
    }
};

constexpr int CMPR_A_BYTES = 272 * 256 + 17 * 16, CMPR_HID = 70144;
__device__ __forceinline__ void phase_cmpr(const Params& p, const Ctx& c, int l) {
    const bf16_t* proj = (const bf16_t*)(p.ws + WS_PROJ); const float* rope = (const float*)(p.ws + WS_ROPE); const float* cbf = (const float*)(p.ws + WS_CBF);
    LAS bf16_t* hid = (LAS bf16_t*)(c.lds + CMPR_HID);
    const int lane = c.lane, w = c.wave, l15 = lane & 15, q4 = lane >> 4;
    const int u = c.bx >> 1, hh = c.bx & 1;
    const int kv = u >> 6, g = (u >> 5) & 1, rb = u & 31, n0 = 16 * rb;
    { bf16x8 sv[9];
      const bf16_t* src = proj + (size_t)((kv ? 10 : 8) + g) * S * HD;
#pragma unroll
      for (int i = 0; i < 9; ++i) { int ci = c.tid + NTHREADS * i; if (ci > 272 * 16 - 1) ci = 272 * 16 - 1; const int tk = ci >> 4, ch = ci & 15; int ta = 16 * n0 + tk; if (ta > S - 1) ta = S - 1;
          sv[i] = *(const bf16x8*)(src + (size_t)ta * HD + ch * 8); }
#pragma unroll
      for (int i = 0; i < 9; ++i) { const int ci = c.tid + NTHREADS * i; const int tk = ci >> 4, ch = ci & 15;
          if (ci < 272 * 16) *(LAS bf16x8*)(c.lds + tk * 256 + (tk >> 4) * 16 + ch * 16) = sv[i]; } }
    __syncthreads();
    const int ct = 8 * hh + w;
    const bf16_t* bf = w_ptr(p, l, W_C1) + (size_t)kv * 256 * 4096 + (size_t)ct * 128 * 512 + lane * 8;
    const LAS unsigned char* abase = c.lds + l15 * (4096 + 16) + q4 * 16;
    f32x4 acc = {0.f, 0.f, 0.f, 0.f};
    {
        bf16x8 B0[8], B1[8];
#define CMPR_LD(B_, ks_) do { _Pragma("unroll") for (int i = 0; i < 8; ++i) B_[i] = *(const bf16x8*)(bf + (size_t)((ks_) + i) * 512); } while (0)
#define CMPR_MM(B_, ks_) do { _Pragma("unroll") for (int i = 0; i < 8; ++i) { const int k_ = 32 * ((ks_) + i); \
            const bf16x8 a_ = *(const LAS bf16x8*)(abase + (k_ >> 7) * 256 + ((k_ >> 7) >= 16 ? 16 : 0) + (k_ & 127) * 2); \
            acc = __builtin_amdgcn_mfma_f32_16x16x32_f16(a_, B_[i], acc, 0, 0, 0); } } while (0)
        CMPR_LD(B0, 0);
        for (int ks = 0; ks < 128; ks += 16) {
            CMPR_LD(B1, ks + 8);
            CMPR_MM(B0, ks);
            if (ks + 16 < 128) CMPR_LD(B0, ks + 16);
            CMPR_MM(B1, ks + 8);
        }
#undef CMPR_LD
#undef CMPR_MM
    }
    { const int col = 16 * ct + l15; const float bs = cbf[(l * 2 + kv) * 256 + col];
#pragma unroll
      for (int j = 0; j < 4; ++j) hid[(q4 * 4 + j) * 136 + 16 * w + l15] = (bf16_t)f2bf(gelu_tanh(acc[j] + bs)); }
    __syncthreads();
    f32x4 o = {0.f, 0.f, 0.f, 0.f};
    const int ocol = (w < 2) ? ((l15 < 8) ? 8 * w + l15 : 16 + 8 * w + (l15 - 8)) : 16 * w + l15;
    const bf16_t* w2 = w_ptr(p, l, W_C2) + (size_t)kv * 128 * 256 + (size_t)ocol * 256 + 128 * hh + 8 * q4;
#pragma unroll
    for (int k0 = 0; k0 < 128; k0 += 32) {
        const bf16x8 a = *(const LAS bf16x8*)(hid + l15 * 136 + k0 + 8 * q4), b = *(const bf16x8*)(w2 + k0);
        o = __builtin_amdgcn_mfma_f32_16x16x32_f16(a, b, o, 0, 0, 0);
    }
    float* part = (float*)(p.ws + WS_CPART) + (size_t)u * 2048; unsigned* flag = (unsigned*)(p.ws + WS_CTL) + CW_CFLAG + 64 * u;
    if (hh == 1) {
#pragma unroll
        for (int j = 0; j < 4; ++j) __hip_atomic_store(part + (q4 * 4 + j) * 128 + 16 * w + l15, o[j], __ATOMIC_RELAXED, __HIP_MEMORY_SCOPE_AGENT);
        asm volatile("s_waitcnt vmcnt(0)" ::: "memory");
        __syncthreads();
        if (c.tid == 0) __hip_atomic_store(flag, (unsigned)(l + 1), __ATOMIC_RELAXED, __HIP_MEMORY_SCOPE_AGENT);
    } else {
        if (c.tid == 0) { unsigned spins = 0; while (__hip_atomic_load(flag, __ATOMIC_RELAXED, __HIP_MEMORY_SCOPE_AGENT) != (unsigned)(l + 1) && ++spins < (1u << 22)) __builtin_amdgcn_s_sleep(2); }
        __syncthreads();
        bf16_t* dst = (bf16_t*)(p.ws + (kv ? WS_VC : WS_KC)) + (size_t)g * 512 * HD;
        float pv[4], cs[4], sn[4];
#pragma unroll
        for (int j = 0; j < 4; ++j) { pv[j] = __hip_atomic_load(part + (q4 * 4 + j) * 128 + 16 * w + l15, __ATOMIC_RELAXED, __HIP_MEMORY_SCOPE_AGENT); cs[j] = 1.f; sn[j] = 0.f;
            if (kv == 0 && w < 2) { int ti = 16 * (n0 + q4 * 4 + j) + 31; if (ti > S - 1) ti = S - 1; const int fi = 8 * w + (l15 & 7); cs[j] = rope[ti * 32 + fi]; sn[j] = rope[ti * 32 + 16 + fi]; } }
#pragma unroll
        for (int j = 0; j < 4; ++j) {
            const int n = n0 + q4 * 4 + j; float v = o[j] + pv[j];
            if (kv == 0 && w < 2) { const float pr = DPP_F(0.f, v, 0x128, 0xf);     v = (l15 < 8) ? v * cs[j] - pr * sn[j] : v * cs[j] + pr * sn[j]; }
            if (n > 510) v = 0.f;
            dst[(size_t)n * HD + ocol] = (bf16_t)f2bf(v);
        }
    }
    __syncthreads();
}
typedef float f32x16 __attribute__((ext_vector_type(16)));
typedef _Float16 h4_t __attribute__((ext_vector_type(4)));
#define KSWZ(row, colB) ((row) * 256 + ((colB) ^ (((row) & 7) << 4)))
__device__ __forceinline__ int v_st(int k, int c) { const int kk = (k & ~0xC) | ((k & 4) << 1) | ((k & 8) >> 1); return ((kk >> 3) * 4 + (c >> 5)) * 512 + ((kk & 7) * 32 + (c & 31)) * 2; }
__device__ __forceinline__ int v_rd_base(int lane) { return ((lane & 3) << 3) | (((lane >> 2) & 3) << 6) | (((lane >> 4) & 1) << 5) | (((lane >> 5) & 1) << 8); }
constexpr int v_rd_off(int d0, int ks, int half) { return d0 * 512 + ks * 4096 + half * 2048; }
__device__ __forceinline__ int crow(int r, int hi) { return (r & 3) + 8 * (r >> 2) + 4 * hi; }
__device__ __forceinline__ void qkt(f32x16& p0, f32x16& p1, const LAS char* K_lds, int r32, int hi, const bf16x8* qr) {
#pragma unroll
    for (int r = 0; r < 16; ++r) { p0[r] = 0.f; p1[r] = 0.f; }
    int base = r32 * 256 + ((hi * 16) ^ ((r32 & 7) << 4));
    asm volatile("" : "+v"(base));
#pragma unroll
    for (int d0 = 0; d0 < 8; ++d0) { const LAS char* a = K_lds + (base ^ ((d0 & 3) << 5)) + (d0 >> 2) * 128;
        const bf16x8 b0 = *(const LAS bf16x8*)a, b1 = *(const LAS bf16x8*)(a + 32 * 256);
        p0 = __builtin_amdgcn_mfma_f32_32x32x16_f16(b0, qr[d0], p0, 0, 0, 0);
        p1 = __builtin_amdgcn_mfma_f32_32x32x16_f16(b1, qr[d0], p1, 0, 0, 0);
        if (d0 == 3) __builtin_amdgcn_sched_barrier(0); }
}
__device__ __forceinline__ void pack_p(const f32x16& p0, const f32x16& p1, bf16x8& pa0, bf16x8& pa1, bf16x8& pa2, bf16x8& pa3) {
#define PK4(P, B_, OUT) do { const unsigned a0 = pk2(P[B_ + 0], P[B_ + 1]), a1 = pk2(P[B_ + 2], P[B_ + 3]), b0 = pk2(P[B_ + 4], P[B_ + 5]), b1 = pk2(P[B_ + 6], P[B_ + 7]); \
        auto r0 = __builtin_amdgcn_permlane32_swap(a0, b0, false, false); auto r1 = __builtin_amdgcn_permlane32_swap(a1, b1, false, false); \
        u32x4 w = {r0[0], r1[0], r0[1], r1[1]}; OUT = __builtin_bit_cast(bf16x8, w); } while (0)
    PK4(p0, 0, pa0); PK4(p0, 8, pa1); PK4(p1, 0, pa2); PK4(p1, 8, pa3);
#undef PK4
}
__device__ __forceinline__ void pv_tile(f32x16* o, int vb0, bf16x8 pa0, bf16x8 pa1, bf16x8 pa2, bf16x8 pa3) {
#define TRRD(dst, off) asm volatile("ds_read_b64_tr_b16 %0, %1 offset:%2" : "=&v"(dst) : "v"(vb0), "i"(off) : "memory")
#define PV_D0(d0) do { h4_t l0, l1, l2, l3, h0, h1, h2, h3; constexpr int b_ = v_rd_off(d0, 0, 0); \
        TRRD(l0, b_); TRRD(h0, b_ + 2048); TRRD(l1, b_ + 4096); TRRD(h1, b_ + 6144); TRRD(l2, b_ + 8192); TRRD(h2, b_ + 10240); TRRD(l3, b_ + 12288); TRRD(h3, b_ + 14336); \
        asm volatile("s_waitcnt lgkmcnt(0)" ::: "memory"); __builtin_amdgcn_sched_barrier(0); \
        o[d0] = __builtin_amdgcn_mfma_f32_32x32x16_f16(pa0, (bf16x8){l0[0], l0[1], l0[2], l0[3], h0[0], h0[1], h0[2], h0[3]}, o[d0], 0, 0, 0); \
        o[d0] = __builtin_amdgcn_mfma_f32_32x32x16_f16(pa1, (bf16x8){l1[0], l1[1], l1[2], l1[3], h1[0], h1[1], h1[2], h1[3]}, o[d0], 0, 0, 0); \
        o[d0] = __builtin_amdgcn_mfma_f32_32x32x16_f16(pa2, (bf16x8){l2[0], l2[1], l2[2], l2[3], h2[0], h2[1], h2[2], h2[3]}, o[d0], 0, 0, 0); \
        o[d0] = __builtin_amdgcn_mfma_f32_32x32x16_f16(pa3, (bf16x8){l3[0], l3[1], l3[2], l3[3], h3[0], h3[1], h3[2], h3[3]}, o[d0], 0, 0, 0); } while (0)
    PV_D0(0); PV_D0(1); PV_D0(2); PV_D0(3);
#undef PV_D0
#undef TRRD
}

__device__ __forceinline__ void qkt_half(f32x16& ph, const LAS char* K_lds, int half, int r32, int hi, const bf16x8* qr) {
#pragma unroll
    for (int r = 0; r < 16; ++r) ph[r] = 0.f;
    int base = r32 * 256 + ((hi * 16) ^ ((r32 & 7) << 4)) + half * 8192;
    asm volatile("" : "+v"(base));
    __builtin_amdgcn_s_setprio(1);
#pragma unroll
    for (int d0 = 0; d0 < 8; ++d0) { const LAS char* a = K_lds + (base ^ ((d0 & 3) << 5)) + (d0 >> 2) * 128;
        const bf16x8 b0 = *(const LAS bf16x8*)a;
        ph = __builtin_amdgcn_mfma_f32_32x32x16_f16(b0, qr[d0], ph, 0, 0, 0); }
    __builtin_amdgcn_s_setprio(0);
}
__device__ __forceinline__ void pack_half(const f32x16& ph, bf16x8& pa0, bf16x8& pa1) {
#define PK4(P, B_, OUT) do { const unsigned a0 = pk2(P[B_ + 0], P[B_ + 1]), a1 = pk2(P[B_ + 2], P[B_ + 3]), b0 = pk2(P[B_ + 4], P[B_ + 5]), b1 = pk2(P[B_ + 6], P[B_ + 7]); \
        auto r0 = __builtin_amdgcn_permlane32_swap(a0, b0, false, false); auto r1 = __builtin_amdgcn_permlane32_swap(a1, b1, false, false); \
        u32x4 w = {r0[0], r1[0], r0[1], r1[1]}; OUT = __builtin_bit_cast(bf16x8, w); } while (0)
    PK4(ph, 0, pa0); PK4(ph, 8, pa1);
#undef PK4
}
__device__ __forceinline__ void pv_half(f32x16* o, int vbh, bf16x8 pa0, bf16x8 pa1) {
#define TRRD(dst, off) asm volatile("ds_read_b64_tr_b16 %0, %1 offset:%2" : "=&v"(dst) : "v"(vbh), "i"(off) : "memory")
    h4_t l0[4], h0[4], l1[4], h1[4];
#define PV_RD(d0) do { constexpr int b_ = v_rd_off(d0, 0, 0); TRRD(l0[d0], b_); TRRD(h0[d0], b_ + 2048); TRRD(l1[d0], b_ + 4096); TRRD(h1[d0], b_ + 6144); } while (0)
    PV_RD(0); PV_RD(1); PV_RD(2); PV_RD(3);
    asm volatile("s_waitcnt lgkmcnt(0)" ::: "memory"); __builtin_amdgcn_sched_barrier(0);
    __builtin_amdgcn_s_setprio(1);
#pragma unroll
    for (int d0 = 0; d0 < 4; ++d0) {
        o[d0] = __builtin_amdgcn_mfma_f32_32x32x16_f16(pa0, (bf16x8){l0[d0][0], l0[d0][1], l0[d0][2], l0[d0][3], h0[d0][0], h0[d0][1], h0[d0][2], h0[d0][3]}, o[d0], 0, 0, 0);
        o[d0] = __builtin_amdgcn_mfma_f32_32x32x16_f16(pa1, (bf16x8){l1[d0][0], l1[d0][1], l1[d0][2], l1[d0][3], h1[d0][0], h1[d0][1], h1[d0][2], h1[d0][3]}, o[d0], 0, 0, 0); }
    __builtin_amdgcn_s_setprio(0);
#undef PV_RD
#undef TRRD
}

__device__ __forceinline__ float wave_max_dpp(float v) {
    v = fmaxf(v, DPP_F(v, v, 0x111, 0xf)); v = fmaxf(v, DPP_F(v, v, 0x112, 0xf)); v = fmaxf(v, DPP_F(v, v, 0x114, 0xf)); v = fmaxf(v, DPP_F(v, v, 0x118, 0xf));
    v = fmaxf(v, DPP_F(v, v, 0x142, 0xa)); v = fmaxf(v, DPP_F(v, v, 0x143, 0xc));
    return __builtin_bit_cast(float, __builtin_amdgcn_readlane(__builtin_bit_cast(int, v), 63));
}
__device__ __forceinline__ float half_sum_dpp(float v, int hi) {
    v += DPP_F(0.f, v, 0x111, 0xf); v += DPP_F(0.f, v, 0x112, 0xf); v += DPP_F(0.f, v, 0x114, 0xf); v += DPP_F(0.f, v, 0x118, 0xf);
    v += DPP_F(0.f, v, 0x142, 0xa);
    const float lo = __builtin_bit_cast(float, __builtin_amdgcn_readlane(__builtin_bit_cast(int, v), 31)), hs = __builtin_bit_cast(float, __builtin_amdgcn_readlane(__builtin_bit_cast(int, v), 63));
    return hi ? hs : lo;
}

__device__ __forceinline__ float quad_swap1(float x) { return __int_as_float(__builtin_amdgcn_update_dpp(0, __float_as_int(x), 0xB1, 0xF, 0xF, true)); }
__device__ __forceinline__ void store_row4(bf16_t* orow_e  , float v0, float v1, float v2, float v3, int odd) {
    { const float y = quad_swap1(odd ? v0 : v1); *(unsigned*)(orow_e + (odd ? 32 : 0)) = odd ? pk2(y, v1) : pk2(v0, y); }
    { const float y = quad_swap1(odd ? v2 : v3); *(unsigned*)(orow_e + (odd ? 96 : 64)) = odd ? pk2(y, v3) : pk2(v2, y); }
}
__device__ __forceinline__ void store_head_rows(const f32x16* o, const float* ggrp_h, bf16_t* Obase  , int r32, int hi) {
    float gg[4];
#pragma unroll
    for (int d0 = 0; d0 < 4; ++d0) gg[d0] = ggrp_h[d0 * 32 + r32];
    const int odd = r32 & 1;
#pragma unroll
    for (int r = 0; r < 16; ++r) {
        const float ss = half_sum_dpp((o[0][r] * o[0][r] + o[1][r] * o[1][r]) + (o[2][r] * o[2][r] + o[3][r] * o[3][r]), hi);
        const float rs = __builtin_amdgcn_rsqf(ss * (1.0f / HD) + EPS);
        store_row4(Obase + (size_t)crow(r, hi) * DM + (r32 & ~1), o[0][r] * rs * gg[0], o[1][r] * rs * gg[1], o[2][r] * rs * gg[2], o[3][r] * rs * gg[3], odd);
    }
}

constexpr int NSA_SHIFT = 12;
typedef unsigned long long u64x2 __attribute__((ext_vector_type(2)));

enum { M_CSTAT = 0, M_CIMP = 1, M_SLC = 2, M_CPV = 3, M_WSTAT = 4, M_WPV = 5, M_SB = 6 };
constexpr int ATT_WS = 0, ATT_FLAGS = 2048, NSA_SEL = 2112, NSA_WUNI = 3136, ATT_V0 = 4096, ATT_K0 = ATT_V0 + 3 * 16384, NSA_P = ATT_V0  ;
constexpr int ATT_END = ATT_K0 + 4 * 16384;
constexpr int TNONE = 128;
static_assert(ATT_END <= MISC_OFF, "LDS map");
__device__ __forceinline__ int next_bit(unsigned m0, unsigned m1, unsigned m2, unsigned m3, int from) {
    if (from < 32) { const unsigned w = m0 & (~0u << from); if (w) return __builtin_ctz(w); from = 32; }
    if (from < 64) { const unsigned w = m1 & (~0u << (from - 32)); if (w) return 32 + __builtin_ctz(w); from = 64; }
    if (from < 96) { const unsigned w = m2 & (~0u << (from - 64)); if (w) return 64 + __builtin_ctz(w); from = 96; }
    if (from < 128) { const unsigned w = m3 & (~0u << (from - 96)); if (w) return 96 + __builtin_ctz(w); }
    return 128;
}
__device__ __forceinline__ unsigned bit_of(unsigned m0, unsigned m1, unsigned m2, unsigned m3, int j) { const unsigned w = j < 32 ? m0 : j < 64 ? m1 : j < 96 ? m2 : m3; return (w >> (j & 31)) & 1u; }
__device__ __forceinline__ float quad_sum(float x) {
    x += __builtin_bit_cast(float, __builtin_amdgcn_update_dpp(0, __builtin_bit_cast(int, x), 0xB1, 0xf, 0xf, true));
    x += __builtin_bit_cast(float, __builtin_amdgcn_update_dpp(0, __builtin_bit_cast(int, x), 0x4E, 0xf, 0xf, true));
    return x;
}
struct PassArgs {
    const bf16_t* Kp; const bf16_t* Vp;
    unsigned tm0, tm1, tm2, tm3;
    unsigned wm0, wm1, wm2, wm3;
    unsigned sw0, sw1, sw2, sw3;
    int tok, nvr, b, nvmin;
    int jtop, tw0;
    float f;
};
template <int MODE>
__device__ __forceinline__ void attn_pass(const Ctx& c, const bf16x8 (&qr)[8], f32x16 (&o)[4], float& m, float& l, const PassArgs& a) {
    constexpr bool SB = (MODE == M_SB);
    constexpr bool HASV = (MODE == M_SLC || MODE == M_CPV || MODE == M_WPV || SB);
    constexpr bool CMP = (MODE == M_CSTAT || MODE == M_CIMP || MODE == M_CPV);
    constexpr bool WIN = (MODE == M_WSTAT || MODE == M_WPV);
    constexpr int HA = SB ? 1 : 0, HB = SB ? 0 : 1;
    constexpr float C2 = SCALE * 1.4426950408889634f;
    const int lane = c.lane, w = c.wave, r32 = lane & 31, hi = lane >> 5;
    LAS char* V_lds = (LAS char*)c.lds + ATT_V0; LAS char* K_lds = (LAS char*)c.lds + ATT_K0;
    LAS float* wsf = (LAS float*)(c.lds + ATT_WS) + w * 64;
    volatile LAS unsigned* flags = (volatile LAS unsigned*)(c.lds + ATT_FLAGS);
    unsigned kg0, kg1, vg0, vg1;
    { const int A0 = 16 * (64 * w + lane), A1 = A0 + 8192;
      { const int row = A0 >> 8, cB = (A0 & 255) ^ ((row & 7) << 4); kg0 = (unsigned)(row * HD * 2 + cB); }
      { const int row = A1 >> 8, cB = (A1 & 255) ^ ((row & 7) << 4); kg1 = (unsigned)(row * HD * 2 + cB); }
      { const int st = A0 >> 9, wi = A0 & 511, kk = (st >> 2) * 8 + (wi >> 6), cc = (st & 3) * 32 + ((wi & 63) >> 1), k = (kk & ~0xC) | ((kk & 4) << 1) | ((kk & 8) >> 1); vg0 = (unsigned)((k * HD + cc) * 2); }
      { const int st = A1 >> 9, wi = A1 & 511, kk = (st >> 2) * 8 + (wi >> 6), cc = (st & 3) * 32 + ((wi & 63) >> 1), k = (kk & ~0xC) | ((kk & 4) << 1) | ((kk & 8) >> 1); vg1 = (unsigned)((k * HD + cc) * 2); } }
    const int vb0 = (int)(unsigned)(size_t)V_lds + v_rd_base(lane);
    const float NEG = -__builtin_inff();
    bool done = false;
#define AP_NEXT(j_) (SB ? ((j_) > 0 ? (j_) - 1 : TNONE) : next_bit(a.tm0, a.tm1, a.tm2, a.tm3, (j_) + 1))
#define AP_ACT(j_) (SB ? (!done && 64 * (j_) <= a.tw0 + 30) : (bit_of(a.wm0, a.wm1, a.wm2, a.wm3, (j_)) != 0u))
#define AP_DMAK(j_, buf) do { const bf16_t* g_ = a.Kp + (size_t)(64 * (j_)) * HD; \
        __builtin_amdgcn_global_load_lds((const unsigned*)((const char*)g_ + kg0), (LAS unsigned*)(K_lds + (buf) * 16384 + w * 1024), 16, 0, 0); \
        __builtin_amdgcn_global_load_lds((const unsigned*)((const char*)g_ + kg1), (LAS unsigned*)(K_lds + (buf) * 16384 + 8192 + w * 1024), 16, 0, 0); } while (0)
#define AP_DMAV(j_, buf) do { if (HASV) { const bf16_t* g_ = a.Vp + (size_t)(64 * (j_)) * HD; \
        __builtin_amdgcn_global_load_lds((const unsigned*)((const char*)g_ + vg0), (LAS unsigned*)(V_lds + (buf) * 16384 + w * 1024), 16, 0, 0); \
        __builtin_amdgcn_global_load_lds((const unsigned*)((const char*)g_ + vg1), (LAS unsigned*)(V_lds + (buf) * 16384 + 8192 + w * 1024), 16, 0, 0); } } while (0)
#define AP_WAITN(full) do { if (full) { if (HASV) asm volatile("s_waitcnt vmcnt(4)" ::: "memory"); else asm volatile("s_waitcnt vmcnt(2)" ::: "memory"); } \
                            else asm volatile("s_waitcnt vmcnt(0)" ::: "memory"); } while (0)
    int j0 = SB ? a.jtop : next_bit(a.tm0, a.tm1, a.tm2, a.tm3, 0);
    if (j0 >= TNONE) return;
    int j1 = AP_NEXT(j0), j2 = j1 < TNONE ? AP_NEXT(j1) : TNONE, j3 = j2 < TNONE ? AP_NEXT(j2) : TNONE;
    int kc = 0, vc = 0;
    f32x16 pX, pY;
    bf16x8 kf[4];
    float carry = 0.f;
    __syncthreads();
    AP_DMAK(j0, 0); AP_DMAV(j0, 0);
    if (j1 < TNONE) AP_DMAK(j1, 1);
    bool full = j2 < TNONE;
    if (j2 < TNONE) AP_DMAK(j2, 2);
    if (j1 < TNONE) AP_DMAV(j1, 1);
    AP_WAITN(full); __syncthreads();
    if (AP_ACT(j0)) qkt_half(pX, K_lds, HA, r32, hi, qr);
#define AP_SB_EL(P, HF, r) do { const float y = P[r] * C2; \
                const float sp = fmaxf(y, 0.f) + __builtin_amdgcn_logf(1.0f + __builtin_amdgcn_exp2f(-fabsf(y))); \
                float Lr = -sp, br = y - sp; \
                if (needmask) { const bool ok = (dq - 32 * (HF) - (((r) & 3) + 8 * ((r) >> 2))) >= 0; Lr = ok ? Lr : 0.f; br = ok ? br : NEG; } \
                Lv[r] = Lr; P[r] = br; } while (0)
#define AP_KADDR(KT, QH, d_) ((KT) + (kb_ ^ (((d_) & 3) << 5)) + ((d_) >> 2) * 128)
#define AP_QMFMA(PN, c_, KT, QH) do { if ((c_) == 0) { f32x16 z_; _Pragma("unroll") for (int q_ = 0; q_ < 16; ++q_) z_[q_] = 0.f; PN = __builtin_amdgcn_mfma_f32_32x32x16_f16(kf[0], qr[0], z_, 0, 0, 0); } \
        else PN = __builtin_amdgcn_mfma_f32_32x32x16_f16(kf[(c_) & 3], qr[c_], PN, 0, 0, 0); \
        if ((c_) + 4 < 8) kf[(c_) & 3] = *(const LAS bf16x8*)AP_KADDR(KT, QH, (c_) + 4);        \
        __builtin_amdgcn_sched_barrier(0); } while (0)
#define AP_QPIN(KT, QH) int kb_ = r32 * 256 + ((hi * 16) ^ ((r32 & 7) << 4)) + (QH) * 8192; asm volatile("" : "+v"(kb_)); \
        _Pragma("unroll") for (int d_ = 0; d_ < 4; ++d_) kf[d_] = *(const LAS bf16x8*)AP_KADDR(KT, QH, d_); \
        __builtin_amdgcn_sched_barrier(0)
#define AP_PROCH(P, J, HF, VB, DOQ, PN, KT, QH) do { \
        if (SB) { \
            const int key0 = 64 * (J); const bool needmask = key0 + 63 >= a.tw0; const int dq = a.tok - 1 - key0 - 4 * hi; float run = carry; \
            float Lv[16]; \
            if (DOQ) { AP_QPIN(KT, QH); _Pragma("unroll") for (int c_ = 0; c_ < 8; ++c_) { AP_SB_EL(P, HF, 2 * c_); AP_SB_EL(P, HF, 2 * c_ + 1); AP_QMFMA(PN, c_, KT, QH); } } \
            else { _Pragma("unroll") for (int r = 0; r < 16; ++r) AP_SB_EL(P, HF, r); } \
            float g[4], pg[4]; \
            _Pragma("unroll") for (int i = 0; i < 4; ++i) { g[i] = (Lv[4 * i] + Lv[4 * i + 1]) + (Lv[4 * i + 2] + Lv[4 * i + 3]); pg[i] = partner32(g[i], hi); } \
            _Pragma("unroll") for (int i = 3; i >= 0; --i) { float aft = run + (hi ? 0.f : pg[i]); run += g[i] + pg[i]; \
                P[4 * i + 3] = __builtin_amdgcn_exp2f(P[4 * i + 3] + aft); aft += Lv[4 * i + 3]; \
                P[4 * i + 2] = __builtin_amdgcn_exp2f(P[4 * i + 2] + aft); aft += Lv[4 * i + 2]; \
                P[4 * i + 1] = __builtin_amdgcn_exp2f(P[4 * i + 1] + aft); aft += Lv[4 * i + 1]; \
                P[4 * i + 0] = __builtin_amdgcn_exp2f(P[4 * i + 0] + aft); } \
            carry = run; \
            bf16x8 pa0, pa1; pack_half(P, pa0, pa1); pv_half(o, vb0 + (VB) * 16384 + (HF) * 8192, pa0, pa1); \
            if ((HF) == HB) done = __all(carry <= -151.0f); \
        } else { \
            if (CMP) { if (64 * (J) + 32 * (HF) + 32 > a.nvmin) { const int dq = a.nvr - 1 - 64 * (J) - 32 * (HF) - 4 * hi;     \
                _Pragma("unroll") for (int r = 0; r < 16; ++r) { const int cr = (r & 3) + 8 * (r >> 2); if (dq - cr < 0) P[r] = NEG; } } } \
            if (WIN) { if ((J) == a.b || (J) == a.b - 8) { const int dq = a.tok - 64 * (J) - 32 * (HF) - 4 * hi; \
                _Pragma("unroll") for (int r = 0; r < 16; ++r) { const int cr = (r & 3) + 8 * (r >> 2); if ((unsigned)(dq - cr) >= 512u) P[r] = NEG; } } } \
            if (MODE == M_SLC) { if ((J) == a.b) { const int dq = a.tok - 64 * (J) - 32 * (HF) - 4 * hi; \
                _Pragma("unroll") for (int r = 0; r < 16; ++r) { const int cr = (r & 3) + 8 * (r >> 2); if (dq - cr < 0) P[r] = NEG; } } } \
            if (MODE == M_CSTAT || MODE == M_WSTAT || MODE == M_SLC) { \
                float pmax = P[0]; \
                _Pragma("unroll") for (int r = 1; r < 16; ++r) pmax = fmaxf(pmax, P[r]); \
                bool selr = true; \
                if (MODE == M_SLC) { selr = bit_of(a.sw0, a.sw1, a.sw2, a.sw3, (J)) != 0u; pmax = selr ? pmax : NEG; } \
                pmax = fmaxf(pmax, partner32(pmax, hi)); \
                  \
                const bool keep = (MODE == M_SLC) && __all((pmax - m) * C2 <= 8.0f); \
                const float mn = keep ? m : fmaxf(m, pmax); \
                const float alpha = keep ? 1.0f : __builtin_amdgcn_exp2f((m - mn) * C2); \
                m = mn; \
                const float mnL = selr ? -mn * C2 : NEG; \
                float ps = 0.f; \
                if (DOQ) { AP_QPIN(KT, QH); _Pragma("unroll") for (int c_ = 0; c_ < 8; ++c_) { \
                        P[2 * c_] = __builtin_amdgcn_exp2f(fmaf(P[2 * c_], C2, mnL)); P[2 * c_ + 1] = __builtin_amdgcn_exp2f(fmaf(P[2 * c_ + 1], C2, mnL)); ps += P[2 * c_] + P[2 * c_ + 1]; AP_QMFMA(PN, c_, KT, QH); } } \
                else { _Pragma("unroll") for (int r = 0; r < 16; ++r) { P[r] = __builtin_amdgcn_exp2f(fmaf(P[r], C2, mnL)); ps += P[r]; } } \
                ps += partner32(ps, hi); \
                l = l * alpha + ps; \
                if (MODE == M_SLC) { \
                    if (!keep && __any(alpha < 1.f)) { \
                        if (hi == 0) wsf[r32] = alpha; \
                        asm volatile("s_waitcnt lgkmcnt(0)" ::: "memory"); \
                        _Pragma("unroll") for (int r = 0; r < 16; ++r) { const float al = wsf[crow(r, hi)]; \
                            _Pragma("unroll") for (int d0 = 0; d0 < 4; ++d0) o[d0][r] *= al; } \
                    } \
                    bf16x8 pa0, pa1; pack_half(P, pa0, pa1); pv_half(o, vb0 + (VB) * 16384 + (HF) * 8192, pa0, pa1); \
                } \
            } else { \
                const float mL = -m * C2; \
                if (DOQ) { AP_QPIN(KT, QH); _Pragma("unroll") for (int c_ = 0; c_ < 8; ++c_) { \
                        P[2 * c_] = __builtin_amdgcn_exp2f(fmaf(P[2 * c_], C2, mL)) * a.f; P[2 * c_ + 1] = __builtin_amdgcn_exp2f(fmaf(P[2 * c_ + 1], C2, mL)) * a.f; AP_QMFMA(PN, c_, KT, QH); } } \
                else { _Pragma("unroll") for (int r = 0; r < 16; ++r) P[r] = __builtin_amdgcn_exp2f(fmaf(P[r], C2, mL)) * a.f; } \
                if (MODE == M_CIMP) { \
                      \
                    LAS float* PT = (LAS float*)(c.lds + NSA_P) + (8 * w + (r32 >> 2)) * 128; \
                    float s3v[4], av[4]; \
                    _Pragma("unroll") for (int i = 0; i < 4; ++i) { \
                        const float s0 = quad_sum(P[4 * i]), s1 = quad_sum(P[4 * i + 1]), s2 = quad_sum(P[4 * i + 2]); s3v[i] = quad_sum(P[4 * i + 3]); \
                        av[i] = 2.f * ((s0 + s1) + s2) + s3v[i]; } \
                    float ps3[4]; \
                    _Pragma("unroll") for (int i = 0; i < 4; ++i) ps3[i] = partner32(s3v[i], hi); \
                    _Pragma("unroll") for (int i = 0; i < 4; ++i) { \
                        const int Jb = 16 * (J) + 8 * (HF) + 2 * i + hi; \
                        const float prev = hi ? ps3[i] : (i == 0 ? carry : ps3[i > 0 ? i - 1 : 0]); \
                        if ((r32 & 3) == 0) PT[Jb] = av[i] + prev; } \
                    carry = ps3[3];      \
                } else { bf16x8 pa0, pa1; pack_half(P, pa0, pa1); pv_half(o, vb0 + (VB) * 16384 + (HF) * 8192, pa0, pa1); } \
            } \
        } } while (0)
    for (;;) {
        if (SB) { if (lane == 0) flags[w] = done ? 1u : 0u; }
        AP_WAITN(full); __syncthreads();
        if (SB) { unsigned all = 1u;
#pragma unroll
            for (int i = 0; i < NWAVES; ++i) all &= flags[i];
            if (all) break; }
        full = j3 < TNONE;
        if (j3 < TNONE) AP_DMAK(j3, (kc + 3) & 3);
        if (j2 < TNONE) AP_DMAV(j2, vc == 0 ? 2 : vc - 1);
        const bool act0 = AP_ACT(j0);
        const bool actq = (j1 < TNONE) && AP_ACT(j1);
        if (act0) AP_PROCH(pX, j0, HA, vc, true, pY, K_lds + kc * 16384, HB);
        if (actq) qkt_half(pX, K_lds + ((kc + 1) & 3) * 16384, HA, r32, hi, qr);
        if (act0) AP_PROCH(pY, j0, HB, vc, false, pX, K_lds, HA);
        if (j1 >= TNONE) break;
        j0 = j1; j1 = j2; j2 = j3; j3 = j3 < TNONE ? AP_NEXT(j3) : TNONE;
        kc = (kc + 1) & 3; vc = vc == 2 ? 0 : vc + 1;
    }
    asm volatile("s_waitcnt vmcnt(0)" ::: "memory");
#undef AP_PROCH
#undef AP_QMFMA
#undef AP_QPIN
#undef AP_KADDR
#undef AP_SB_EL
#undef AP_NEXT
#undef AP_ACT
#undef AP_DMAK
#undef AP_DMAV
#undef AP_WAITN
}

__device__ __forceinline__ void sb_unit(const Params& p, const Ctx& c, int l, int h, int qb) {
    const bf16_t* proj = (const bf16_t*)(p.ws + WS_PROJ);
    const bf16_t* Q = proj + (size_t)(20 + h) * S * HD;
    int lane_; asm volatile("v_mbcnt_lo_u32_b32 %0, -1, 0\n\tv_mbcnt_hi_u32_b32 %0, -1, %0" : "=v"(lane_));
    const int lane = lane_, w = c.wave, r32 = lane & 31, hi = lane >> 5;
    const int t0 = 256 * qb, tw0 = t0 + 32 * w, tq = tw0 + r32;
    bf16x8 qr[8];
#pragma unroll
    for (int d0 = 0; d0 < 8; ++d0) qr[d0] = *(const bf16x8*)(Q + (size_t)tq * HD + d0 * 16 + hi * 8);
    f32x16 o[4];
#pragma unroll
    for (int d0 = 0; d0 < 4; ++d0)
#pragma unroll
        for (int r = 0; r < 16; ++r) o[d0][r] = 0.f;
    PassArgs a{}; a.Kp = proj + (size_t)(28 + h) * S * HD; a.Vp = proj + (size_t)(36 + h) * S * HD; a.tok = tq; a.jtop = (t0 + 254) >> 6; a.tw0 = tw0;
    float m = 0.f, lsum = 0.f;
    attn_pass<M_SB>(c, qr, o, m, lsum, a);
    store_head_rows(o, p.in[10] + (size_t)l * DM + (8 + h) * HD, (bf16_t*)(p.ws + WS_O) + (size_t)tw0 * DM + (8 + h) * HD, r32, hi);
}

template <int role>
__device__ __forceinline__ void nsa_unit(const Params& p, const Ctx& c, int l, int g, int b) {
    const bf16_t* proj = (const bf16_t*)(p.ws + WS_PROJ);
    const bf16_t* kc = (const bf16_t*)(p.ws + WS_KC) + (size_t)g * 512 * HD; const bf16_t* vc = (const bf16_t*)(p.ws + WS_VC) + (size_t)g * 512 * HD;
    const float* gates = (const float*)(p.ws + WS_GATES);
    const int lane = c.lane, w = c.wave, r32 = lane & 31, hi = lane >> 5;
    const int t0 = 64 * b, tl = 8 * w + (r32 >> 2), tok = t0 + tl, H = 4 * g + (r32 & 3);
    bf16x8 qr[8];
#pragma unroll
    for (int d0 = 0; d0 < 8; ++d0) qr[d0] = *(const bf16x8*)(proj + (size_t)H * S * HD + (size_t)tok * HD + d0 * 16 + hi * 8);
    const float g0 = gates[(size_t)tok * 24 + H], g1 = gates[(size_t)tok * 24 + 8 + H], g2 = gates[(size_t)tok * 24 + 16 + H];
    f32x16 o[4];
    __syncthreads();
    { LAS f32x4* za = (LAS f32x4*)(c.lds + NSA_P);
      for (int i = c.tid; i < 32768 / 16; i += NTHREADS) za[i] = (f32x4){0.f, 0.f, 0.f, 0.f}; }
    PassArgs a{}; a.tok = tok; a.b = b;
    a.nvr = tok >= 31 ? (tok - 31) / 16 + 1 : 0; if (a.nvr > NCMP) a.nvr = NCMP;
    { const int tmin = t0 + 8 * w; a.nvmin = tmin >= 31 ? (tmin - 31) / 16 + 1 : 0; if (a.nvmin > NCMP) a.nvmin = NCMP; }
    int nvmax = (t0 + 63 - 31) / 16 + 1; if (nvmax > NCMP) nvmax = NCMP;
    const unsigned cm0 = (1u << ((nvmax + 63) >> 6)) - 1u;
    float mc = -1e30f, lc = 0.f;
    a.Kp = kc; a.Vp = vc; a.tm0 = cm0; a.wm0 = cm0;
    attn_pass<M_CSTAT>(c, qr, o, mc, lc, a);
    const float ilc = lc > 0.f ? 1.0f / lc : 0.f;
    a.f = ilc;
    attn_pass<M_CIMP>(c, qr, o, mc, lc, a);
    __syncthreads();
    { const LAS float* PTb = (const LAS float*)(c.lds + NSA_P);
      LAS unsigned* selw = (LAS unsigned*)(c.lds + NSA_SEL); LAS unsigned* wuni = (LAS unsigned*)(c.lds + NSA_WUNI);
      unsigned long long u0 = 0ull, u1 = 0ull;
      for (int tt = 0; tt < 8; ++tt) {
          const int tk = 8 * w + tt; const int j0 = lane, j1 = lane + 64;
          const float a0 = PTb[tk * 128 + j0], a1 = PTb[tk * 128 + j1];
          const bool f0 = (j0 == 0) || (j0 == b) || (j0 == b - 1), f1 = (j1 == b) || (j1 == b - 1);
          bool sel0 = f0 && j0 <= b, sel1 = f1 && j1 <= b;
          float c0 = (!f0 && j0 >= 1 && j0 <= b - 2) ? a0 : -1.f, c1 = (!f1 && j1 <= b - 2) ? a1 : -1.f;
          const int ncand = b - 2 > 0 ? b - 2 : 0, ksel = 16 - (b >= 2 ? 3 : b + 1);
          if (ncand <= ksel) { if (c0 >= 0.f) sel0 = true; if (c1 >= 0.f) sel1 = true; }
          else { for (int it = 0; it < ksel; ++it) {
                     const float mx = wave_max_dpp(fmaxf(c0, c1));
                     const unsigned long long b0 = __ballot(c0 == mx);
                     if (b0) { const int first = __ffsll((long long)b0) - 1; if (lane == first) { c0 = -1.f; sel0 = true; } }
                     else { const unsigned long long b1 = __ballot(c1 == mx); const int first = __ffsll((long long)b1) - 1; if (lane == first) { c1 = -1.f; sel1 = true; } } } }
          const unsigned long long m0 = __ballot(sel0), m1 = __ballot(sel1);
          u0 |= m0; u1 |= m1;
          if (lane == 0) { selw[tk * 4 + 0] = (unsigned)m0; selw[tk * 4 + 1] = (unsigned)(m0 >> 32); selw[tk * 4 + 2] = (unsigned)m1; selw[tk * 4 + 3] = (unsigned)(m1 >> 32); }
      }
      if (lane == 0) { wuni[w * 4 + 0] = (unsigned)u0; wuni[w * 4 + 1] = (unsigned)(u0 >> 32); wuni[w * 4 + 2] = (unsigned)u1; wuni[w * 4 + 3] = (unsigned)(u1 >> 32); }
      __syncthreads();
      unsigned gu0 = 0u, gu1 = 0u, gu2 = 0u, gu3 = 0u;
#pragma unroll
      for (int i = 0; i < NWAVES; ++i) { gu0 |= wuni[i * 4 + 0]; gu1 |= wuni[i * 4 + 1]; gu2 |= wuni[i * 4 + 2]; gu3 |= wuni[i * 4 + 3]; }
      a.tm0 = __builtin_amdgcn_readfirstlane(gu0); a.tm1 = __builtin_amdgcn_readfirstlane(gu1); a.tm2 = __builtin_amdgcn_readfirstlane(gu2); a.tm3 = __builtin_amdgcn_readfirstlane(gu3);
      a.wm0 = (unsigned)u0; a.wm1 = (unsigned)(u0 >> 32); a.wm2 = (unsigned)u1; a.wm3 = (unsigned)(u1 >> 32);
      a.sw0 = selw[tl * 4 + 0]; a.sw1 = selw[tl * 4 + 1]; a.sw2 = selw[tl * 4 + 2]; a.sw3 = selw[tl * 4 + 3];
      if (role != 0) {
          const int n = b - 63 > NSA_SHIFT + 1 ? b - 63 - NSA_SHIFT : 1;     const unsigned lo0 = n >= 32 ? ~0u : ((1u << n) - 1u), lo1 = n >= 64 ? ~0u : (n > 32 ? ((1u << (n - 32)) - 1u) : 0u);
          if (role == 2) { a.tm0 &= lo0; a.tm1 &= lo1; a.tm2 = 0u; a.tm3 = 0u; a.wm0 &= lo0; a.wm1 &= lo1; a.wm2 = 0u; a.wm3 = 0u; }
          else { a.tm0 &= ~lo0; a.tm1 &= ~lo1; a.wm0 &= ~lo0; a.wm1 &= ~lo1; } }
    }
#pragma unroll
    for (int d0 = 0; d0 < 4; ++d0)
#pragma unroll
        for (int r = 0; r < 16; ++r) o[d0][r] = 0.f;
    { float ms = -1e30f, ls = 0.f;
      a.Kp = proj + (size_t)(12 + g) * S * HD; a.Vp = proj + (size_t)(14 + g) * S * HD;
      attn_pass<M_SLC>(c, qr, o, ms, ls, a);
      LAS float* wsf = (LAS float*)(c.lds + ATT_WS) + w * 64;
      constexpr float C2 = SCALE * 1.4426950408889634f;
      if (role != 0) {
          int lane_; asm volatile("v_mbcnt_lo_u32_b32 %0, -1, 0\n\tv_mbcnt_hi_u32_b32 %0, -1, %0" : "=v"(lane_));
          const int lane = lane_, r32 = lane & 31, hi = lane >> 5;
          float* part = (float*)(p.ws + WS_PART + (size_t)(g * 64 + (b - 64)) * PART_SLOT); float* pml = part + 32768 + w * 64;
          unsigned* flag = (unsigned*)(p.ws + WS_CTL) + CW_NSAFLAG + 64 * (g * 64 + (b - 64));
          if (role == 2) {
#pragma unroll
              for (int r = 0; r < 16; ++r) { const f32x4 v_ = (f32x4){o[0][r], o[1][r], o[2][r], o[3][r]}; float* dp_ = part + (size_t)(w * 16 + r) * 256 + lane * 4;
                  asm volatile("global_store_dwordx4 %0, %1, off sc1\n\ts_nop 1" :: "v"(dp_), "v"(v_) : "memory"); }
              if (hi == 0) { __hip_atomic_store(pml + r32, ms, __ATOMIC_RELAXED, __HIP_MEMORY_SCOPE_AGENT); __hip_atomic_store(pml + 32 + r32, ls, __ATOMIC_RELAXED, __HIP_MEMORY_SCOPE_AGENT); }
              asm volatile("s_waitcnt vmcnt(0)" ::: "memory");
              __syncthreads();
              if (c.tid == 0) __hip_atomic_store(flag, (unsigned)(l + 1), __ATOMIC_RELAXED, __HIP_MEMORY_SCOPE_AGENT);
              return;
          }
          if (c.tid == 0) { unsigned spins = 0; while (__hip_atomic_load(flag, __ATOMIC_RELAXED, __HIP_MEMORY_SCOPE_AGENT) != (unsigned)(l + 1) && ++spins < (1u << 22)) __builtin_amdgcn_s_sleep(4); }
          __syncthreads();
          const float m1 = __hip_atomic_load(pml + r32, __ATOMIC_RELAXED, __HIP_MEMORY_SCOPE_AGENT), l1 = __hip_atomic_load(pml + 32 + r32, __ATOMIC_RELAXED, __HIP_MEMORY_SCOPE_AGENT);
          f32x4 qa[4];
#define NSA_LDROW(i_, r_) do { unsigned long long* qp_ = (unsigned long long*)(part + (size_t)(w * 16 + (r_)) * 256 + lane * 4); u64x2 t_; \
              t_.x = __hip_atomic_load(qp_, __ATOMIC_RELAXED, __HIP_MEMORY_SCOPE_AGENT); t_.y = __hip_atomic_load(qp_ + 1, __ATOMIC_RELAXED, __HIP_MEMORY_SCOPE_AGENT); qa[i_] = __builtin_bit_cast(f32x4, t_); } while (0)
#pragma unroll
          for (int i = 0; i < 4; ++i) NSA_LDROW(i, i);
          const float mm = fmaxf(m1, ms), f1 = __builtin_amdgcn_exp2f((m1 - mm) * C2), f2 = __builtin_amdgcn_exp2f((ms - mm) * C2);
          ls = l1 * f1 + ls * f2;
          if (hi == 0) { wsf[r32] = f1; wsf[32 + r32] = f2; }
          asm volatile("s_waitcnt lgkmcnt(0)" ::: "memory");
#pragma unroll
          for (int hb = 0; hb < 4; ++hb) {
#pragma unroll
              for (int i = 0; i < 4; ++i) { const int r = hb * 4 + i; const float a1 = wsf[crow(r, hi)], a2 = wsf[32 + crow(r, hi)];
#pragma unroll
                  for (int d0 = 0; d0 < 4; ++d0) o[d0][r] = qa[i][d0] * a1 + o[d0][r] * a2; }
              asm volatile("" : "+v"(o[0][4 * hb]), "+v"(o[1][4 * hb]), "+v"(o[2][4 * hb]), "+v"(o[3][4 * hb]), "+v"(o[0][4 * hb + 1]), "+v"(o[1][4 * hb + 1]), "+v"(o[2][4 * hb + 1]), "+v"(o[3][4 * hb + 1]),
                               "+v"(o[0][4 * hb + 2]), "+v"(o[1][4 * hb + 2]), "+v"(o[2][4 * hb + 2]), "+v"(o[3][4 * hb + 2]), "+v"(o[0][4 * hb + 3]), "+v"(o[1][4 * hb + 3]), "+v"(o[2][4 * hb + 3]), "+v"(o[3][4 * hb + 3]) :: "memory");
              if (hb < 3) {
#pragma unroll
                  for (int i = 0; i < 4; ++i) NSA_LDROW(i, 4 * (hb + 1) + i); }
          }
          asm volatile("s_waitcnt lgkmcnt(0)" ::: "memory");
      }
      if (hi == 0) wsf[r32] = g1 / ls;
      asm volatile("s_waitcnt lgkmcnt(0)" ::: "memory");
#pragma unroll
      for (int r = 0; r < 16; ++r) { const float al = wsf[crow(r, hi)];
#pragma unroll
          for (int d0 = 0; d0 < 4; ++d0) o[d0][r] *= al; } }
    a.Kp = kc; a.Vp = vc; a.tm0 = cm0; a.tm1 = a.tm2 = a.tm3 = 0u; a.wm0 = cm0; a.wm1 = a.wm2 = a.wm3 = 0u; a.f = g0 * ilc;
    attn_pass<M_CPV>(c, qr, o, mc, lc, a);
    { unsigned wt0 = 0u, wt1 = 0u, wt2 = 0u, wt3 = 0u;
      for (int j = (b - 8 > 0 ? b - 8 : 0); j <= b; ++j) { const unsigned bit = 1u << (j & 31); if (j < 32) wt0 |= bit; else if (j < 64) wt1 |= bit; else if (j < 96) wt2 |= bit; else wt3 |= bit; }
      float mw = -1e30f, lw = 0.f;
      a.Kp = proj + (size_t)(16 + g) * S * HD; a.Vp = proj + (size_t)(18 + g) * S * HD;
      a.tm0 = wt0; a.tm1 = wt1; a.tm2 = wt2; a.tm3 = wt3; a.wm0 = wt0; a.wm1 = wt1; a.wm2 = wt2; a.wm3 = wt3; a.f = 0.f;
      attn_pass<M_WSTAT>(c, qr, o, mw, lw, a);
      a.f = g2 / lw;
      attn_pass<M_WPV>(c, qr, o, mw, lw, a); }
    { const float* ggrp = p.in[10] + (size_t)l * DM; bf16_t* O = (bf16_t*)(p.ws + WS_O);
      int lane_; asm volatile("v_mbcnt_lo_u32_b32 %0, -1, 0\n\tv_mbcnt_hi_u32_b32 %0, -1, %0" : "=v"(lane_));
      const int r32 = lane_ & 31, hi = lane_ >> 5, odd = lane_ & 1;
      float gg[4][4];
#pragma unroll
      for (int hh = 0; hh < 4; ++hh)
#pragma unroll
          for (int d0 = 0; d0 < 4; ++d0) gg[hh][d0] = ggrp[(4 * g + hh) * HD + d0 * 32 + r32];
#pragma unroll
      for (int r = 0; r < 16; ++r) {
          const float ss = half_sum_dpp((o[0][r] * o[0][r] + o[1][r] * o[1][r]) + (o[2][r] * o[2][r] + o[3][r] * o[3][r]), hi);
          const float rs = __builtin_amdgcn_rsqf(ss * (1.0f / HD) + EPS);
          const int rr = crow(r, hi), Hh = 4 * g + (r & 3); const int tk = t0 + 8 * w + (rr >> 2);
          store_row4(O + (size_t)tk * DM + Hh * HD + (r32 & ~1), o[0][r] * rs * gg[r & 3][0], o[1][r] * rs * gg[r & 3][1], o[2][r] * rs * gg[r & 3][2], o[3][r] * rs * gg[r & 3][3], odd);
      } }
}
__device__ __forceinline__ void phase_nsa(const Params& p, const Ctx& c, int l) {
    const int u0 = c.bx, g = u0 & 1, rk = u0 >> 1;
    if (rk < 64) { nsa_unit<2>(p, c, l, g, 127 - rk); nsa_unit<0>(p, c, l, g, rk); }
    else nsa_unit<1>(p, c, l, g, rk);
    __syncthreads();
}
__device__ __forceinline__ void phase_cmpr_sb(const Params& p, const Ctx& c, int l) {
    phase_cmpr(p, c, l);
    sb_unit(p, c, l, c.bx & 7, 31 - (c.bx >> 3));
    __syncthreads();
}
__device__ __forceinline__ Ctx make_ctx(unsigned char* lds, int wave) {
    Ctx c; c.lds = (LAS unsigned char*)lds; int ln_; asm volatile("v_mbcnt_lo_u32_b32 %0, -1, 0\n\tv_mbcnt_hi_u32_b32 %0, -1, %0" : "=v"(ln_));
    int wv_ = wave; asm volatile("" : "+s"(wv_));
    c.lane = ln_; c.wave = wv_; c.tid = wv_ * 64 + ln_;
    int bx_ = blockIdx.x; asm volatile("" : "+s"(bx_)); c.bx = bx_;
    c.gw = bx_ * NWAVES + c.wave; c.ngw = gridDim.x * NWAVES; return c;
}
#define AS4 __attribute__((address_space(4)))
__device__ __forceinline__ Params load_params() {
    unsigned long long v = (unsigned long long)(const AS4 void*)__builtin_amdgcn_kernarg_segment_ptr();
    asm volatile("" : "+s"(v));
    const AS4 Params* q = (const AS4 Params*)v; Params r;
#pragma unroll
    for (int i = 0; i < 17; ++i) r.in[i] = q->in[i];
    r.out = q->out; r.ws = q->ws; return r;
}
constexpr int CW_BAR = 4096;
#ifndef MEGA
#define MEGA 1
#endif
__global__ void __launch_bounds__(NTHREADS, 2) k_mega(Params p_arg) {
    extern __shared__ __attribute__((aligned(16))) unsigned char lds_raw[];
#define PCTX const Ctx c = make_ctx(lds_raw, wave0); const Params p = load_params()
    const int wave0 = __builtin_amdgcn_readfirstlane((int)threadIdx.x >> 6);
    volatile LAS unsigned* misc = (volatile LAS unsigned*)((LAS unsigned char*)lds_raw + MISC_OFF);
    if (threadIdx.x < 8) misc[threadIdx.x] = 0u;
    __syncthreads();
    { const Params p = load_params(); (void)xcd_barrier_post((unsigned*)(p.ws + WS_CTL) + CW_BAR, misc, threadIdx.x == 0); }
#define GBAR() do { const Params p = load_params(); XcdBarrier b_; b_.bar = (unsigned*)(p.ws + WS_CTL) + CW_BAR; b_.x = xb_xcc_id(); b_.st = misc; { int ln__; asm volatile("v_mbcnt_lo_u32_b32 %0, -1, 0\n\tv_mbcnt_hi_u32_b32 %0, -1, %0" : "=v"(ln__)); b_.leader = (wave0 == 0) && (ln__ == 0); } xcd_barrier(b_); } while (0)
    { PCTX; phase_conv(p, c); }
    GBAR();
    for (int l = 0; l < NL; ++l) {
        { PCTX; if (l == 0) cbias_reduce(p, c);
          pg8::Gemm g{(const bf16_t*)(p.ws + WS_XN8), (const bf16_t*)(p.ws + WS_WI8 + (size_t)l * 12 * MiB), S, DINP, DM / 2}; pg8::StaticOrder so; so.init(S, DINP, gridDim.x, c.bx);
          EpiProj E{(bf16_t*)(p.ws + WS_PROJ), (float*)(p.ws + WS_GATES), (const bf16_t*)(p.ws + WS_ROPEH), p.in[4] + 24 * l, (const LAS float*)(c.lds + RSTD_OFF), (const LAS float*)(c.lds + CSC_OFF)};
          pg8::gemm_phase<EpiProj, pg8::StaticOrder, true, true, PrepRstd, 2>(c.lds, g, so, E, c.tid, PrepRstd{c, so, (const float*)(p.ws + WS_SSQ), (const float*)(p.ws + WS_ASC), (const float*)(p.ws + WS_WISC) + l * DINP});
          { const int G_ = (int)gridDim.x, nfull = ((S / 256) * (DINP / 256)) % G_;
            if (nfull > 0) { if (c.bx >= nfull) { __syncthreads(); conv_items(p, c, l * I_LAYER + (c.bx - nfull) * NWAVES + c.wave, l * I_LAYER + I_OUT, (G_ - nfull) * NWAVES); } }
            else { __syncthreads(); conv_items(p, c, l * I_LAYER + c.gw, l * I_LAYER + I_OUT, c.ngw); } }
        }
        GBAR();
        { PCTX; phase_cmpr_sb(p, c, l); }
        GBAR();
        { PCTX; phase_nsa(p, c, l); }
        GBAR();
        { PCTX; pg8::Gemm g{(const bf16_t*)(p.ws + WS_O), w_ptr(p, l, W_OUT), S, DM, DM}; pg8::StaticOrder so; so.init(S, DM, gridDim.x, c.bx);
          EpiResidH E{(bf16_t*)(p.ws + WS_XN), (float*)(p.ws + WS_SSQ), 1.0f, p.ws + WS_XN8, (float*)(p.ws + WS_ASC), (float*)(p.ws + WS_XSLAB), (unsigned*)(p.ws + WS_CTL) + CW_XCNT, 8u * (unsigned)(2 * l + 1)};
          pg8::gemm_phase<EpiResidH, pg8::StaticOrder, false, true>(c.lds, g, so, E, c.tid); }
        GBAR();
        { PCTX; pg8::Gemm g{(const bf16_t*)(p.ws + WS_XN8), (const bf16_t*)(p.ws + WS_W8 + (size_t)l * 22 * MiB), S, 2 * DFF, DM / 2}; pg8::StaticOrder so; so.init(S, 2 * DFF, gridDim.x, c.bx);
          EpiSwiGLU E{p.ws + WS_ACT, (const LAS float*)(c.lds + RSTD_OFF), (const LAS float*)(c.lds + CSC_OFF)};
          pg8::gemm_phase<EpiSwiGLU, pg8::StaticOrder, true, true, PrepRstd, 2>(c.lds, g, so, E, c.tid, PrepRstd{c, so, (const float*)(p.ws + WS_SSQ), (const float*)(p.ws + WS_ASC), (const float*)(p.ws + WS_WSC) + l * 2 * DFF});
          { const int G_ = (int)gridDim.x, nfull = ((S / 256) * (2 * DFF / 256)) % G_;
            const bool some = nfull > 0; const int w0 = some ? (c.bx - nfull) * NWAVES + c.wave : c.gw, nw = some ? (G_ - nfull) * NWAVES : c.ngw;
            if (!some || c.bx >= nfull) { __syncthreads();
                const int a0 = l * I_LAYER + I_OUT, nA = a0 + I_DN;
                conv_items(p, c, a0 + w0, nA + (l + 1 < NL ? I_C1 + I_C2 : 0), nw, nA, (l + 1) * I_LAYER + I_OUT + I_DN); } }
        }
        GBAR();
        if (l + 1 < NL) {
          { PCTX; pg8::Gemm g{(const bf16_t*)(p.ws + WS_ACT), w_ptr(p, l, W_DN), S, DM, DFF / 2}; pg8::StaticOrder so; so.init(S, DM, gridDim.x, c.bx);
            EpiResidH E{(bf16_t*)(p.ws + WS_XN), (float*)(p.ws + WS_SSQ), 1.0f / (A8_SCALE * W8_SCALE), p.ws + WS_XN8, (float*)(p.ws + WS_ASC), (float*)(p.ws + WS_XSLAB), (unsigned*)(p.ws + WS_CTL) + CW_XCNT, 8u * (unsigned)(2 * l + 2)};
            pg8::gemm_phase<EpiResidH, pg8::StaticOrder, false, true, pg8::NoPre, 1>(c.lds, g, so, E, c.tid); }
          GBAR();
        } else {
          PCTX; pg8::Gemm g{(const bf16_t*)(p.ws + WS_ACT), w_ptr(p, l, W_DN), S, DM, DFF / 2}; pg8::StaticOrder so; so.init(S, DM, gridDim.x, c.bx);
          EpiFinal E{(const bf16_t*)(p.ws + WS_XN), 1.0f / (A8_SCALE * W8_SCALE), (float*)p.out, p.in[16], (float*)(p.ws + WS_XSLAB), (unsigned*)(p.ws + WS_CTL) + CW_XCNT, 8u * (unsigned)(2 * l + 2)};
          pg8::gemm_phase<EpiFinal, pg8::StaticOrder, false, true, pg8::NoPre, 1>(c.lds, g, so, E, c.tid);
        }
    }
}

extern "C" void kernel_launch(void* const* d_in, const int* in_sizes, int n_in, void* d_out, int out_size, void* d_ws, size_t ws_size, hipStream_t stream) {
    static int grid = 0;
    if (grid == 0) {
        if (n_in != 17 || out_size != S * DM || ws_size < WS_END) { fprintf(stderr, "kernel_launch: unexpected shapes (n_in %d, out %d, ws %zu)\n", n_in, out_size, ws_size); grid = -1; return; }
        int dev = 0, cus = 0; (void)hipGetDevice(&dev); (void)hipDeviceGetAttribute(&cus, hipDeviceAttributeMultiprocessorCount, dev); if (cus <= 0) cus = 256;
#if MEGA
        if (hipFuncSetAttribute((const void*)k_mega, hipFuncAttributeMaxDynamicSharedMemorySize, LDS_BYTES) != hipSuccess) { fprintf(stderr, "kernel_launch: hipFuncSetAttribute failed\n"); grid = -1; return; }
        int per_cu = 0;
        if (hipOccupancyMaxActiveBlocksPerMultiprocessor(&per_cu, (const void*)k_mega, NTHREADS, LDS_BYTES) != hipSuccess || per_cu < 1) { fprintf(stderr, "kernel_launch: occupancy query says %d\n", per_cu); per_cu = 1; }
        (void)hipGetLastError();
        if (cus < 256) fprintf(stderr, "kernel_launch: this kernel's static unit schedules need 256 resident workgroups; the device reports %d CUs\n", cus);
        grid = 256;
#endif
    }
    if (grid < 0) return;
    Params p{};
    for (int i = 0; i < 17; ++i) p.in[i] = (const float*)d_in[i];
    p.out = (float*)d_out; p.ws = (unsigned char*)d_ws;
    const dim3 G(grid), B(NTHREADS);
#if MEGA
    (void)hipMemsetAsync((unsigned char*)d_ws + WS_CTL, 0, CTL_ZERO_BYTES, stream);
    hipLaunchKernelGGL(k_mega, G, B, LDS_BYTES, stream, p);
#endif
}
```
